# Optimizing an MI355X kernel written in HIP

```python
import math
import jax, jax.numpy as jnp
from jax import lax
import numpy as np

D_MODEL = 1024
BATCH = 8
SEQ = 4096
DEPTH = 4

CTX_LEN = 256
GRID_W = 64
MIX_WIDTH = D_MODEL
ATTN_WIDTH = MIX_WIDTH // 2
SSM_WIDTH = MIX_WIDTH - ATTN_WIDTH
DA_HEADS = 4
DA_HEAD_DIM = ATTN_WIDTH // (2 * DA_HEADS)
QK_WIDTH = DA_HEADS * DA_HEAD_DIM
PROJ_SIZES = (QK_WIDTH, QK_WIDTH, QK_WIDTH, QK_WIDTH, ATTN_WIDTH, SSM_WIDTH)
PROJ_WIDTH = 4 * QK_WIDTH + ATTN_WIDTH + SSM_WIDTH
SSM_GROUP = 16
SSM_GROUPS = SSM_WIDTH // SSM_GROUP
SSM_STATE = 64
DT_MIN = 1e-3
DT_MAX = 1e-1
N_EXPERTS = 16
EC_CAPACITY = 2
D_FF_EXPERT = 2 * D_MODEL
ROPE_BASE = 10000.0
Q_BLOCK = 128
EPS = 1e-6

kernel_name = 'hybrid_s5_diffattn_ecmoe_dit'


def rms_norm(x, g):
    xf = x.astype(jnp.float32)
    y = xf * lax.rsqrt(jnp.mean(xf * xf, axis=-1, keepdims=True) + EPS)
    return (y * g.astype(jnp.float32)).astype(x.dtype)


def modulate(h, shift, scale):
    return h * (1 + scale) + shift


def split_columns(z, sizes):
    offsets = [int(o) for o in np.cumsum(sizes)[:-1]]
    return jnp.split(z, offsets, axis=-1)


def to_heads(z, n_heads=DA_HEADS):
    b_, n, _ = z.shape
    return z.reshape(b_, n, n_heads, -1).transpose(0, 2, 1, 3)


def from_heads(z):
    b_, h_, n, dh = z.shape
    return z.transpose(0, 2, 1, 3).reshape(b_, n, h_ * dh)


def axial_rope_tables(rows):
    row = jnp.repeat(jnp.arange(rows, dtype=jnp.float32), GRID_W)
    col = jnp.tile(jnp.arange(GRID_W, dtype=jnp.float32), rows)
    half = DA_HEAD_DIM // 2
    inv_freq = ROPE_BASE ** (-jnp.arange(0, half, 2, dtype=jnp.float32) / half)
    ang_r = row[:, None] * inv_freq
    ang_c = col[:, None] * inv_freq
    return (jnp.cos(ang_r), jnp.sin(ang_r), jnp.cos(ang_c), jnp.sin(ang_c))


def rope_1d(t, cos, sin):
    t1, t2 = jnp.split(t, 2, axis=-1)
    return jnp.concatenate([t1 * cos - t2 * sin, t2 * cos + t1 * sin], axis=-1)


def apply_axial_rope(t, tables):
    cos_r, sin_r, cos_c, sin_c = [a.astype(t.dtype) for a in tables]
    t_row, t_col = jnp.split(t, 2, axis=-1)
    return jnp.concatenate([rope_1d(t_row, cos_r, sin_r), rope_1d(t_col, cos_c, sin_c)], axis=-1)


def latent_heads_rotated(z, tables):
    return apply_axial_rope(to_heads(z), tables)


def diff_attention(q1, q2, k1, k2, v, lam):
    b_, h_, n_q, dh = q1.shape
    n_blk = n_q // Q_BLOCK
    scale = dh ** -0.5

    def one_block(qs):
        qb1, qb2 = qs
        p1 = jax.nn.softmax(jnp.einsum('bhqd,bhkd->bhqk', qb1, k1).astype(jnp.float32) * scale, axis=-1)
        p2 = jax.nn.softmax(jnp.einsum('bhqd,bhkd->bhqk', qb2, k2).astype(jnp.float32) * scale, axis=-1)
        return jnp.einsum('bhqk,bhkv->bhqv', (p1 - lam * p2).astype(v.dtype), v)

    def blocks(t):
        return t.reshape(b_, h_, n_blk, Q_BLOCK, dh).transpose(2, 0, 1, 3, 4)

    out = lax.map(one_block, (blocks(q1), blocks(q2)))
    return out.transpose(1, 2, 0, 3, 4).reshape(b_, h_, n_q, -1)


def diff_attn_group(q1, q2, k1, k2, v, lam, lam_init, subln_g):
    o = diff_attention(q1, q2, k1, k2, v, lam)
    o = rms_norm(o, subln_g) * (1.0 - lam_init)
    return from_heads(o)


def s5_discretise(lam_re, lam_im, log_dt, b_re, b_im):
    lam = lax.complex(lam_re.astype(jnp.float32), lam_im.astype(jnp.float32))
    dt = jnp.exp(log_dt.astype(jnp.float32))[..., None]
    lam_bar = jnp.exp(lam * dt)
    b = lax.complex(b_re.astype(jnp.float32), b_im.astype(jnp.float32))
    b_bar = ((lam_bar - 1.0) / lam)[..., None] * b
    return lam_bar, b_bar


def linear_recurrence_combine(left, right):
    a1, b1 = left
    a2, b2 = right
    return a1 * a2, a2 * b1 + b2


def s5_scan(lam_bar, b_bar, ug, h0, reverse):
    bu = jnp.einsum('gph,blgh->lbgp', b_bar, ug)
    if h0 is not None:
        edge = -1 if reverse else 0
        bu = bu.at[edge].add(lam_bar * h0)
    a = jnp.broadcast_to(lam_bar, (bu.shape[0], 1) + lam_bar.shape)
    _, states = lax.associative_scan(linear_recurrence_combine, (a, bu), reverse=reverse, axis=0)
    return states


def s5_states(u, lam_bar, b_bar, h0_f, h0_b):
    b_, n, _ = u.shape
    ug = u.astype(jnp.float32).reshape(b_, n, SSM_GROUPS, SSM_GROUP).astype(jnp.complex64)
    st_f = s5_scan(lam_bar[0], b_bar[0], ug, h0_f, reverse=False)
    st_b = s5_scan(lam_bar[1], b_bar[1], ug, h0_b, reverse=True)
    return st_f, st_b


def s5_output(u, st_f, st_b, c_re, c_im, d_skip):
    b_, n, _ = u.shape
    c = lax.complex(c_re.astype(jnp.float32), c_im.astype(jnp.float32))
    y = (jnp.real(jnp.einsum('ghp,lbgp->blgh', c[0], st_f))
         + jnp.real(jnp.einsum('ghp,lbgp->blgh', c[1], st_b))).reshape(b_, n, SSM_WIDTH)
    return (y + d_skip.astype(jnp.float32) * u.astype(jnp.float32)).astype(u.dtype)


def s5_glu(y, w_glu, b_glu):
    y = jax.nn.gelu(y)
    return y * jax.nn.sigmoid(y @ w_glu + b_glu)


def expert_choice_ffn(h, w_router, w1, w3, w2):
    b_, n, d = h.shape
    cap = EC_CAPACITY * n // N_EXPERTS
    aff = jax.nn.softmax(jnp.einsum('bnd,de->bne', h, w_router).astype(jnp.float32), axis=-1)
    gate, idx = lax.top_k(jnp.swapaxes(aff, 1, 2), cap)
    x_in = jax.vmap(lambda hb, ib: hb[ib])(h, idx)
    hid = jax.nn.silu(jnp.einsum('becd,edf->becf', x_in, w1)) * jnp.einsum('becd,edf->becf', x_in, w3)
    out = jnp.einsum('becf,efd->becd', hid, w2) * gate[..., None].astype(h.dtype)

    def scatter(ib, ob):
        return jnp.zeros((n, d), ob.dtype).at[ib.reshape(-1)].add(ob.reshape(-1, d))

    return jax.vmap(scatter)(idx, out)


def setup_inputs(seed: int = 0) -> dict:
    key = jax.random.key(seed)
    keys = iter(jax.random.split(key, 40))

    def nrm(shape, std):
        return jax.random.normal(next(keys), shape, jnp.float32) * std

    G, P, H = SSM_GROUPS, SSM_STATE, SSM_GROUP
    return {
        'x': nrm((BATCH, SEQ, D_MODEL), 1.0),
        'c': nrm((BATCH, D_MODEL), 1.0),
        'ctx': nrm((BATCH, CTX_LEN, D_MODEL), 1.0),
        'c_ctx': nrm((D_MODEL,), 1.0),
        'w_ada': nrm((DEPTH, D_MODEL, 6 * D_MODEL), 0.5 * D_MODEL ** -0.5),
        'b_ada': nrm((DEPTH, 6 * D_MODEL), 0.01),
        'norm1_g': 1.0 + nrm((DEPTH, D_MODEL), 0.01),
        'norm2_g': 1.0 + nrm((DEPTH, D_MODEL), 0.01),
        'w_in': nrm((DEPTH, D_MODEL, PROJ_WIDTH), D_MODEL ** -0.5),
        'lam_q1': nrm((DEPTH, DA_HEAD_DIM), 0.1),
        'lam_k1': nrm((DEPTH, DA_HEAD_DIM), 0.1),
        'lam_q2': nrm((DEPTH, DA_HEAD_DIM), 0.1),
        'lam_k2': nrm((DEPTH, DA_HEAD_DIM), 0.1),
        'subln_g': 1.0 + nrm((DEPTH, 2 * DA_HEAD_DIM), 0.01),
        'ssm_lam_re': -0.5 + nrm((DEPTH, 2, G, P), 0.01),
        'ssm_lam_im': jnp.pi * jnp.arange(P, dtype=jnp.float32) + nrm((DEPTH, 2, G, P), 0.01),
        'ssm_log_dt': jax.random.uniform(next(keys), (DEPTH, 2, G), jnp.float32,
                                         math.log(DT_MIN), math.log(DT_MAX)),
        'ssm_b_re': nrm((DEPTH, 2, G, P, H), (2 * H) ** -0.5),
        'ssm_b_im': nrm((DEPTH, 2, G, P, H), (2 * H) ** -0.5),
        'ssm_c_re': nrm((DEPTH, 2, G, H, P), 0.5),
        'ssm_c_im': nrm((DEPTH, 2, G, H, P), 0.5),
        'ssm_d': nrm((DEPTH, SSM_WIDTH), 0.5),
        'w_glu': nrm((DEPTH, SSM_WIDTH, SSM_WIDTH), SSM_WIDTH ** -0.5),
        'b_glu': nrm((DEPTH, SSM_WIDTH), 0.01),
        'w_out': nrm((DEPTH, MIX_WIDTH, D_MODEL), MIX_WIDTH ** -0.5),
        'w_router': nrm((DEPTH, D_MODEL, N_EXPERTS), D_MODEL ** -0.5),
        'w1': nrm((DEPTH, N_EXPERTS, D_MODEL, D_FF_EXPERT), D_MODEL ** -0.5),
        'w3': nrm((DEPTH, N_EXPERTS, D_MODEL, D_FF_EXPERT), D_MODEL ** -0.5),
        'w2': nrm((DEPTH, N_EXPERTS, D_FF_EXPERT, D_MODEL), D_FF_EXPERT ** -0.5),
        'final_g': 1.0 + nrm((D_MODEL,), 0.01),
    }


def reference(x, c, ctx, c_ctx, w_ada, b_ada, norm1_g, norm2_g, w_in, lam_q1, lam_k1, lam_q2, lam_k2,
              subln_g, ssm_lam_re, ssm_lam_im, ssm_log_dt, ssm_b_re, ssm_b_im, ssm_c_re, ssm_c_im, ssm_d,
              w_glu, b_glu, w_out, w_router, w1, w3, w2, final_g):
    n_lat = x.shape[1]
    ROWS = n_lat // GRID_W
    rope_tables = axial_rope_tables(ROWS)
    silu_c = jax.nn.silu(c)
    silu_cc = jax.nn.silu(c_ctx)

    for l in range(DEPTH):
        last = l == DEPTH - 1
        lam_init = 0.8 - 0.6 * math.exp(-0.3 * l)
        lam = (jnp.exp(jnp.sum(lam_q1[l].astype(jnp.float32) * lam_k1[l].astype(jnp.float32)))
               - jnp.exp(jnp.sum(lam_q2[l].astype(jnp.float32) * lam_k2[l].astype(jnp.float32)))
               + lam_init)
        sh1_x, sc1_x, g1_x, sh2_x, sc2_x, g2_x = [
            m[:, None, :] for m in jnp.split(silu_c @ w_ada[l] + b_ada[l], 6, axis=-1)]
        sh1_c, sc1_c, g1_c, sh2_c, sc2_c, g2_c = jnp.split(silu_cc @ w_ada[l] + b_ada[l], 6, axis=-1)
        lam_bar, b_bar = s5_discretise(ssm_lam_re[l], ssm_lam_im[l], ssm_log_dt[l], ssm_b_re[l], ssm_b_im[l])

        hc = modulate(rms_norm(ctx, norm1_g[l]), sh1_c, sc1_c)
        if last:
            k1c, k2c, vc, uc = split_columns(hc @ w_in[l][:, 2 * QK_WIDTH:], PROJ_SIZES[2:])
        else:
            q1c, q2c, k1c, k2c, vc, uc = split_columns(hc @ w_in[l], PROJ_SIZES)
        k1c, k2c, vc = to_heads(k1c), to_heads(k2c), to_heads(vc)
        st_fc, st_bc = s5_states(uc, lam_bar, b_bar, None, None)

        hx = modulate(rms_norm(x, norm1_g[l]), sh1_x, sc1_x)
        q1x, q2x, k1x, k2x, vx, ux = split_columns(hx @ w_in[l], PROJ_SIZES)
        k1 = jnp.concatenate([k1c, latent_heads_rotated(k1x, rope_tables)], axis=2)
        k2 = jnp.concatenate([k2c, latent_heads_rotated(k2x, rope_tables)], axis=2)
        v = jnp.concatenate([vc, to_heads(vx)], axis=2)
        attn_x = diff_attn_group(latent_heads_rotated(q1x, rope_tables), latent_heads_rotated(q2x, rope_tables),
                                 k1, k2, v, lam, lam_init, subln_g[l])
        st_fx, st_bx = s5_states(ux, lam_bar, b_bar, st_fc[-1], st_bc[0])
        ssm_x = s5_glu(s5_output(ux, st_fx, st_bx, ssm_c_re[l], ssm_c_im[l], ssm_d[l]), w_glu[l], b_glu[l])
        x_mid = x + g1_x * (jnp.concatenate([attn_x, ssm_x], axis=-1) @ w_out[l])
        x = x_mid + g2_x * expert_choice_ffn(modulate(rms_norm(x_mid, norm2_g[l]), sh2_x, sc2_x),
                                             w_router[l], w1[l], w3[l], w2[l])

        if not last:
            attn_c = diff_attn_group(to_heads(q1c), to_heads(q2c), k1c, k2c, vc, lam, lam_init, subln_g[l])
            ssm_c = s5_glu(s5_output(uc, st_fc, st_bc, ssm_c_re[l], ssm_c_im[l], ssm_d[l]), w_glu[l], b_glu[l])
            ctx_mid = ctx + g1_c * (jnp.concatenate([attn_c, ssm_c], axis=-1) @ w_out[l])
            ctx = ctx_mid + g2_c * expert_choice_ffn(modulate(rms_norm(ctx_mid, norm2_g[l]), sh2_c, sc2_c),
                                                     w_router[l], w1[l], w3[l], w2[l])

    return rms_norm(x, final_g)
```

```cpp
#include <hip/hip_runtime.h>
#include <cstdio>
#include <cstdint>
#include <cmath>

#define DEVI __device__ __forceinline__
#define LAS __attribute__((address_space(3)))

typedef unsigned short bf16_t;
typedef short bf16x8 __attribute__((ext_vector_type(8)));
typedef float f32x2 __attribute__((ext_vector_type(2)));
typedef float f32x4 __attribute__((ext_vector_type(4)));
typedef float f32x16 __attribute__((ext_vector_type(16)));
typedef unsigned u32x2 __attribute__((ext_vector_type(2)));
typedef unsigned u32x4 __attribute__((ext_vector_type(4)));
typedef __bf16 bf16x2_t __attribute__((ext_vector_type(2)));

constexpr int NB = 8, SEQ = 4096, CTXL = 256, DM = 1024, DEPTH = 4;
constexpr int LP = CTXL + SEQ;
constexpr int R = NB * LP;
constexpr int NCHB = LP / 16;
constexpr int NCH = NB * NCHB;
constexpr int NE = 16, CAPL = 512, CAPC = 32, ROWS_BE = CAPL + CAPC  , ROWS_E = NB * ROWS_BE  , FF = 2048;
constexpr int NH = 4;
constexpr float EPS = 1e-6f;
constexpr float QSCALE = 0.125f * 1.4426950408889634f;

constexpr size_t al256(size_t x) { return (x + 255) & ~(size_t)255; }
constexpr size_t WS_CTL = 0, CTL_BYTES = 65536;
constexpr size_t WS_MOD = WS_CTL + CTL_BYTES;
constexpr size_t WS_ROPE = WS_MOD + al256((size_t)4 * 9 * 6144 * 4);
constexpr size_t WS_LAM = WS_ROPE + al256(64 * 16 * 2 * 4);
constexpr size_t WS_KTAB = WS_LAM + 256;
constexpr size_t WS_PW = WS_KTAB + (size_t)4 * 2 * 32 * 4096 * 4;
constexpr size_t WS_BBAR = WS_PW + al256((size_t)4 * 2 * 32 * 64 * 17 * 2 * 4);
constexpr size_t WS_WENDT = WS_BBAR + al256((size_t)4 * 2 * 32 * 64 * 16 * 2 * 4);
constexpr size_t WS_BT2 = WS_WENDT + (size_t)4 * 32 * 256 * 512 * 2;
constexpr size_t WS_WINT = WS_BT2 + (size_t)4 * 32 * 256 * 512 * 2;
constexpr size_t WS_WOUTT = WS_WINT + (size_t)4 * 2048 * 1024 * 2;
constexpr size_t WS_WGLUT = WS_WOUTT + (size_t)4 * 1024 * 1024 * 2;
constexpr size_t WS_W13T = WS_WGLUT + (size_t)4 * 512 * 512 * 2;
constexpr size_t WS_W2T = WS_W13T + (size_t)4 * 16 * 4096 * 1024 * 2;
constexpr size_t WS_X = WS_W2T + (size_t)4 * 16 * 1024 * 2048 * 2;
constexpr size_t WS_HX = WS_X + (size_t)R * 1024 * 4;
constexpr size_t WS_QK = WS_HX + (size_t)R * 1024 * 2;
constexpr size_t WS_VT = WS_QK + (size_t)R * 1024 * 2;
constexpr int NCHP = 2304;
constexpr size_t WS_US = WS_VT + (size_t)R * 512 * 2;
constexpr size_t WS_EB = WS_US + (size_t)32 * NCHP * 512 * 2;
constexpr size_t WS_MIX = WS_EB + (size_t)32 * NCHP * 256 * 4;
constexpr size_t WS_YG = WS_MIX + (size_t)R * 1024 * 2;
constexpr size_t WS_AFFT = WS_YG + (size_t)R * 512 * 2;
constexpr size_t WS_SLOT = WS_AFFT + (size_t)NB * 16 * LP * 4;
constexpr size_t WS_GATE = WS_SLOT + (size_t)R * 16 * 4;
constexpr size_t WS_IDX = WS_GATE + al256((size_t)16 * ROWS_E * 4);
constexpr size_t WS_XG = WS_IDX + al256((size_t)16 * ROWS_E * 4);
constexpr size_t WS_HG = WS_XG + (size_t)16 * ROWS_E * 1024 * 2;
constexpr size_t WS_OG = WS_HG + (size_t)16 * ROWS_E * 2048 * 2;
constexpr size_t WS_END = WS_OG + (size_t)16 * ROWS_E * 1024 * 2;

constexpr int LDS_BYTES = 131072 + 64 + 16384;

DEVI unsigned pk2(float lo, float hi) { f32x2 v = {lo, hi}; bf16x2_t b = __builtin_convertvector(v, bf16x2_t); return __builtin_bit_cast(unsigned, b); }
DEVI bf16_t f2bf(float f) { return (bf16_t)(pk2(f, 0.f) & 0xffffu); }
DEVI float bflo(unsigned u) { return __builtin_bit_cast(float, u << 16); }
DEVI float bfhi(unsigned u) { return __builtin_bit_cast(float, u & 0xffff0000u); }
DEVI f32x4 bf4(u32x2 w) { return (f32x4){bflo(w.x), bfhi(w.x), bflo(w.y), bfhi(w.y)}; }
typedef _Float16 h16x2 __attribute__((ext_vector_type(2)));
DEVI unsigned hpk2(float lo, float hi) { unsigned r; asm("v_cvt_pk_f16_f32 %0, %1, %2" : "=v"(r) : "v"(lo), "v"(hi)); return r; }
DEVI float hlo(unsigned u) { return (float)__builtin_bit_cast(_Float16, (unsigned short)(u & 0xffffu)); }
DEVI float hhi(unsigned u) { return (float)__builtin_bit_cast(_Float16, (unsigned short)(u >> 16)); }
DEVI f32x4 hf4(u32x2 w) { return (f32x4){hlo(w.x), hhi(w.x), hlo(w.y), hhi(w.y)}; }
DEVI int tid_l() { int t = threadIdx.x; asm volatile("" : "+v"(t)); return t; }
#define GAS __attribute__((address_space(1)))
DEVI unsigned char* ptr_l(unsigned char* w) { GAS unsigned char* g = (GAS unsigned char*)w; asm volatile("" : "+s"(g)); return (unsigned char*)g; }
template <int CTRL> DEVI float dppmov(float x) { return __builtin_bit_cast(float, __builtin_amdgcn_update_dpp(0, __builtin_bit_cast(int, x), CTRL, 0xf, 0xf, true)); }
DEVI void swap16(float a, float b, float& r0, float& r1) { const auto r = __builtin_amdgcn_permlane16_swap(__builtin_bit_cast(unsigned, a), __builtin_bit_cast(unsigned, b), false, false); r0 = __builtin_bit_cast(float, (unsigned)r[0]); r1 = __builtin_bit_cast(float, (unsigned)r[1]); }
DEVI void swap32(float a, float b, float& r0, float& r1) { const auto r = __builtin_amdgcn_permlane32_swap(__builtin_bit_cast(unsigned, a), __builtin_bit_cast(unsigned, b), false, false); r0 = __builtin_bit_cast(float, (unsigned)r[0]); r1 = __builtin_bit_cast(float, (unsigned)r[1]); }
DEVI float wave_sum(float v) {
    v += dppmov<0xB1>(v);
    v += dppmov<0x4E>(v);
    v += dppmov<0x124>(v);
    v += dppmov<0x128>(v);
    float r0, r1; swap16(v, v, r0, r1); v = r0 + r1;
    swap32(v, v, r0, r1); return r0 + r1;
}
DEVI float fast_exp2(float x) { return __builtin_amdgcn_exp2f(x); }
DEVI float sigmoidf_(float x) { return __builtin_amdgcn_rcpf(1.f + __expf(-x)); }
DEVI float gelu_tanh(float x) { const float z = 0.7978845608028654f * (x + 0.044715f * x * x * x); const float t = 1.f - 2.f * __builtin_amdgcn_rcpf(__expf(2.f * z) + 1.f); return 0.5f * x * (1.f + t); }
#define MFMA32(a, b, c) __builtin_amdgcn_mfma_f32_32x32x16_bf16(a, b, c, 0, 0, 0)

#define XB_TMO      128
#define XB_XCNT(j)  (256  + 64 * (j))
#define XB_XSUB(j)  (1280 + 64 * (j))
#define XB_XGEN(j)  (2304 + 64 * (j))
#define XB_TOP      3328
#define XB_TOPGEN   3392
#define XCD_BAR_WORDS 3456
#define XB_SPIN_CAP (1u << 20)
DEVI unsigned xb_ld(unsigned* p)              { return __hip_atomic_load(p, __ATOMIC_RELAXED, __HIP_MEMORY_SCOPE_AGENT); }
DEVI unsigned xb_add(unsigned* p, unsigned v) { return __hip_atomic_fetch_add(p, v, __ATOMIC_RELAXED, __HIP_MEMORY_SCOPE_AGENT); }
DEVI unsigned xb_xcc_id() { return (unsigned)__builtin_amdgcn_s_getreg((3 << 11) | 20) & 0xFu; }
#define XB_SPIN(cond, bar) do { unsigned _sp = 0; while (cond) { __builtin_amdgcn_s_sleep(1); \
    if ((++_sp & 255u) == 0u) { if (xb_ld(&(bar)[XB_TMO])) break; if (_sp > XB_SPIN_CAP) { atomicAdd(&(bar)[XB_TMO], 1u); break; } } } } while (0)
struct XcdBarrier { unsigned* bar; unsigned x; volatile LAS unsigned* st; };
DEVI XcdBarrier xcd_barrier_post(unsigned* bar, volatile LAS unsigned* st) {
    XcdBarrier b; b.bar = bar; b.x = xb_xcc_id(); b.st = st;
    if (threadIdx.x == 0) (void)xb_add(&bar[XB_XCNT(b.x)], 1u);
    return b;
}
DEVI void xcd_barrier_complete(unsigned* bar, unsigned x, unsigned& nloc, unsigned& nx) {
    const unsigned G = gridDim.x * gridDim.y * gridDim.z;
    unsigned sum, cnt, mine, sp = 0u;
    for (;;) {
        sum = 0u; cnt = 0u; mine = 0u;
#pragma unroll
        for (unsigned j = 0; j < 16; ++j) { const unsigned c = xb_ld(&bar[XB_XCNT(j)]); sum += c; cnt += (c > 0u) ? 1u : 0u; mine = (j == x) ? c : mine; }
        if (sum == G) break;
        __builtin_amdgcn_s_sleep(1);
        if ((++sp & 255u) == 0u) { if (xb_ld(&bar[XB_TMO])) break; if (sp > XB_SPIN_CAP) { atomicAdd(&bar[XB_TMO], 1u); break; } }
    }
    nloc = mine > 0u ? mine : 1u; nx = cnt > 0u ? cnt : 1u;
}
DEVI void xcd_barrier(const XcdBarrier& b) {
    asm volatile("s_waitcnt vmcnt(0)" ::: "memory");
    __syncthreads();
    if (threadIdx.x == 0) {
        unsigned* bar = b.bar;
        __builtin_amdgcn_s_waitcnt(0);
        unsigned nloc = b.st[0], nx = b.st[1];
        if (nloc == 0u) { xcd_barrier_complete(bar, b.x, nloc, nx); b.st[0] = nloc; b.st[1] = nx; }
        const unsigned old = xb_add(&bar[XB_XSUB(b.x)], 1u);
        const unsigned gen = old / nloc;
        if (old + 1u == (gen + 1u) * nloc) {
            __builtin_amdgcn_fence(__ATOMIC_RELEASE, "agent");
            asm volatile("s_waitcnt vmcnt(0)" ::: "memory");
            const unsigned og = xb_add(&bar[XB_TOP], 1u);
            const unsigned tg = og / nx;
            if (og + 1u == (tg + 1u) * nx) xb_add(&bar[XB_TOPGEN], 1u);
            else XB_SPIN(xb_ld(&bar[XB_TOPGEN]) == tg, bar);
            __builtin_amdgcn_fence(__ATOMIC_ACQUIRE, "agent");
            xb_add(&bar[XB_XGEN(b.x)], 1u);
            asm volatile("s_waitcnt vmcnt(0)" ::: "memory");
        } else {
            XB_SPIN(xb_ld(&bar[XB_XGEN(b.x)]) == gen, bar);
            __builtin_amdgcn_fence(__ATOMIC_ACQUIRE, "agent");
            asm volatile("s_waitcnt vmcnt(0)" ::: "memory");
        }
    }
    __syncthreads();
}

DEVI int chunk_row(int b, int c) { return c >= 16 ? b * 256 + (c - 16) : 2048 + b * 16 + c; }
DEVI int chunk_row_token(int cr) { return cr < 2048 ? (cr >> 8) * LP + (16 + (cr & 255)) * 16 : ((cr - 2048) >> 4) * LP + ((cr - 2048) & 15) * 16; }
DEVI int perm16(int k) { return (k & 3) | ((k & 4) << 1) | ((k & 8) >> 1); }

namespace pg8 {
#define PG8_LAS __attribute__((address_space(3)))
typedef unsigned short bf16_t;
typedef short bf16x8 __attribute__((ext_vector_type(8)));
typedef float f32x4 __attribute__((ext_vector_type(4)));
typedef unsigned u32x4 __attribute__((ext_vector_type(4)));
constexpr int BM = 256, BK = 64, HALF = 128, HTB = HALF * BK * 2  , STAGE_BYTES = 8 * HTB, NXCD = 8, WGM = 8;

__host__ __device__ __forceinline__ int lds_byte(int r, int c) { const int st = (r >> 4) * 2 + (c >> 5), rr = r & 15, cc = c & 31, ob = rr * 64 + cc * 2; return st * 1024 + (ob ^ (((ob >> 9) & 1) << 5)); }
__host__ __device__ __forceinline__ void stage_rc(int b, int& R, int& C) { const int st = b / 1024, sb = b % 1024, swz = sb ^ (((sb >> 9) & 1) << 5); R = (st >> 1) * 16 + swz / 64; C = (st & 1) * 32 + (swz % 64) / 2; }
__host__ __device__ __forceinline__ int perm32(int rho) { const int n = rho >> 4, i = rho & 15; return 8 * (i >> 2) + 4 * n + (i & 3); }

struct Unit { int pm, pn; };
struct Gemm { const bf16_t* A; const bf16_t* Bt; int M, N, K; const int* gidx = nullptr; int islot = 0; };
__device__ __forceinline__ unsigned cvt_pk_bf16(float lo, float hi) { unsigned r; asm volatile("v_cvt_pk_bf16_f32 %0, %1, %2" : "=v"(r) : "v"(lo), "v"(hi)); return r; }
template <class Epi, class Sched, bool ALIGN_EPI = false, bool SP2 = false, bool GATH = false>
__device__ __forceinline__ void gemm_phase(PG8_LAS unsigned char* lds, const Gemm g, const Sched& S, const Epi& E) {
    static_assert(!GATH || SP2, "the gathered-A form is written for the SP2 loop only");
    const int tid = tid_l(), wid = __builtin_amdgcn_readfirstlane(tid >> 6), lane = tid & 63, wr = wid >> 2, wc = wid & 3, fr = lane & 15, fq = lane >> 4;
    const int K = g.K, nt = K / BK;
    unsigned voffA[2], voffB[2];
    int stR[2], stC[2];
#pragma unroll
    for (int i = 0; i < 2; ++i) { int R, C; stage_rc(tid * 16 + i * 8192, R, C); const int Rb = Epi::PERM ? ((R & ~31) + perm32(R & 31)) : R; stR[i] = R; stC[i] = C;
        voffA[i] = (unsigned)(R * K + C) * 2u; voffB[i] = (unsigned)(Rb * K + C) * 2u; }
    unsigned goff[2][2], ngoff[2][2];
    const char* gA = (const char*)g.A;
    const size_t kstep = (size_t)(BK * 2);
    const size_t hstep = (size_t)HALF * K * 2;
    const size_t tstep = 2 * hstep;
    const unsigned ldsw = (unsigned)wid * 1024u;
    const int aoff = lds_byte(wr * 64 + fr, fq * 8), boff = lds_byte(wc * 32 + fr, fq * 8);
#define PG8_SA(b, h) (((b) * 2 + (h)) * HTB)
#define PG8_SB(b, h) ((4 + (b) * 2 + (h)) * HTB)
#define PG8_STAGE(bufoff, gbase, voff) do { _Pragma("unroll") for (int _i = 0; _i < 2; ++_i) \
        __builtin_amdgcn_global_load_lds((const unsigned*)((const char*)(gbase) + (voff)[_i]), (PG8_LAS unsigned*)(lds + (bufoff) + ldsw + _i * 8192), 16, 0, 0); } while (0)
#define PG8_STAGE_A(bufoff, selnext, kt, h) do { if constexpr (GATH) PG8_STAGE(bufoff, gA + (size_t)(kt) * kstep, ((selnext) ? ngoff[h] : goff[h])); \
        else PG8_STAGE(bufoff, ((selnext) ? nA : cA) + (size_t)(kt) * kstep + (size_t)(h) * hstep, voffA); } while (0)
#define PG8_LDA(dst, b, h) do { _Pragma("unroll") for (int m = 0; m < 4; ++m) _Pragma("unroll") for (int k = 0; k < 2; ++k) dst[m][k] = *(const PG8_LAS bf16x8*)(lds + PG8_SA(b, h) + aoff + m * 2048 + k * 1024); } while (0)
#define PG8_LDB(dst, b, h) do { _Pragma("unroll") for (int n = 0; n < 2; ++n) _Pragma("unroll") for (int k = 0; k < 2; ++k) dst[n][k] = *(const PG8_LAS bf16x8*)(lds + PG8_SB(b, h) + boff + n * 2048 + k * 1024); } while (0)
#define PG8_MMA(ai, bj, At, Bt) do { __builtin_amdgcn_s_setprio(1); _Pragma("unroll") for (int m = 0; m < 4; ++m) _Pragma("unroll") for (int n = 0; n < 2; ++n) _Pragma("unroll") for (int k = 0; k < 2; ++k) \
        acc[ai][bj][m][n] = __builtin_amdgcn_mfma_f32_16x16x32_bf16(Bt[n][k], At[m][k], acc[ai][bj][m][n], 0, 0, 0); __builtin_amdgcn_s_setprio(0); } while (0)
#define PG8_WAIT_V(n) asm volatile("s_waitcnt vmcnt(" #n ")" ::: "memory")
#define PG8_WAIT_L(n) asm volatile("s_waitcnt lgkmcnt(" #n ")" ::: "memory")
#define PG8_BAR __builtin_amdgcn_s_barrier()
#define PG8_SCHED __builtin_amdgcn_sched_barrier(0)
    Unit cur, nxt; int ui = 0;
    if (!S.next(0, cur)) return;
    f32x4 acc[2][2][4][2];
#pragma unroll
    for (int a = 0; a < 2; ++a)
#pragma unroll
        for (int b = 0; b < 2; ++b)
#pragma unroll
            for (int m = 0; m < 4; ++m)
#pragma unroll
                for (int n = 0; n < 2; ++n) acc[a][b][m][n] = (f32x4){0.f, 0.f, 0.f, 0.f};
    bf16x8 At[4][2], B0[2][2], B1[2][2];
    const char* cA = (const char*)g.A + (size_t)cur.pm * tstep; const char* cB = (const char*)g.Bt + (size_t)cur.pn * tstep;
    const char* nA = cA;
    if constexpr (GATH) {
#pragma unroll
        for (int h = 0; h < 2; ++h)
#pragma unroll
            for (int i = 0; i < 2; ++i) { goff[h][i] = (unsigned)(g.gidx[cur.pm * 256 + h * 128 + stR[i]] * K + stC[i]) * 2u; ngoff[h][i] = goff[h][i]; }
    }
    S.a_ready(cur);
    if constexpr (SP2) {
        PG8_STAGE(PG8_SB(0, 0), cB, voffB); PG8_STAGE(PG8_SB(0, 1), cB + hstep, voffB); PG8_STAGE_A(PG8_SA(0, 0), false, 0, 0); PG8_STAGE_A(PG8_SA(0, 1), false, 0, 1);
        if (wr == 1) PG8_BAR;
        PG8_WAIT_V(2); PG8_BAR;
        PG8_STAGE(PG8_SB(1, 0), cB + kstep, voffB); PG8_STAGE_A(PG8_SA(1, 0), false, 1, 0); PG8_STAGE(PG8_SB(1, 1), cB + hstep + kstep, voffB);
        PG8_WAIT_V(6); PG8_BAR;
    } else {
        PG8_STAGE(PG8_SB(0, 0), cB, voffB); PG8_STAGE(PG8_SA(0, 0), cA, voffA); PG8_STAGE(PG8_SB(0, 1), cB + hstep, voffB); PG8_STAGE(PG8_SA(0, 1), cA + hstep, voffA);
        if (wr == 1) PG8_BAR;
        PG8_WAIT_V(4); PG8_BAR;
        PG8_STAGE(PG8_SB(1, 0), cB + kstep, voffB); PG8_STAGE(PG8_SA(1, 0), cA + kstep, voffA); PG8_STAGE(PG8_SB(1, 1), cB + hstep + kstep, voffB);
        PG8_WAIT_V(6); PG8_BAR;
    }
    for (;;) {
        const bool has_next = S.next(ui + 1, nxt);
        nA = has_next ? (const char*)g.A + (size_t)nxt.pm * tstep : cA; const char* nB = has_next ? (const char*)g.Bt + (size_t)nxt.pn * tstep : cB;
        if constexpr (GATH) {
            if (has_next) {
#pragma unroll
                for (int h = 0; h < 2; ++h)
#pragma unroll
                    for (int i = 0; i < 2; ++i)
                        __builtin_amdgcn_global_load_lds((const unsigned*)(g.gidx + nxt.pm * 256 + h * 128 + stR[i]), (PG8_LAS unsigned*)(lds + g.islot + ((ui + 1) & 1) * 8192 + (h * 2 + i) * 2048 + wid * 256), 4, 0, 0);
            }
        }
        for (int t = 0; t < nt; t += 2) {
            const bool last = (t == nt - 2);
            if constexpr (GATH) {
                if (last) {
                    if (has_next) {
#pragma unroll
                        for (int h = 0; h < 2; ++h)
#pragma unroll
                            for (int i = 0; i < 2; ++i) { const int ix = *(const PG8_LAS int*)(lds + g.islot + ((ui + 1) & 1) * 8192 + (h * 2 + i) * 2048 + wid * 256 + lane * 4); ngoff[h][i] = (unsigned)(ix * K + stC[i]) * 2u; }
                    } else {
#pragma unroll
                        for (int h = 0; h < 2; ++h)
#pragma unroll
                            for (int i = 0; i < 2; ++i) ngoff[h][i] = goff[h][i];
                    }
                }
            }
            const char* a1 = cA + (size_t)(t + 1) * kstep;
            const char* a2 = last ? nA : cA + (size_t)(t + 2) * kstep; const char* b2 = last ? nB : cB + (size_t)(t + 2) * kstep;
            const char* a3 = a2 + kstep; const char* b3 = b2 + kstep;
            if (last && has_next) S.a_ready(nxt);
            if constexpr (SP2) {
            PG8_LDB(B0, 0, 0); PG8_LDB(B1, 0, 1); PG8_SCHED; PG8_LDA(At, 0, 0); PG8_STAGE_A(PG8_SA(1, 1), false, t + 1, 1);
            PG8_WAIT_V(8); PG8_WAIT_L(0); PG8_BAR; PG8_MMA(0, 0, At, B0); PG8_MMA(0, 1, At, B1); PG8_BAR; PG8_SCHED;
            PG8_LDA(At, 0, 1); PG8_STAGE(PG8_SB(0, 0), b2, voffB); PG8_STAGE(PG8_SB(0, 1), b2 + hstep, voffB); PG8_STAGE_A(PG8_SA(0, 0), last, last ? 0 : t + 2, 0);
            PG8_WAIT_V(8); PG8_WAIT_L(0); PG8_BAR; PG8_MMA(1, 0, At, B0); PG8_MMA(1, 1, At, B1); PG8_BAR; PG8_SCHED;
            PG8_LDB(B0, 1, 0); PG8_LDB(B1, 1, 1); PG8_SCHED; PG8_LDA(At, 1, 0); PG8_STAGE_A(PG8_SA(0, 1), last, last ? 0 : t + 2, 1);
            PG8_WAIT_V(8); PG8_WAIT_L(0); PG8_BAR; PG8_MMA(0, 0, At, B0); PG8_MMA(0, 1, At, B1); PG8_BAR; PG8_SCHED;
            PG8_LDA(At, 1, 1); PG8_STAGE(PG8_SB(1, 0), b3, voffB); PG8_STAGE(PG8_SB(1, 1), b3 + hstep, voffB); PG8_STAGE_A(PG8_SA(1, 0), last, last ? 1 : t + 3, 0);
            PG8_WAIT_V(8); PG8_WAIT_L(0); PG8_BAR; PG8_MMA(1, 0, At, B0); PG8_MMA(1, 1, At, B1); PG8_BAR; PG8_SCHED;
            } else {
            PG8_LDB(B0, 0, 0); PG8_SCHED; PG8_LDA(At, 0, 0); PG8_STAGE(PG8_SA(1, 1), a1 + hstep, voffA);
            PG8_WAIT_L(8); PG8_BAR; PG8_WAIT_L(0); PG8_MMA(0, 0, At, B0); PG8_BAR; PG8_SCHED;
            PG8_LDB(B1, 0, 1); PG8_STAGE(PG8_SB(0, 0), b2, voffB);
            PG8_BAR; PG8_WAIT_L(0); PG8_MMA(0, 1, At, B1); PG8_BAR;
            PG8_LDA(At, 0, 1); PG8_STAGE(PG8_SA(0, 0), a2, voffA);
            PG8_BAR; PG8_WAIT_L(0); PG8_MMA(1, 0, At, B0); PG8_BAR; PG8_SCHED;
            PG8_STAGE(PG8_SB(0, 1), b2 + hstep, voffB);
            PG8_WAIT_V(6); PG8_BAR; PG8_MMA(1, 1, At, B1); PG8_BAR;
            PG8_LDB(B0, 1, 0); PG8_SCHED; PG8_LDA(At, 1, 0); PG8_STAGE(PG8_SA(0, 1), a2 + hstep, voffA);
            PG8_WAIT_L(8); PG8_BAR; PG8_WAIT_L(0); PG8_MMA(0, 0, At, B0); PG8_BAR; PG8_SCHED;
            PG8_LDB(B1, 1, 1); PG8_STAGE(PG8_SB(1, 0), b3, voffB);
            PG8_BAR; PG8_WAIT_L(0); PG8_MMA(0, 1, At, B1); PG8_BAR;
            PG8_LDA(At, 1, 1); PG8_STAGE(PG8_SA(1, 0), a3, voffA);
            PG8_BAR; PG8_WAIT_L(0); PG8_MMA(1, 0, At, B0); PG8_BAR; PG8_SCHED;
            PG8_STAGE(PG8_SB(1, 1), b3 + hstep, voffB);
            PG8_WAIT_V(6); PG8_BAR; PG8_MMA(1, 1, At, B1); PG8_BAR;
            }
        }
        if constexpr (ALIGN_EPI) { if (wr == 0) PG8_BAR; }
        if constexpr (!Epi::AFTER_DRAIN) { E(acc, cur, wr, wc, fr, fq); S.done(cur); }
        if (!has_next) break;
#pragma unroll
        for (int a = 0; a < 2; ++a)
#pragma unroll
            for (int b = 0; b < 2; ++b)
#pragma unroll
                for (int m = 0; m < 4; ++m)
#pragma unroll
                    for (int n = 0; n < 2; ++n) acc[a][b][m][n] = (f32x4){0.f, 0.f, 0.f, 0.f};
        cur = nxt; cA = nA; cB = nB; ++ui;
        if constexpr (GATH) {
#pragma unroll
            for (int h = 0; h < 2; ++h)
#pragma unroll
                for (int i = 0; i < 2; ++i) goff[h][i] = ngoff[h][i];
        }
        if constexpr (ALIGN_EPI) { if (wr == 1) PG8_BAR; }
    }
    PG8_WAIT_V(0);
    if constexpr (!ALIGN_EPI) { if (wr == 0) PG8_BAR; }
    PG8_BAR;
    if constexpr (Epi::AFTER_DRAIN) { E.fused(acc, cur, wr, wc, fr, fq, lds, wid, lane); S.done(cur); }
#undef PG8_SA
#undef PG8_SB
#undef PG8_STAGE
#undef PG8_STAGE_A
#undef PG8_LDA
#undef PG8_LDB
#undef PG8_MMA
#undef PG8_WAIT_V
#undef PG8_WAIT_L
#undef PG8_BAR
#undef PG8_SCHED
}
}


struct TileOrder {
    int nunits, G, c, npm, npn, pn_gs, pm_gs, pm_off, blk48 = 0;
    DEVI bool next(int i, pg8::Unit& u) const {
        const int L = i * G + c; if (L >= nunits) return false;
        const int per = npm * npn, e = L / per, v = L - e * per; int pml = v / npn, pnl = v - pml * npn;
        if (blk48 && v < 256) { const int blk = v >> 5, w = v & 31; pml = (blk >> 1) * 4 + (w >> 3); pnl = (blk & 1) * 8 + (w & 7); }
        u.pm = e * pm_gs + pm_off + pml; u.pn = e * pn_gs + pnl; return true;
    }
    DEVI void a_ready(const pg8::Unit&) const {}
    DEVI void done(const pg8::Unit&) const {}
};

struct Epi8Inproj { static constexpr bool PERM = false, AFTER_DRAIN = false;
    bf16_t* QK; bf16_t* VT; bf16_t* UG; const float* rope;
    DEVI void operator()(const f32x4 (&acc)[2][2][4][2], const pg8::Unit& u, int wr, int wc, int fr, int fq) const {
        const int pn = u.pn;
#pragma unroll
        for (int ai = 0; ai < 2; ++ai)
#pragma unroll
            for (int m = 0; m < 4; ++m) {
                const int r = u.pm * 256 + ai * 128 + wr * 64 + m * 16 + fr, b = r / LP, p = r - b * LP; const bool latent = p >= CTXL; const int t = p - CTXL;
#pragma unroll
                for (int bj = 0; bj < 2; ++bj) {
                    const int cb = bj * 128 + wc * 32;
                    if (pn < 4) {
                        const int head = cb >> 6, dbase = cb & 63, pos = dbase == 0 ? (t >> 6) : (t & 63);
                        const float sc = pn < 2 ? QSCALE : 1.f;
                        f32x4 cs0 = {1.f, 0.f, 1.f, 0.f}, cs1 = {1.f, 0.f, 1.f, 0.f};
                        if (latent) { cs0 = *(const f32x4*)(rope + (pos * 16 + 4 * fq) * 2); cs1 = *(const f32x4*)(rope + (pos * 16 + 4 * fq + 2) * 2); }
                        const float cc[4] = {cs0.x, cs0.z, cs1.x, cs1.z}, sn[4] = {cs0.y, cs0.w, cs1.y, cs1.w};
                        bf16_t* dst = QK + ((size_t)((pn * NB + b) * NH + head) * LP + p) * 64 + dbase + 4 * fq;
#pragma unroll
                        for (int n = 0; n < 2; ++n) {
                            float o[4];
#pragma unroll
                            for (int j = 0; j < 4; ++j) { const float x = acc[ai][bj][m][n][j], y = acc[ai][bj][m][n ^ 1][j]; o[j] = (n == 0 ? x * cc[j] - y * sn[j] : x * cc[j] + y * sn[j]) * sc; }
                            u32x2 w; w.x = pk2(o[0], o[1]); w.y = pk2(o[2], o[3]);
                            *(u32x2*)(dst + 16 * n) = w;
                        }
                    } else if (pn < 6) {
                        const int cv = (pn - 4) * 256 + cb, head = cv >> 7, dv0 = (cv & 127) + 4 * fq;
                        const int pp = (p & ~15) | perm16(p & 15);
                        bf16_t* dst = VT + ((size_t)(b * NH + head) * 128 + dv0) * LP + pp;
#pragma unroll
                        for (int n = 0; n < 2; ++n)
#pragma unroll
                            for (int j = 0; j < 4; ++j) dst[(size_t)(16 * n + j) * LP] = f2bf(acc[ai][bj][m][n][j]);
                    } else {
                        const int ch0 = (pn - 6) * 256 + cb;
                        bf16_t* dst = UG + (size_t)chunk_row(b, p >> 4) * 512 + (p & 15) * 16 + 4 * fq;
#pragma unroll
                        for (int n = 0; n < 2; ++n) {
                            const int g = (ch0 + 16 * n) >> 4;
                            u32x2 w; w.x = pk2(acc[ai][bj][m][n][0], acc[ai][bj][m][n][1]); w.y = pk2(acc[ai][bj][m][n][2], acc[ai][bj][m][n][3]);
                            *(u32x2*)(dst + (size_t)g * NCHP * 512) = w;
                        }
                    }
                }
            }
    }
};

struct Epi8Out { static constexpr bool PERM = true, AFTER_DRAIN = false;
    bf16_t* X; const float* mod;
    DEVI void operator()(const f32x4 (&acc)[2][2][4][2], const pg8::Unit& u, int wr, int wc, int fr, int fq) const {
#pragma unroll
        for (int ai = 0; ai < 2; ++ai)
#pragma unroll
            for (int m = 0; m < 4; ++m) {
                const int r = u.pm * 256 + ai * 128 + wr * 64 + m * 16 + fr, b = r / LP, p = r - b * LP, jm = p < CTXL ? 8 : b;
                const float* g1 = mod + (size_t)jm * 6144 + 2 * 1024;
#pragma unroll
                for (int bj = 0; bj < 2; ++bj) {
                    const int c = u.pn * 256 + bj * 128 + wc * 32 + 8 * fq;
                    bf16_t* xp = X + (size_t)r * 1024 + c;
                    const u32x4 xw = *(const u32x4*)xp;
                    const f32x4 g0 = *(const f32x4*)(g1 + c), g4 = *(const f32x4*)(g1 + c + 4);
                    const f32x4 o0 = hf4((u32x2){xw.x, xw.y}) + g0 * acc[ai][bj][m][0], o1 = hf4((u32x2){xw.z, xw.w}) + g4 * acc[ai][bj][m][1];
                    u32x4 w; w.x = hpk2(o0.x, o0.y); w.y = hpk2(o0.z, o0.w); w.z = hpk2(o1.x, o1.y); w.w = hpk2(o1.z, o1.w);
                    *(u32x4*)xp = w;
                }
            }
    }
};

struct Epi8Moe1 { static constexpr bool PERM = true, AFTER_DRAIN = false;
    bf16_t* HG;
    DEVI void operator()(const f32x4 (&acc)[2][2][4][2], const pg8::Unit& u, int wr, int wc, int fr, int fq) const {
        const int t = u.pn & 15;
#pragma unroll
        for (int ai = 0; ai < 2; ++ai)
#pragma unroll
            for (int m = 0; m < 4; ++m) {
                const size_t row = (size_t)u.pm * 256 + ai * 128 + wr * 64 + m * 16 + fr;
                float o[8];
#pragma unroll
                for (int n = 0; n < 2; ++n)
#pragma unroll
                    for (int j = 0; j < 4; ++j) { const float a1 = acc[ai][0][m][n][j], a3 = acc[ai][1][m][n][j]; o[4 * n + j] = a1 * sigmoidf_(a1) * a3; }
                u32x4 w; w.x = pk2(o[0], o[1]); w.y = pk2(o[2], o[3]); w.z = pk2(o[4], o[5]); w.w = pk2(o[6], o[7]);
                *(u32x4*)(HG + row * FF + t * 128 + wc * 32 + 8 * fq) = w;
            }
    }
};

struct Epi8Moe2 { static constexpr bool PERM = true, AFTER_DRAIN = false;
    bf16_t* OG; const float* gate;
    DEVI void operator()(const f32x4 (&acc)[2][2][4][2], const pg8::Unit& u, int wr, int wc, int fr, int fq) const {
        const int t = u.pn & 3;
#pragma unroll
        for (int ai = 0; ai < 2; ++ai)
#pragma unroll
            for (int m = 0; m < 4; ++m) {
                const size_t row = (size_t)u.pm * 256 + ai * 128 + wr * 64 + m * 16 + fr; const float gt = gate[row];
#pragma unroll
                for (int bj = 0; bj < 2; ++bj) {
                    const f32x4 a = acc[ai][bj][m][0] * gt, c = acc[ai][bj][m][1] * gt;
                    u32x4 w; w.x = pk2(a.x, a.y); w.y = pk2(a.z, a.w); w.z = pk2(c.x, c.y); w.w = pk2(c.z, c.w);
                    *(u32x4*)(OG + row * 1024 + t * 256 + bj * 128 + wc * 32 + 8 * fq) = w;
                }
            }
    }
};

struct Epi8S1 { static constexpr bool PERM = true, AFTER_DRAIN = false;
    unsigned short* E;
    DEVI void operator()(const f32x4 (&acc)[2][2][4][2], const pg8::Unit& u, int wr, int wc, int fr, int fq) const {
        const int g = u.pn, r0 = (u.pm - g * 9) * 256 + wr * 64 + fr;
#pragma unroll
        for (int ai = 0; ai < 2; ++ai)
#pragma unroll
            for (int m = 0; m < 4; ++m) {
                const int cr = r0 + ai * 128 + m * 16;
                if (cr < NCH) {
                    unsigned short* dst = E + ((size_t)g * NCHP + cr) * 256 + wc * 32 + 8 * fq;
#pragma unroll
                    for (int bj = 0; bj < 2; ++bj) {
                        const f32x4 a = acc[ai][bj][m][0], d = acc[ai][bj][m][1];
                        u32x4 w; w.x = hpk2(a.x, a.y); w.y = hpk2(a.z, a.w); w.z = hpk2(d.x, d.y); w.w = hpk2(d.z, d.w);
                        *(u32x4*)(dst + bj * 128) = w;
                    }
                }
            }
    }
};
struct Epi8S2 { static constexpr bool PERM = true, AFTER_DRAIN = false;
    bf16_t* YG;
    DEVI void operator()(const f32x4 (&acc)[2][2][4][2], const pg8::Unit& u, int wr, int wc, int fr, int fq) const {
        const int g = u.pn, r0 = (u.pm - g * 9) * 256 + wr * 64 + fr;
#pragma unroll
        for (int ai = 0; ai < 2; ++ai)
#pragma unroll
            for (int m = 0; m < 4; ++m) {
                const int cr = r0 + ai * 128 + m * 16;
                if (cr < NCH) {
                    const size_t tok0 = (size_t)chunk_row_token(cr);
#pragma unroll
                    for (int bj = 0; bj < 2; ++bj) {
                        const int col = bj * 128 + wc * 32 + 8 * fq, j = col >> 4, h = col & 15;
                        const f32x4 a = acc[ai][bj][m][0], d = acc[ai][bj][m][1];
                        u32x4 w; w.x = pk2(gelu_tanh(a.x), gelu_tanh(a.y)); w.y = pk2(gelu_tanh(a.z), gelu_tanh(a.w)); w.z = pk2(gelu_tanh(d.x), gelu_tanh(d.y)); w.w = pk2(gelu_tanh(d.z), gelu_tanh(d.w));
                        *(u32x4*)(YG + (tok0 + j) * 512 + g * 16 + h) = w;
                    }
                }
            }
    }
};
struct Epi8Glu { static constexpr bool PERM = true, AFTER_DRAIN = false;
    const bf16_t* YG; bf16_t* MIX; const float* bglu;
    DEVI void operator()(const f32x4 (&acc)[2][2][4][2], const pg8::Unit& u, int wr, int wc, int fr, int fq) const {
#pragma unroll
        for (int ai = 0; ai < 2; ++ai)
#pragma unroll
            for (int m = 0; m < 4; ++m) {
                const size_t tok = (size_t)u.pm * 256 + ai * 128 + wr * 64 + m * 16 + fr;
#pragma unroll
                for (int bj = 0; bj < 2; ++bj) {
                    const int n0 = u.pn * 256 + bj * 128 + wc * 32 + 8 * fq;
                    const u32x4 y = *(const u32x4*)(YG + tok * 512 + n0);
                    const f32x4 b0 = *(const f32x4*)(bglu + n0), b1 = *(const f32x4*)(bglu + n0 + 4);
                    const f32x4 a = acc[ai][bj][m][0] + b0, d = acc[ai][bj][m][1] + b1;
                    u32x4 w; w.x = pk2(bflo(y.x) * sigmoidf_(a.x), bfhi(y.x) * sigmoidf_(a.y)); w.y = pk2(bflo(y.y) * sigmoidf_(a.z), bfhi(y.y) * sigmoidf_(a.w));
                    w.z = pk2(bflo(y.z) * sigmoidf_(d.x), bfhi(y.z) * sigmoidf_(d.y)); w.w = pk2(bflo(y.w) * sigmoidf_(d.z), bfhi(y.w) * sigmoidf_(d.w));
                    *(u32x4*)(MIX + tok * 1024 + 512 + n0) = w;
                }
            }
    }
};

struct Params {
    const float* in[30];
    float* out;
    unsigned char* ws;
    int lo, hi;
};

DEVI int swz(int row, int kc) { return row * 128 + ((kc ^ ((row >> 1) & 7)) << 4); }

struct APlain { const bf16_t* A; int lda; DEVI const bf16_t* ptr(int row, int k) const { return A + (size_t)row * lda + k; } };
struct AS2 { const bf16_t* U; const bf16_t* S; DEVI const bf16_t* ptr(int row, int k) const { return (k < 256 ? U : S) + (size_t)row * 8192 + (k & 255); } };

template <int BM, class AF, class Epi>
DEVI void gemm_unit(char* lds, const AF& af, const bf16_t* __restrict__ Bt, int ldb, int K, int m0, int n0, const Epi& epi) {
    constexpr int MT = BM / 128, ACH = BM / 64, A_BYTES = BM * 128, STAGE = A_BYTES + 16384, WM = BM / 4;
    const int tid = tid_l(), lane = tid & 63, wid = tid >> 6, wm = wid >> 1, wn = wid & 1, r32 = lane & 31, hi = lane >> 5;
    f32x16 acc[MT][2];
#pragma unroll
    for (int a = 0; a < MT; ++a)
#pragma unroll
        for (int b = 0; b < 2; ++b)
#pragma unroll
            for (int i = 0; i < 16; ++i) acc[a][b][i] = 0.f;
    u32x4 ra[ACH], rb[2];
    const int nk = K >> 6;
    const int crow = tid >> 3, ckc = tid & 7;
#define G_LOAD(kt) do { \
        _Pragma("unroll") for (int i = 0; i < ACH; ++i) ra[i] = *(const u32x4*)af.ptr(m0 + crow + 64 * i, (kt) * 64 + ckc * 8); \
        _Pragma("unroll") for (int i = 0; i < 2; ++i) rb[i] = *(const u32x4*)(Bt + (size_t)(n0 + crow + 64 * i) * ldb + (kt) * 64 + ckc * 8); } while (0)
#define G_STORE(s) do { char* _a = lds + (s) * STAGE; char* _b = _a + A_BYTES; \
        _Pragma("unroll") for (int i = 0; i < ACH; ++i) *(u32x4*)(_a + swz(crow + 64 * i, ckc)) = ra[i]; \
        _Pragma("unroll") for (int i = 0; i < 2; ++i) *(u32x4*)(_b + swz(crow + 64 * i, ckc)) = rb[i]; } while (0)
    G_LOAD(0); G_STORE(0); __syncthreads();
    for (int kt = 0; kt < nk; ++kt) {
        if (kt + 1 < nk) G_LOAD(kt + 1);
        const char* a = lds + (kt & 1) * STAGE; const char* b = a + A_BYTES;
#pragma unroll
        for (int ks = 0; ks < 4; ++ks) {
            bf16x8 wf[2], xf[MT];
#pragma unroll
            for (int nt = 0; nt < 2; ++nt) wf[nt] = *(const bf16x8*)(b + swz(wn * 64 + nt * 32 + r32, ks * 2 + hi));
#pragma unroll
            for (int mt = 0; mt < MT; ++mt) xf[mt] = *(const bf16x8*)(a + swz(wm * WM + mt * 32 + r32, ks * 2 + hi));
#pragma unroll
            for (int mt = 0; mt < MT; ++mt)
#pragma unroll
                for (int nt = 0; nt < 2; ++nt) acc[mt][nt] = MFMA32(wf[nt], xf[mt], acc[mt][nt]);
        }
        if (kt + 1 < nk) G_STORE((kt + 1) & 1);
        __syncthreads();
    }
#undef G_LOAD
#undef G_STORE
    epi.template run<MT>(acc, m0 + wm * WM + r32, n0 + wn * 64, hi);
}

template <class AF, class Epi>
DEVI void gemm_unit_dma(char* lds, const AF& af, const bf16_t* __restrict__ Bt, int ldb, int K, int m0, int n0, const Epi& epi) {
    const int tid = tid_l(), lane = tid & 63, wid = tid >> 6, wm = wid >> 1, wn = wid & 1, r32 = lane & 31, hi = lane >> 5;
    f32x16 acc[1][2];
#pragma unroll
    for (int b = 0; b < 2; ++b)
#pragma unroll
        for (int i = 0; i < 16; ++i) acc[0][b][i] = 0.f;
    const int nk = K >> 6;
    const int drow0 = wid * 16 + (lane >> 3), drow1 = drow0 + 8;
    const int kc0 = (lane & 7) ^ ((drow0 >> 1) & 7), kc1 = (lane & 7) ^ ((drow1 >> 1) & 7);
    const bf16_t* ga0 = af.ptr(m0 + drow0, kc0 * 8); const bf16_t* ga1 = af.ptr(m0 + drow1, kc1 * 8);
    const bf16_t* gb0 = Bt + (size_t)(n0 + drow0) * ldb + kc0 * 8; const bf16_t* gb1 = Bt + (size_t)(n0 + drow1) * ldb + kc1 * 8;
    LAS unsigned char* dl = (LAS unsigned char*)lds + wid * 2048;
#define GD_LDS(g, off) __builtin_amdgcn_global_load_lds((const unsigned*)(g), (LAS unsigned*)(dl + (off)), 16, 0, 0)
#define GD_ISSUE(kt) do { const int _s = ((kt) & 3) * 32768; GD_LDS(ga0 + (kt) * 64, _s); GD_LDS(ga1 + (kt) * 64, _s + 1024); GD_LDS(gb0 + (kt) * 64, _s + 16384); GD_LDS(gb1 + (kt) * 64, _s + 16384 + 1024); } while (0)
#define GD_WAITBAR(N) asm volatile("s_waitcnt vmcnt(" #N ") lgkmcnt(0)\n\ts_barrier" ::: "memory")
    GD_ISSUE(0); GD_ISSUE(1); GD_ISSUE(2);
    for (int kt = 0; kt < nk; ++kt) {
        if (kt + 2 < nk) GD_WAITBAR(8); else if (kt + 1 < nk) GD_WAITBAR(4); else GD_WAITBAR(0);
        if (kt + 3 < nk) GD_ISSUE(kt + 3);
        const char* a = lds + (kt & 3) * 32768; const char* b = a + 16384;
#pragma unroll
        for (int ks = 0; ks < 4; ++ks) {
            bf16x8 wf[2], xf;
#pragma unroll
            for (int nt = 0; nt < 2; ++nt) wf[nt] = *(const bf16x8*)(b + swz(wn * 64 + nt * 32 + r32, ks * 2 + hi));
            xf = *(const bf16x8*)(a + swz(wm * 32 + r32, ks * 2 + hi));
#pragma unroll
            for (int nt = 0; nt < 2; ++nt) acc[0][nt] = MFMA32(wf[nt], xf, acc[0][nt]);
        }
    }
#undef GD_LDS
#undef GD_ISSUE
#undef GD_WAITBAR
    __syncthreads();
    epi.template run<1>(acc, m0 + wm * 32 + r32, n0 + wn * 64, hi);
}


struct EpiInproj {
    bf16_t* QK; bf16_t* VT; bf16_t* UG; const float* rope;
    template <int MT> DEVI void run(const f32x16 (&acc)[MT][2], int mrow0, int ncol0, int hi) const {
#pragma unroll
        for (int mt = 0; mt < MT; ++mt) {
            const int r = mrow0 + mt * 32, b = r / LP, p = r - b * LP; const bool latent = p >= CTXL; const int t = p - CTXL;
#pragma unroll
            for (int nt = 0; nt < 2; ++nt) {
                const int nb = ncol0 + nt * 32; const f32x16& v = acc[mt][nt];
                if (nb < 1024) {
                    const int which = nb >> 8, head = (nb >> 6) & 3, dbase = nb & 63;
                    const int pos = dbase == 0 ? (t >> 6) : (t & 63);
                    bf16_t* dst = QK + ((size_t)((which * NB + b) * NH + head) * LP + p) * 64 + dbase + 4 * hi;
                    const float sc = which < 2 ? QSCALE : 1.f;
#pragma unroll
                    for (int i4 = 0; i4 < 4; ++i4) {
                        float o[4];
#pragma unroll
                        for (int j = 0; j < 4; ++j) {
                            float x = v[4 * i4 + j];
                            if (latent) {
                                const float y = v[4 * (i4 ^ 2) + j];
                                const f32x2 cs = *(const f32x2*)(rope + (pos * 16 + 8 * (i4 & 1) + 4 * hi + j) * 2);
                                x = (i4 < 2) ? (x * cs.x - y * cs.y) : (x * cs.x + y * cs.y);
                            }
                            o[j] = x * sc;
                        }
                        u32x2 w; w.x = pk2(o[0], o[1]); w.y = pk2(o[2], o[3]);
                        *(u32x2*)(dst + 8 * i4) = w;
                    }
                } else if (nb < 1536) {
                    const int n1 = nb - 1024, head = n1 >> 7, dv0 = n1 & 127;
                    const int pp = (p & ~15) | perm16(p & 15);
                    bf16_t* dst = VT + ((size_t)(b * NH + head) * 128 + dv0 + 4 * hi) * LP + pp;
#pragma unroll
                    for (int i = 0; i < 16; ++i) dst[(size_t)((i & 3) + 8 * (i >> 2)) * LP] = f2bf(v[i]);
                } else {
                    const int n1 = nb - 1536;
                    bf16_t* dst = UG + (size_t)chunk_row(b, p >> 4) * 512 + (p & 15) * 16;
#pragma unroll
                    for (int i4 = 0; i4 < 4; ++i4) {
                        const int ch = n1 + 8 * i4 + 4 * hi, g = ch >> 4, hc = ch & 15;
                        u32x2 w; w.x = pk2(v[4 * i4], v[4 * i4 + 1]); w.y = pk2(v[4 * i4 + 2], v[4 * i4 + 3]);
                        *(u32x2*)(dst + (size_t)g * NCHP * 512 + hc) = w;
                    }
                }
            }
        }
    }
};

struct EpiS1 {
    unsigned short* E;
    template <int MT> DEVI void run(const f32x16 (&acc)[MT][2], int mrow0, int ncol0, int hi) const {
#pragma unroll
        for (int mt = 0; mt < MT; ++mt) {
            unsigned short* dst = E + (size_t)(mrow0 + mt * 32) * 256 + ncol0 + 4 * hi;
#pragma unroll
            for (int nt = 0; nt < 2; ++nt)
#pragma unroll
                for (int i4 = 0; i4 < 4; ++i4) {
                    u32x2 w; w.x = hpk2(acc[mt][nt][4 * i4], acc[mt][nt][4 * i4 + 1]); w.y = hpk2(acc[mt][nt][4 * i4 + 2], acc[mt][nt][4 * i4 + 3]);
                    *(u32x2*)(dst + nt * 32 + 8 * i4) = w;
                }
        }
    }
};

struct EpiS2 {
    bf16_t* YG; int g;
    template <int MT> DEVI void run(const f32x16 (&acc)[MT][2], int mrow0, int ncol0, int hi) const {
#pragma unroll
        for (int mt = 0; mt < MT; ++mt) {
            const size_t tok0 = (size_t)chunk_row_token(mrow0 + mt * 32);
#pragma unroll
            for (int nt = 0; nt < 2; ++nt)
#pragma unroll
                for (int i4 = 0; i4 < 4; ++i4) {
                    const int n = ncol0 + nt * 32 + 8 * i4 + 4 * hi, j = n >> 4, h = n & 15;
                    u32x2 w; w.x = pk2(gelu_tanh(acc[mt][nt][4 * i4]), gelu_tanh(acc[mt][nt][4 * i4 + 1]));
                    w.y = pk2(gelu_tanh(acc[mt][nt][4 * i4 + 2]), gelu_tanh(acc[mt][nt][4 * i4 + 3]));
                    *(u32x2*)(YG + (tok0 + j) * 512 + g * 16 + h) = w;
                }
        }
    }
};

struct EpiGlu {
    const bf16_t* YG; bf16_t* MIX; const float* bglu;
    template <int MT> DEVI void run(const f32x16 (&acc)[MT][2], int mrow0, int ncol0, int hi) const {
#pragma unroll
        for (int mt = 0; mt < MT; ++mt) {
            const size_t tok = mrow0 + mt * 32;
#pragma unroll
            for (int nt = 0; nt < 2; ++nt)
#pragma unroll
                for (int i4 = 0; i4 < 4; ++i4) {
                    const int n = ncol0 + nt * 32 + 8 * i4 + 4 * hi;
                    const u32x2 y = *(const u32x2*)(YG + tok * 512 + n);
                    const f32x4 bb = *(const f32x4*)(bglu + n);
                    const float o0 = bflo(y.x) * sigmoidf_(acc[mt][nt][4 * i4] + bb.x), o1 = bfhi(y.x) * sigmoidf_(acc[mt][nt][4 * i4 + 1] + bb.y);
                    const float o2 = bflo(y.y) * sigmoidf_(acc[mt][nt][4 * i4 + 2] + bb.z), o3 = bfhi(y.y) * sigmoidf_(acc[mt][nt][4 * i4 + 3] + bb.w);
                    u32x2 w; w.x = pk2(o0, o1); w.y = pk2(o2, o3);
                    *(u32x2*)(MIX + tok * 1024 + 512 + n) = w;
                }
        }
    }
};

struct EpiOut {
    bf16_t* X; const float* mod;
    template <int MT> DEVI void run(const f32x16 (&acc)[MT][2], int mrow0, int ncol0, int hi) const {
#pragma unroll
        for (int mt = 0; mt < MT; ++mt) {
            const int r = mrow0 + mt * 32, b = r / LP, p = r - b * LP, j = p < CTXL ? 8 : b;
            const float* g1 = mod + (size_t)j * 6144 + 2 * 1024;
#pragma unroll
            for (int nt = 0; nt < 2; ++nt)
#pragma unroll
                for (int i4 = 0; i4 < 4; ++i4) {
                    const int n = ncol0 + nt * 32 + 8 * i4 + 4 * hi;
                    bf16_t* xp = X + (size_t)r * 1024 + n;
                    f32x4 x = hf4(*(const u32x2*)xp); const f32x4 g = *(const f32x4*)(g1 + n);
                    x.x += g.x * acc[mt][nt][4 * i4]; x.y += g.y * acc[mt][nt][4 * i4 + 1]; x.z += g.z * acc[mt][nt][4 * i4 + 2]; x.w += g.w * acc[mt][nt][4 * i4 + 3];
                    u32x2 w; w.x = hpk2(x.x, x.y); w.y = hpk2(x.z, x.w);
                    *(u32x2*)xp = w;
                }
        }
    }
};

struct EpiMoe1 {
    bf16_t* HG;
    template <int MT> DEVI void run(const f32x16 (&acc)[MT][2], int mrow0, int ncol0, int hi) const {
#pragma unroll
        for (int mt = 0; mt < MT; ++mt) {
            bf16_t* dst = HG + (size_t)(mrow0 + mt * 32) * FF + (ncol0 >> 1) + 4 * hi;
#pragma unroll
            for (int i4 = 0; i4 < 4; ++i4) {
                float o[4];
#pragma unroll
                for (int j = 0; j < 4; ++j) { const float a1 = acc[mt][0][4 * i4 + j], a3 = acc[mt][1][4 * i4 + j]; o[j] = a1 * sigmoidf_(a1) * a3; }
                u32x2 w; w.x = pk2(o[0], o[1]); w.y = pk2(o[2], o[3]);
                *(u32x2*)(dst + 8 * i4) = w;
            }
        }
    }
};

struct EpiMoe2 {
    bf16_t* OG; const float* gate;
    template <int MT> DEVI void run(const f32x16 (&acc)[MT][2], int mrow0, int ncol0, int hi) const {
#pragma unroll
        for (int mt = 0; mt < MT; ++mt) {
            const int row = mrow0 + mt * 32; const float gt = gate[row];
            bf16_t* dst = OG + (size_t)row * 1024 + ncol0 + 4 * hi;
#pragma unroll
            for (int nt = 0; nt < 2; ++nt)
#pragma unroll
                for (int i4 = 0; i4 < 4; ++i4) {
                    u32x2 w; w.x = pk2(acc[mt][nt][4 * i4] * gt, acc[mt][nt][4 * i4 + 1] * gt); w.y = pk2(acc[mt][nt][4 * i4 + 2] * gt, acc[mt][nt][4 * i4 + 3] * gt);
                    *(u32x2*)(dst + nt * 32 + 8 * i4) = w;
                }
        }
    }
};

DEVI void transpose_unit(char* lds, const float* __restrict__ W, int K, int N, bf16_t* __restrict__ out, int k0, int n0, int mode  ) {
    float* tile = (float*)lds;
    const int tid = tid_l();
    f32x4 v[8];
#pragma unroll
    for (int i = 0; i < 8; ++i) { const int c = tid + 512 * i, k = c >> 6, n4 = (c & 63) * 4; v[i] = *(const f32x4*)(W + (size_t)(k0 + k) * N + n0 + n4); }
#pragma unroll
    for (int i = 0; i < 8; ++i) { const int c = tid + 512 * i, k = c >> 6, n4 = (c & 63) * 4; float* t = tile + k * 257 + n4; t[0] = v[i].x; t[1] = v[i].y; t[2] = v[i].z; t[3] = v[i].w; }
    __syncthreads();
#pragma unroll
    for (int i = 0; i < 4; ++i) {
        const int c = tid + 512 * i, n = c >> 3, k8 = (c & 7) * 8;
        float f[8];
#pragma unroll
        for (int j = 0; j < 8; ++j) f[j] = tile[(k8 + j) * 257 + n];
        u32x4 w; w.x = pk2(f[0], f[1]); w.y = pk2(f[2], f[3]); w.z = pk2(f[4], f[5]); w.w = pk2(f[6], f[7]);
        const int ng = n0 + n; const int orow = mode == 0 ? ng : ((ng >> 7) * 256 + (mode - 1) * 128 + (ng & 127));
        *(u32x4*)(out + (size_t)orow * K + k0 + k8) = w;
    }
    __syncthreads();
}

DEVI void adaln_unit(char* lds, const Params& P, int l, int n0) {
    float* sc = (float*)lds;
    float* red = sc + 9 * 1024;
    const int tid = tid_l(), lane = tid & 63, wid = tid >> 6;
    for (int i = tid; i < 9 * 1024; i += 512) { const float c = i < 8192 ? P.in[1][i] : P.in[3][i - 8192]; sc[i] = c / (1.f + __expf(-c)); }
    __syncthreads();
    const float* W = P.in[4] + (size_t)l * 1024 * 6144 + n0 + lane;
    float a[9];
#pragma unroll
    for (int j = 0; j < 9; ++j) a[j] = 0.f;
    for (int kk = 0; kk < 128; kk += 16) {
        float w[16];
#pragma unroll
        for (int u = 0; u < 16; ++u) w[u] = W[(size_t)(wid * 128 + kk + u) * 6144];
#pragma unroll
        for (int u = 0; u < 16; ++u)
#pragma unroll
            for (int j = 0; j < 9; ++j) a[j] += sc[j * 1024 + wid * 128 + kk + u] * w[u];
    }
#pragma unroll
    for (int j = 0; j < 9; ++j) red[(wid * 9 + j) * 64 + lane] = a[j];
    __syncthreads();
    for (int i = tid; i < 9 * 64; i += 512) {
        const int j = i >> 6, n = i & 63; float s = 0.f;
#pragma unroll
        for (int w = 0; w < 8; ++w) s += red[(w * 9 + j) * 64 + n];
        ((float*)(ptr_l(P.ws) + WS_MOD))[((size_t)l * 9 + j) * 6144 + n0 + n] = s + P.in[5][(size_t)l * 6144 + n0 + n];
    }
    __syncthreads();
}

DEVI void ssm_tab_unit(char* lds, const Params& P, int l, int d, int g) {
    float* pw = (float*)lds;
    float* bb = pw + 64 * 17 * 2;
    float* cc = bb + 64 * 16 * 2;
    const int tid = tid_l();
    const size_t ldg = ((size_t)l * 2 + d) * 32 + g;
    const float dt = expf(P.in[16][ldg]);
    float* PW = (float*)(ptr_l(P.ws) + WS_PW) + ldg * 64 * 17 * 2;
    float* BB = (float*)(ptr_l(P.ws) + WS_BBAR) + ldg * 64 * 16 * 2;
    for (int i = tid; i < 64 * 17; i += 512) {
        const int p = i / 17, n = i - p * 17;
        const float lr = P.in[14][ldg * 64 + p], li = P.in[15][ldg * 64 + p];
        const float mag = expf(lr * dt * n); float s, c; sincosf(li * dt * n, &s, &c);
        pw[i * 2] = mag * c; pw[i * 2 + 1] = mag * s; PW[i * 2] = mag * c; PW[i * 2 + 1] = mag * s;
    }
    for (int i = tid; i < 64 * 16; i += 512) {
        const int p = i >> 4, h = i & 15;
        const float lr = P.in[14][ldg * 64 + p], li = P.in[15][ldg * 64 + p];
        const float mag = expf(lr * dt); float s, c; sincosf(li * dt, &s, &c);
        const float nr = mag * c - 1.f, ni = mag * s;
        const float den = lr * lr + li * li;
        const float qr = (nr * lr + ni * li) / den, qi = (ni * lr - nr * li) / den;
        const float br = P.in[17][(ldg * 64 + p) * 16 + h], bi = P.in[18][(ldg * 64 + p) * 16 + h];
        const float xr = qr * br - qi * bi, xi = qr * bi + qi * br;
        bb[i * 2] = xr; bb[i * 2 + 1] = xi; BB[i * 2] = xr; BB[i * 2 + 1] = xi;
    }
    for (int i = tid; i < 16 * 64; i += 512) { cc[i * 2] = P.in[19][ldg * 1024 + i]; cc[i * 2 + 1] = P.in[20][ldg * 1024 + i]; }
    __syncthreads();
    float* KT = (float*)(ptr_l(P.ws) + WS_KTAB) + ldg * 4096;
    for (int i = tid; i < 4096; i += 512) {
        const int dl = i >> 8, h = (i >> 4) & 15, h2 = i & 15;
        float s = 0.f;
        for (int p = 0; p < 64; ++p) {
            const float cr = cc[(h * 64 + p) * 2], ci = cc[(h * 64 + p) * 2 + 1];
            const float wr = pw[(p * 17 + dl) * 2], wi = pw[(p * 17 + dl) * 2 + 1];
            const float br = bb[(p * 16 + h2) * 2], bi = bb[(p * 16 + h2) * 2 + 1];
            const float tr = cr * wr - ci * wi, ti = cr * wi + ci * wr;
            s += tr * br - ti * bi;
        }
        KT[i] = s;
    }
    __syncthreads();
}

template <bool FIRST>
DEVI void rowpass1(const Params& P, int l) {
    const int tid = tid_l(), lane = tid & 63, wid = tid >> 6;
    bf16_t* X = (bf16_t*)(ptr_l(P.ws) + WS_X); bf16_t* HX = (bf16_t*)(ptr_l(P.ws) + WS_HX);
    const bf16_t* OG = (const bf16_t*)(ptr_l(P.ws) + WS_OG); const int* SLOT = (const int*)(ptr_l(P.ws) + WS_SLOT);
    const float* MOD = (const float*)(ptr_l(P.ws) + WS_MOD);
    const int stride = gridDim.x * 8;
    int r = blockIdx.x * 8 + wid;
    f32x4 xf[4]; u32x2 xb[4]; int svn = -1;
    auto issue = [&](int rr) {
        if constexpr (FIRST) {
            const int b = rr / LP, p = rr - b * LP;
            const float* src = p < CTXL ? P.in[2] + ((size_t)b * CTXL + p) * 1024 : P.in[0] + ((size_t)b * SEQ + (p - CTXL)) * 1024;
#pragma unroll
            for (int i = 0; i < 4; ++i) xf[i] = *(const f32x4*)(src + lane * 4 + 256 * i);
        } else {
#pragma unroll
            for (int i = 0; i < 4; ++i) xb[i] = *(const u32x2*)(X + (size_t)rr * 1024 + lane * 4 + 256 * i);
            svn = SLOT[(size_t)rr * 16 + (lane & 15)];
        }
    };
    if (r < R) issue(r);
    for (; r < R; r += stride) {
        const int b = r / LP, p = r - b * LP, j = p < CTXL ? 8 : b;
        f32x4 x[4]; const int sv = svn;
#pragma unroll
        for (int i = 0; i < 4; ++i) { if constexpr (FIRST) x[i] = xf[i]; else x[i] = hf4(xb[i]); }
        if (r + stride < R) issue(r + stride);
        if (l == DEPTH && p < CTXL) continue;
        if constexpr (!FIRST) {
            const float* g2 = MOD + ((size_t)(l - 1) * 9 + j) * 6144 + 5 * 1024;
            f32x4 m[4];
#pragma unroll
            for (int i = 0; i < 4; ++i) m[i] = (f32x4){0.f, 0.f, 0.f, 0.f};
            unsigned mask = (unsigned)__ballot(sv >= 0 && lane < 16) & 0xffffu;
            while (mask) {
                const int e0 = __builtin_ctz(mask); mask &= mask - 1;
                const int s0 = __builtin_amdgcn_readlane(sv, e0);
                const bool two = mask != 0u;
                const int e1 = two ? __builtin_ctz(mask) : e0; if (two) mask &= mask - 1;
                const int s1 = __builtin_amdgcn_readlane(sv, e1);
                const bf16_t* o0 = OG + ((size_t)e0 * ROWS_E + s0) * 1024 + lane * 4; const bf16_t* o1 = OG + ((size_t)e1 * ROWS_E + s1) * 1024 + lane * 4;
                u32x2 w0[4], w1[4];
#pragma unroll
                for (int i = 0; i < 4; ++i) { w0[i] = *(const u32x2*)(o0 + 256 * i); w1[i] = *(const u32x2*)(o1 + 256 * i); }
                const float f1 = two ? 1.f : 0.f;
#pragma unroll
                for (int i = 0; i < 4; ++i) m[i] += bf4(w0[i]) + f1 * bf4(w1[i]);
            }
#pragma unroll
            for (int i = 0; i < 4; ++i) { const f32x4 g = *(const f32x4*)(g2 + lane * 4 + 256 * i); x[i] += g * m[i]; }
        }
        float ss = 0.f;
#pragma unroll
        for (int i = 0; i < 4; ++i) ss += x[i].x * x[i].x + x[i].y * x[i].y + x[i].z * x[i].z + x[i].w * x[i].w;
        ss = wave_sum(ss);
        const float rstd = rsqrtf(ss * (1.f / 1024.f) + EPS);
        if (l < DEPTH) {
            const float* ng = P.in[6] + (size_t)l * 1024; const float* sh = MOD + ((size_t)l * 9 + j) * 6144; const float* scl = sh + 1024;
#pragma unroll
            for (int i = 0; i < 4; ++i) {
                const int c = lane * 4 + 256 * i;
                u32x2 xw; xw.x = hpk2(x[i].x, x[i].y); xw.y = hpk2(x[i].z, x[i].w);
                *(u32x2*)(X + (size_t)r * 1024 + c) = xw;
                const f32x4 g = *(const f32x4*)(ng + c), s1 = *(const f32x4*)(scl + c), s0 = *(const f32x4*)(sh + c);
                const f32x4 h = (x[i] * rstd * g) * (1.f + s1) + s0;
                u32x2 w; w.x = pk2(h.x, h.y); w.y = pk2(h.z, h.w);
                *(u32x2*)(HX + (size_t)r * 1024 + c) = w;
            }
        } else {
            float* o = P.out + ((size_t)b * SEQ + (p - CTXL)) * 1024;
#pragma unroll
            for (int i = 0; i < 4; ++i) { const int c = lane * 4 + 256 * i; const f32x4 g = *(const f32x4*)(P.in[29] + c); *(f32x4*)(o + c) = x[i] * rstd * g; }
        }
    }
}

DEVI float router_fold_softmax(const float (&pa)[16], int lane) {
    float q8[8], q4[4], q2[2];
#pragma unroll
    for (int i = 0; i < 8; ++i) { float r0, r1; swap32(pa[i], pa[i + 8], r0, r1); q8[i] = r0 + r1; }
#pragma unroll
    for (int i = 0; i < 4; ++i) { float r0, r1; swap16(q8[i], q8[i + 4], r0, r1); q4[i] = r0 + r1; }
    { const bool hb = (lane & 8) != 0;
#pragma unroll
      for (int i = 0; i < 2; ++i) { const float snd = hb ? q4[i] : q4[i + 2], kp = hb ? q4[i + 2] : q4[i]; q2[i] = kp + dppmov<0x128>(snd); } }
    float lg;
    { const bool hb = (lane & 4) != 0; const float snd = hb ? q2[0] : q2[1], kp = hb ? q2[1] : q2[0];
      const float up = dppmov<0x104>(snd), dn = dppmov<0x114>(snd);
      lg = kp + (hb ? dn : up); }
    lg += dppmov<0x4E>(lg); lg += dppmov<0xB1>(lg);
    float mx = fmaxf(lg, dppmov<0x124>(lg)); mx = fmaxf(mx, dppmov<0x128>(mx));
    { float r0, r1; swap16(mx, mx, r0, r1); mx = fmaxf(r0, r1); swap32(mx, mx, r0, r1); mx = fmaxf(r0, r1); }
    const float ex = expf(lg - mx);
    float sum = ex + dppmov<0x124>(ex); sum += dppmov<0x128>(sum);
    { float r0, r1; swap16(sum, sum, r0, r1); sum = r0 + r1; swap32(sum, sum, r0, r1); sum = r0 + r1; }
    return ex / sum;
}
DEVI void rowpass2(char* lds, const Params& P, int l) {
    const int tid = tid_l(), lane = tid & 63, wid = tid >> 6;
    float* wrT = (float*)lds;
    const float* wr = P.in[25] + (size_t)l * 1024 * 16;
    for (int i = tid; i < 16384; i += 512) { const int k = i >> 4, e = i & 15; wrT[e * 1024 + k] = wr[i]; }
    __syncthreads();
    const bf16_t* X = (const bf16_t*)(ptr_l(P.ws) + WS_X); bf16_t* HX = (bf16_t*)(ptr_l(P.ws) + WS_HX);
    const float* MOD = (const float*)(ptr_l(P.ws) + WS_MOD); float* AFFT = (float*)(ptr_l(P.ws) + WS_AFFT);
    const float* ng = P.in[7] + (size_t)l * 1024;
    const int stride = gridDim.x * 8;
    int r = blockIdx.x * 8 + wid;
    u32x2 xn[2][4];
#pragma unroll
    for (int q = 0; q < 2; ++q) if (r + q * stride < R) {
#pragma unroll
        for (int i = 0; i < 4; ++i) xn[q][i] = *(const u32x2*)(X + (size_t)(r + q * stride) * 1024 + lane * 4 + 256 * i);
    }
    for (; r < R; r += 2 * stride) {
        const bool two = r + stride < R;
        f32x4 h[2][4]; int bb[2], pp[2];
#pragma unroll
        for (int q = 0; q < 2; ++q) {
            const int rq = (q == 0 || two) ? r + q * stride : r;
            const int b = rq / LP, p = rq - b * LP, j = p < CTXL ? 8 : b; bb[q] = b; pp[q] = p;
            float ss = 0.f;
#pragma unroll
            for (int i = 0; i < 4; ++i) { h[q][i] = hf4(xn[q][i]); ss += h[q][i].x * h[q][i].x + h[q][i].y * h[q][i].y + h[q][i].z * h[q][i].z + h[q][i].w * h[q][i].w; }
            ss = wave_sum(ss);
            const float rstd = rsqrtf(ss * (1.f / 1024.f) + EPS);
            const float* sh = MOD + ((size_t)l * 9 + j) * 6144 + 3 * 1024; const float* scl = sh + 1024;
#pragma unroll
            for (int i = 0; i < 4; ++i) {
                const int c = lane * 4 + 256 * i;
                const f32x4 g = *(const f32x4*)(ng + c), s1 = *(const f32x4*)(scl + c), s0 = *(const f32x4*)(sh + c);
                h[q][i] = (h[q][i] * rstd * g) * (1.f + s1) + s0;
                if (q == 0 || two) { u32x2 w; w.x = pk2(h[q][i].x, h[q][i].y); w.y = pk2(h[q][i].z, h[q][i].w); *(u32x2*)(HX + (size_t)rq * 1024 + c) = w; }
            }
        }
#pragma unroll
        for (int q = 0; q < 2; ++q) if (r + (2 + q) * stride < R) {
#pragma unroll
            for (int i = 0; i < 4; ++i) xn[q][i] = *(const u32x2*)(X + (size_t)(r + (2 + q) * stride) * 1024 + lane * 4 + 256 * i);
        }
        float pa[2][16];
#pragma unroll
        for (int eg = 0; eg < 4; ++eg) {
#pragma unroll
            for (int e = 4 * eg; e < 4 * eg + 4; ++e) {
                float s0 = 0.f, s1 = 0.f;
#pragma unroll
                for (int i = 0; i < 4; ++i) { const f32x4 w = *(const f32x4*)(wrT + e * 1024 + lane * 4 + 256 * i);
                    s0 += h[0][i].x * w.x + h[0][i].y * w.y + h[0][i].z * w.z + h[0][i].w * w.w; s1 += h[1][i].x * w.x + h[1][i].y * w.y + h[1][i].z * w.z + h[1][i].w * w.w; }
                pa[0][e] = s0; pa[1][e] = s1;
            }
            asm volatile("" ::: "memory");
        }
        const float a0 = router_fold_softmax(pa[0], lane), a1 = router_fold_softmax(pa[1], lane);
        if ((lane & 3) == 0) {
            AFFT[((size_t)bb[0] * 16 + (lane >> 2)) * LP + pp[0]] = a0;
            if (two) AFFT[((size_t)bb[1] * 16 + (lane >> 2)) * LP + pp[1]] = a1;
        }
    }
    __syncthreads();
}

DEVI int block_sum_i(int v, volatile int* red, int par, int wid, int lane) {
    if (lane == 0) red[par * 8 + wid] = v;
    __syncthreads();
    int s = 0;
#pragma unroll
    for (int w = 0; w < 8; ++w) s += red[par * 8 + w];
    return s;
}
DEVI int wave_incl_scan_i(int v, int lane) {
#pragma unroll
    for (int o = 1; o < 64; o <<= 1) { const int t = __shfl_up(v, o); if (lane >= o) v += t; }
    return v;
}
DEVI void select_unit(char* lds, const Params& P, int b, int e, bool lat) {
    volatile int* red = (volatile int*)lds;
    volatile int* wtot = (volatile int*)(lds + 64);
    const int tid = tid_l(), lane = tid & 63, wid = tid >> 6;
    const int n = lat ? SEQ : CTXL, K = lat ? CAPL : CAPC, p0 = lat ? CTXL : 0;
    const bool act = 8 * tid < n;
    const float* src = (const float*)(ptr_l(P.ws) + WS_AFFT) + ((size_t)b * 16 + e) * LP + p0 + 8 * tid;
    unsigned bits[8];
    if (act) { const u32x4 v0 = *(const u32x4*)src, v1 = *(const u32x4*)(src + 4); bits[0] = v0.x; bits[1] = v0.y; bits[2] = v0.z; bits[3] = v0.w; bits[4] = v1.x; bits[5] = v1.y; bits[6] = v1.z; bits[7] = v1.w; }
    else {
#pragma unroll
        for (int j = 0; j < 8; ++j) bits[j] = 0u;
    }
    unsigned prefix = 0u; int par = 0;
    for (int bit = 30; bit >= 0; --bit) {
        const unsigned cand = prefix | (1u << bit);
        int c = 0;
#pragma unroll
        for (int j = 0; j < 8; ++j) c += (int)__popcll(__ballot(bits[j] >= cand));
        const int tot = block_sum_i(c, red, par, wid, lane); par ^= 1;
        if (tot >= K) prefix = cand;
    }
    int cg = 0, ceq = 0;
#pragma unroll
    for (int j = 0; j < 8; ++j) { cg += (int)__popcll(__ballot(bits[j] > prefix)); ceq += (bits[j] == prefix) ? 1 : 0; }
    const int need = K - block_sum_i(cg, red, par, wid, lane); par ^= 1;
    int inc = wave_incl_scan_i(ceq, lane);
    if (lane == 63) wtot[par * 8 + wid] = inc;
    __syncthreads();
    int eqb = inc - ceq;
    for (int w = 0; w < wid; ++w) eqb += wtot[par * 8 + w];
    par ^= 1;
    bool sel[8]; int ns = 0;
#pragma unroll
    for (int j = 0; j < 8; ++j) { const bool eq = bits[j] == prefix; sel[j] = (bits[j] > prefix) || (eq && eqb < need); eqb += eq ? 1 : 0; ns += sel[j] ? 1 : 0; }
    inc = wave_incl_scan_i(ns, lane);
    if (lane == 63) wtot[par * 8 + wid] = inc;
    __syncthreads();
    int sb = inc - ns;
    for (int w = 0; w < wid; ++w) sb += wtot[par * 8 + w];
    if (act) {
        int* SLOT = (int*)(ptr_l(P.ws) + WS_SLOT); float* GATE = (float*)(ptr_l(P.ws) + WS_GATE); int* IDX = (int*)(ptr_l(P.ws) + WS_IDX);
#pragma unroll
        for (int j = 0; j < 8; ++j) {
            const int tok = b * LP + p0 + 8 * tid + j;
            if (sel[j]) {
                const int row = (lat ? b * CAPL : NB * CAPL + b * CAPC) + sb; ++sb;
                SLOT[(size_t)tok * 16 + e] = row; GATE[(size_t)e * ROWS_E + row] = __builtin_bit_cast(float, bits[j]); IDX[(size_t)e * ROWS_E + row] = tok;
            } else SLOT[(size_t)tok * 16 + e] = -1;
        }
    }
    __syncthreads();
}
DEVI void gather_rows(const Params& P, bool last) {
    const int tid = tid_l(), lane = tid & 63, wid = tid >> 6;
    const bf16_t* HX = (const bf16_t*)(ptr_l(P.ws) + WS_HX); bf16_t* XG = (bf16_t*)(ptr_l(P.ws) + WS_XG); const int* IDX = (const int*)(ptr_l(P.ws) + WS_IDX);
    const int stride = gridDim.x * 8;
    for (int r0 = blockIdx.x * 8 + wid; r0 < 16 * ROWS_E; r0 += 4 * stride) {
        u32x4 v[4][2];
#pragma unroll
        for (int q = 0; q < 4; ++q) { const int r = r0 + q * stride; if (r < 16 * ROWS_E && !(last && (r % ROWS_E) >= NB * CAPL)) { const u32x4* s = (const u32x4*)(HX + (size_t)IDX[r] * 1024); v[q][0] = s[lane]; v[q][1] = s[lane + 64]; } }
#pragma unroll
        for (int q = 0; q < 4; ++q) { const int r = r0 + q * stride; if (r < 16 * ROWS_E && !(last && (r % ROWS_E) >= NB * CAPL)) { u32x4* d = (u32x4*)(XG + (size_t)r * 1024); d[lane] = v[q][0]; d[lane + 64] = v[q][1]; } }
    }
}

DEVI int scan_ci(int d, int k) { return d == 0 ? k : (k < 16 ? 15 - k : 287 - k); }
DEVI void scan_block(char* lds, const Params& P, int l, int unit0) {
    const int tid = tid_l(), lane = tid & 63, wid = tid >> 6, seg = wid & 3, unit = unit0 + (wid >> 2);
    const int d = unit & 1, g = (unit >> 1) & 31, b = unit >> 6;
    const size_t ldg = ((size_t)l * 2 + d) * 32 + g;
    const float dt = expf(P.in[16][ldg]);
    const float lr = P.in[14][ldg * 64 + lane], li = P.in[15][ldg * 64 + lane];
    const float mag = expf(lr * dt * 16.f); float sn, cs; sincosf(li * dt * 16.f, &sn, &cs);
    const float ar = mag * cs, ai = mag * sn;
    const unsigned short* E = (const unsigned short*)(ptr_l(P.ws) + WS_EB) + (size_t)g * NCHP * 256 + d * 128 + lane * 2;
    bf16_t* S = (bf16_t*)(ptr_l(P.ws) + WS_US) + (size_t)g * NCHP * 512 + 256 + d * 128 + lane * 2;
    f32x2* ends = (f32x2*)lds + (size_t)(wid >> 2) * 4 * 64;
    const int k0 = seg * 68;
    float sr = 0.f, si = 0.f;
    for (int kk = 0; kk < 68; kk += 17) {
        unsigned ev[17];
#pragma unroll
        for (int u = 0; u < 17; ++u) ev[u] = *(const unsigned*)(E + (size_t)chunk_row(b, scan_ci(d, k0 + kk + u)) * 256);
#pragma unroll
        for (int u = 0; u < 17; ++u) { const float nr = ar * sr - ai * si + hlo(ev[u]), ni = ar * si + ai * sr + hhi(ev[u]); sr = nr; si = ni; }
    }
    ends[seg * 64 + lane] = (f32x2){sr, si};
    float pr = ar, pi = ai, p4r = 0.f, p4i = 0.f;
#pragma unroll
    for (int q = 0; q < 6; ++q) { const float nr = pr * pr - pi * pi, ni = 2.f * pr * pi; pr = nr; pi = ni; if (q == 1) { p4r = pr; p4i = pi; } }
    const float br = pr * p4r - pi * p4i, bi = pr * p4i + pi * p4r;
    __syncthreads();
    sr = 0.f; si = 0.f;
    for (int j = 0; j < seg; ++j) { const f32x2 e = ends[j * 64 + lane]; const float nr = br * sr - bi * si + e.x, ni = br * si + bi * sr + e.y; sr = nr; si = ni; }
    for (int kk = 0; kk < 68; kk += 17) {
        unsigned ev[17];
#pragma unroll
        for (int u = 0; u < 17; ++u) ev[u] = *(const unsigned*)(E + (size_t)chunk_row(b, scan_ci(d, k0 + kk + u)) * 256);
#pragma unroll
        for (int u = 0; u < 17; ++u) {
            *(unsigned*)(S + (size_t)chunk_row(b, scan_ci(d, k0 + kk + u)) * 512) = pk2(sr, si);
            const float nr = ar * sr - ai * si + hlo(ev[u]), ni = ar * si + ai * sr + hhi(ev[u]); sr = nr; si = ni;
        }
    }
    __syncthreads();
}

DEVI float max3f(float a, float b, float c) { return fmaxf(fmaxf(a, b), c); }
DEVI float xhalf_max(float x) { const unsigned u = __builtin_bit_cast(unsigned, x); const auto r = __builtin_amdgcn_permlane32_swap(u, u, false, false); return fmaxf(__builtin_bit_cast(float, (unsigned)r[0]), __builtin_bit_cast(float, (unsigned)r[1])); }
DEVI float xhalf_sum(float x) { const unsigned u = __builtin_bit_cast(unsigned, x); const auto r = __builtin_amdgcn_permlane32_swap(u, u, false, false); return __builtin_bit_cast(float, (unsigned)r[0]) + __builtin_bit_cast(float, (unsigned)r[1]); }
DEVI void attn_unit(char* lds, const Params& P, int l, int b, int head, int q0  , int nkeys, float lam, float lam_init) {
    const int tid = tid_l(), lane = tid & 63, wid = tid >> 6, qg = wid >> 1, which = wid & 1, r32 = lane & 31, hi = lane >> 5;
    const bf16_t* QK = (const bf16_t*)(ptr_l(P.ws) + WS_QK);
    const bf16_t* Qs = QK + ((size_t)((which * NB + b) * NH + head) * LP) * 64;
    const bf16_t* K1 = QK + ((size_t)((2 * NB + b) * NH + head) * LP) * 64;
    const bf16_t* K2 = QK + ((size_t)((3 * NB + b) * NH + head) * LP) * 64;
    const bf16_t* Vt = (const bf16_t*)(ptr_l(P.ws) + WS_VT) + (size_t)(b * NH + head) * 128 * LP;
    bf16x8 qf[4];
#pragma unroll
    for (int ks = 0; ks < 4; ++ks) qf[ks] = *(const bf16x8*)(Qs + (size_t)(q0 + qg * 32 + r32) * 64 + ks * 16 + hi * 8);
    f32x16 o[4];
#pragma unroll
    for (int t = 0; t < 4; ++t)
#pragma unroll
        for (int i = 0; i < 16; ++i) o[t][i] = 0.f;
    float m = 0.f, lsum = 0.f;
    const int nt = nkeys >> 6;
    const int drow = wid * 8 + (lane >> 3), dkc = (lane & 7) ^ ((drow >> 1) & 7);
    const unsigned koff = (unsigned)(drow * 64 + dkc * 8), voff = (unsigned)(drow * LP + dkc * 8);
    LAS unsigned char* dl = (LAS unsigned char*)lds + wid * 1024;
#define GLDS(g, off) __builtin_amdgcn_global_load_lds((const unsigned*)(g), (LAS unsigned*)(dl + (off)), 16, 0, 0)
#define K_DMA(kt, s) do { GLDS((K1 + (size_t)(kt) * 4096) + koff, (s) * 16384); GLDS((K2 + (size_t)(kt) * 4096) + koff, (s) * 16384 + 8192); } while (0)
#define V_DMA(kt, s) do { GLDS((Vt + (kt) * 64) + voff, 32768 + (s) * 16384); GLDS((Vt + (kt) * 64 + 64 * LP) + voff, 32768 + (s) * 16384 + 8192); } while (0)
#define QKT(dst, s, init) do { const char* _k = lds + (s) * 16384 + which * 8192; \
        _Pragma("unroll") for (int t2 = 0; t2 < 2; ++t2) _Pragma("unroll") for (int i = 0; i < 16; ++i) dst[t2][i] = (init); \
        _Pragma("unroll") for (int ks = 0; ks < 4; ++ks) _Pragma("unroll") for (int t2 = 0; t2 < 2; ++t2) { \
            const bf16x8 kf = *(const bf16x8*)(_k + swz(t2 * 32 + r32, ks * 2 + hi)); dst[t2] = MFMA32(kf, qf[ks], dst[t2]); } } while (0)
    K_DMA(0, 0); V_DMA(0, 0); K_DMA(1, 1);
    __syncthreads();
    f32x16 sc[2], sn[2];
    QKT(sc, 0, 0.f);
    __syncthreads();
    {
        float tm = max3f(sc[0][0], sc[0][1], sc[0][2]);
#pragma unroll
        for (int i = 3; i < 15; i += 2) tm = max3f(tm, sc[0][i], sc[0][i + 1]);
        tm = fmaxf(tm, sc[0][15]);
#pragma unroll
        for (int i = 0; i < 16; i += 2) tm = max3f(tm, sc[1][i], sc[1][i + 1]);
        tm = xhalf_max(tm);
        m = tm;
#pragma unroll
        for (int t2 = 0; t2 < 2; ++t2)
#pragma unroll
            for (int i = 0; i < 16; ++i) sc[t2][i] -= m;
    }
#define SB() __builtin_amdgcn_sched_barrier(0)
#define SGB(mask, n) __builtin_amdgcn_sched_group_barrier(mask, n, 0)
    int fo[4];
#pragma unroll
    for (int j = 0; j < 4; ++j) fo[j] = swz(r32, 2 * j + hi);
    const char* kbase = lds + which * 8192;
    const char* vbase = lds + 32768;
#define ATT_STEP(KT, PAR, SC, SN) do { \
        const bool has1 = (KT) + 1 < nt, has2 = (KT) + 2 < nt; \
        if (has2) K_DMA((KT) + 2, PAR); \
        if (has1) V_DMA((KT) + 1, 1 - (PAR)); \
        const char* kst = kbase + (1 - (PAR)) * 16384; \
        const char* vs = vbase + (PAR) * 16384; \
        bf16x8 kf[8]; \
        _Pragma("unroll") for (int ks = 0; ks < 4; ++ks) _Pragma("unroll") for (int t2 = 0; t2 < 2; ++t2) kf[ks * 2 + t2] = *(const bf16x8*)(kst + fo[ks] + t2 * 4096); \
        SB(); \
        _Pragma("unroll") for (int t2 = 0; t2 < 2; ++t2) _Pragma("unroll") for (int i = 0; i < 16; ++i) SN[t2][i] = -m; \
        _Pragma("unroll") for (int ks = 0; ks < 4; ++ks) _Pragma("unroll") for (int t2 = 0; t2 < 2; ++t2) SN[t2] = MFMA32(kf[ks * 2 + t2], qf[ks], SN[t2]); \
        bf16x8 va[4], vb[4]; \
        _Pragma("unroll") for (int t = 0; t < 4; ++t) va[t] = *(const bf16x8*)(vs + fo[0] + t * 4096); \
        SGB(0x002, 16); SGB(0x008, 8); SGB(0x100, 4); SB(); \
        if (__any(pprev > 4096.f)) {        \
            const float pr = xhalf_sum(pprev); \
            const float dl = pr > 4096.f ? (float)((int)((__builtin_bit_cast(unsigned, pr) >> 23) & 255u) - 127) : 0.f, al = fast_exp2(-dl); \
            m += dl; lsum *= al; \
            _Pragma("unroll") for (int t = 0; t < 4; ++t) _Pragma("unroll") for (int i = 0; i < 16; ++i) o[t][i] *= al; \
            _Pragma("unroll") for (int t2 = 0; t2 < 2; ++t2) _Pragma("unroll") for (int i = 0; i < 16; ++i) { SC[t2][i] -= dl; SN[t2][i] -= dl; } \
        } \
        float ps = 0.f; \
        _Pragma("unroll") for (int t2 = 0; t2 < 2; ++t2) _Pragma("unroll") for (int i = 0; i < 16; ++i) { SC[t2][i] = fast_exp2(SC[t2][i]); ps += SC[t2][i]; } \
        lsum += ps; pprev = ps; \
        bf16x8 pf[4]; \
        _Pragma("unroll") for (int t2 = 0; t2 < 2; ++t2) _Pragma("unroll") for (int sh = 0; sh < 2; ++sh) { \
            u32x4 pw; pw.x = pk2(SC[t2][8 * sh], SC[t2][8 * sh + 1]); pw.y = pk2(SC[t2][8 * sh + 2], SC[t2][8 * sh + 3]); \
            pw.z = pk2(SC[t2][8 * sh + 4], SC[t2][8 * sh + 5]); pw.w = pk2(SC[t2][8 * sh + 6], SC[t2][8 * sh + 7]); \
            pf[t2 * 2 + sh] = __builtin_bit_cast(bf16x8, pw); } \
        SB(); \
        _Pragma("unroll") for (int t = 0; t < 4; ++t) vb[t] = *(const bf16x8*)(vs + fo[1] + t * 4096); \
        _Pragma("unroll") for (int t = 0; t < 4; ++t) o[t] = MFMA32(va[t], pf[0], o[t]); \
        SGB(0x100, 4); SGB(0x008, 4); SB(); \
        _Pragma("unroll") for (int t = 0; t < 4; ++t) va[t] = *(const bf16x8*)(vs + fo[2] + t * 4096); \
        _Pragma("unroll") for (int t = 0; t < 4; ++t) o[t] = MFMA32(vb[t], pf[1], o[t]); \
        SGB(0x100, 4); SGB(0x008, 4); SB(); \
        _Pragma("unroll") for (int t = 0; t < 4; ++t) vb[t] = *(const bf16x8*)(vs + fo[3] + t * 4096); \
        _Pragma("unroll") for (int t = 0; t < 4; ++t) o[t] = MFMA32(va[t], pf[2], o[t]); \
        SGB(0x100, 4); SGB(0x008, 4); SB(); \
        _Pragma("unroll") for (int t = 0; t < 4; ++t) o[t] = MFMA32(vb[t], pf[3], o[t]); \
        SB(); \
        __syncthreads(); \
    } while (0)
    float pprev = 0.f;
    for (int kt = 0; kt < nt; kt += 2) {
        ATT_STEP(kt, 0, sc, sn);
        ATT_STEP(kt + 1, 1, sn, sc);
    }
#undef ATT_STEP
#undef SB
#undef SGB
#undef GLDS
#undef K_DMA
#undef V_DMA
#undef QKT
    lsum = xhalf_sum(lsum);
    const float inv = 1.f / lsum;
    float* xb = (float*)lds + (size_t)qg * 4096;
    if (which == 1) {
#pragma unroll
        for (int t = 0; t < 4; ++t)
#pragma unroll
            for (int i = 0; i < 16; ++i) xb[(t * 16 + i) * 64 + lane] = o[t][i] * inv;
    }
    __syncthreads();
    if (which == 0) {
        float ss = 0.f;
#pragma unroll
        for (int t = 0; t < 4; ++t)
#pragma unroll
            for (int i = 0; i < 16; ++i) { const float v = o[t][i] * inv - lam * xb[(t * 16 + i) * 64 + lane]; o[t][i] = v; ss += v * v; }
        ss = xhalf_sum(ss);
        const float rs = rsqrtf(ss * (1.f / 128.f) + EPS) * (1.f - lam_init);
        const float* sg = P.in[13] + (size_t)l * 128;
        bf16_t* dst = (bf16_t*)(ptr_l(P.ws) + WS_MIX) + ((size_t)b * LP + q0 + qg * 32 + r32) * 1024 + head * 128 + 4 * hi;
#pragma unroll
        for (int t = 0; t < 4; ++t)
#pragma unroll
            for (int i4 = 0; i4 < 4; ++i4) {
                const f32x4 g = *(const f32x4*)(sg + t * 32 + 8 * i4 + 4 * hi);
                u32x2 w; w.x = pk2(o[t][4 * i4] * rs * g.x, o[t][4 * i4 + 1] * rs * g.y); w.y = pk2(o[t][4 * i4 + 2] * rs * g.z, o[t][4 * i4 + 3] * rs * g.w);
                *(u32x2*)(dst + t * 32 + 8 * i4) = w;
            }
    }
    __syncthreads();
}

struct ConvTile { const float* src; bf16_t* dst; int K, N, mode; };
DEVI ConvTile conv_tile(const Params& P, unsigned char* w, int l, int u) {
    if (u < 4096) { const int w3 = u >= 2048; const int v = u & 2047, le = l * 16 + (v >> 7), k = (v >> 3) & 15, n = v & 7;
        return {P.in[w3 ? 27 : 26] + (size_t)le * 1024 * 2048 + (size_t)(k * 64) * 2048 + n * 256, (bf16_t*)(w + WS_W13T) + (size_t)le * 4096 * 1024 + k * 64, 1024, 2048, (n * 256) | ((1 + w3) << 16)}; }
    const int v = u - 4096, le = l * 16 + (v >> 7), k = (v >> 2) & 31, n = v & 3;
    return {P.in[28] + (size_t)le * 2048 * 1024 + (size_t)(k * 64) * 1024 + n * 256, (bf16_t*)(w + WS_W2T) + (size_t)le * 1024 * 2048 + k * 64, 2048, 1024, n * 256};
}
#define CV_LOAD(v, t) do { const unsigned voff_ = (unsigned)((2 * (tid >> 6)) * (t).N + (tid & 63) * 4) * 4u; \
        _Pragma("unroll") for (int i = 0; i < 8; ++i) { const float* sb_ = (t).src + (size_t)((i >> 1) * 16 + (i & 1)) * (t).N; \
        asm volatile("s_nop 4\n\tglobal_load_dwordx4 %0, %1, %2\n\ts_nop 1" : "=&v"(v[i]) : "v"(voff_), "s"(sb_) : "memory"); } } while (0)
#define CV_WAIT(v, N) asm volatile("s_waitcnt vmcnt(" #N ")" : "+v"(v[0]), "+v"(v[1]), "+v"(v[2]), "+v"(v[3]), "+v"(v[4]), "+v"(v[5]), "+v"(v[6]), "+v"(v[7]) :: "memory")
#define CV_STEP(v, t, N, UNEXT) do { \
        unsigned* tile = (unsigned*)lds + par * (32 * 256); par ^= 1; \
        CV_WAIT(v, N); \
        _Pragma("unroll") for (int j = 0; j < 4; ++j) { const int kp = (tid >> 6) + 8 * j; \
            u32x4 wv; wv.x = pk2(v[2 * j].x, v[2 * j + 1].x); wv.y = pk2(v[2 * j].y, v[2 * j + 1].y); wv.z = pk2(v[2 * j].z, v[2 * j + 1].z); wv.w = pk2(v[2 * j].w, v[2 * j + 1].w); \
            *(u32x4*)(tile + kp * 256 + (((tid & 63) * 4) ^ (((kp >> 2) & 7) << 3))) = wv; } \
        const ConvTile cur = t; \
        if ((UNEXT) >= 0) { t = conv_tile(P, w, l, (UNEXT)); CV_LOAD(v, t); } \
        asm volatile("s_waitcnt lgkmcnt(0)\n\ts_barrier" ::: "memory"); \
        const int n0 = cur.mode & 0xffff, mode = cur.mode >> 16; \
        _Pragma("unroll") for (int i = 0; i < 4; ++i) { \
            const int c = tid + 512 * i, n = c >> 3, kq = c & 7; \
            u32x4 o; o.x = tile[(4 * kq) * 256 + (n ^ (kq << 3))]; o.y = tile[(4 * kq + 1) * 256 + (n ^ (kq << 3))]; o.z = tile[(4 * kq + 2) * 256 + (n ^ (kq << 3))]; o.w = tile[(4 * kq + 3) * 256 + (n ^ (kq << 3))]; \
            const int ng = n0 + n; const int orow = mode == 0 ? ng : ((ng >> 7) * 256 + (mode - 1) * 128 + (ng & 127)); \
            const unsigned so_ = (unsigned)(orow * cur.K + 8 * kq) * 2u; \
            asm volatile("s_nop 4\n\tglobal_store_dwordx4 %0, %1, %2\n\ts_nop 1" :: "v"(so_), "v"(o), "s"(cur.dst) : "memory"); \
        } } while (0)
DEVI void conv_share(char* lds, const Params& P, int l, int bid, int G) {
    unsigned char* w = ptr_l(P.ws);
    const int tid = tid_l();
    if (G != 256) {
        for (int u = bid; u < 3 * 2048; u += G) {
            if (u < 4096) { const int w3 = u >= 2048; const int v = u & 2047, le = l * 16 + (v >> 7), k = (v >> 3) & 15, n = v & 7;
                transpose_unit(lds, P.in[w3 ? 27 : 26] + (size_t)le * 1024 * 2048, 1024, 2048, (bf16_t*)(w + WS_W13T) + (size_t)le * 4096 * 1024, k * 64, n * 256, 1 + w3); }
            else { const int v = u - 4096, le = l * 16 + (v >> 7), k = (v >> 2) & 31, n = v & 3;
                transpose_unit(lds, P.in[28] + (size_t)le * 2048 * 1024, 2048, 1024, (bf16_t*)(w + WS_W2T) + (size_t)le * 1024 * 2048, k * 64, n * 256, 0); }
        }
        return;
    }
    f32x4 va[8], vb[8], vc[8];
    ConvTile ta = conv_tile(P, w, l, bid), tb = conv_tile(P, w, l, bid + 256), tc = conv_tile(P, w, l, bid + 512);
    int par = 0;
    CV_LOAD(va, ta); CV_LOAD(vb, tb); CV_LOAD(vc, tc);
    CV_STEP(va, ta, 16, bid + 3 * 256); CV_STEP(vb, tb, 20, bid + 4 * 256); CV_STEP(vc, tc, 24, bid + 5 * 256);
    for (int r = 2; r < 8; ++r) {
        const int u = bid + (3 * r) * 256;
        CV_STEP(va, ta, 28, u); CV_STEP(vb, tb, 28, u + 256); CV_STEP(vc, tc, 28, u + 512);
    }
    CV_STEP(va, ta, 28, -1); CV_STEP(vb, tb, 20, -1); CV_STEP(vc, tc, 12, -1);
    asm volatile("s_waitcnt vmcnt(0)" ::: "memory");
    __syncthreads();
}
#undef CV_LOAD
#undef CV_WAIT
#undef CV_STEP
constexpr int PH_PER_LAYER = 11, PH_LAYER0 = 2, PH_FINAL = PH_LAYER0 + DEPTH * PH_PER_LAYER, N_PHASES = PH_FINAL + 1;

__global__ void __launch_bounds__(512, 2) fwd_kernel(Params P) {
    extern __shared__ __attribute__((aligned(16))) char lds[];
    volatile LAS unsigned* xbw = (volatile LAS unsigned*)(lds + 131072);
    if (threadIdx.x == 0) { xbw[0] = 0u; xbw[1] = 0u; }
    __syncthreads();
    XcdBarrier bar = xcd_barrier_post((unsigned*)(P.ws + WS_CTL), xbw);
    const int G = gridDim.x, bid = blockIdx.x;
    const int vcu = (G % 8 == 0) ? (bid % 8) * (G / 8) + bid / 8 : bid;
    LAS unsigned char* ldsp = (LAS unsigned char*)lds;
    const int lo = P.lo, hi = P.hi;
#ifndef EN_MASK
#define EN_MASK 0xFFFFFFFFu
#endif
#define PHASE(id) if ((id) >= lo && (id) < hi)
#ifndef REP_MASK
#define REP_MASK 0x0u
#endif
#define PHASE_K(k, id) if (((EN_MASK >> (k)) & 1u) && (id) >= lo && (id) < hi) for (int rep_ = 0; rep_ <= (int)((REP_MASK >> (k)) & 1u); ++rep_)
#define SEAM(id) do { if ((id) >= lo && (id) + 1 < hi) xcd_barrier(bar); } while (0)
    unsigned char* ws0 = P.ws;
#define ws ptr_l(ws0)

    PHASE_K(0, 0) {
        constexpr int U_SSM = 256, U_ROPE = 1, U_ADA = 4 * 96;
        constexpr int T_WIN = 4 * 16 * 8, T_WOUT = 4 * 16 * 4, T_WGLU = 4 * 8 * 2, T_W1 = 64 * 16 * 8, T_W2 = 64 * 32 * 4;
        constexpr int U0 = U_SSM + U_ROPE + U_ADA, U1 = U0 + T_WIN, U2 = U1 + T_WOUT, U3 = U2 + T_WGLU, U4 = U3 + T_W1, U5 = U4 + T_W1, U6 = U5 + T_W2;
        for (int u = bid; u < U3; u += G) {
            if (u < U_SSM) { ssm_tab_unit(lds, P, u >> 6, (u >> 5) & 1, u & 31); }
            else if (u == U_SSM) {
                const int tid = tid_l(), wid = tid >> 6, lane = tid & 63;
                float* rope = (float*)(ws + WS_ROPE);
                for (int i = tid; i < 64 * 16; i += 512) {
                    const int pos = i >> 4, f = i & 15; const float inv = powf(10000.f, -(float)(2 * f) / 32.f);
                    float s, c; sincosf((float)pos * inv, &s, &c); rope[i * 2] = c; rope[i * 2 + 1] = s;
                }
                if (wid < 4) {
                    const float a = P.in[9][wid * 64 + lane] * P.in[10][wid * 64 + lane], c2 = P.in[11][wid * 64 + lane] * P.in[12][wid * 64 + lane];
                    const float s1 = wave_sum(a), s2 = wave_sum(c2);
                    if (lane == 0) ((float*)(ws + WS_LAM))[wid] = expf(s1) - expf(s2) + (0.8f - 0.6f * expf(-0.3f * (float)wid));
                }
            }
            else if (u < U0) { const int v = u - U_SSM - U_ROPE; adaln_unit(lds, P, v / 96, (v % 96) * 64); }
            else if (u < U1) { const int v = u - U0, l = v >> 7, k = (v >> 3) & 15, n = v & 7; transpose_unit(lds, P.in[8] + (size_t)l * 1024 * 2048, 1024, 2048, (bf16_t*)(ws + WS_WINT) + (size_t)l * 2048 * 1024, k * 64, n * 256, 0); }
            else if (u < U2) { const int v = u - U1, l = v >> 6, k = (v >> 2) & 15, n = v & 3; transpose_unit(lds, P.in[24] + (size_t)l * 1024 * 1024, 1024, 1024, (bf16_t*)(ws + WS_WOUTT) + (size_t)l * 1024 * 1024, k * 64, n * 256, 0); }
            else { const int v = u - U2, l = v >> 4, k = (v >> 1) & 7, n = v & 1; transpose_unit(lds, P.in[22] + (size_t)l * 512 * 512, 512, 512, (bf16_t*)(ws + WS_WGLUT) + (size_t)l * 512 * 512, k * 64, n * 256, 0); }
        }
        (void)U4; (void)U5; (void)U6;
    }
    SEAM(0);
    PHASE_K(1, 1) {
        const float* KT = (const float*)(ws + WS_KTAB); const float* PW = (const float*)(ws + WS_PW); const float* BB = (const float*)(ws + WS_BBAR);
        bf16_t* WE = (bf16_t*)(ws + WS_WENDT); bf16_t* B2 = (bf16_t*)(ws + WS_BT2);
        const int tid = tid_l();
        for (size_t idx = (size_t)bid * 512 + tid; idx < (size_t)4 * 32 * 256 * 256; idx += (size_t)G * 512) {
            const int kp = idx & 255, n = (idx >> 8) & 255, g = (idx >> 16) & 31, l = (int)(idx >> 21);
            if (kp >= 128) { *(unsigned*)(WE + (((size_t)l * 32 + g) * 256 + n) * 512 + kp * 2) = 0u; continue; }
            const int d = n >> 7, p = (n >> 1) & 63, ri = n & 1, k = kp * 2, i = k >> 4, h = k & 15;
            const size_t ldg = ((size_t)l * 2 + d) * 32 + g;
            const int e = d == 0 ? 15 - i : i;
            const float wr = PW[((ldg * 64 + p) * 17 + e) * 2], wi = PW[((ldg * 64 + p) * 17 + e) * 2 + 1];
            float o[2];
#pragma unroll
            for (int q = 0; q < 2; ++q) { const float br = BB[((ldg * 64 + p) * 16 + h + q) * 2], bi = BB[((ldg * 64 + p) * 16 + h + q) * 2 + 1]; o[q] = ri == 0 ? wr * br - wi * bi : wr * bi + wi * br; }
            *(unsigned*)(WE + (((size_t)l * 32 + g) * 256 + n) * 512 + k) = pk2(o[0], o[1]);
        }
        for (size_t idx = (size_t)bid * 512 + tid; idx < (size_t)4 * 32 * 256 * 256; idx += (size_t)G * 512) {
            const int kp = idx & 255, n2 = (idx >> 8) & 255, g = (idx >> 16) & 31, l = (int)(idx >> 21);
            const int j = n2 >> 4, h = n2 & 15, k = kp * 2;
            float o[2];
            if (k < 256) {
                const int i = k >> 4;
#pragma unroll
                for (int q = 0; q < 2; ++q) {
                    const int h2 = (k & 15) + q; float v = 0.f;
                    if (i <= j) v += KT[((((size_t)l * 2 + 0) * 32 + g) * 16 + (j - i)) * 256 + h * 16 + h2];
                    if (i >= j) v += KT[((((size_t)l * 2 + 1) * 32 + g) * 16 + (i - j)) * 256 + h * 16 + h2];
                    if (i == j && h == h2) v += P.in[21][(size_t)l * 512 + g * 16 + h];
                    o[q] = v;
                }
            } else {
                const int n = k - 256, d = n >> 7, p = (n >> 1) & 63;
                const size_t ldg = ((size_t)l * 2 + d) * 32 + g;
                const int e = d == 0 ? j + 1 : 16 - j;
                const float wr = PW[((ldg * 64 + p) * 17 + e) * 2], wi = PW[((ldg * 64 + p) * 17 + e) * 2 + 1];
                const float cr = P.in[19][(ldg * 16 + h) * 64 + p], ci = P.in[20][(ldg * 16 + h) * 64 + p];
                o[0] = cr * wr - ci * wi; o[1] = -(cr * wi + ci * wr);
            }
            *(unsigned*)(B2 + (((size_t)l * 32 + g) * 256 + n2) * 512 + k) = pk2(o[0], o[1]);
        }
    }
    SEAM(1);

    for (int l = 0; l < DEPTH; ++l) {
        const int ph = PH_LAYER0 + l * PH_PER_LAYER;
        const bool last = l == DEPTH - 1;
        const float* MODl = (const float*)(ws + WS_MOD) + (size_t)l * 9 * 6144;
        PHASE_K(2, ph + 0) { if (l == 0) rowpass1<true>(P, 0); else rowpass1<false>(P, l); }
        SEAM(ph + 0);
        PHASE_K(3, ph + 1) {
            {
                Epi8Inproj ep{(bf16_t*)(ws + WS_QK), (bf16_t*)(ws + WS_VT), (bf16_t*)(ws + WS_US), (const float*)(ws + WS_ROPE)};
                const pg8::Gemm g{(const bf16_t*)(ws + WS_HX), (const bf16_t*)(ws + WS_WINT) + (size_t)l * 2048 * 1024, R, 2048, 1024};
                const TileOrder S{128 * 8, G, vcu, 16, 8, 0, 17, 1};
                pg8::gemm_phase<Epi8Inproj, TileOrder, true, true>(ldsp, g, S, ep);
            }
            for (int u = vcu; u < 16 * 16; u += G) {
                EpiInproj ep{(bf16_t*)(ws + WS_QK), (bf16_t*)(ws + WS_VT), (bf16_t*)(ws + WS_US), (const float*)(ws + WS_ROPE)};
                APlain af{(const bf16_t*)(ws + WS_HX), 1024};
                const int mt = u >> 4, nt = u & 15;
                gemm_unit_dma(lds, af, (const bf16_t*)(ws + WS_WINT) + (size_t)l * 2048 * 1024, 1024, 1024, (mt >> 1) * LP + (mt & 1) * 128, nt * 128, ep);
            }
        }
        SEAM(ph + 1);
        PHASE_K(4, ph + 2) {
            {
                Epi8S1 ep{(unsigned short*)(ws + WS_EB)};
                const pg8::Gemm g{(const bf16_t*)(ws + WS_US), (const bf16_t*)(ws + WS_WENDT) + (size_t)l * 32 * 256 * 512, 32 * NCHP, 32 * 256, 512};
                const TileOrder S{32 * 8, G, vcu, 8, 1, 1, 9, 0};
                pg8::gemm_phase<Epi8S1, TileOrder, true, true>(ldsp, g, S, ep);
            }
            for (int u = vcu; u < 64; u += G) {
                const int g = u >> 1, nt = u & 1;
                EpiS1 ep{(unsigned short*)(ws + WS_EB) + (size_t)g * NCHP * 256};
                APlain af{(const bf16_t*)(ws + WS_US) + (size_t)g * NCHP * 512, 512};
                gemm_unit_dma(lds, af, (const bf16_t*)(ws + WS_WENDT) + ((size_t)l * 32 + g) * 256 * 512, 512, 256, 2048, nt * 128, ep);
            }
        }
        SEAM(ph + 2);
        PHASE_K(15, ph + 3) {
            for (int u = bid * 2; u < NB * 32 * 2; u += G * 2) scan_block(lds, P, l, u);
        }
        SEAM(ph + 3);
        PHASE_K(5, ph + 4) {
            const float lam = ((const float*)(ws + WS_LAM))[l], lam_init = 0.8f - 0.6f * expf(-0.3f * (float)l);
            int rnd = 0;
            for (int u = vcu; u < (last ? 1024 : 1024 + 64); u += G, ++rnd) {
                if (rnd == ((bid >> 3) & 3)) conv_share(lds, P, l, bid, G);
                if (u < 1024) { const int qb = u & 31, bh = u >> 5; attn_unit(lds, P, l, bh >> 2, bh & 3, CTXL + qb * 128, LP, lam, lam_init); }
                else { const int v = u - 1024, qb = v & 1, bh = v >> 1; attn_unit(lds, P, l, bh >> 2, bh & 3, qb * 128, CTXL, lam, lam_init); }
            }
        }
        PHASE_K(6, ph + 4) {
            {
                Epi8S2 ep{(bf16_t*)(ws + WS_YG)};
                const pg8::Gemm g{(const bf16_t*)(ws + WS_US), (const bf16_t*)(ws + WS_BT2) + (size_t)l * 32 * 256 * 512, 32 * NCHP, 32 * 256, 512};
                const TileOrder S{32 * 8, G, vcu, 8, 1, 1, 9, 0};
                pg8::gemm_phase<Epi8S2, TileOrder, true, true>(ldsp, g, S, ep);
            }
            if (!last) for (int u = (vcu + G / 2) % G; u < 64; u += G) {
                const int g = u >> 1, nt = u & 1;
                EpiS2 ep{(bf16_t*)(ws + WS_YG), g};
                APlain af{(const bf16_t*)(ws + WS_US) + (size_t)g * NCHP * 512, 512};
                gemm_unit_dma(lds, af, (const bf16_t*)(ws + WS_BT2) + ((size_t)l * 32 + g) * 256 * 512, 512, 512, 2048, nt * 128, ep);
            }
        }
        SEAM(ph + 4);
        PHASE_K(7, ph + 5) {
            {
                Epi8Glu ep{(const bf16_t*)(ws + WS_YG), (bf16_t*)(ws + WS_MIX), P.in[23] + (size_t)l * 512};
                const pg8::Gemm g{(const bf16_t*)(ws + WS_YG), (const bf16_t*)(ws + WS_WGLUT) + (size_t)l * 512 * 512, R, 512, 512};
                const TileOrder S{128 * 2, G, vcu, 16, 2, 0, 17, 1};
                pg8::gemm_phase<Epi8Glu, TileOrder, true, true>(ldsp, g, S, ep);
            }
            if (!last) for (int u = vcu; u < 8 * 4; u += G) {
                EpiGlu ep{(const bf16_t*)(ws + WS_YG), (bf16_t*)(ws + WS_MIX), P.in[23] + (size_t)l * 512};
                APlain af{(const bf16_t*)(ws + WS_YG), 512};
                gemm_unit<256>(lds, af, (const bf16_t*)(ws + WS_WGLUT) + (size_t)l * 512 * 512, 512, 512, (u >> 2) * LP, (u & 3) * 128, ep);
            }
        }
        SEAM(ph + 5);
        PHASE_K(8, ph + 6) {
            {
                Epi8Out ep{(bf16_t*)(ws + WS_X), MODl};
                const pg8::Gemm g{(const bf16_t*)(ws + WS_MIX), (const bf16_t*)(ws + WS_WOUTT) + (size_t)l * 1024 * 1024, R, 1024, 1024};
                const TileOrder S{128 * 4, G, vcu, 16, 4, 0, 17, 1};
                pg8::gemm_phase<Epi8Out, TileOrder, true, true>(ldsp, g, S, ep);
            }
            if (!last) for (int u = vcu; u < 16 * 8; u += G) {
                EpiOut ep{(bf16_t*)(ws + WS_X), MODl};
                APlain af{(const bf16_t*)(ws + WS_MIX), 1024};
                const int mt = u >> 3, nt = u & 7;
                gemm_unit_dma(lds, af, (const bf16_t*)(ws + WS_WOUTT) + (size_t)l * 1024 * 1024, 1024, 1024, (mt >> 1) * LP + (mt & 1) * 128, nt * 128, ep);
            }
        }
        SEAM(ph + 6);
        PHASE_K(9, ph + 7) { rowpass2(lds, P, l); }
        SEAM(ph + 7);
        PHASE_K(10, ph + 8) {
            for (int u = bid; u < (last ? 128 : 256); u += G) select_unit(lds, P, (u & 127) >> 4, u & 15, u < 128);
        }
        SEAM(ph + 8);
        PHASE_K(11, ph + 9) {
            Epi8Moe1 ep{(bf16_t*)(ws + WS_HG)};
            const pg8::Gemm g{(const bf16_t*)(ws + WS_HX), (const bf16_t*)(ws + WS_W13T) + (size_t)l * 16 * 4096 * 1024, 16 * ROWS_E, 16 * 4096, 1024, (const int*)(ws + WS_IDX), 131072 + 64};
            const TileOrder S = last ? TileOrder{16 * 16 * 16, G, vcu, 16, 16, 16, 17, 0, 1} : TileOrder{16 * 17 * 16, G, vcu, 17, 16, 16, 17, 0, 1};
            pg8::gemm_phase<Epi8Moe1, TileOrder, true, true, true>(ldsp, g, S, ep);
        }
        SEAM(ph + 9);
        PHASE_K(12, ph + 10) {
            {
                Epi8Moe2 ep{(bf16_t*)(ws + WS_OG), (const float*)(ws + WS_GATE)};
                const pg8::Gemm g{(const bf16_t*)(ws + WS_HG), (const bf16_t*)(ws + WS_W2T) + (size_t)l * 16 * 1024 * 2048, 16 * ROWS_E, 16 * 1024, 2048};
                const TileOrder S{16 * 16 * 4, G, vcu, 16, 4, 4, 17, 0};
                pg8::gemm_phase<Epi8Moe2, TileOrder, true, true>(ldsp, g, S, ep);
            }
            if (!last) for (int u = vcu; u < 16 * 2 * 8; u += G) {
                const int e = u >> 4, mt = (u >> 3) & 1, nt = u & 7;
                EpiMoe2 ep{(bf16_t*)(ws + WS_OG) + (size_t)e * ROWS_E * 1024, (const float*)(ws + WS_GATE) + (size_t)e * ROWS_E};
                APlain af{(const bf16_t*)(ws + WS_HG) + (size_t)e * ROWS_E * FF, FF};
                gemm_unit_dma(lds, af, (const bf16_t*)(ws + WS_W2T) + ((size_t)l * 16 + e) * 1024 * 2048, 2048, 2048, NB * CAPL + mt * 128, nt * 128, ep);
            }
        }
        SEAM(ph + 10);
    }
    PHASE_K(13, PH_FINAL) { rowpass1<false>(P, DEPTH); }
#undef ws
}

#ifndef MK_MULTI
#define MK_MULTI 0
#endif

extern "C" void kernel_launch(void* const* d_in, const int* in_sizes, int n_in, void* d_out, int out_size, void* d_ws, size_t ws_size, hipStream_t stream) {
    static int grid = 0;
    if (!grid) {
        int dev = 0, cus = 0, per_cu = 0;
        hipGetDevice(&dev);
        hipDeviceGetAttribute(&cus, hipDeviceAttributeMultiprocessorCount, dev);
        hipFuncSetAttribute((const void*)fwd_kernel, hipFuncAttributeMaxDynamicSharedMemorySize, LDS_BYTES);
        hipOccupancyMaxActiveBlocksPerMultiprocessor(&per_cu, fwd_kernel, 512, LDS_BYTES);
        grid = cus * (per_cu < 1 ? per_cu : 1);
        if (grid <= 0) { fprintf(stderr, "occupancy query failed (per_cu=%d cus=%d)\n", per_cu, cus); grid = 256; }
        if (ws_size < WS_END) fprintf(stderr, "workspace too small: %zu < %zu\n", ws_size, (size_t)WS_END);
    }
    Params p{};
    for (int i = 0; i < 30; ++i) p.in[i] = (const float*)d_in[i];
    p.out = (float*)d_out; p.ws = (unsigned char*)d_ws;
    hipMemsetAsync(d_ws, 0, CTL_BYTES, stream);
#if MK_MULTI
    for (int ph = 0; ph < N_PHASES; ++ph) {
        p.lo = ph; p.hi = ph + 1;
        hipLaunchKernelGGL(fwd_kernel, dim3(grid), dim3(512), LDS_BYTES, stream, p);
    }
#else
    p.lo = 0; p.hi = N_PHASES;
    hipLaunchKernelGGL(fwd_kernel, dim3(grid), dim3(512), LDS_BYTES, stream, p);
#endif
}
```

```cpp
#include <hip/hip_runtime.h>
#include <cstdio>
#include <cstdint>
#include <cmath>

#define DEVI __device__ __forceinline__
#define LAS __attribute__((address_space(3)))

typedef unsigned short bf16_t;
typedef short bf16x8 __attribute__((ext_vector_type(8)));
typedef float f32x2 __attribute__((ext_vector_type(2)));
typedef float f32x4 __attribute__((ext_vector_type(4)));
typedef float f32x16 __attribute__((ext_vector_type(16)));
typedef unsigned u32x2 __attribute__((ext_vector_type(2)));
typedef unsigned u32x4 __attribute__((ext_vector_type(4)));
typedef __bf16 bf16x2_t __attribute__((ext_vector_type(2)));

constexpr int NB = 8, SEQ = 4096, CTXL = 256, DM = 1024, DEPTH = 4;
constexpr int LP = CTXL + SEQ;
constexpr int R = NB * LP;
constexpr int NCHB = LP / 16;
constexpr int NCH = NB * NCHB;
constexpr int NE = 16, CAPL = 512, CAPC = 32, ROWS_BE = CAPL + CAPC  , ROWS_E = NB * ROWS_BE  , FF = 2048;
constexpr int NH = 4;
constexpr float EPS = 1e-6f;
constexpr float QSCALE = 0.125f * 1.4426950408889634f;

constexpr size_t al256(size_t x) { return (x + 255) & ~(size_t)255; }
constexpr size_t WS_CTL = 0, CTL_BYTES = 65536;
constexpr size_t WS_MOD = WS_CTL + CTL_BYTES;
constexpr size_t WS_ROPE = WS_MOD + al256((size_t)4 * 9 * 6144 * 4);
constexpr size_t WS_LAM = WS_ROPE + al256(64 * 16 * 2 * 4);
constexpr size_t WS_KTAB = WS_LAM + 256;
constexpr size_t WS_PW = WS_KTAB + (size_t)4 * 2 * 32 * 4096 * 4;
constexpr size_t WS_BBAR = WS_PW + al256((size_t)4 * 2 * 32 * 64 * 17 * 2 * 4);
constexpr size_t WS_WENDT = WS_BBAR + al256((size_t)4 * 2 * 32 * 64 * 16 * 2 * 4);
constexpr size_t WS_BT2 = WS_WENDT + (size_t)4 * 32 * 256 * 512 * 2;
constexpr size_t WS_WINT = WS_BT2 + (size_t)4 * 32 * 256 * 512 * 2;
constexpr size_t WS_WOUTT = WS_WINT + (size_t)4 * 2048 * 1024 * 2;
constexpr size_t WS_WGLUT = WS_WOUTT + (size_t)4 * 1024 * 1024 * 2;
constexpr size_t WS_W13T = WS_WGLUT + (size_t)4 * 512 * 512 * 2;
constexpr size_t WS_W2T = WS_W13T + (size_t)4 * 16 * 4096 * 1024 * 2;
constexpr size_t WS_X = WS_W2T + (size_t)4 * 16 * 1024 * 2048 * 2;
constexpr size_t WS_HX = WS_X + (size_t)R * 1024 * 4;
constexpr size_t WS_QK = WS_HX + (size_t)R * 1024 * 2;
constexpr size_t WS_VT = WS_QK + (size_t)R * 1024 * 2;
constexpr int NCHP = 2304;
constexpr size_t WS_US = WS_VT + (size_t)R * 512 * 2;
constexpr size_t WS_EB = WS_US + (size_t)32 * NCHP * 512 * 2;
constexpr size_t WS_MIX = WS_EB + (size_t)32 * NCHP * 256 * 4;
constexpr size_t WS_YG = WS_MIX + (size_t)R * 1024 * 2;
constexpr size_t WS_AFFT = WS_YG + (size_t)R * 512 * 2;
constexpr size_t WS_SLOT = WS_AFFT + (size_t)NB * 16 * LP * 4;
constexpr size_t WS_GATE = WS_SLOT + (size_t)R * 16 * 4;
constexpr size_t WS_IDX = WS_GATE + al256((size_t)16 * ROWS_E * 4);
constexpr size_t WS_XG = WS_IDX + al256((size_t)16 * ROWS_E * 4);
constexpr size_t WS_HG = WS_XG + (size_t)16 * ROWS_E * 1024 * 2;
constexpr size_t WS_OG = WS_HG + (size_t)16 * ROWS_E * 2048 * 2;
constexpr size_t WS_END = WS_OG + (size_t)16 * ROWS_E * 1024 * 2;

constexpr int LDS_BYTES = 131072 + 64 + 16384;

DEVI unsigned pk2(float lo, float hi) { f32x2 v = {lo, hi}; bf16x2_t b = __builtin_convertvector(v, bf16x2_t); return __builtin_bit_cast(unsigned, b); }
DEVI bf16_t f2bf(float f) { return (bf16_t)(pk2(f, 0.f) & 0xffffu); }
DEVI float bflo(unsigned u) { return __builtin_bit_cast(float, u << 16); }
DEVI float bfhi(unsigned u) { return __builtin_bit_cast(float, u & 0xffff0000u); }
DEVI f32x4 bf4(u32x2 w) { return (f32x4){bflo(w.x), bfhi(w.x), bflo(w.y), bfhi(w.y)}; }
typedef _Float16 h16x2 __attribute__((ext_vector_type(2)));
DEVI unsigned hpk2(float lo, float hi) { unsigned r; asm("v_cvt_pk_f16_f32 %0, %1, %2" : "=v"(r) : "v"(lo), "v"(hi)); return r; }
DEVI float hlo(unsigned u) { return (float)__builtin_bit_cast(_Float16, (unsigned short)(u & 0xffffu)); }
DEVI float hhi(unsigned u) { return (float)__builtin_bit_cast(_Float16, (unsigned short)(u >> 16)); }
DEVI f32x4 hf4(u32x2 w) { return (f32x4){hlo(w.x), hhi(w.x), hlo(w.y), hhi(w.y)}; }
DEVI int tid_l() { int t = threadIdx.x; asm volatile("" : "+v"(t)); return t; }
#define GAS __attribute__((address_space(1)))
DEVI unsigned char* ptr_l(unsigned char* w) { GAS unsigned char* g = (GAS unsigned char*)w; asm volatile("" : "+s"(g)); return (unsigned char*)g; }
template <int CTRL> DEVI float dppmov(float x) { return __builtin_bit_cast(float, __builtin_amdgcn_update_dpp(0, __builtin_bit_cast(int, x), CTRL, 0xf, 0xf, true)); }
DEVI void swap16(float a, float b, float& r0, float& r1) { const auto r = __builtin_amdgcn_permlane16_swap(__builtin_bit_cast(unsigned, a), __builtin_bit_cast(unsigned, b), false, false); r0 = __builtin_bit_cast(float, (unsigned)r[0]); r1 = __builtin_bit_cast(float, (unsigned)r[1]); }
DEVI void swap32(float a, float b, float& r0, float& r1) { const auto r = __builtin_amdgcn_permlane32_swap(__builtin_bit_cast(unsigned, a), __builtin_bit_cast(unsigned, b), false, false); r0 = __builtin_bit_cast(float, (unsigned)r[0]); r1 = __builtin_bit_cast(float, (unsigned)r[1]); }
DEVI float wave_sum(float v) {
    v += dppmov<0xB1>(v);
    v += dppmov<0x4E>(v);
    v += dppmov<0x124>(v);
    v += dppmov<0x128>(v);
    float r0, r1; swap16(v, v, r0, r1); v = r0 + r1;
    swap32(v, v, r0, r1); return r0 + r1;
}
DEVI float fast_exp2(float x) { return __builtin_amdgcn_exp2f(x); }
DEVI float sigmoidf_(float x) { return __builtin_amdgcn_rcpf(1.f + __expf(-x)); }
DEVI float gelu_tanh(float x) { const float z = 0.7978845608028654f * (x + 0.044715f * x * x * x); const float t = 1.f - 2.f * __builtin_amdgcn_rcpf(__expf(2.f * z) + 1.f); return 0.5f * x * (1.f + t); }
#define MFMA32(a, b, c) __builtin_amdgcn_mfma_f32_32x32x16_bf16(a, b, c, 0, 0, 0)

#define XB_TMO      128
#define XB_XCNT(j)  (256  + 64 * (j))
#define XB_XSUB(j)  (1280 + 64 * (j))
#define XB_XGEN(j)  (2304 + 64 * (j))
#define XB_TOP      3328
#define XB_TOPGEN   3392
#define XCD_BAR_WORDS 3456
#define XB_SPIN_CAP (1u << 20)
DEVI unsigned xb_ld(unsigned* p)              { return __hip_atomic_load(p, __ATOMIC_RELAXED, __HIP_MEMORY_SCOPE_AGENT); }
DEVI unsigned xb_add(unsigned* p, unsigned v) { return __hip_atomic_fetch_add(p, v, __ATOMIC_RELAXED, __HIP_MEMORY_SCOPE_AGENT); }
DEVI unsigned xb_xcc_id() { return (unsigned)__builtin_amdgcn_s_getreg((3 << 11) | 20) & 0xFu; }
#define XB_SPIN(cond, bar) do { unsigned _sp = 0; while (cond) { __builtin_amdgcn_s_sleep(1); \
    if ((++_sp & 255u) == 0u) { if (xb_ld(&(bar)[XB_TMO])) break; if (_sp > XB_SPIN_CAP) { atomicAdd(&(bar)[XB_TMO], 1u); break; } } } } while (0)
struct XcdBarrier { unsigned* bar; unsigned x; volatile LAS unsigned* st; };
DEVI XcdBarrier xcd_barrier_post(unsigned* bar, volatile LAS unsigned* st) {
    XcdBarrier b; b.bar = bar; b.x = xb_xcc_id(); b.st = st;
    if (threadIdx.x == 0) (void)xb_add(&bar[XB_XCNT(b.x)], 1u);
    return b;
}
DEVI void xcd_barrier_complete(unsigned* bar, unsigned x, unsigned& nloc, unsigned& nx) {
    const unsigned G = gridDim.x * gridDim.y * gridDim.z;
    unsigned sum, cnt, mine, sp = 0u;
    for (;;) {
        sum = 0u; cnt = 0u; mine = 0u;
#pragma unroll
        for (unsigned j = 0; j < 16; ++j) { const unsigned c = xb_ld(&bar[XB_XCNT(j)]); sum += c; cnt += (c > 0u) ? 1u : 0u; mine = (j == x) ? c : mine; }
        if (sum == G) break;
        __builtin_amdgcn_s_sleep(1);
        if ((++sp & 255u) == 0u) { if (xb_ld(&bar[XB_TMO])) break; if (sp > XB_SPIN_CAP) { atomicAdd(&bar[XB_TMO], 1u); break; } }
    }
    nloc = mine > 0u ? mine : 1u; nx = cnt > 0u ? cnt : 1u;
}
DEVI void xcd_barrier(const XcdBarrier& b) {
    asm volatile("s_waitcnt vmcnt(0)" ::: "memory");
    __syncthreads();
    if (threadIdx.x == 0) {
        unsigned* bar = b.bar;
        __builtin_amdgcn_s_waitcnt(0);
        unsigned nloc = b.st[0], nx = b.st[1];
        if (nloc == 0u) { xcd_barrier_complete(bar, b.x, nloc, nx); b.st[0] = nloc; b.st[1] = nx; }
        const unsigned old = xb_add(&bar[XB_XSUB(b.x)], 1u);
        const unsigned gen = old / nloc;
        if (old + 1u == (gen + 1u) * nloc) {
            __builtin_amdgcn_fence(__ATOMIC_RELEASE, "agent");
            asm volatile("s_waitcnt vmcnt(0)" ::: "memory");
            const unsigned og = xb_add(&bar[XB_TOP], 1u);
            const unsigned tg = og / nx;
            if (og + 1u == (tg + 1u) * nx) xb_add(&bar[XB_TOPGEN], 1u);
            else XB_SPIN(xb_ld(&bar[XB_TOPGEN]) == tg, bar);
            __builtin_amdgcn_fence(__ATOMIC_ACQUIRE, "agent");
            xb_add(&bar[XB_XGEN(b.x)], 1u);
            asm volatile("s_waitcnt vmcnt(0)" ::: "memory");
        } else {
            XB_SPIN(xb_ld(&bar[XB_XGEN(b.x)]) == gen, bar);
            __builtin_amdgcn_fence(__ATOMIC_ACQUIRE, "agent");
            asm volatile("s_waitcnt vmcnt(0)" ::: "memory");
        }
    }
    __syncthreads();
}

DEVI int chunk_row(int b, int c) { return c >= 16 ? b * 256 + (c - 16) : 2048 + b * 16 + c; }
DEVI int chunk_row_token(int cr) { return cr < 2048 ? (cr >> 8) * LP + (16 + (cr & 255)) * 16 : ((cr - 2048) >> 4) * LP + ((cr - 2048) & 15) * 16; }
DEVI int perm16(int k) { return (k & 3) | ((k & 4) << 1) | ((k & 8) >> 1); }

namespace pg8 {
#define PG8_LAS __attribute__((address_space(3)))
typedef unsigned short bf16_t;
typedef short bf16x8 __attribute__((ext_vector_type(8)));
typedef float f32x4 __attribute__((ext_vector_type(4)));
typedef unsigned u32x4 __attribute__((ext_vector_type(4)));
constexpr int BM = 256, BK = 64, HALF = 128, HTB = HALF * BK * 2  , STAGE_BYTES = 8 * HTB, NXCD = 8, WGM = 8;

__host__ __device__ __forceinline__ int lds_byte(int r, int c) { const int st = (r >> 4) * 2 + (c >> 5), rr = r & 15, cc = c & 31, ob = rr * 64 + cc * 2; return st * 1024 + (ob ^ (((ob >> 9) & 1) << 5)); }
__host__ __device__ __forceinline__ void stage_rc(int b, int& R, int& C) { const int st = b / 1024, sb = b % 1024, swz = sb ^ (((sb >> 9) & 1) << 5); R = (st >> 1) * 16 + swz / 64; C = (st & 1) * 32 + (swz % 64) / 2; }
__host__ __device__ __forceinline__ int perm32(int rho) { const int n = rho >> 4, i = rho & 15; return 8 * (i >> 2) + 4 * n + (i & 3); }

struct Unit { int pm, pn; };
struct Gemm { const bf16_t* A; const bf16_t* Bt; int M, N, K; const int* gidx = nullptr; int islot = 0; };
__device__ __forceinline__ unsigned cvt_pk_bf16(float lo, float hi) { unsigned r; asm volatile("v_cvt_pk_bf16_f32 %0, %1, %2" : "=v"(r) : "v"(lo), "v"(hi)); return r; }
template <class Epi, class Sched, bool ALIGN_EPI = false, bool SP2 = false, bool GATH = false>
__device__ __forceinline__ void gemm_phase(PG8_LAS unsigned char* lds, const Gemm g, const Sched& S, const Epi& E) {
    static_assert(!GATH || SP2, "the gathered-A form is written for the SP2 loop only");
    const int tid = tid_l(), wid = __builtin_amdgcn_readfirstlane(tid >> 6), lane = tid & 63, wr = wid >> 2, wc = wid & 3, fr = lane & 15, fq = lane >> 4;
    const int K = g.K, nt = K / BK;
    unsigned voffA[2], voffB[2];
    int stR[2], stC[2];
#pragma unroll
    for (int i = 0; i < 2; ++i) { int R, C; stage_rc(tid * 16 + i * 8192, R, C); const int Rb = Epi::PERM ? ((R & ~31) + perm32(R & 31)) : R; stR[i] = R; stC[i] = C;
        voffA[i] = (unsigned)(R * K + C) * 2u; voffB[i] = (unsigned)(Rb * K + C) * 2u; }
    unsigned goff[2][2], ngoff[2][2];
    const char* gA = (const char*)g.A;
    const size_t kstep = (size_t)(BK * 2);
    const size_t hstep = (size_t)HALF * K * 2;
    const size_t tstep = 2 * hstep;
    const unsigned ldsw = (unsigned)wid * 1024u;
    const int aoff = lds_byte(wr * 64 + fr, fq * 8), boff = lds_byte(wc * 32 + fr, fq * 8);
#define PG8_SA(b, h) (((b) * 2 + (h)) * HTB)
#define PG8_SB(b, h) ((4 + (b) * 2 + (h)) * HTB)
#define PG8_STAGE(bufoff, gbase, voff) do { _Pragma("unroll") for (int _i = 0; _i < 2; ++_i) \
        __builtin_amdgcn_global_load_lds((const unsigned*)((const char*)(gbase) + (voff)[_i]), (PG8_LAS unsigned*)(lds + (bufoff) + ldsw + _i * 8192), 16, 0, 0); } while (0)
#define PG8_STAGE_A(bufoff, selnext, kt, h) do { if constexpr (GATH) PG8_STAGE(bufoff, gA + (size_t)(kt) * kstep, ((selnext) ? ngoff[h] : goff[h])); \
        else PG8_STAGE(bufoff, ((selnext) ? nA : cA) + (size_t)(kt) * kstep + (size_t)(h) * hstep, voffA); } while (0)
#define PG8_LDA(dst, b, h) do { _Pragma("unroll") for (int m = 0; m < 4; ++m) _Pragma("unroll") for (int k = 0; k < 2; ++k) dst[m][k] = *(const PG8_LAS bf16x8*)(lds + PG8_SA(b, h) + aoff + m * 2048 + k * 1024); } while (0)
#define PG8_LDB(dst, b, h) do { _Pragma("unroll") for (int n = 0; n < 2; ++n) _Pragma("unroll") for (int k = 0; k < 2; ++k) dst[n][k] = *(const PG8_LAS bf16x8*)(lds + PG8_SB(b, h) + boff + n * 2048 + k * 1024); } while (0)
#define PG8_MMA(ai, bj, At, Bt) do { __builtin_amdgcn_s_setprio(1); _Pragma("unroll") for (int m = 0; m < 4; ++m) _Pragma("unroll") for (int n = 0; n < 2; ++n) _Pragma("unroll") for (int k = 0; k < 2; ++k) \
        acc[ai][bj][m][n] = __builtin_amdgcn_mfma_f32_16x16x32_bf16(Bt[n][k], At[m][k], acc[ai][bj][m][n], 0, 0, 0); __builtin_amdgcn_s_setprio(0); } while (0)
#define PG8_WAIT_V(n) asm volatile("s_waitcnt vmcnt(" #n ")" ::: "memory")
#define PG8_WAIT_L(n) asm volatile("s_waitcnt lgkmcnt(" #n ")" ::: "memory")
#define PG8_BAR __builtin_amdgcn_s_barrier()
#define PG8_SCHED __builtin_amdgcn_sched_barrier(0)
    Unit cur, nxt; int ui = 0;
    if (!S.next(0, cur)) return;
    f32x4 acc[2][2][4][2];
#pragma unroll
    for (int a = 0; a < 2; ++a)
#pragma unroll
        for (int b = 0; b < 2; ++b)
#pragma unroll
            for (int m = 0; m < 4; ++m)
#pragma unroll
                for (int n = 0; n < 2; ++n) acc[a][b][m][n] = (f32x4){0.f, 0.f, 0.f, 0.f};
    bf16x8 At[4][2], B0[2][2], B1[2][2];
    const char* cA = (const char*)g.A + (size_t)cur.pm * tstep; const char* cB = (const char*)g.Bt + (size_t)cur.pn * tstep;
    const char* nA = cA;
    if constexpr (GATH) {
#pragma unroll
        for (int h = 0; h < 2; ++h)
#pragma unroll
            for (int i = 0; i < 2; ++i) { goff[h][i] = (unsigned)(g.gidx[cur.pm * 256 + h * 128 + stR[i]] * K + stC[i]) * 2u; ngoff[h][i] = goff[h][i]; }
    }
    S.a_ready(cur);
    if constexpr (SP2) {
        PG8_STAGE(PG8_SB(0, 0), cB, voffB); PG8_STAGE(PG8_SB(0, 1), cB + hstep, voffB); PG8_STAGE_A(PG8_SA(0, 0), false, 0, 0); PG8_STAGE_A(PG8_SA(0, 1), false, 0, 1);
        if (wr == 1) PG8_BAR;
        PG8_WAIT_V(2); PG8_BAR;
        PG8_STAGE(PG8_SB(1, 0), cB + kstep, voffB); PG8_STAGE_A(PG8_SA(1, 0), false, 1, 0); PG8_STAGE(PG8_SB(1, 1), cB + hstep + kstep, voffB);
        PG8_WAIT_V(6); PG8_BAR;
    } else {
        PG8_STAGE(PG8_SB(0, 0), cB, voffB); PG8_STAGE(PG8_SA(0, 0), cA, voffA); PG8_STAGE(PG8_SB(0, 1), cB + hstep, voffB); PG8_STAGE(PG8_SA(0, 1), cA + hstep, voffA);
        if (wr == 1) PG8_BAR;
        PG8_WAIT_V(4); PG8_BAR;
        PG8_STAGE(PG8_SB(1, 0), cB + kstep, voffB); PG8_STAGE(PG8_SA(1, 0), cA + kstep, voffA); PG8_STAGE(PG8_SB(1, 1), cB + hstep + kstep, voffB);
        PG8_WAIT_V(6); PG8_BAR;
    }
    for (;;) {
        const bool has_next = S.next(ui + 1, nxt);
        nA = has_next ? (const char*)g.A + (size_t)nxt.pm * tstep : cA; const char* nB = has_next ? (const char*)g.Bt + (size_t)nxt.pn * tstep : cB;
        if constexpr (GATH) {
            if (has_next) {
#pragma unroll
                for (int h = 0; h < 2; ++h)
#pragma unroll
                    for (int i = 0; i < 2; ++i)
                        __builtin_amdgcn_global_load_lds((const unsigned*)(g.gidx + nxt.pm * 256 + h * 128 + stR[i]), (PG8_LAS unsigned*)(lds + g.islot + ((ui + 1) & 1) * 8192 + (h * 2 + i) * 2048 + wid * 256), 4, 0, 0);
            }
        }
        for (int t = 0; t < nt; t += 2) {
            const bool last = (t == nt - 2);
            if constexpr (GATH) {
                if (last) {
                    if (has_next) {
#pragma unroll
                        for (int h = 0; h < 2; ++h)
#pragma unroll
                            for (int i = 0; i < 2; ++i) { const int ix = *(const PG8_LAS int*)(lds + g.islot + ((ui + 1) & 1) * 8192 + (h * 2 + i) * 2048 + wid * 256 + lane * 4); ngoff[h][i] = (unsigned)(ix * K + stC[i]) * 2u; }
                    } else {
#pragma unroll
                        for (int h = 0; h < 2; ++h)
#pragma unroll
                            for (int i = 0; i < 2; ++i) ngoff[h][i] = goff[h][i];
                    }
                }
            }
            const char* a1 = cA + (size_t)(t + 1) * kstep;
            const char* a2 = last ? nA : cA + (size_t)(t + 2) * kstep; const char* b2 = last ? nB : cB + (size_t)(t + 2) * kstep;
            const char* a3 = a2 + kstep; const char* b3 = b2 + kstep;
            if (last && has_next) S.a_ready(nxt);
            if constexpr (SP2) {
            PG8_LDB(B0, 0, 0); PG8_LDB(B1, 0, 1); PG8_SCHED; PG8_LDA(At, 0, 0); PG8_STAGE_A(PG8_SA(1, 1), false, t + 1, 1);
            PG8_WAIT_V(8); PG8_WAIT_L(0); PG8_BAR; PG8_MMA(0, 0, At, B0); PG8_MMA(0, 1, At, B1); PG8_BAR; PG8_SCHED;
            PG8_LDA(At, 0, 1); PG8_STAGE(PG8_SB(0, 0), b2, voffB); PG8_STAGE(PG8_SB(0, 1), b2 + hstep, voffB); PG8_STAGE_A(PG8_SA(0, 0), last, last ? 0 : t + 2, 0);
            PG8_WAIT_V(8); PG8_WAIT_L(0); PG8_BAR; PG8_MMA(1, 0, At, B0); PG8_MMA(1, 1, At, B1); PG8_BAR; PG8_SCHED;
            PG8_LDB(B0, 1, 0); PG8_LDB(B1, 1, 1); PG8_SCHED; PG8_LDA(At, 1, 0); PG8_STAGE_A(PG8_SA(0, 1), last, last ? 0 : t + 2, 1);
            PG8_WAIT_V(8); PG8_WAIT_L(0); PG8_BAR; PG8_MMA(0, 0, At, B0); PG8_MMA(0, 1, At, B1); PG8_BAR; PG8_SCHED;
            PG8_LDA(At, 1, 1); PG8_STAGE(PG8_SB(1, 0), b3, voffB); PG8_STAGE(PG8_SB(1, 1), b3 + hstep, voffB); PG8_STAGE_A(PG8_SA(1, 0), last, last ? 1 : t + 3, 0);
            PG8_WAIT_V(8); PG8_WAIT_L(0); PG8_BAR; PG8_MMA(1, 0, At, B0); PG8_MMA(1, 1, At, B1); PG8_BAR; PG8_SCHED;
            } else {
            PG8_LDB(B0, 0, 0); PG8_SCHED; PG8_LDA(At, 0, 0); PG8_STAGE(PG8_SA(1, 1), a1 + hstep, voffA);
            PG8_WAIT_L(8); PG8_BAR; PG8_WAIT_L(0); PG8_MMA(0, 0, At, B0); PG8_BAR; PG8_SCHED;
            PG8_LDB(B1, 0, 1); PG8_STAGE(PG8_SB(0, 0), b2, voffB);
            PG8_BAR; PG8_WAIT_L(0); PG8_MMA(0, 1, At, B1); PG8_BAR;
            PG8_LDA(At, 0, 1); PG8_STAGE(PG8_SA(0, 0), a2, voffA);
            PG8_BAR; PG8_WAIT_L(0); PG8_MMA(1, 0, At, B0); PG8_BAR; PG8_SCHED;
            PG8_STAGE(PG8_SB(0, 1), b2 + hstep, voffB);
            PG8_WAIT_V(6); PG8_BAR; PG8_MMA(1, 1, At, B1); PG8_BAR;
            PG8_LDB(B0, 1, 0); PG8_SCHED; PG8_LDA(At, 1, 0); PG8_STAGE(PG8_SA(0, 1), a2 + hstep, voffA);
            PG8_WAIT_L(8); PG8_BAR; PG8_WAIT_L(0); PG8_MMA(0, 0, At, B0); PG8_BAR; PG8_SCHED;
            PG8_LDB(B1, 1, 1); PG8_STAGE(PG8_SB(1, 0), b3, voffB);
            PG8_BAR; PG8_WAIT_L(0); PG8_MMA(0, 1, At, B1); PG8_BAR;
            PG8_LDA(At, 1, 1); PG8_STAGE(PG8_SA(1, 0), a3, voffA);
            PG8_BAR; PG8_WAIT_L(0); PG8_MMA(1, 0, At, B0); PG8_BAR; PG8_SCHED;
            PG8_STAGE(PG8_SB(1, 1), b3 + hstep, voffB);
            PG8_WAIT_V(6); PG8_BAR; PG8_MMA(1, 1, At, B1); PG8_BAR;
            }
        }
        if constexpr (ALIGN_EPI) { if (wr == 0) PG8_BAR; }
        if constexpr (!Epi::AFTER_DRAIN) { E(acc, cur, wr, wc, fr, fq); S.done(cur); }
        if (!has_next) break;
#pragma unroll
        for (int a = 0; a < 2; ++a)
#pragma unroll
            for (int b = 0; b < 2; ++b)
#pragma unroll
                for (int m = 0; m < 4; ++m)
#pragma unroll
                    for (int n = 0; n < 2; ++n) acc[a][b][m][n] = (f32x4){0.f, 0.f, 0.f, 0.f};
        cur = nxt; cA = nA; cB = nB; ++ui;
        if constexpr (GATH) {
#pragma unroll
            for (int h = 0; h < 2; ++h)
#pragma unroll
                for (int i = 0; i < 2; ++i) goff[h][i] = ngoff[h][i];
        }
        if constexpr (ALIGN_EPI) { if (wr == 1) PG8_BAR; }
    }
    PG8_WAIT_V(0);
    if constexpr (!ALIGN_EPI) { if (wr == 0) PG8_BAR; }
    PG8_BAR;
    if constexpr (Epi::AFTER_DRAIN) { E.fused(acc, cur, wr, wc, fr, fq, lds, wid, lane); S.done(cur); }
#undef PG8_SA
#undef PG8_SB
#undef PG8_STAGE
#undef PG8_STAGE_A
#undef PG8_LDA
#undef PG8_LDB
#undef PG8_MMA
#undef PG8_WAIT_V
#undef PG8_WAIT_L
#undef PG8_BAR
#undef PG8_SCHED
}
}


struct TileOrder {
    int nunits, G, c, npm, npn, pn_gs, pm_gs, pm_off, blk48 = 0;
    DEVI bool next(int i, pg8::Unit& u) const {
        const int L = i * G + c; if (L >= nunits) return false;
        const int per = npm * npn, e = L / per, v = L - e * per; int pml = v / npn, pnl = v - pml * npn;
        if (blk48 && v < 256) { const int blk = v >> 5, w = v & 31; pml = (blk >> 1) * 4 + (w >> 3); pnl = (blk & 1) * 8 + (w & 7); }
        u.pm = e * pm_gs + pm_off + pml; u.pn = e * pn_gs + pnl; return true;
    }
    DEVI void a_ready(const pg8::Unit&) const {}
    DEVI void done(const pg8::Unit&) const {}
};

struct Epi8Inproj { static constexpr bool PERM = false, AFTER_DRAIN = false;
    bf16_t* QK; bf16_t* VT; bf16_t* UG; const float* rope;
    DEVI void operator()(const f32x4 (&acc)[2][2][4][2], const pg8::Unit& u, int wr, int wc, int fr, int fq) const {
        const int pn = u.pn;
#pragma unroll
        for (int ai = 0; ai < 2; ++ai)
#pragma unroll
            for (int m = 0; m < 4; ++m) {
                const int r = u.pm * 256 + ai * 128 + wr * 64 + m * 16 + fr, b = r / LP, p = r - b * LP; const bool latent = p >= CTXL; const int t = p - CTXL;
#pragma unroll
                for (int bj = 0; bj < 2; ++bj) {
                    const int cb = bj * 128 + wc * 32;
                    if (pn < 4) {
                        const int head = cb >> 6, dbase = cb & 63, pos = dbase == 0 ? (t >> 6) : (t & 63);
                        const float sc = pn < 2 ? QSCALE : 1.f;
                        f32x4 cs0 = {1.f, 0.f, 1.f, 0.f}, cs1 = {1.f, 0.f, 1.f, 0.f};
                        if (latent) { cs0 = *(const f32x4*)(rope + (pos * 16 + 4 * fq) * 2); cs1 = *(const f32x4*)(rope + (pos * 16 + 4 * fq + 2) * 2); }
                        const float cc[4] = {cs0.x, cs0.z, cs1.x, cs1.z}, sn[4] = {cs0.y, cs0.w, cs1.y, cs1.w};
                        bf16_t* dst = QK + ((size_t)((pn * NB + b) * NH + head) * LP + p) * 64 + dbase + 4 * fq;
#pragma unroll
                        for (int n = 0; n < 2; ++n) {
                            float o[4];
#pragma unroll
                            for (int j = 0; j < 4; ++j) { const float x = acc[ai][bj][m][n][j], y = acc[ai][bj][m][n ^ 1][j]; o[j] = (n == 0 ? x * cc[j] - y * sn[j] : x * cc[j] + y * sn[j]) * sc; }
                            u32x2 w; w.x = pk2(o[0], o[1]); w.y = pk2(o[2], o[3]);
                            *(u32x2*)(dst + 16 * n) = w;
                        }
                    } else if (pn < 6) {
                        const int cv = (pn - 4) * 256 + cb, head = cv >> 7, dv0 = (cv & 127) + 4 * fq;
                        const int pp = (p & ~15) | perm16(p & 15);
                        bf16_t* dst = VT + ((size_t)(b * NH + head) * 128 + dv0) * LP + pp;
#pragma unroll
                        for (int n = 0; n < 2; ++n)
#pragma unroll
                            for (int j = 0; j < 4; ++j) dst[(size_t)(16 * n + j) * LP] = f2bf(acc[ai][bj][m][n][j]);
                    } else {
                        const int ch0 = (pn - 6) * 256 + cb;
                        bf16_t* dst = UG + (size_t)chunk_row(b, p >> 4) * 512 + (p & 15) * 16 + 4 * fq;
#pragma unroll
                        for (int n = 0; n < 2; ++n) {
                            const int g = (ch0 + 16 * n) >> 4;
                            u32x2 w; w.x = pk2(acc[ai][bj][m][n][0], acc[ai][bj][m][n][1]); w.y = pk2(acc[ai][bj][m][n][2], acc[ai][bj][m][n][3]);
                            *(u32x2*)(dst + (size_t)g * NCHP * 512) = w;
                        }
                    }
                }
            }
    }
};

struct Epi8Out { static constexpr bool PERM = true, AFTER_DRAIN = false;
    bf16_t* X; const float* mod;
    DEVI void operator()(const f32x4 (&acc)[2][2][4][2], const pg8::Unit& u, int wr, int wc, int fr, int fq) const {
#pragma unroll
        for (int ai = 0; ai < 2; ++ai)
#pragma unroll
            for (int m = 0; m < 4; ++m) {
                const int r = u.pm * 256 + ai * 128 + wr * 64 + m * 16 + fr, b = r / LP, p = r - b * LP, jm = p < CTXL ? 8 : b;
                const float* g1 = mod + (size_t)jm * 6144 + 2 * 1024;
#pragma unroll
                for (int bj = 0; bj < 2; ++bj) {
                    const int c = u.pn * 256 + bj * 128 + wc * 32 + 8 * fq;
                    bf16_t* xp = X + (size_t)r * 1024 + c;
                    const u32x4 xw = *(const u32x4*)xp;
                    const f32x4 g0 = *(const f32x4*)(g1 + c), g4 = *(const f32x4*)(g1 + c + 4);
                    const f32x4 o0 = hf4((u32x2){xw.x, xw.y}) + g0 * acc[ai][bj][m][0], o1 = hf4((u32x2){xw.z, xw.w}) + g4 * acc[ai][bj][m][1];
                    u32x4 w; w.x = hpk2(o0.x, o0.y); w.y = hpk2(o0.z, o0.w); w.z = hpk2(o1.x, o1.y); w.w = hpk2(o1.z, o1.w);
                    *(u32x4*)xp = w;
                }
            }
    }
};

struct Epi8Moe1 { static constexpr bool PERM = true, AFTER_DRAIN = false;
    bf16_t* HG;
    DEVI void operator()(const f32x4 (&acc)[2][2][4][2], const pg8::Unit& u, int wr, int wc, int fr, int fq) const {
        const int t = u.pn & 15;
#pragma unroll
        for (int ai = 0; ai < 2; ++ai)
#pragma unroll
            for (int m = 0; m < 4; ++m) {
                const size_t row = (size_t)u.pm * 256 + ai * 128 + wr * 64 + m * 16 + fr;
                float o[8];
#pragma unroll
                for (int n = 0; n < 2; ++n)
#pragma unroll
                    for (int j = 0; j < 4; ++j) { const float a1 = acc[ai][0][m][n][j], a3 = acc[ai][1][m][n][j]; o[4 * n + j] = a1 * sigmoidf_(a1) * a3; }
                u32x4 w; w.x = pk2(o[0], o[1]); w.y = pk2(o[2], o[3]); w.z = pk2(o[4], o[5]); w.w = pk2(o[6], o[7]);
                *(u32x4*)(HG + row * FF + t * 128 + wc * 32 + 8 * fq) = w;
            }
    }
};

struct Epi8Moe2 { static constexpr bool PERM = true, AFTER_DRAIN = false;
    bf16_t* OG; const float* gate;
    DEVI void operator()(const f32x4 (&acc)[2][2][4][2], const pg8::Unit& u, int wr, int wc, int fr, int fq) const {
        const int t = u.pn & 3;
#pragma unroll
        for (int ai = 0; ai < 2; ++ai)
#pragma unroll
            for (int m = 0; m < 4; ++m) {
                const size_t row = (size_t)u.pm * 256 + ai * 128 + wr * 64 + m * 16 + fr; const float gt = gate[row];
#pragma unroll
                for (int bj = 0; bj < 2; ++bj) {
                    const f32x4 a = acc[ai][bj][m][0] * gt, c = acc[ai][bj][m][1] * gt;
                    u32x4 w; w.x = pk2(a.x, a.y); w.y = pk2(a.z, a.w); w.z = pk2(c.x, c.y); w.w = pk2(c.z, c.w);
                    *(u32x4*)(OG + row * 1024 + t * 256 + bj * 128 + wc * 32 + 8 * fq) = w;
                }
            }
    }
};

struct Epi8S1 { static constexpr bool PERM = true, AFTER_DRAIN = false;
    unsigned short* E;
    DEVI void operator()(const f32x4 (&acc)[2][2][4][2], const pg8::Unit& u, int wr, int wc, int fr, int fq) const {
        const int g = u.pn, r0 = (u.pm - g * 9) * 256 + wr * 64 + fr;
#pragma unroll
        for (int ai = 0; ai < 2; ++ai)
#pragma unroll
            for (int m = 0; m < 4; ++m) {
                const int cr = r0 + ai * 128 + m * 16;
                if (cr < NCH) {
                    unsigned short* dst = E + ((size_t)g * NCHP + cr) * 256 + wc * 32 + 8 * fq;
#pragma unroll
                    for (int bj = 0; bj < 2; ++bj) {
                        const f32x4 a = acc[ai][bj][m][0], d = acc[ai][bj][m][1];
                        u32x4 w; w.x = hpk2(a.x, a.y); w.y = hpk2(a.z, a.w); w.z = hpk2(d.x, d.y); w.w = hpk2(d.z, d.w);
                        *(u32x4*)(dst + bj * 128) = w;
                    }
                }
            }
    }
};
struct Epi8S2 { static constexpr bool PERM = true, AFTER_DRAIN = false;
    bf16_t* YG;
    DEVI void operator()(const f32x4 (&acc)[2][2][4][2], const pg8::Unit& u, int wr, int wc, int fr, int fq) const {
        const int g = u.pn, r0 = (u.pm - g * 9) * 256 + wr * 64 + fr;
#pragma unroll
        for (int ai = 0; ai < 2; ++ai)
#pragma unroll
            for (int m = 0; m < 4; ++m) {
                const int cr = r0 + ai * 128 + m * 16;
                if (cr < NCH) {
                    const size_t tok0 = (size_t)chunk_row_token(cr);
#pragma unroll
                    for (int bj = 0; bj < 2; ++bj) {
                        const int col = bj * 128 + wc * 32 + 8 * fq, j = col >> 4, h = col & 15;
                        const f32x4 a = acc[ai][bj][m][0], d = acc[ai][bj][m][1];
                        u32x4 w; w.x = pk2(gelu_tanh(a.x), gelu_tanh(a.y)); w.y = pk2(gelu_tanh(a.z), gelu_tanh(a.w)); w.z = pk2(gelu_tanh(d.x), gelu_tanh(d.y)); w.w = pk2(gelu_tanh(d.z), gelu_tanh(d.w));
                        *(u32x4*)(YG + (tok0 + j) * 512 + g * 16 + h) = w;
                    }
                }
            }
    }
};
struct Epi8Glu { static constexpr bool PERM = true, AFTER_DRAIN = false;
    const bf16_t* YG; bf16_t* MIX; const float* bglu;
    DEVI void operator()(const f32x4 (&acc)[2][2][4][2], const pg8::Unit& u, int wr, int wc, int fr, int fq) const {
#pragma unroll
        for (int ai = 0; ai < 2; ++ai)
#pragma unroll
            for (int m = 0; m < 4; ++m) {
                const size_t tok = (size_t)u.pm * 256 + ai * 128 + wr * 64 + m * 16 + fr;
#pragma unroll
                for (int bj = 0; bj < 2; ++bj) {
                    const int n0 = u.pn * 256 + bj * 128 + wc * 32 + 8 * fq;
                    const u32x4 y = *(const u32x4*)(YG + tok * 512 + n0);
                    const f32x4 b0 = *(const f32x4*)(bglu + n0), b1 = *(const f32x4*)(bglu + n0 + 4);
                    const f32x4 a = acc[ai][bj][m][0] + b0, d = acc[ai][bj][m][1] + b1;
                    u32x4 w; w.x = pk2(bflo(y.x) * sigmoidf_(a.x), bfhi(y.x) * sigmoidf_(a.y)); w.y = pk2(bflo(y.y) * sigmoidf_(a.z), bfhi(y.y) * sigmoidf_(a.w));
                    w.z = pk2(bflo(y.z) * sigmoidf_(d.x), bfhi(y.z) * sigmoidf_(d.y)); w.w = pk2(bflo(y.w) * sigmoidf_(d.z), bfhi(y.w) * sigmoidf_(d.w));
                    *(u32x4*)(MIX + tok * 1024 + 512 + n0) = w;
                }
            }
    }
};

struct Params {
    const float* in[30];
    float* out;
    unsigned char* ws;
    int lo, hi;
};

DEVI int swz(int row, int kc) { return row * 128 + ((kc ^ ((row >> 1) & 7)) << 4); }

struct APlain { const bf16_t* A; int lda; DEVI const bf16_t* ptr(int row, int k) const { return A + (size_t)row * lda + k; } };
struct AS2 { const bf16_t* U; const bf16_t* S; DEVI const bf16_t* ptr(int row, int k) const { return (k < 256 ? U : S) + (size_t)row * 8192 + (k & 255); } };

template <int BM, class AF, class Epi>
DEVI void gemm_unit(char* lds, const AF& af, const bf16_t* __restrict__ Bt, int ldb, int K, int m0, int n0, const Epi& epi) {
    constexpr int MT = BM / 128, ACH = BM / 64, A_BYTES = BM * 128, STAGE = A_BYTES + 16384, WM = BM / 4;
    const int tid = tid_l(), lane = tid & 63, wid = tid >> 6, wm = wid >> 1, wn = wid & 1, r32 = lane & 31, hi = lane >> 5;
    f32x16 acc[MT][2];
#pragma unroll
    for (int a = 0; a < MT; ++a)
#pragma unroll
        for (int b = 0; b < 2; ++b)
#pragma unroll
            for (int i = 0; i < 16; ++i) acc[a][b][i] = 0.f;
    u32x4 ra[ACH], rb[2];
    const int nk = K >> 6;
    const int crow = tid >> 3, ckc = tid & 7;
#define G_LOAD(kt) do { \
        _Pragma("unroll") for (int i = 0; i < ACH; ++i) ra[i] = *(const u32x4*)af.ptr(m0 + crow + 64 * i, (kt) * 64 + ckc * 8); \
        _Pragma("unroll") for (int i = 0; i < 2; ++i) rb[i] = *(const u32x4*)(Bt + (size_t)(n0 + crow + 64 * i) * ldb + (kt) * 64 + ckc * 8); } while (0)
#define G_STORE(s) do { char* _a = lds + (s) * STAGE; char* _b = _a + A_BYTES; \
        _Pragma("unroll") for (int i = 0; i < ACH; ++i) *(u32x4*)(_a + swz(crow + 64 * i, ckc)) = ra[i]; \
        _Pragma("unroll") for (int i = 0; i < 2; ++i) *(u32x4*)(_b + swz(crow + 64 * i, ckc)) = rb[i]; } while (0)
    G_LOAD(0); G_STORE(0); __syncthreads();
    for (int kt = 0; kt < nk; ++kt) {
        if (kt + 1 < nk) G_LOAD(kt + 1);
        const char* a = lds + (kt & 1) * STAGE; const char* b = a + A_BYTES;
#pragma unroll
        for (int ks = 0; ks < 4; ++ks) {
            bf16x8 wf[2], xf[MT];
#pragma unroll
            for (int nt = 0; nt < 2; ++nt) wf[nt] = *(const bf16x8*)(b + swz(wn * 64 + nt * 32 + r32, ks * 2 + hi));
#pragma unroll
            for (int mt = 0; mt < MT; ++mt) xf[mt] = *(const bf16x8*)(a + swz(wm * WM + mt * 32 + r32, ks * 2 + hi));
#pragma unroll
            for (int mt = 0; mt < MT; ++mt)
#pragma unroll
                for (int nt = 0; nt < 2; ++nt) acc[mt][nt] = MFMA32(wf[nt], xf[mt], acc[mt][nt]);
        }
        if (kt + 1 < nk) G_STORE((kt + 1) & 1);
        __syncthreads();
    }
#undef G_LOAD
#undef G_STORE
    epi.template run<MT>(acc, m0 + wm * WM + r32, n0 + wn * 64, hi);
}

template <class AF, class Epi>
DEVI void gemm_unit_dma(char* lds, const AF& af, const bf16_t* __restrict__ Bt, int ldb, int K, int m0, int n0, const Epi& epi) {
    const int tid = tid_l(), lane = tid & 63, wid = tid >> 6, wm = wid >> 1, wn = wid & 1, r32 = lane & 31, hi = lane >> 5;
    f32x16 acc[1][2];
#pragma unroll
    for (int b = 0; b < 2; ++b)
#pragma unroll
        for (int i = 0; i < 16; ++i) acc[0][b][i] = 0.f;
    const int nk = K >> 6;
    const int drow0 = wid * 16 + (lane >> 3), drow1 = drow0 + 8;
    const int kc0 = (lane & 7) ^ ((drow0 >> 1) & 7), kc1 = (lane & 7) ^ ((drow1 >> 1) & 7);
    const bf16_t* ga0 = af.ptr(m0 + drow0, kc0 * 8); const bf16_t* ga1 = af.ptr(m0 + drow1, kc1 * 8);
    const bf16_t* gb0 = Bt + (size_t)(n0 + drow0) * ldb + kc0 * 8; const bf16_t* gb1 = Bt + (size_t)(n0 + drow1) * ldb + kc1 * 8;
    LAS unsigned char* dl = (LAS unsigned char*)lds + wid * 2048;
#define GD_LDS(g, off) __builtin_amdgcn_global_load_lds((const unsigned*)(g), (LAS unsigned*)(dl + (off)), 16, 0, 0)
#define GD_ISSUE(kt) do { const int _s = ((kt) & 3) * 32768; GD_LDS(ga0 + (kt) * 64, _s); GD_LDS(ga1 + (kt) * 64, _s + 1024); GD_LDS(gb0 + (kt) * 64, _s + 16384); GD_LDS(gb1 + (kt) * 64, _s + 16384 + 1024); } while (0)
#define GD_WAITBAR(N) asm volatile("s_waitcnt vmcnt(" #N ") lgkmcnt(0)\n\ts_barrier" ::: "memory")
    GD_ISSUE(0); GD_ISSUE(1); GD_ISSUE(2);
    for (int kt = 0; kt < nk; ++kt) {
        if (kt + 2 < nk) GD_WAITBAR(8); else if (kt + 1 < nk) GD_WAITBAR(4); else GD_WAITBAR(0);
        if (kt + 3 < nk) GD_ISSUE(kt + 3);
        const char* a = lds + (kt & 3) * 32768; const char* b = a + 16384;
#pragma unroll
        for (int ks = 0; ks < 4; ++ks) {
            bf16x8 wf[2], xf;
#pragma unroll
            for (int nt = 0; nt < 2; ++nt) wf[nt] = *(const bf16x8*)(b + swz(wn * 64 + nt * 32 + r32, ks * 2 + hi));
            xf = *(const bf16x8*)(a + swz(wm * 32 + r32, ks * 2 + hi));
#pragma unroll
            for (int nt = 0; nt < 2; ++nt) acc[0][nt] = MFMA32(wf[nt], xf, acc[0][nt]);
        }
    }
#undef GD_LDS
#undef GD_ISSUE
#undef GD_WAITBAR
    __syncthreads();
    epi.template run<1>(acc, m0 + wm * 32 + r32, n0 + wn * 64, hi);
}


struct EpiInproj {
    bf16_t* QK; bf16_t* VT; bf16_t* UG; const float* rope;
    template <int MT> DEVI void run(const f32x16 (&acc)[MT][2], int mrow0, int ncol0, int hi) const {
#pragma unroll
        for (int mt = 0; mt < MT; ++mt) {
            const int r = mrow0 + mt * 32, b = r / LP, p = r - b * LP; const bool latent = p >= CTXL; const int t = p - CTXL;
#pragma unroll
            for (int nt = 0; nt < 2; ++nt) {
                const int nb = ncol0 + nt * 32; const f32x16& v = acc[mt][nt];
                if (nb < 1024) {
                    const int which = nb >> 8, head = (nb >> 6) & 3, dbase = nb & 63;
                    const int pos = dbase == 0 ? (t >> 6) : (t & 63);
                    bf16_t* dst = QK + ((size_t)((which * NB + b) * NH + head) * LP + p) * 64 + dbase + 4 * hi;
                    const float sc = which < 2 ? QSCALE : 1.f;
#pragma unroll
                    for (int i4 = 0; i4 < 4; ++i4) {
                        float o[4];
#pragma unroll
                        for (int j = 0; j < 4; ++j) {
                            float x = v[4 * i4 + j];
                            if (latent) {
                                const float y = v[4 * (i4 ^ 2) + j];
                                const f32x2 cs = *(const f32x2*)(rope + (pos * 16 + 8 * (i4 & 1) + 4 * hi + j) * 2);
                                x = (i4 < 2) ? (x * cs.x - y * cs.y) : (x * cs.x + y * cs.y);
                            }
                            o[j] = x * sc;
                        }
                        u32x2 w; w.x = pk2(o[0], o[1]); w.y = pk2(o[2], o[3]);
                        *(u32x2*)(dst + 8 * i4) = w;
                    }
                } else if (nb < 1536) {
                    const int n1 = nb - 1024, head = n1 >> 7, dv0 = n1 & 127;
                    const int pp = (p & ~15) | perm16(p & 15);
                    bf16_t* dst = VT + ((size_t)(b * NH + head) * 128 + dv0 + 4 * hi) * LP + pp;
#pragma unroll
                    for (int i = 0; i < 16; ++i) dst[(size_t)((i & 3) + 8 * (i >> 2)) * LP] = f2bf(v[i]);
                } else {
                    const int n1 = nb - 1536;
                    bf16_t* dst = UG + (size_t)chunk_row(b, p >> 4) * 512 + (p & 15) * 16;
#pragma unroll
                    for (int i4 = 0; i4 < 4; ++i4) {
                        const int ch = n1 + 8 * i4 + 4 * hi, g = ch >> 4, hc = ch & 15;
                        u32x2 w; w.x = pk2(v[4 * i4], v[4 * i4 + 1]); w.y = pk2(v[4 * i4 + 2], v[4 * i4 + 3]);
                        *(u32x2*)(dst + (size_t)g * NCHP * 512 + hc) = w;
                    }
                }
            }
        }
    }
};

struct EpiS1 {
    unsigned short* E;
    template <int MT> DEVI void run(const f32x16 (&acc)[MT][2], int mrow0, int ncol0, int hi) const {
#pragma unroll
        for (int mt = 0; mt < MT; ++mt) {
            unsigned short* dst = E + (size_t)(mrow0 + mt * 32) * 256 + ncol0 + 4 * hi;
#pragma unroll
            for (int nt = 0; nt < 2; ++nt)
#pragma unroll
                for (int i4 = 0; i4 < 4; ++i4) {
                    u32x2 w; w.x = hpk2(acc[mt][nt][4 * i4], acc[mt][nt][4 * i4 + 1]); w.y = hpk2(acc[mt][nt][4 * i4 + 2], acc[mt][nt][4 * i4 + 3]);
                    *(u32x2*)(dst + nt * 32 + 8 * i4) = w;
                }
        }
    }
};

struct EpiS2 {
    bf16_t* YG; int g;
    template <int MT> DEVI void run(const f32x16 (&acc)[MT][2], int mrow0, int ncol0, int hi) const {
#pragma unroll
        for (int mt = 0; mt < MT; ++mt) {
            const size_t tok0 = (size_t)chunk_row_token(mrow0 + mt * 32);
#pragma unroll
            for (int nt = 0; nt < 2; ++nt)
#pragma unroll
                for (int i4 = 0; i4 < 4; ++i4) {
                    const int n = ncol0 + nt * 32 + 8 * i4 + 4 * hi, j = n >> 4, h = n & 15;
                    u32x2 w; w.x = pk2(gelu_tanh(acc[mt][nt][4 * i4]), gelu_tanh(acc[mt][nt][4 * i4 + 1]));
                    w.y = pk2(gelu_tanh(acc[mt][nt][4 * i4 + 2]), gelu_tanh(acc[mt][nt][4 * i4 + 3]));
                    *(u32x2*)(YG + (tok0 + j) * 512 + g * 16 + h) = w;
                }
        }
    }
};

struct EpiGlu {
    const bf16_t* YG; bf16_t* MIX; const float* bglu;
    template <int MT> DEVI void run(const f32x16 (&acc)[MT][2], int mrow0, int ncol0, int hi) const {
#pragma unroll
        for (int mt = 0; mt < MT; ++mt) {
            const size_t tok = mrow0 + mt * 32;
#pragma unroll
            for (int nt = 0; nt < 2; ++nt)
#pragma unroll
                for (int i4 = 0; i4 < 4; ++i4) {
                    const int n = ncol0 + nt * 32 + 8 * i4 + 4 * hi;
                    const u32x2 y = *(const u32x2*)(YG + tok * 512 + n);
                    const f32x4 bb = *(const f32x4*)(bglu + n);
                    const float o0 = bflo(y.x) * sigmoidf_(acc[mt][nt][4 * i4] + bb.x), o1 = bfhi(y.x) * sigmoidf_(acc[mt][nt][4 * i4 + 1] + bb.y);
                    const float o2 = bflo(y.y) * sigmoidf_(acc[mt][nt][4 * i4 + 2] + bb.z), o3 = bfhi(y.y) * sigmoidf_(acc[mt][nt][4 * i4 + 3] + bb.w);
                    u32x2 w; w.x = pk2(o0, o1); w.y = pk2(o2, o3);
                    *(u32x2*)(MIX + tok * 1024 + 512 + n) = w;
                }
        }
    }
};

struct EpiOut {
    bf16_t* X; const float* mod;
    template <int MT> DEVI void run(const f32x16 (&acc)[MT][2], int mrow0, int ncol0, int hi) const {
#pragma unroll
        for (int mt = 0; mt < MT; ++mt) {
            const int r = mrow0 + mt * 32, b = r / LP, p = r - b * LP, j = p < CTXL ? 8 : b;
            const float* g1 = mod + (size_t)j * 6144 + 2 * 1024;
#pragma unroll
            for (int nt = 0; nt < 2; ++nt)
#pragma unroll
                for (int i4 = 0; i4 < 4; ++i4) {
                    const int n = ncol0 + nt * 32 + 8 * i4 + 4 * hi;
                    bf16_t* xp = X + (size_t)r * 1024 + n;
                    f32x4 x = hf4(*(const u32x2*)xp); const f32x4 g = *(const f32x4*)(g1 + n);
                    x.x += g.x * acc[mt][nt][4 * i4]; x.y += g.y * acc[mt][nt][4 * i4 + 1]; x.z += g.z * acc[mt][nt][4 * i4 + 2]; x.w += g.w * acc[mt][nt][4 * i4 + 3];
                    u32x2 w; w.x = hpk2(x.x, x.y); w.y = hpk2(x.z, x.w);
                    *(u32x2*)xp = w;
                }
        }
    }
};

struct EpiMoe1 {
    bf16_t* HG;
    template <int MT> DEVI void run(const f32x16 (&acc)[MT][2], int mrow0, int ncol0, int hi) const {
#pragma unroll
        for (int mt = 0; mt < MT; ++mt) {
            bf16_t* dst = HG + (size_t)(mrow0 + mt * 32) * FF + (ncol0 >> 1) + 4 * hi;
#pragma unroll
            for (int i4 = 0; i4 < 4; ++i4) {
                float o[4];
#pragma unroll
                for (int j = 0; j < 4; ++j) { const float a1 = acc[mt][0][4 * i4 + j], a3 = acc[mt][1][4 * i4 + j]; o[j] = a1 * sigmoidf_(a1) * a3; }
                u32x2 w; w.x = pk2(o[0], o[1]); w.y = pk2(o[2], o[3]);
                *(u32x2*)(dst + 8 * i4) = w;
            }
        }
    }
};

struct EpiMoe2 {
    bf16_t* OG; const float* gate;
    template <int MT> DEVI void run(const f32x16 (&acc)[MT][2], int mrow0, int ncol0, int hi) const {
#pragma unroll
        for (int mt = 0; mt < MT; ++mt) {
            const int row = mrow0 + mt * 32; const float gt = gate[row];
            bf16_t* dst = OG + (size_t)row * 1024 + ncol0 + 4 * hi;
#pragma unroll
            for (int nt = 0; nt < 2; ++nt)
#pragma unroll
                for (int i4 = 0; i4 < 4; ++i4) {
                    u32x2 w; w.x = pk2(acc[mt][nt][4 * i4] * gt, acc[mt][nt][4 * i4 + 1] * gt); w.y = pk2(acc[mt][nt][4 * i4 + 2] * gt, acc[mt][nt][4 * i4 + 3] * gt);
                    *(u32x2*)(dst + nt * 32 + 8 * i4) = w;
                }
        }
    }
};

DEVI void transpose_unit(char* lds, const float* __restrict__ W, int K, int N, bf16_t* __restrict__ out, int k0, int n0, int mode  ) {
    float* tile = (float*)lds;
    const int tid = tid_l();
    f32x4 v[8];
#pragma unroll
    for (int i = 0; i < 8; ++i) { const int c = tid + 512 * i, k = c >> 6, n4 = (c & 63) * 4; v[i] = *(const f32x4*)(W + (size_t)(k0 + k) * N + n0 + n4); }
#pragma unroll
    for (int i = 0; i < 8; ++i) { const int c = tid + 512 * i, k = c >> 6, n4 = (c & 63) * 4; float* t = tile + k * 257 + n4; t[0] = v[i].x; t[1] = v[i].y; t[2] = v[i].z; t[3] = v[i].w; }
    __syncthreads();
#pragma unroll
    for (int i = 0; i < 4; ++i) {
        const int c = tid + 512 * i, n = c >> 3, k8 = (c & 7) * 8;
        float f[8];
#pragma unroll
        for (int j = 0; j < 8; ++j) f[j] = tile[(k8 + j) * 257 + n];
        u32x4 w; w.x = pk2(f[0], f[1]); w.y = pk2(f[2], f[3]); w.z = pk2(f[4], f[5]); w.w = pk2(f[6], f[7]);
        const int ng = n0 + n; const int orow = mode == 0 ? ng : ((ng >> 7) * 256 + (mode - 1) * 128 + (ng & 127));
        *(u32x4*)(out + (size_t)orow * K + k0 + k8) = w;
    }
    __syncthreads();
}

DEVI void adaln_unit(char* lds, const Params& P, int l, int n0) {
    float* sc = (float*)lds;
    float* red = sc + 9 * 1024;
    const int tid = tid_l(), lane = tid & 63, wid = tid >> 6;
    for (int i = tid; i < 9 * 1024; i += 512) { const float c = i < 8192 ? P.in[1][i] : P.in[3][i - 8192]; sc[i] = c / (1.f + __expf(-c)); }
    __syncthreads();
    const float* W = P.in[4] + (size_t)l * 1024 * 6144 + n0 + lane;
    float a[9];
#pragma unroll
    for (int j = 0; j < 9; ++j) a[j] = 0.f;
    for (int kk = 0; kk < 128; kk += 16) {
        float w[16];
#pragma unroll
        for (int u = 0; u < 16; ++u) w[u] = W[(size_t)(wid * 128 + kk + u) * 6144];
#pragma unroll
        for (int u = 0; u < 16; ++u)
#pragma unroll
            for (int j = 0; j < 9; ++j) a[j] += sc[j * 1024 + wid * 128 + kk + u] * w[u];
    }
#pragma unroll
    for (int j = 0; j < 9; ++j) red[(wid * 9 + j) * 64 + lane] = a[j];
    __syncthreads();
    for (int i = tid; i < 9 * 64; i += 512) {
        const int j = i >> 6, n = i & 63; float s = 0.f;
#pragma unroll
        for (int w = 0; w < 8; ++w) s += red[(w * 9 + j) * 64 + n];
        ((float*)(ptr_l(P.ws) + WS_MOD))[((size_t)l * 9 + j) * 6144 + n0 + n] = s + P.in[5][(size_t)l * 6144 + n0 + n];
    }
    __syncthreads();
}

DEVI void ssm_tab_unit(char* lds, const Params& P, int l, int d, int g) {
    float* pw = (float*)lds;
    float* bb = pw + 64 * 17 * 2;
    float* cc = bb + 64 * 16 * 2;
    const int tid = tid_l();
    const size_t ldg = ((size_t)l * 2 + d) * 32 + g;
    const float dt = expf(P.in[16][ldg]);
    float* PW = (float*)(ptr_l(P.ws) + WS_PW) + ldg * 64 * 17 * 2;
    float* BB = (float*)(ptr_l(P.ws) + WS_BBAR) + ldg * 64 * 16 * 2;
    for (int i = tid; i < 64 * 17; i += 512) {
        const int p = i / 17, n = i - p * 17;
        const float lr = P.in[14][ldg * 64 + p], li = P.in[15][ldg * 64 + p];
        const float mag = expf(lr * dt * n); float s, c; sincosf(li * dt * n, &s, &c);
        pw[i * 2] = mag * c; pw[i * 2 + 1] = mag * s; PW[i * 2] = mag * c; PW[i * 2 + 1] = mag * s;
    }
    for (int i = tid; i < 64 * 16; i += 512) {
        const int p = i >> 4, h = i & 15;
        const float lr = P.in[14][ldg * 64 + p], li = P.in[15][ldg * 64 + p];
        const float mag = expf(lr * dt); float s, c; sincosf(li * dt, &s, &c);
        const float nr = mag * c - 1.f, ni = mag * s;
        const float den = lr * lr + li * li;
        const float qr = (nr * lr + ni * li) / den, qi = (ni * lr - nr * li) / den;
        const float br = P.in[17][(ldg * 64 + p) * 16 + h], bi = P.in[18][(ldg * 64 + p) * 16 + h];
        const float xr = qr * br - qi * bi, xi = qr * bi + qi * br;
        bb[i * 2] = xr; bb[i * 2 + 1] = xi; BB[i * 2] = xr; BB[i * 2 + 1] = xi;
    }
    for (int i = tid; i < 16 * 64; i += 512) { cc[i * 2] = P.in[19][ldg * 1024 + i]; cc[i * 2 + 1] = P.in[20][ldg * 1024 + i]; }
    __syncthreads();
    float* KT = (float*)(ptr_l(P.ws) + WS_KTAB) + ldg * 4096;
    for (int i = tid; i < 4096; i += 512) {
        const int dl = i >> 8, h = (i >> 4) & 15, h2 = i & 15;
        float s = 0.f;
        for (int p = 0; p < 64; ++p) {
            const float cr = cc[(h * 64 + p) * 2], ci = cc[(h * 64 + p) * 2 + 1];
            const float wr = pw[(p * 17 + dl) * 2], wi = pw[(p * 17 + dl) * 2 + 1];
            const float br = bb[(p * 16 + h2) * 2], bi = bb[(p * 16 + h2) * 2 + 1];
            const float tr = cr * wr - ci * wi, ti = cr * wi + ci * wr;
            s += tr * br - ti * bi;
        }
        KT[i] = s;
    }
    __syncthreads();
}

template <bool FIRST>
DEVI void rowpass1(const Params& P, int l) {
    const int tid = tid_l(), lane = tid & 63, wid = tid >> 6;
    bf16_t* X = (bf16_t*)(ptr_l(P.ws) + WS_X); bf16_t* HX = (bf16_t*)(ptr_l(P.ws) + WS_HX);
    const bf16_t* OG = (const bf16_t*)(ptr_l(P.ws) + WS_OG); const int* SLOT = (const int*)(ptr_l(P.ws) + WS_SLOT);
    const float* MOD = (const float*)(ptr_l(P.ws) + WS_MOD);
    const int stride = gridDim.x * 8;
    int r = blockIdx.x * 8 + wid;
    f32x4 xf[4]; u32x2 xb[4]; int svn = -1;
    auto issue = [&](int rr) {
        if constexpr (FIRST) {
            const int b = rr / LP, p = rr - b * LP;
            const float* src = p < CTXL ? P.in[2] + ((size_t)b * CTXL + p) * 1024 : P.in[0] + ((size_t)b * SEQ + (p - CTXL)) * 1024;
#pragma unroll
            for (int i = 0; i < 4; ++i) xf[i] = *(const f32x4*)(src + lane * 4 + 256 * i);
        } else {
#pragma unroll
            for (int i = 0; i < 4; ++i) xb[i] = *(const u32x2*)(X + (size_t)rr * 1024 + lane * 4 + 256 * i);
            svn = SLOT[(size_t)rr * 16 + (lane & 15)];
        }
    };
    if (r < R) issue(r);
    for (; r < R; r += stride) {
        const int b = r / LP, p = r - b * LP, j = p < CTXL ? 8 : b;
        f32x4 x[4]; const int sv = svn;
#pragma unroll
        for (int i = 0; i < 4; ++i) { if constexpr (FIRST) x[i] = xf[i]; else x[i] = hf4(xb[i]); }
        if (r + stride < R) issue(r + stride);
        if (l == DEPTH && p < CTXL) continue;
        if constexpr (!FIRST) {
            const float* g2 = MOD + ((size_t)(l - 1) * 9 + j) * 6144 + 5 * 1024;
            f32x4 m[4];
#pragma unroll
            for (int i = 0; i < 4; ++i) m[i] = (f32x4){0.f, 0.f, 0.f, 0.f};
            unsigned mask = (unsigned)__ballot(sv >= 0 && lane < 16) & 0xffffu;
            while (mask) {
                const int e0 = __builtin_ctz(mask); mask &= mask - 1;
                const int s0 = __builtin_amdgcn_readlane(sv, e0);
                const bool two = mask != 0u;
                const int e1 = two ? __builtin_ctz(mask) : e0; if (two) mask &= mask - 1;
                const int s1 = __builtin_amdgcn_readlane(sv, e1);
                const bf16_t* o0 = OG + ((size_t)e0 * ROWS_E + s0) * 1024 + lane * 4; const bf16_t* o1 = OG + ((size_t)e1 * ROWS_E + s1) * 1024 + lane * 4;
                u32x2 w0[4], w1[4];
#pragma unroll
                for (int i = 0; i < 4; ++i) { w0[i] = *(const u32x2*)(o0 + 256 * i); w1[i] = *(const u32x2*)(o1 + 256 * i); }
                const float f1 = two ? 1.f : 0.f;
#pragma unroll
                for (int i = 0; i < 4; ++i) m[i] += bf4(w0[i]) + f1 * bf4(w1[i]);
            }
#pragma unroll
            for (int i = 0; i < 4; ++i) { const f32x4 g = *(const f32x4*)(g2 + lane * 4 + 256 * i); x[i] += g * m[i]; }
        }
        float ss = 0.f;
#pragma unroll
        for (int i = 0; i < 4; ++i) ss += x[i].x * x[i].x + x[i].y * x[i].y + x[i].z * x[i].z + x[i].w * x[i].w;
        ss = wave_sum(ss);
        const float rstd = rsqrtf(ss * (1.f / 1024.f) + EPS);
        if (l < DEPTH) {
            const float* ng = P.in[6] + (size_t)l * 1024; const float* sh = MOD + ((size_t)l * 9 + j) * 6144; const float* scl = sh + 1024;
#pragma unroll
            for (int i = 0; i < 4; ++i) {
                const int c = lane * 4 + 256 * i;
                u32x2 xw; xw.x = hpk2(x[i].x, x[i].y); xw.y = hpk2(x[i].z, x[i].w);
                *(u32x2*)(X + (size_t)r * 1024 + c) = xw;
                const f32x4 g = *(const f32x4*)(ng + c), s1 = *(const f32x4*)(scl + c), s0 = *(const f32x4*)(sh + c);
                const f32x4 h = (x[i] * rstd * g) * (1.f + s1) + s0;
                u32x2 w; w.x = pk2(h.x, h.y); w.y = pk2(h.z, h.w);
                *(u32x2*)(HX + (size_t)r * 1024 + c) = w;
            }
        } else {
            float* o = P.out + ((size_t)b * SEQ + (p - CTXL)) * 1024;
#pragma unroll
            for (int i = 0; i < 4; ++i) { const int c = lane * 4 + 256 * i; const f32x4 g = *(const f32x4*)(P.in[29] + c); *(f32x4*)(o + c) = x[i] * rstd * g; }
        }
    }
}

DEVI float router_fold_softmax(const float (&pa)[16], int lane) {
    float q8[8], q4[4], q2[2];
#pragma unroll
    for (int i = 0; i < 8; ++i) { float r0, r1; swap32(pa[i], pa[i + 8], r0, r1); q8[i] = r0 + r1; }
#pragma unroll
    for (int i = 0; i < 4; ++i) { float r0, r1; swap16(q8[i], q8[i + 4], r0, r1); q4[i] = r0 + r1; }
    { const bool hb = (lane & 8) != 0;
#pragma unroll
      for (int i = 0; i < 2; ++i) { const float snd = hb ? q4[i] : q4[i + 2], kp = hb ? q4[i + 2] : q4[i]; q2[i] = kp + dppmov<0x128>(snd); } }
    float lg;
    { const bool hb = (lane & 4) != 0; const float snd = hb ? q2[0] : q2[1], kp = hb ? q2[1] : q2[0];
      const float up = dppmov<0x104>(snd), dn = dppmov<0x114>(snd);
      lg = kp + (hb ? dn : up); }
    lg += dppmov<0x4E>(lg); lg += dppmov<0xB1>(lg);
    float mx = fmaxf(lg, dppmov<0x124>(lg)); mx = fmaxf(mx, dppmov<0x128>(mx));
    { float r0, r1; swap16(mx, mx, r0, r1); mx = fmaxf(r0, r1); swap32(mx, mx, r0, r1); mx = fmaxf(r0, r1); }
    const float ex = expf(lg - mx);
    float sum = ex + dppmov<0x124>(ex); sum += dppmov<0x128>(sum);
    { float r0, r1; swap16(sum, sum, r0, r1); sum = r0 + r1; swap32(sum, sum, r0, r1); sum = r0 + r1; }
    return ex / sum;
}
DEVI void rowpass2(char* lds, const Params& P, int l) {
    const int tid = tid_l(), lane = tid & 63, wid = tid >> 6;
    float* wrT = (float*)lds;
    const float* wr = P.in[25] + (size_t)l * 1024 * 16;
    for (int i = tid; i < 16384; i += 512) { const int k = i >> 4, e = i & 15; wrT[e * 1024 + k] = wr[i]; }
    __syncthreads();
    const bf16_t* X = (const bf16_t*)(ptr_l(P.ws) + WS_X); bf16_t* HX = (bf16_t*)(ptr_l(P.ws) + WS_HX);
    const float* MOD = (const float*)(ptr_l(P.ws) + WS_MOD); float* AFFT = (float*)(ptr_l(P.ws) + WS_AFFT);
    const float* ng = P.in[7] + (size_t)l * 1024;
    const int stride = gridDim.x * 8;
    int r = blockIdx.x * 8 + wid;
    u32x2 xn[2][4];
#pragma unroll
    for (int q = 0; q < 2; ++q) if (r + q * stride < R) {
#pragma unroll
        for (int i = 0; i < 4; ++i) xn[q][i] = *(const u32x2*)(X + (size_t)(r + q * stride) * 1024 + lane * 4 + 256 * i);
    }
    for (; r < R; r += 2 * stride) {
        const bool two = r + stride < R;
        f32x4 h[2][4]; int bb[2], pp[2];
#pragma unroll
        for (int q = 0; q < 2; ++q) {
            const int rq = (q == 0 || two) ? r + q * stride : r;
            const int b = rq / LP, p = rq - b * LP, j = p < CTXL ? 8 : b; bb[q] = b; pp[q] = p;
            float ss = 0.f;
#pragma unroll
            for (int i = 0; i < 4; ++i) { h[q][i] = hf4(xn[q][i]); ss += h[q][i].x * h[q][i].x + h[q][i].y * h[q][i].y + h[q][i].z * h[q][i].z + h[q][i].w * h[q][i].w; }
            ss = wave_sum(ss);
            const float rstd = rsqrtf(ss * (1.f / 1024.f) + EPS);
            const float* sh = MOD + ((size_t)l * 9 + j) * 6144 + 3 * 1024; const float* scl = sh + 1024;
#pragma unroll
            for (int i = 0; i < 4; ++i) {
                const int c = lane * 4 + 256 * i;
                const f32x4 g = *(const f32x4*)(ng + c), s1 = *(const f32x4*)(scl + c), s0 = *(const f32x4*)(sh + c);
                h[q][i] = (h[q][i] * rstd * g) * (1.f + s1) + s0;
                if (q == 0 || two) { u32x2 w; w.x = pk2(h[q][i].x, h[q][i].y); w.y = pk2(h[q][i].z, h[q][i].w); *(u32x2*)(HX + (size_t)rq * 1024 + c) = w; }
            }
        }
#pragma unroll
        for (int q = 0; q < 2; ++q) if (r + (2 + q) * stride < R) {
#pragma unroll
            for (int i = 0; i < 4; ++i) xn[q][i] = *(const u32x2*)(X + (size_t)(r + (2 + q) * stride) * 1024 + lane * 4 + 256 * i);
        }
        float pa[2][16];
#pragma unroll
        for (int eg = 0; eg < 4; ++eg) {
#pragma unroll
            for (int e = 4 * eg; e < 4 * eg + 4; ++e) {
                f32x2 s0 = {0.f, 0.f}, s1 = {0.f, 0.f};
#pragma unroll
                for (int i = 0; i < 4; ++i) { const f32x4 w = *(const f32x4*)(wrT + e * 1024 + lane * 4 + 256 * i);
                    const f32x2 wl = __builtin_shufflevector(w, w, 0, 1), wh = __builtin_shufflevector(w, w, 2, 3);
                    s0 = __builtin_elementwise_fma(__builtin_shufflevector(h[0][i], h[0][i], 0, 1), wl, s0); s0 = __builtin_elementwise_fma(__builtin_shufflevector(h[0][i], h[0][i], 2, 3), wh, s0);
                    s1 = __builtin_elementwise_fma(__builtin_shufflevector(h[1][i], h[1][i], 0, 1), wl, s1); s1 = __builtin_elementwise_fma(__builtin_shufflevector(h[1][i], h[1][i], 2, 3), wh, s1); }
                pa[0][e] = s0.x + s0.y; pa[1][e] = s1.x + s1.y;
            }
            asm volatile("" ::: "memory");
        }
        const float a0 = router_fold_softmax(pa[0], lane), a1 = router_fold_softmax(pa[1], lane);
        if ((lane & 3) == 0) {
            AFFT[((size_t)bb[0] * 16 + (lane >> 2)) * LP + pp[0]] = a0;
            if (two) AFFT[((size_t)bb[1] * 16 + (lane >> 2)) * LP + pp[1]] = a1;
        }
    }
    __syncthreads();
}

DEVI int block_sum_i(int v, volatile int* red, int par, int wid, int lane) {
    if (lane == 0) red[par * 8 + wid] = v;
    __syncthreads();
    int s = 0;
#pragma unroll
    for (int w = 0; w < 8; ++w) s += red[par * 8 + w];
    return s;
}
DEVI int wave_incl_scan_i(int v, int lane) {
#pragma unroll
    for (int o = 1; o < 64; o <<= 1) { const int t = __shfl_up(v, o); if (lane >= o) v += t; }
    return v;
}
DEVI void select_unit(char* lds, const Params& P, int b, int e, bool lat) {
    volatile int* red = (volatile int*)lds;
    volatile int* wtot = (volatile int*)(lds + 64);
    const int tid = tid_l(), lane = tid & 63, wid = tid >> 6;
    const int n = lat ? SEQ : CTXL, K = lat ? CAPL : CAPC, p0 = lat ? CTXL : 0;
    const bool act = 8 * tid < n;
    const float* src = (const float*)(ptr_l(P.ws) + WS_AFFT) + ((size_t)b * 16 + e) * LP + p0 + 8 * tid;
    unsigned bits[8];
    if (act) { const u32x4 v0 = *(const u32x4*)src, v1 = *(const u32x4*)(src + 4); bits[0] = v0.x; bits[1] = v0.y; bits[2] = v0.z; bits[3] = v0.w; bits[4] = v1.x; bits[5] = v1.y; bits[6] = v1.z; bits[7] = v1.w; }
    else {
#pragma unroll
        for (int j = 0; j < 8; ++j) bits[j] = 0u;
    }
    unsigned prefix = 0u; int par = 0;
    for (int bit = 30; bit >= 0; --bit) {
        const unsigned cand = prefix | (1u << bit);
        int c = 0;
#pragma unroll
        for (int j = 0; j < 8; ++j) c += (int)__popcll(__ballot(bits[j] >= cand));
        const int tot = block_sum_i(c, red, par, wid, lane); par ^= 1;
        if (tot >= K) prefix = cand;
    }
    int cg = 0, ceq = 0;
#pragma unroll
    for (int j = 0; j < 8; ++j) { cg += (int)__popcll(__ballot(bits[j] > prefix)); ceq += (bits[j] == prefix) ? 1 : 0; }
    const int need = K - block_sum_i(cg, red, par, wid, lane); par ^= 1;
    int inc = wave_incl_scan_i(ceq, lane);
    if (lane == 63) wtot[par * 8 + wid] = inc;
    __syncthreads();
    int eqb = inc - ceq;
    for (int w = 0; w < wid; ++w) eqb += wtot[par * 8 + w];
    par ^= 1;
    bool sel[8]; int ns = 0;
#pragma unroll
    for (int j = 0; j < 8; ++j) { const bool eq = bits[j] == prefix; sel[j] = (bits[j] > prefix) || (eq && eqb < need); eqb += eq ? 1 : 0; ns += sel[j] ? 1 : 0; }
    inc = wave_incl_scan_i(ns, lane);
    if (lane == 63) wtot[par * 8 + wid] = inc;
    __syncthreads();
    int sb = inc - ns;
    for (int w = 0; w < wid; ++w) sb += wtot[par * 8 + w];
    if (act) {
        int* SLOT = (int*)(ptr_l(P.ws) + WS_SLOT); float* GATE = (float*)(ptr_l(P.ws) + WS_GATE); int* IDX = (int*)(ptr_l(P.ws) + WS_IDX);
#pragma unroll
        for (int j = 0; j < 8; ++j) {
            const int tok = b * LP + p0 + 8 * tid + j;
            if (sel[j]) {
                const int row = (lat ? b * CAPL : NB * CAPL + b * CAPC) + sb; ++sb;
                SLOT[(size_t)tok * 16 + e] = row; GATE[(size_t)e * ROWS_E + row] = __builtin_bit_cast(float, bits[j]); IDX[(size_t)e * ROWS_E + row] = tok;
            } else SLOT[(size_t)tok * 16 + e] = -1;
        }
    }
    __syncthreads();
}
DEVI void gather_rows(const Params& P, bool last) {
    const int tid = tid_l(), lane = tid & 63, wid = tid >> 6;
    const bf16_t* HX = (const bf16_t*)(ptr_l(P.ws) + WS_HX); bf16_t* XG = (bf16_t*)(ptr_l(P.ws) + WS_XG); const int* IDX = (const int*)(ptr_l(P.ws) + WS_IDX);
    const int stride = gridDim.x * 8;
    for (int r0 = blockIdx.x * 8 + wid; r0 < 16 * ROWS_E; r0 += 4 * stride) {
        u32x4 v[4][2];
#pragma unroll
        for (int q = 0; q < 4; ++q) { const int r = r0 + q * stride; if (r < 16 * ROWS_E && !(last && (r % ROWS_E) >= NB * CAPL)) { const u32x4* s = (const u32x4*)(HX + (size_t)IDX[r] * 1024); v[q][0] = s[lane]; v[q][1] = s[lane + 64]; } }
#pragma unroll
        for (int q = 0; q < 4; ++q) { const int r = r0 + q * stride; if (r < 16 * ROWS_E && !(last && (r % ROWS_E) >= NB * CAPL)) { u32x4* d = (u32x4*)(XG + (size_t)r * 1024); d[lane] = v[q][0]; d[lane + 64] = v[q][1]; } }
    }
}

DEVI int scan_ci(int d, int k) { return d == 0 ? k : (k < 16 ? 15 - k : 287 - k); }
DEVI void scan_block(char* lds, const Params& P, int l, int unit0) {
    const int tid = tid_l(), lane = tid & 63, wid = tid >> 6, seg = wid & 3, unit = unit0 + (wid >> 2);
    const int d = unit & 1, g = (unit >> 1) & 31, b = unit >> 6;
    const size_t ldg = ((size_t)l * 2 + d) * 32 + g;
    const float dt = expf(P.in[16][ldg]);
    const float lr = P.in[14][ldg * 64 + lane], li = P.in[15][ldg * 64 + lane];
    const float mag = expf(lr * dt * 16.f); float sn, cs; sincosf(li * dt * 16.f, &sn, &cs);
    const float ar = mag * cs, ai = mag * sn;
    const unsigned short* E = (const unsigned short*)(ptr_l(P.ws) + WS_EB) + (size_t)g * NCHP * 256 + d * 128 + lane * 2;
    bf16_t* S = (bf16_t*)(ptr_l(P.ws) + WS_US) + (size_t)g * NCHP * 512 + 256 + d * 128 + lane * 2;
    f32x2* ends = (f32x2*)lds + (size_t)(wid >> 2) * 4 * 64;
    const int k0 = seg * 68;
    float sr = 0.f, si = 0.f;
    for (int kk = 0; kk < 68; kk += 17) {
        unsigned ev[17];
#pragma unroll
        for (int u = 0; u < 17; ++u) ev[u] = *(const unsigned*)(E + (size_t)chunk_row(b, scan_ci(d, k0 + kk + u)) * 256);
#pragma unroll
        for (int u = 0; u < 17; ++u) { const float nr = ar * sr - ai * si + hlo(ev[u]), ni = ar * si + ai * sr + hhi(ev[u]); sr = nr; si = ni; }
    }
    ends[seg * 64 + lane] = (f32x2){sr, si};
    float pr = ar, pi = ai, p4r = 0.f, p4i = 0.f;
#pragma unroll
    for (int q = 0; q < 6; ++q) { const float nr = pr * pr - pi * pi, ni = 2.f * pr * pi; pr = nr; pi = ni; if (q == 1) { p4r = pr; p4i = pi; } }
    const float br = pr * p4r - pi * p4i, bi = pr * p4i + pi * p4r;
    __syncthreads();
    sr = 0.f; si = 0.f;
    for (int j = 0; j < seg; ++j) { const f32x2 e = ends[j * 64 + lane]; const float nr = br * sr - bi * si + e.x, ni = br * si + bi * sr + e.y; sr = nr; si = ni; }
    for (int kk = 0; kk < 68; kk += 17) {
        unsigned ev[17];
#pragma unroll
        for (int u = 0; u < 17; ++u) ev[u] = *(const unsigned*)(E + (size_t)chunk_row(b, scan_ci(d, k0 + kk + u)) * 256);
#pragma unroll
        for (int u = 0; u < 17; ++u) {
            *(unsigned*)(S + (size_t)chunk_row(b, scan_ci(d, k0 + kk + u)) * 512) = pk2(sr, si);
            const float nr = ar * sr - ai * si + hlo(ev[u]), ni = ar * si + ai * sr + hhi(ev[u]); sr = nr; si = ni;
        }
    }
    __syncthreads();
}

DEVI float max3f(float a, float b, float c) { return fmaxf(fmaxf(a, b), c); }
DEVI float xhalf_max(float x) { const unsigned u = __builtin_bit_cast(unsigned, x); const auto r = __builtin_amdgcn_permlane32_swap(u, u, false, false); return fmaxf(__builtin_bit_cast(float, (unsigned)r[0]), __builtin_bit_cast(float, (unsigned)r[1])); }
DEVI float xhalf_sum(float x) { const unsigned u = __builtin_bit_cast(unsigned, x); const auto r = __builtin_amdgcn_permlane32_swap(u, u, false, false); return __builtin_bit_cast(float, (unsigned)r[0]) + __builtin_bit_cast(float, (unsigned)r[1]); }
DEVI void attn_unit(char* lds, const Params& P, int l, int b, int head, int q0  , int nkeys, float lam, float lam_init) {
    const int tid = tid_l(), lane = tid & 63, wid = tid >> 6, qg = wid >> 1, which = wid & 1, r32 = lane & 31, hi = lane >> 5;
    const bf16_t* QK = (const bf16_t*)(ptr_l(P.ws) + WS_QK);
    const bf16_t* Qs = QK + ((size_t)((which * NB + b) * NH + head) * LP) * 64;
    const bf16_t* K1 = QK + ((size_t)((2 * NB + b) * NH + head) * LP) * 64;
    const bf16_t* K2 = QK + ((size_t)((3 * NB + b) * NH + head) * LP) * 64;
    const bf16_t* Vt = (const bf16_t*)(ptr_l(P.ws) + WS_VT) + (size_t)(b * NH + head) * 128 * LP;
    bf16x8 qf[4];
#pragma unroll
    for (int ks = 0; ks < 4; ++ks) qf[ks] = *(const bf16x8*)(Qs + (size_t)(q0 + qg * 32 + r32) * 64 + ks * 16 + hi * 8);
    f32x16 o[4];
#pragma unroll
    for (int t = 0; t < 4; ++t)
#pragma unroll
        for (int i = 0; i < 16; ++i) o[t][i] = 0.f;
    float m = 0.f, lsum = 0.f;
    const int nt = nkeys >> 6;
    const int drow = wid * 8 + (lane >> 3), dkc = (lane & 7) ^ ((drow >> 1) & 7);
    const unsigned koff = (unsigned)(drow * 64 + dkc * 8), voff = (unsigned)(drow * LP + dkc * 8);
    LAS unsigned char* dl = (LAS unsigned char*)lds + wid * 1024;
#define GLDS(g, off) __builtin_amdgcn_global_load_lds((const unsigned*)(g), (LAS unsigned*)(dl + (off)), 16, 0, 0)
#define K_DMA(kt, s) do { GLDS((K1 + (size_t)(kt) * 4096) + koff, (s) * 16384); GLDS((K2 + (size_t)(kt) * 4096) + koff, (s) * 16384 + 8192); } while (0)
#define V_DMA(kt, s) do { GLDS((Vt + (kt) * 64) + voff, 32768 + (s) * 16384); GLDS((Vt + (kt) * 64 + 64 * LP) + voff, 32768 + (s) * 16384 + 8192); } while (0)
#define QKT(dst, s, init) do { const char* _k = lds + (s) * 16384 + which * 8192; \
        _Pragma("unroll") for (int t2 = 0; t2 < 2; ++t2) _Pragma("unroll") for (int i = 0; i < 16; ++i) dst[t2][i] = (init); \
        _Pragma("unroll") for (int ks = 0; ks < 4; ++ks) _Pragma("unroll") for (int t2 = 0; t2 < 2; ++t2) { \
            const bf16x8 kf = *(const bf16x8*)(_k + swz(t2 * 32 + r32, ks * 2 + hi)); dst[t2] = MFMA32(kf, qf[ks], dst[t2]); } } while (0)
    K_DMA(0, 0); V_DMA(0, 0); K_DMA(1, 1);
    __syncthreads();
    f32x16 sc[2], sn[2];
    QKT(sc, 0, 0.f);
    __syncthreads();
    {
        float tm = max3f(sc[0][0], sc[0][1], sc[0][2]);
#pragma unroll
        for (int i = 3; i < 15; i += 2) tm = max3f(tm, sc[0][i], sc[0][i + 1]);
        tm = fmaxf(tm, sc[0][15]);
#pragma unroll
        for (int i = 0; i < 16; i += 2) tm = max3f(tm, sc[1][i], sc[1][i + 1]);
        tm = xhalf_max(tm);
        m = tm;
#pragma unroll
        for (int t2 = 0; t2 < 2; ++t2)
#pragma unroll
            for (int i = 0; i < 16; ++i) sc[t2][i] -= m;
    }
#define SB() __builtin_amdgcn_sched_barrier(0)
#define SGB(mask, n) __builtin_amdgcn_sched_group_barrier(mask, n, 0)
    int fo[4];
#pragma unroll
    for (int j = 0; j < 4; ++j) fo[j] = swz(r32, 2 * j + hi);
    const char* kbase = lds + which * 8192;
    const char* vbase = lds + 32768;
#define ATT_STEP(KT, PAR, SC, SN) do { \
        const bool has1 = (KT) + 1 < nt, has2 = (KT) + 2 < nt; \
        if (has2) K_DMA((KT) + 2, PAR); \
        if (has1) V_DMA((KT) + 1, 1 - (PAR)); \
        const char* kst = kbase + (1 - (PAR)) * 16384; \
        const char* vs = vbase + (PAR) * 16384; \
        bf16x8 kf[8]; \
        _Pragma("unroll") for (int ks = 0; ks < 4; ++ks) _Pragma("unroll") for (int t2 = 0; t2 < 2; ++t2) kf[ks * 2 + t2] = *(const bf16x8*)(kst + fo[ks] + t2 * 4096); \
        SB(); \
        _Pragma("unroll") for (int t2 = 0; t2 < 2; ++t2) _Pragma("unroll") for (int i = 0; i < 16; ++i) SN[t2][i] = -m; \
        _Pragma("unroll") for (int ks = 0; ks < 4; ++ks) _Pragma("unroll") for (int t2 = 0; t2 < 2; ++t2) SN[t2] = MFMA32(kf[ks * 2 + t2], qf[ks], SN[t2]); \
        bf16x8 va[4], vb[4]; \
        _Pragma("unroll") for (int t = 0; t < 4; ++t) va[t] = *(const bf16x8*)(vs + fo[0] + t * 4096); \
        SGB(0x002, 16); SGB(0x008, 8); SGB(0x100, 4); SB(); \
        if (__any(pprev > 4096.f)) {        \
            const float pr = xhalf_sum(pprev); \
            const float dl = pr > 4096.f ? (float)((int)((__builtin_bit_cast(unsigned, pr) >> 23) & 255u) - 127) : 0.f, al = fast_exp2(-dl); \
            m += dl; lsum *= al; \
            _Pragma("unroll") for (int t = 0; t < 4; ++t) _Pragma("unroll") for (int i = 0; i < 16; ++i) o[t][i] *= al; \
            _Pragma("unroll") for (int t2 = 0; t2 < 2; ++t2) _Pragma("unroll") for (int i = 0; i < 16; ++i) { SC[t2][i] -= dl; SN[t2][i] -= dl; } \
        } \
        float ps = 0.f; \
        _Pragma("unroll") for (int t2 = 0; t2 < 2; ++t2) _Pragma("unroll") for (int i = 0; i < 16; ++i) { SC[t2][i] = fast_exp2(SC[t2][i]); ps += SC[t2][i]; } \
        lsum += ps; pprev = ps; \
        bf16x8 pf[4]; \
        _Pragma("unroll") for (int t2 = 0; t2 < 2; ++t2) _Pragma("unroll") for (int sh = 0; sh < 2; ++sh) { \
            u32x4 pw; pw.x = pk2(SC[t2][8 * sh], SC[t2][8 * sh + 1]); pw.y = pk2(SC[t2][8 * sh + 2], SC[t2][8 * sh + 3]); \
            pw.z = pk2(SC[t2][8 * sh + 4], SC[t2][8 * sh + 5]); pw.w = pk2(SC[t2][8 * sh + 6], SC[t2][8 * sh + 7]); \
            pf[t2 * 2 + sh] = __builtin_bit_cast(bf16x8, pw); } \
        SB(); \
        _Pragma("unroll") for (int t = 0; t < 4; ++t) vb[t] = *(const bf16x8*)(vs + fo[1] + t * 4096); \
        _Pragma("unroll") for (int t = 0; t < 4; ++t) o[t] = MFMA32(va[t], pf[0], o[t]); \
        SGB(0x100, 4); SGB(0x008, 4); SB(); \
        _Pragma("unroll") for (int t = 0; t < 4; ++t) va[t] = *(const bf16x8*)(vs + fo[2] + t * 4096); \
        _Pragma("unroll") for (int t = 0; t < 4; ++t) o[t] = MFMA32(vb[t], pf[1], o[t]); \
        SGB(0x100, 4); SGB(0x008, 4); SB(); \
        _Pragma("unroll") for (int t = 0; t < 4; ++t) vb[t] = *(const bf16x8*)(vs + fo[3] + t * 4096); \
        _Pragma("unroll") for (int t = 0; t < 4; ++t) o[t] = MFMA32(va[t], pf[2], o[t]); \
        SGB(0x100, 4); SGB(0x008, 4); SB(); \
        _Pragma("unroll") for (int t = 0; t < 4; ++t) o[t] = MFMA32(vb[t], pf[3], o[t]); \
        SB(); \
        __syncthreads(); \
    } while (0)
    float pprev = 0.f;
    for (int kt = 0; kt < nt; kt += 2) {
        ATT_STEP(kt, 0, sc, sn);
        ATT_STEP(kt + 1, 1, sn, sc);
    }
#undef ATT_STEP
#undef SB
#undef SGB
#undef GLDS
#undef K_DMA
#undef V_DMA
#undef QKT
    lsum = xhalf_sum(lsum);
    const float inv = 1.f / lsum;
    float* xb = (float*)lds + (size_t)qg * 4096;
    if (which == 1) {
#pragma unroll
        for (int t = 0; t < 4; ++t)
#pragma unroll
            for (int i = 0; i < 16; ++i) xb[(t * 16 + i) * 64 + lane] = o[t][i] * inv;
    }
    __syncthreads();
    if (which == 0) {
        float ss = 0.f;
#pragma unroll
        for (int t = 0; t < 4; ++t)
#pragma unroll
            for (int i = 0; i < 16; ++i) { const float v = o[t][i] * inv - lam * xb[(t * 16 + i) * 64 + lane]; o[t][i] = v; ss += v * v; }
        ss = xhalf_sum(ss);
        const float rs = rsqrtf(ss * (1.f / 128.f) + EPS) * (1.f - lam_init);
        const float* sg = P.in[13] + (size_t)l * 128;
        bf16_t* dst = (bf16_t*)(ptr_l(P.ws) + WS_MIX) + ((size_t)b * LP + q0 + qg * 32 + r32) * 1024 + head * 128 + 4 * hi;
#pragma unroll
        for (int t = 0; t < 4; ++t)
#pragma unroll
            for (int i4 = 0; i4 < 4; ++i4) {
                const f32x4 g = *(const f32x4*)(sg + t * 32 + 8 * i4 + 4 * hi);
                u32x2 w; w.x = pk2(o[t][4 * i4] * rs * g.x, o[t][4 * i4 + 1] * rs * g.y); w.y = pk2(o[t][4 * i4 + 2] * rs * g.z, o[t][4 * i4 + 3] * rs * g.w);
                *(u32x2*)(dst + t * 32 + 8 * i4) = w;
            }
    }
    __syncthreads();
}

struct ConvTile { const float* src; bf16_t* dst; int K, N, mode; };
DEVI ConvTile conv_tile(const Params& P, unsigned char* w, int l, int u) {
    if (u < 4096) { const int w3 = u >= 2048; const int v = u & 2047, le = l * 16 + (v >> 7), k = (v >> 3) & 15, n = v & 7;
        return {P.in[w3 ? 27 : 26] + (size_t)le * 1024 * 2048 + (size_t)(k * 64) * 2048 + n * 256, (bf16_t*)(w + WS_W13T) + (size_t)le * 4096 * 1024 + k * 64, 1024, 2048, (n * 256) | ((1 + w3) << 16)}; }
    const int v = u - 4096, le = l * 16 + (v >> 7), k = (v >> 2) & 31, n = v & 3;
    return {P.in[28] + (size_t)le * 2048 * 1024 + (size_t)(k * 64) * 1024 + n * 256, (bf16_t*)(w + WS_W2T) + (size_t)le * 1024 * 2048 + k * 64, 2048, 1024, n * 256};
}
#define CV_LOAD(v, t) do { const unsigned voff_ = (unsigned)((2 * (tid >> 6)) * (t).N + (tid & 63) * 4) * 4u; \
        _Pragma("unroll") for (int i = 0; i < 8; ++i) { const float* sb_ = (t).src + (size_t)((i >> 1) * 16 + (i & 1)) * (t).N; \
        asm volatile("s_nop 4\n\tglobal_load_dwordx4 %0, %1, %2\n\ts_nop 1" : "=&v"(v[i]) : "v"(voff_), "s"(sb_) : "memory"); } } while (0)
#define CV_WAIT(v, N) asm volatile("s_waitcnt vmcnt(" #N ")" : "+v"(v[0]), "+v"(v[1]), "+v"(v[2]), "+v"(v[3]), "+v"(v[4]), "+v"(v[5]), "+v"(v[6]), "+v"(v[7]) :: "memory")
#define CV_STEP(v, t, N, UNEXT) do { \
        unsigned* tile = (unsigned*)lds + par * (32 * 256); par ^= 1; \
        CV_WAIT(v, N); \
        _Pragma("unroll") for (int j = 0; j < 4; ++j) { const int kp = (tid >> 6) + 8 * j; \
            u32x4 wv; wv.x = pk2(v[2 * j].x, v[2 * j + 1].x); wv.y = pk2(v[2 * j].y, v[2 * j + 1].y); wv.z = pk2(v[2 * j].z, v[2 * j + 1].z); wv.w = pk2(v[2 * j].w, v[2 * j + 1].w); \
            *(u32x4*)(tile + kp * 256 + (((tid & 63) * 4) ^ (((kp >> 2) & 7) << 3))) = wv; } \
        const ConvTile cur = t; \
        if ((UNEXT) >= 0) { t = conv_tile(P, w, l, (UNEXT)); CV_LOAD(v, t); } \
        asm volatile("s_waitcnt lgkmcnt(0)\n\ts_barrier" ::: "memory"); \
        const int n0 = cur.mode & 0xffff, mode = cur.mode >> 16; \
        _Pragma("unroll") for (int i = 0; i < 4; ++i) { \
            const int c = tid + 512 * i, n = c >> 3, kq = c & 7; \
            u32x4 o; o.x = tile[(4 * kq) * 256 + (n ^ (kq << 3))]; o.y = tile[(4 * kq + 1) * 256 + (n ^ (kq << 3))]; o.z = tile[(4 * kq + 2) * 256 + (n ^ (kq << 3))]; o.w = tile[(4 * kq + 3) * 256 + (n ^ (kq << 3))]; \
            const int ng = n0 + n; const int orow = mode == 0 ? ng : ((ng >> 7) * 256 + (mode - 1) * 128 + (ng & 127)); \
            const unsigned so_ = (unsigned)(orow * cur.K + 8 * kq) * 2u; \
            asm volatile("s_nop 4\n\tglobal_store_dwordx4 %0, %1, %2\n\ts_nop 1" :: "v"(so_), "v"(o), "s"(cur.dst) : "memory"); \
        } } while (0)
DEVI void conv_share(char* lds, const Params& P, int l, int bid, int G) {
    unsigned char* w = ptr_l(P.ws);
    const int tid = tid_l();
    if (G != 256) {
        for (int u = bid; u < 3 * 2048; u += G) {
            if (u < 4096) { const int w3 = u >= 2048; const int v = u & 2047, le = l * 16 + (v >> 7), k = (v >> 3) & 15, n = v & 7;
                transpose_unit(lds, P.in[w3 ? 27 : 26] + (size_t)le * 1024 * 2048, 1024, 2048, (bf16_t*)(w + WS_W13T) + (size_t)le * 4096 * 1024, k * 64, n * 256, 1 + w3); }
            else { const int v = u - 4096, le = l * 16 + (v >> 7), k = (v >> 2) & 31, n = v & 3;
                transpose_unit(lds, P.in[28] + (size_t)le * 2048 * 1024, 2048, 1024, (bf16_t*)(w + WS_W2T) + (size_t)le * 1024 * 2048, k * 64, n * 256, 0); }
        }
        return;
    }
    f32x4 va[8], vb[8], vc[8];
    ConvTile ta = conv_tile(P, w, l, bid), tb = conv_tile(P, w, l, bid + 256), tc = conv_tile(P, w, l, bid + 512);
    int par = 0;
    CV_LOAD(va, ta); CV_LOAD(vb, tb); CV_LOAD(vc, tc);
    CV_STEP(va, ta, 16, bid + 3 * 256); CV_STEP(vb, tb, 20, bid + 4 * 256); CV_STEP(vc, tc, 24, bid + 5 * 256);
    for (int r = 2; r < 8; ++r) {
        const int u = bid + (3 * r) * 256;
        CV_STEP(va, ta, 28, u); CV_STEP(vb, tb, 28, u + 256); CV_STEP(vc, tc, 28, u + 512);
    }
    CV_STEP(va, ta, 28, -1); CV_STEP(vb, tb, 20, -1); CV_STEP(vc, tc, 12, -1);
    asm volatile("s_waitcnt vmcnt(0)" ::: "memory");
    __syncthreads();
}
#undef CV_LOAD
#undef CV_WAIT
#undef CV_STEP
constexpr int PH_PER_LAYER = 11, PH_LAYER0 = 2, PH_FINAL = PH_LAYER0 + DEPTH * PH_PER_LAYER, N_PHASES = PH_FINAL + 1;

__global__ void __launch_bounds__(512, 2) fwd_kernel(Params P) {
    extern __shared__ __attribute__((aligned(16))) char lds[];
    volatile LAS unsigned* xbw = (volatile LAS unsigned*)(lds + 131072);
    if (threadIdx.x == 0) { xbw[0] = 0u; xbw[1] = 0u; }
    __syncthreads();
    XcdBarrier bar = xcd_barrier_post((unsigned*)(P.ws + WS_CTL), xbw);
    const int G = gridDim.x, bid = blockIdx.x;
    const int vcu = (G % 8 == 0) ? (bid % 8) * (G / 8) + bid / 8 : bid;
    LAS unsigned char* ldsp = (LAS unsigned char*)lds;
    const int lo = P.lo, hi = P.hi;
#ifndef EN_MASK
#define EN_MASK 0xFFFFFFFFu
#endif
#define PHASE(id) if ((id) >= lo && (id) < hi)
#ifndef REP_MASK
#define REP_MASK 0x0u
#endif
#define PHASE_K(k, id) if (((EN_MASK >> (k)) & 1u) && (id) >= lo && (id) < hi) for (int rep_ = 0; rep_ <= (int)((REP_MASK >> (k)) & 1u); ++rep_)
#define SEAM(id) do { if ((id) >= lo && (id) + 1 < hi) xcd_barrier(bar); } while (0)
    unsigned char* ws0 = P.ws;
#define ws ptr_l(ws0)

    PHASE_K(0, 0) {
        constexpr int U_SSM = 256, U_ROPE = 1, U_ADA = 4 * 96;
        constexpr int T_WIN = 4 * 16 * 8, T_WOUT = 4 * 16 * 4, T_WGLU = 4 * 8 * 2, T_W1 = 64 * 16 * 8, T_W2 = 64 * 32 * 4;
        constexpr int U0 = U_SSM + U_ROPE + U_ADA, U1 = U0 + T_WIN, U2 = U1 + T_WOUT, U3 = U2 + T_WGLU, U4 = U3 + T_W1, U5 = U4 + T_W1, U6 = U5 + T_W2;
        for (int u = bid; u < U3; u += G) {
            if (u < U_SSM) { ssm_tab_unit(lds, P, u >> 6, (u >> 5) & 1, u & 31); }
            else if (u == U_SSM) {
                const int tid = tid_l(), wid = tid >> 6, lane = tid & 63;
                float* rope = (float*)(ws + WS_ROPE);
                for (int i = tid; i < 64 * 16; i += 512) {
                    const int pos = i >> 4, f = i & 15; const float inv = powf(10000.f, -(float)(2 * f) / 32.f);
                    float s, c; sincosf((float)pos * inv, &s, &c); rope[i * 2] = c; rope[i * 2 + 1] = s;
                }
                if (wid < 4) {
                    const float a = P.in[9][wid * 64 + lane] * P.in[10][wid * 64 + lane], c2 = P.in[11][wid * 64 + lane] * P.in[12][wid * 64 + lane];
                    const float s1 = wave_sum(a), s2 = wave_sum(c2);
                    if (lane == 0) ((float*)(ws + WS_LAM))[wid] = expf(s1) - expf(s2) + (0.8f - 0.6f * expf(-0.3f * (float)wid));
                }
            }
            else if (u < U0) { const int v = u - U_SSM - U_ROPE; adaln_unit(lds, P, v / 96, (v % 96) * 64); }
            else if (u < U1) { const int v = u - U0, l = v >> 7, k = (v >> 3) & 15, n = v & 7; transpose_unit(lds, P.in[8] + (size_t)l * 1024 * 2048, 1024, 2048, (bf16_t*)(ws + WS_WINT) + (size_t)l * 2048 * 1024, k * 64, n * 256, 0); }
            else if (u < U2) { const int v = u - U1, l = v >> 6, k = (v >> 2) & 15, n = v & 3; transpose_unit(lds, P.in[24] + (size_t)l * 1024 * 1024, 1024, 1024, (bf16_t*)(ws + WS_WOUTT) + (size_t)l * 1024 * 1024, k * 64, n * 256, 0); }
            else { const int v = u - U2, l = v >> 4, k = (v >> 1) & 7, n = v & 1; transpose_unit(lds, P.in[22] + (size_t)l * 512 * 512, 512, 512, (bf16_t*)(ws + WS_WGLUT) + (size_t)l * 512 * 512, k * 64, n * 256, 0); }
        }
        (void)U4; (void)U5; (void)U6;
    }
    SEAM(0);
    PHASE_K(1, 1) {
        const float* KT = (const float*)(ws + WS_KTAB); const float* PW = (const float*)(ws + WS_PW); const float* BB = (const float*)(ws + WS_BBAR);
        bf16_t* WE = (bf16_t*)(ws + WS_WENDT); bf16_t* B2 = (bf16_t*)(ws + WS_BT2);
        const int tid = tid_l();
        for (size_t idx = (size_t)bid * 512 + tid; idx < (size_t)4 * 32 * 256 * 256; idx += (size_t)G * 512) {
            const int kp = idx & 255, n = (idx >> 8) & 255, g = (idx >> 16) & 31, l = (int)(idx >> 21);
            if (kp >= 128) { *(unsigned*)(WE + (((size_t)l * 32 + g) * 256 + n) * 512 + kp * 2) = 0u; continue; }
            const int d = n >> 7, p = (n >> 1) & 63, ri = n & 1, k = kp * 2, i = k >> 4, h = k & 15;
            const size_t ldg = ((size_t)l * 2 + d) * 32 + g;
            const int e = d == 0 ? 15 - i : i;
            const float wr = PW[((ldg * 64 + p) * 17 + e) * 2], wi = PW[((ldg * 64 + p) * 17 + e) * 2 + 1];
            float o[2];
#pragma unroll
            for (int q = 0; q < 2; ++q) { const float br = BB[((ldg * 64 + p) * 16 + h + q) * 2], bi = BB[((ldg * 64 + p) * 16 + h + q) * 2 + 1]; o[q] = ri == 0 ? wr * br - wi * bi : wr * bi + wi * br; }
            *(unsigned*)(WE + (((size_t)l * 32 + g) * 256 + n) * 512 + k) = pk2(o[0], o[1]);
        }
        for (size_t idx = (size_t)bid * 512 + tid; idx < (size_t)4 * 32 * 256 * 256; idx += (size_t)G * 512) {
            const int kp = idx & 255, n2 = (idx >> 8) & 255, g = (idx >> 16) & 31, l = (int)(idx >> 21);
            const int j = n2 >> 4, h = n2 & 15, k = kp * 2;
            float o[2];
            if (k < 256) {
                const int i = k >> 4;
#pragma unroll
                for (int q = 0; q < 2; ++q) {
                    const int h2 = (k & 15) + q; float v = 0.f;
                    if (i <= j) v += KT[((((size_t)l * 2 + 0) * 32 + g) * 16 + (j - i)) * 256 + h * 16 + h2];
                    if (i >= j) v += KT[((((size_t)l * 2 + 1) * 32 + g) * 16 + (i - j)) * 256 + h * 16 + h2];
                    if (i == j && h == h2) v += P.in[21][(size_t)l * 512 + g * 16 + h];
                    o[q] = v;
                }
            } else {
                const int n = k - 256, d = n >> 7, p = (n >> 1) & 63;
                const size_t ldg = ((size_t)l * 2 + d) * 32 + g;
                const int e = d == 0 ? j + 1 : 16 - j;
                const float wr = PW[((ldg * 64 + p) * 17 + e) * 2], wi = PW[((ldg * 64 + p) * 17 + e) * 2 + 1];
                const float cr = P.in[19][(ldg * 16 + h) * 64 + p], ci = P.in[20][(ldg * 16 + h) * 64 + p];
                o[0] = cr * wr - ci * wi; o[1] = -(cr * wi + ci * wr);
            }
            *(unsigned*)(B2 + (((size_t)l * 32 + g) * 256 + n2) * 512 + k) = pk2(o[0], o[1]);
        }
    }
    SEAM(1);

    for (int l = 0; l < DEPTH; ++l) {
        const int ph = PH_LAYER0 + l * PH_PER_LAYER;
        const bool last = l == DEPTH - 1;
        const float* MODl = (const float*)(ws + WS_MOD) + (size_t)l * 9 * 6144;
        PHASE_K(2, ph + 0) { if (l == 0) rowpass1<true>(P, 0); else rowpass1<false>(P, l); }
        SEAM(ph + 0);
        PHASE_K(3, ph + 1) {
            {
                Epi8Inproj ep{(bf16_t*)(ws + WS_QK), (bf16_t*)(ws + WS_VT), (bf16_t*)(ws + WS_US), (const float*)(ws + WS_ROPE)};
                const pg8::Gemm g{(const bf16_t*)(ws + WS_HX), (const bf16_t*)(ws + WS_WINT) + (size_t)l * 2048 * 1024, R, 2048, 1024};
                const TileOrder S{128 * 8, G, vcu, 16, 8, 0, 17, 1};
                pg8::gemm_phase<Epi8Inproj, TileOrder, true, true>(ldsp, g, S, ep);
            }
            for (int u = vcu; u < 16 * 16; u += G) {
                EpiInproj ep{(bf16_t*)(ws + WS_QK), (bf16_t*)(ws + WS_VT), (bf16_t*)(ws + WS_US), (const float*)(ws + WS_ROPE)};
                APlain af{(const bf16_t*)(ws + WS_HX), 1024};
                const int mt = u >> 4, nt = u & 15;
                gemm_unit_dma(lds, af, (const bf16_t*)(ws + WS_WINT) + (size_t)l * 2048 * 1024, 1024, 1024, (mt >> 1) * LP + (mt & 1) * 128, nt * 128, ep);
            }
        }
        SEAM(ph + 1);
        PHASE_K(4, ph + 2) {
            {
                Epi8S1 ep{(unsigned short*)(ws + WS_EB)};
                const pg8::Gemm g{(const bf16_t*)(ws + WS_US), (const bf16_t*)(ws + WS_WENDT) + (size_t)l * 32 * 256 * 512, 32 * NCHP, 32 * 256, 512};
                const TileOrder S{32 * 8, G, vcu, 8, 1, 1, 9, 0};
                pg8::gemm_phase<Epi8S1, TileOrder, true, true>(ldsp, g, S, ep);
            }
            for (int u = vcu; u < 64; u += G) {
                const int g = u >> 1, nt = u & 1;
                EpiS1 ep{(unsigned short*)(ws + WS_EB) + (size_t)g * NCHP * 256};
                APlain af{(const bf16_t*)(ws + WS_US) + (size_t)g * NCHP * 512, 512};
                gemm_unit_dma(lds, af, (const bf16_t*)(ws + WS_WENDT) + ((size_t)l * 32 + g) * 256 * 512, 512, 256, 2048, nt * 128, ep);
            }
        }
        SEAM(ph + 2);
        PHASE_K(15, ph + 3) {
            for (int u = bid * 2; u < NB * 32 * 2; u += G * 2) scan_block(lds, P, l, u);
        }
        SEAM(ph + 3);
        PHASE_K(5, ph + 4) {
            const float lam = ((const float*)(ws + WS_LAM))[l], lam_init = 0.8f - 0.6f * expf(-0.3f * (float)l);
            int rnd = 0;
            for (int u = vcu; u < (last ? 1024 : 1024 + 64); u += G, ++rnd) {
                if (rnd == ((bid >> 3) & 3)) conv_share(lds, P, l, bid, G);
                if (u < 1024) { const int qb = u & 31, bh = u >> 5; attn_unit(lds, P, l, bh >> 2, bh & 3, CTXL + qb * 128, LP, lam, lam_init); }
                else { const int v = u - 1024, qb = v & 1, bh = v >> 1; attn_unit(lds, P, l, bh >> 2, bh & 3, qb * 128, CTXL, lam, lam_init); }
            }
        }
        PHASE_K(6, ph + 4) {
            {
                Epi8S2 ep{(bf16_t*)(ws + WS_YG)};
                const pg8::Gemm g{(const bf16_t*)(ws + WS_US), (const bf16_t*)(ws + WS_BT2) + (size_t)l * 32 * 256 * 512, 32 * NCHP, 32 * 256, 512};
                const TileOrder S{32 * 8, G, vcu, 8, 1, 1, 9, 0};
                pg8::gemm_phase<Epi8S2, TileOrder, true, true>(ldsp, g, S, ep);
            }
            if (!last) for (int u = (vcu + G / 2) % G; u < 64; u += G) {
                const int g = u >> 1, nt = u & 1;
                EpiS2 ep{(bf16_t*)(ws + WS_YG), g};
                APlain af{(const bf16_t*)(ws + WS_US) + (size_t)g * NCHP * 512, 512};
                gemm_unit_dma(lds, af, (const bf16_t*)(ws + WS_BT2) + ((size_t)l * 32 + g) * 256 * 512, 512, 512, 2048, nt * 128, ep);
            }
        }
        SEAM(ph + 4);
        PHASE_K(7, ph + 5) {
            {
                Epi8Glu ep{(const bf16_t*)(ws + WS_YG), (bf16_t*)(ws + WS_MIX), P.in[23] + (size_t)l * 512};
                const pg8::Gemm g{(const bf16_t*)(ws + WS_YG), (const bf16_t*)(ws + WS_WGLUT) + (size_t)l * 512 * 512, R, 512, 512};
                const TileOrder S{128 * 2, G, vcu, 16, 2, 0, 17, 1};
                pg8::gemm_phase<Epi8Glu, TileOrder, true, true>(ldsp, g, S, ep);
            }
            if (!last) for (int u = vcu; u < 8 * 4; u += G) {
                EpiGlu ep{(const bf16_t*)(ws + WS_YG), (bf16_t*)(ws + WS_MIX), P.in[23] + (size_t)l * 512};
                APlain af{(const bf16_t*)(ws + WS_YG), 512};
                gemm_unit<256>(lds, af, (const bf16_t*)(ws + WS_WGLUT) + (size_t)l * 512 * 512, 512, 512, (u >> 2) * LP, (u & 3) * 128, ep);
            }
        }
        SEAM(ph + 5);
        PHASE_K(8, ph + 6) {
            {
                Epi8Out ep{(bf16_t*)(ws + WS_X), MODl};
                const pg8::Gemm g{(const bf16_t*)(ws + WS_MIX), (const bf16_t*)(ws + WS_WOUTT) + (size_t)l * 1024 * 1024, R, 1024, 1024};
                const TileOrder S{128 * 4, G, vcu, 16, 4, 0, 17, 1};
                pg8::gemm_phase<Epi8Out, TileOrder, true, true>(ldsp, g, S, ep);
            }
            if (!last) for (int u = vcu; u < 16 * 8; u += G) {
                EpiOut ep{(bf16_t*)(ws + WS_X), MODl};
                APlain af{(const bf16_t*)(ws + WS_MIX), 1024};
                const int mt = u >> 3, nt = u & 7;
                gemm_unit_dma(lds, af, (const bf16_t*)(ws + WS_WOUTT) + (size_t)l * 1024 * 1024, 1024, 1024, (mt >> 1) * LP + (mt & 1) * 128, nt * 128, ep);
            }
        }
        SEAM(ph + 6);
        PHASE_K(9, ph + 7) { rowpass2(lds, P, l); }
        SEAM(ph + 7);
        PHASE_K(10, ph + 8) {
            for (int u = bid; u < (last ? 128 : 256); u += G) select_unit(lds, P, (u & 127) >> 4, u & 15, u < 128);
        }
        SEAM(ph + 8);
        PHASE_K(11, ph + 9) {
            Epi8Moe1 ep{(bf16_t*)(ws + WS_HG)};
            const pg8::Gemm g{(const bf16_t*)(ws + WS_HX), (const bf16_t*)(ws + WS_W13T) + (size_t)l * 16 * 4096 * 1024, 16 * ROWS_E, 16 * 4096, 1024, (const int*)(ws + WS_IDX), 131072 + 64};
            const TileOrder S = last ? TileOrder{16 * 16 * 16, G, vcu, 16, 16, 16, 17, 0, 1} : TileOrder{16 * 17 * 16, G, vcu, 17, 16, 16, 17, 0, 1};
            pg8::gemm_phase<Epi8Moe1, TileOrder, true, true, true>(ldsp, g, S, ep);
        }
        SEAM(ph + 9);
        PHASE_K(12, ph + 10) {
            {
                Epi8Moe2 ep{(bf16_t*)(ws + WS_OG), (const float*)(ws + WS_GATE)};
                const pg8::Gemm g{(const bf16_t*)(ws + WS_HG), (const bf16_t*)(ws + WS_W2T) + (size_t)l * 16 * 1024 * 2048, 16 * ROWS_E, 16 * 1024, 2048};
                const TileOrder S{16 * 16 * 4, G, vcu, 16, 4, 4, 17, 0};
                pg8::gemm_phase<Epi8Moe2, TileOrder, true, true>(ldsp, g, S, ep);
            }
            if (!last) for (int u = vcu; u < 16 * 2 * 8; u += G) {
                const int e = u >> 4, mt = (u >> 3) & 1, nt = u & 7;
                EpiMoe2 ep{(bf16_t*)(ws + WS_OG) + (size_t)e * ROWS_E * 1024, (const float*)(ws + WS_GATE) + (size_t)e * ROWS_E};
                APlain af{(const bf16_t*)(ws + WS_HG) + (size_t)e * ROWS_E * FF, FF};
                gemm_unit_dma(lds, af, (const bf16_t*)(ws + WS_W2T) + ((size_t)l * 16 + e) * 1024 * 2048, 2048, 2048, NB * CAPL + mt * 128, nt * 128, ep);
            }
        }
        SEAM(ph + 10);
    }
    PHASE_K(13, PH_FINAL) { rowpass1<false>(P, DEPTH); }
#undef ws
}

#ifndef MK_MULTI
#define MK_MULTI 0
#endif

extern "C" void kernel_launch(void* const* d_in, const int* in_sizes, int n_in, void* d_out, int out_size, void* d_ws, size_t ws_size, hipStream_t stream) {
    static int grid = 0;
    if (!grid) {
        int dev = 0, cus = 0, per_cu = 0;
        hipGetDevice(&dev);
        hipDeviceGetAttribute(&cus, hipDeviceAttributeMultiprocessorCount, dev);
        hipFuncSetAttribute((const void*)fwd_kernel, hipFuncAttributeMaxDynamicSharedMemorySize, LDS_BYTES);
        hipOccupancyMaxActiveBlocksPerMultiprocessor(&per_cu, fwd_kernel, 512, LDS_BYTES);
        grid = cus * (per_cu < 1 ? per_cu : 1);
        if (grid <= 0) { fprintf(stderr, "occupancy query failed (per_cu=%d cus=%d)\n", per_cu, cus); grid = 256; }
        if (ws_size < WS_END) fprintf(stderr, "workspace too small: %zu < %zu\n", ws_size, (size_t)WS_END);
    }
    Params p{};
    for (int i = 0; i < 30; ++i) p.in[i] = (const float*)d_in[i];
    p.out = (float*)d_out; p.ws = (unsigned char*)d_ws;
    hipMemsetAsync(d_ws, 0, CTL_BYTES, stream);
#if MK_MULTI
    for (int ph = 0; ph < N_PHASES; ++ph) {
        p.lo = ph; p.hi = ph + 1;
        hipLaunchKernelGGL(fwd_kernel, dim3(grid), dim3(512), LDS_BYTES, stream, p);
    }
#else
    p.lo = 0; p.hi = N_PHASES;
    hipLaunchKernelGGL(fwd_kernel, dim3(grid), dim3(512), LDS_BYTES, stream, p);
#endif
}
```

```cpp
#include <hip/hip_runtime.h>
#include <cstdio>
#include <cstdint>
#include <cmath>

#define DEVI __device__ __forceinline__
#define LAS __attribute__((address_space(3)))

typedef unsigned short bf16_t;
typedef short bf16x8 __attribute__((ext_vector_type(8)));
typedef float f32x2 __attribute__((ext_vector_type(2)));
typedef float f32x4 __attribute__((ext_vector_type(4)));
typedef float f32x16 __attribute__((ext_vector_type(16)));
typedef unsigned u32x2 __attribute__((ext_vector_type(2)));
typedef unsigned u32x4 __attribute__((ext_vector_type(4)));
typedef __bf16 bf16x2_t __attribute__((ext_vector_type(2)));

constexpr int NB = 8, SEQ = 4096, CTXL = 256, DM = 1024, DEPTH = 4;
constexpr int LP = CTXL + SEQ;
constexpr int R = NB * LP;
constexpr int NCHB = LP / 16;
constexpr int NCH = NB * NCHB;
constexpr int NE = 16, CAPL = 512, CAPC = 32, ROWS_BE = CAPL + CAPC  , ROWS_E = NB * ROWS_BE  , FF = 2048;
constexpr int NH = 4;
constexpr float EPS = 1e-6f;
constexpr float QSCALE = 0.125f * 1.4426950408889634f;

constexpr size_t al256(size_t x) { return (x + 255) & ~(size_t)255; }
constexpr size_t WS_CTL = 0, CTL_BYTES = 65536;
constexpr size_t WS_MOD = WS_CTL + CTL_BYTES;
constexpr size_t WS_ROPE = WS_MOD + al256((size_t)4 * 9 * 6144 * 4);
constexpr size_t WS_LAM = WS_ROPE + al256(64 * 16 * 2 * 4);
constexpr size_t WS_KTAB = WS_LAM + 256;
constexpr size_t WS_PW = WS_KTAB + (size_t)4 * 2 * 32 * 4096 * 4;
constexpr size_t WS_BBAR = WS_PW + al256((size_t)4 * 2 * 32 * 64 * 17 * 2 * 4);
constexpr size_t WS_WENDT = WS_BBAR + al256((size_t)4 * 2 * 32 * 64 * 16 * 2 * 4);
constexpr size_t WS_BT2 = WS_WENDT + (size_t)4 * 32 * 256 * 512 * 2;
constexpr size_t WS_WINT = WS_BT2 + (size_t)4 * 32 * 256 * 512 * 2;
constexpr size_t WS_WOUTT = WS_WINT + (size_t)4 * 2048 * 1024 * 2;
constexpr size_t WS_WGLUT = WS_WOUTT + (size_t)4 * 1024 * 1024 * 2;
constexpr size_t WS_W13T = WS_WGLUT + (size_t)4 * 512 * 512 * 2;
constexpr size_t WS_W2T = WS_W13T + (size_t)4 * 16 * 4096 * 1024 * 2;
constexpr size_t WS_X = WS_W2T + (size_t)4 * 16 * 1024 * 2048 * 2;
constexpr size_t WS_HX = WS_X + (size_t)R * 1024 * 4;
constexpr size_t WS_QK = WS_HX + (size_t)R * 1024 * 2;
constexpr size_t WS_VT = WS_QK + (size_t)R * 1024 * 2;
constexpr int NCHP = 2304;
constexpr size_t WS_US = WS_VT + (size_t)R * 512 * 2;
constexpr size_t WS_EB = WS_US + (size_t)32 * NCHP * 512 * 2;
constexpr size_t WS_MIX = WS_EB + (size_t)32 * NCHP * 256 * 4;
constexpr size_t WS_YG = WS_MIX + (size_t)R * 1024 * 2;
constexpr size_t WS_AFFT = WS_YG + (size_t)R * 512 * 2;
constexpr size_t WS_SLOT = WS_AFFT + (size_t)NB * 16 * LP * 4;
constexpr size_t WS_GATE = WS_SLOT + (size_t)R * 16 * 4;
constexpr size_t WS_IDX = WS_GATE + al256((size_t)16 * ROWS_E * 4);
constexpr size_t WS_XG = WS_IDX + al256((size_t)16 * ROWS_E * 4);
constexpr size_t WS_HG = WS_XG + (size_t)16 * ROWS_E * 1024 * 2;
constexpr size_t WS_OG = WS_HG + (size_t)16 * ROWS_E * 2048 * 2;
constexpr size_t WS_END = WS_OG + (size_t)16 * ROWS_E * 1024 * 2;

constexpr int LDS_BYTES = 131072 + 64 + 16384;

DEVI unsigned pk2(float lo, float hi) { f32x2 v = {lo, hi}; bf16x2_t b = __builtin_convertvector(v, bf16x2_t); return __builtin_bit_cast(unsigned, b); }
DEVI bf16_t f2bf(float f) { return (bf16_t)(pk2(f, 0.f) & 0xffffu); }
DEVI float bflo(unsigned u) { return __builtin_bit_cast(float, u << 16); }
DEVI float bfhi(unsigned u) { return __builtin_bit_cast(float, u & 0xffff0000u); }
DEVI f32x4 bf4(u32x2 w) { return (f32x4){bflo(w.x), bfhi(w.x), bflo(w.y), bfhi(w.y)}; }
typedef _Float16 h16x2 __attribute__((ext_vector_type(2)));
DEVI unsigned hpk2(float lo, float hi) { unsigned r; asm("v_cvt_pk_f16_f32 %0, %1, %2" : "=v"(r) : "v"(lo), "v"(hi)); return r; }
DEVI float hlo(unsigned u) { return (float)__builtin_bit_cast(_Float16, (unsigned short)(u & 0xffffu)); }
DEVI float hhi(unsigned u) { return (float)__builtin_bit_cast(_Float16, (unsigned short)(u >> 16)); }
DEVI f32x4 hf4(u32x2 w) { return (f32x4){hlo(w.x), hhi(w.x), hlo(w.y), hhi(w.y)}; }
DEVI int tid_l() { int t = threadIdx.x; asm volatile("" : "+v"(t)); return t; }
#define GAS __attribute__((address_space(1)))
DEVI unsigned char* ptr_l(unsigned char* w) { GAS unsigned char* g = (GAS unsigned char*)w; asm volatile("" : "+s"(g)); return (unsigned char*)g; }
template <int CTRL> DEVI float dppmov(float x) { return __builtin_bit_cast(float, __builtin_amdgcn_update_dpp(0, __builtin_bit_cast(int, x), CTRL, 0xf, 0xf, true)); }
DEVI void swap16(float a, float b, float& r0, float& r1) { const auto r = __builtin_amdgcn_permlane16_swap(__builtin_bit_cast(unsigned, a), __builtin_bit_cast(unsigned, b), false, false); r0 = __builtin_bit_cast(float, (unsigned)r[0]); r1 = __builtin_bit_cast(float, (unsigned)r[1]); }
DEVI void swap32(float a, float b, float& r0, float& r1) { const auto r = __builtin_amdgcn_permlane32_swap(__builtin_bit_cast(unsigned, a), __builtin_bit_cast(unsigned, b), false, false); r0 = __builtin_bit_cast(float, (unsigned)r[0]); r1 = __builtin_bit_cast(float, (unsigned)r[1]); }
DEVI float wave_sum(float v) {
    v += dppmov<0xB1>(v);
    v += dppmov<0x4E>(v);
    v += dppmov<0x124>(v);
    v += dppmov<0x128>(v);
    float r0, r1; swap16(v, v, r0, r1); v = r0 + r1;
    swap32(v, v, r0, r1); return r0 + r1;
}
DEVI float fast_exp2(float x) { return __builtin_amdgcn_exp2f(x); }
DEVI float sigmoidf_(float x) { return __builtin_amdgcn_rcpf(1.f + __expf(-x)); }
DEVI float gelu_tanh(float x) { const float z = 0.7978845608028654f * (x + 0.044715f * x * x * x); const float t = 1.f - 2.f * __builtin_amdgcn_rcpf(__expf(2.f * z) + 1.f); return 0.5f * x * (1.f + t); }
#define MFMA32(a, b, c) __builtin_amdgcn_mfma_f32_32x32x16_bf16(a, b, c, 0, 0, 0)

#define XB_TMO      128
#define XB_XCNT(j)  (256  + 64 * (j))
#define XB_XSUB(j)  (1280 + 64 * (j))
#define XB_XGEN(j)  (2304 + 64 * (j))
#define XB_TOP      3328
#define XB_TOPGEN   3392
#define XCD_BAR_WORDS 3456
#define XB_SPIN_CAP (1u << 20)
DEVI unsigned xb_ld(unsigned* p)              { return __hip_atomic_load(p, __ATOMIC_RELAXED, __HIP_MEMORY_SCOPE_AGENT); }
DEVI unsigned xb_add(unsigned* p, unsigned v) { return __hip_atomic_fetch_add(p, v, __ATOMIC_RELAXED, __HIP_MEMORY_SCOPE_AGENT); }
DEVI unsigned xb_xcc_id() { return (unsigned)__builtin_amdgcn_s_getreg((3 << 11) | 20) & 0xFu; }
#define XB_SPIN(cond, bar) do { unsigned _sp = 0; while (cond) { __builtin_amdgcn_s_sleep(1); \
    if ((++_sp & 255u) == 0u) { if (xb_ld(&(bar)[XB_TMO])) break; if (_sp > XB_SPIN_CAP) { atomicAdd(&(bar)[XB_TMO], 1u); break; } } } } while (0)
struct XcdBarrier { unsigned* bar; unsigned x; volatile LAS unsigned* st; };
DEVI XcdBarrier xcd_barrier_post(unsigned* bar, volatile LAS unsigned* st) {
    XcdBarrier b; b.bar = bar; b.x = xb_xcc_id(); b.st = st;
    if (threadIdx.x == 0) (void)xb_add(&bar[XB_XCNT(b.x)], 1u);
    return b;
}
DEVI void xcd_barrier_complete(unsigned* bar, unsigned x, unsigned& nloc, unsigned& nx) {
    const unsigned G = gridDim.x * gridDim.y * gridDim.z;
    unsigned sum, cnt, mine, sp = 0u;
    for (;;) {
        sum = 0u; cnt = 0u; mine = 0u;
#pragma unroll
        for (unsigned j = 0; j < 16; ++j) { const unsigned c = xb_ld(&bar[XB_XCNT(j)]); sum += c; cnt += (c > 0u) ? 1u : 0u; mine = (j == x) ? c : mine; }
        if (sum == G) break;
        __builtin_amdgcn_s_sleep(1);
        if ((++sp & 255u) == 0u) { if (xb_ld(&bar[XB_TMO])) break; if (sp > XB_SPIN_CAP) { atomicAdd(&bar[XB_TMO], 1u); break; } }
    }
    nloc = mine > 0u ? mine : 1u; nx = cnt > 0u ? cnt : 1u;
}
DEVI void xcd_barrier(const XcdBarrier& b) {
    asm volatile("s_waitcnt vmcnt(0)" ::: "memory");
    __syncthreads();
    if (threadIdx.x == 0) {
        unsigned* bar = b.bar;
        __builtin_amdgcn_s_waitcnt(0);
        unsigned nloc = b.st[0], nx = b.st[1];
        if (nloc == 0u) { xcd_barrier_complete(bar, b.x, nloc, nx); b.st[0] = nloc; b.st[1] = nx; }
        const unsigned old = xb_add(&bar[XB_XSUB(b.x)], 1u);
        const unsigned gen = old / nloc;
        if (old + 1u == (gen + 1u) * nloc) {
            __builtin_amdgcn_fence(__ATOMIC_RELEASE, "agent");
            asm volatile("s_waitcnt vmcnt(0)" ::: "memory");
            const unsigned og = xb_add(&bar[XB_TOP], 1u);
            const unsigned tg = og / nx;
            if (og + 1u == (tg + 1u) * nx) xb_add(&bar[XB_TOPGEN], 1u);
            else XB_SPIN(xb_ld(&bar[XB_TOPGEN]) == tg, bar);
            __builtin_amdgcn_fence(__ATOMIC_ACQUIRE, "agent");
            xb_add(&bar[XB_XGEN(b.x)], 1u);
            asm volatile("s_waitcnt vmcnt(0)" ::: "memory");
        } else {
            XB_SPIN(xb_ld(&bar[XB_XGEN(b.x)]) == gen, bar);
            __builtin_amdgcn_fence(__ATOMIC_ACQUIRE, "agent");
            asm volatile("s_waitcnt vmcnt(0)" ::: "memory");
        }
    }
    __syncthreads();
}

DEVI int chunk_row(int b, int c) { return c >= 16 ? b * 256 + (c - 16) : 2048 + b * 16 + c; }
DEVI int chunk_row_token(int cr) { return cr < 2048 ? (cr >> 8) * LP + (16 + (cr & 255)) * 16 : ((cr - 2048) >> 4) * LP + ((cr - 2048) & 15) * 16; }
DEVI int perm16(int k) { return (k & 3) | ((k & 4) << 1) | ((k & 8) >> 1); }

namespace pg8 {
#define PG8_LAS __attribute__((address_space(3)))
typedef unsigned short bf16_t;
typedef short bf16x8 __attribute__((ext_vector_type(8)));
typedef float f32x4 __attribute__((ext_vector_type(4)));
typedef unsigned u32x4 __attribute__((ext_vector_type(4)));
constexpr int BM = 256, BK = 64, HALF = 128, HTB = HALF * BK * 2  , STAGE_BYTES = 8 * HTB, NXCD = 8, WGM = 8;

__host__ __device__ __forceinline__ int lds_byte(int r, int c) { const int st = (r >> 4) * 2 + (c >> 5), rr = r & 15, cc = c & 31, ob = rr * 64 + cc * 2; return st * 1024 + (ob ^ (((ob >> 9) & 1) << 5)); }
__host__ __device__ __forceinline__ void stage_rc(int b, int& R, int& C) { const int st = b / 1024, sb = b % 1024, swz = sb ^ (((sb >> 9) & 1) << 5); R = (st >> 1) * 16 + swz / 64; C = (st & 1) * 32 + (swz % 64) / 2; }
__host__ __device__ __forceinline__ int perm32(int rho) { const int n = rho >> 4, i = rho & 15; return 8 * (i >> 2) + 4 * n + (i & 3); }

struct Unit { int pm, pn; };
struct Gemm { const bf16_t* A; const bf16_t* Bt; int M, N, K; const int* gidx = nullptr; int islot = 0; };
__device__ __forceinline__ unsigned cvt_pk_bf16(float lo, float hi) { unsigned r; asm volatile("v_cvt_pk_bf16_f32 %0, %1, %2" : "=v"(r) : "v"(lo), "v"(hi)); return r; }
template <class Epi, class Sched, bool ALIGN_EPI = false, bool SP2 = false, bool GATH = false>
__device__ __forceinline__ void gemm_phase(PG8_LAS unsigned char* lds, const Gemm g, const Sched& S, const Epi& E) {
    static_assert(!GATH || SP2, "the gathered-A form is written for the SP2 loop only");
    const int tid = tid_l(), wid = __builtin_amdgcn_readfirstlane(tid >> 6), lane = tid & 63, wr = wid >> 2, wc = wid & 3, fr = lane & 15, fq = lane >> 4;
    const int K = g.K, nt = K / BK;
    unsigned voffA[2], voffB[2];
    int stR[2], stC[2];
#pragma unroll
    for (int i = 0; i < 2; ++i) { int R, C; stage_rc(tid * 16 + i * 8192, R, C); const int Rb = Epi::PERM ? ((R & ~31) + perm32(R & 31)) : R; stR[i] = R; stC[i] = C;
        voffA[i] = (unsigned)(R * K + C) * 2u; voffB[i] = (unsigned)(Rb * K + C) * 2u; }
    unsigned goff[2][2], ngoff[2][2];
    const char* gA = (const char*)g.A;
    const size_t kstep = (size_t)(BK * 2);
    const size_t hstep = (size_t)HALF * K * 2;
    const size_t tstep = 2 * hstep;
    const unsigned ldsw = (unsigned)wid * 1024u;
    const int aoff = lds_byte(wr * 64 + fr, fq * 8), boff = lds_byte(wc * 32 + fr, fq * 8);
#define PG8_SA(b, h) (((b) * 2 + (h)) * HTB)
#define PG8_SB(b, h) ((4 + (b) * 2 + (h)) * HTB)
#define PG8_STAGE(bufoff, gbase, voff) do { _Pragma("unroll") for (int _i = 0; _i < 2; ++_i) \
        __builtin_amdgcn_global_load_lds((const unsigned*)((const char*)(gbase) + (voff)[_i]), (PG8_LAS unsigned*)(lds + (bufoff) + ldsw + _i * 8192), 16, 0, 0); } while (0)
#define PG8_STAGE_A(bufoff, selnext, kt, h) do { if constexpr (GATH) PG8_STAGE(bufoff, gA + (size_t)(kt) * kstep, ((selnext) ? ngoff[h] : goff[h])); \
        else PG8_STAGE(bufoff, ((selnext) ? nA : cA) + (size_t)(kt) * kstep + (size_t)(h) * hstep, voffA); } while (0)
#define PG8_LDA(dst, b, h) do { _Pragma("unroll") for (int m = 0; m < 4; ++m) _Pragma("unroll") for (int k = 0; k < 2; ++k) dst[m][k] = *(const PG8_LAS bf16x8*)(lds + PG8_SA(b, h) + aoff + m * 2048 + k * 1024); } while (0)
#define PG8_LDB(dst, b, h) do { _Pragma("unroll") for (int n = 0; n < 2; ++n) _Pragma("unroll") for (int k = 0; k < 2; ++k) dst[n][k] = *(const PG8_LAS bf16x8*)(lds + PG8_SB(b, h) + boff + n * 2048 + k * 1024); } while (0)
#define PG8_MMA(ai, bj, At, Bt) do { __builtin_amdgcn_s_setprio(1); _Pragma("unroll") for (int m = 0; m < 4; ++m) _Pragma("unroll") for (int n = 0; n < 2; ++n) _Pragma("unroll") for (int k = 0; k < 2; ++k) \
        acc[ai][bj][m][n] = __builtin_amdgcn_mfma_f32_16x16x32_bf16(Bt[n][k], At[m][k], acc[ai][bj][m][n], 0, 0, 0); __builtin_amdgcn_s_setprio(0); } while (0)
#define PG8_WAIT_V(n) asm volatile("s_waitcnt vmcnt(" #n ")" ::: "memory")
#define PG8_WAIT_L(n) asm volatile("s_waitcnt lgkmcnt(" #n ")" ::: "memory")
#define PG8_BAR __builtin_amdgcn_s_barrier()
#define PG8_SCHED __builtin_amdgcn_sched_barrier(0)
    Unit cur, nxt; int ui = 0;
    if (!S.next(0, cur)) return;
    f32x4 acc[2][2][4][2];
#pragma unroll
    for (int a = 0; a < 2; ++a)
#pragma unroll
        for (int b = 0; b < 2; ++b)
#pragma unroll
            for (int m = 0; m < 4; ++m)
#pragma unroll
                for (int n = 0; n < 2; ++n) acc[a][b][m][n] = (f32x4){0.f, 0.f, 0.f, 0.f};
    bf16x8 At[4][2], B0[2][2], B1[2][2];
    const char* cA = (const char*)g.A + (size_t)cur.pm * tstep; const char* cB = (const char*)g.Bt + (size_t)cur.pn * tstep;
    const char* nA = cA;
    if constexpr (GATH) {
#pragma unroll
        for (int h = 0; h < 2; ++h)
#pragma unroll
            for (int i = 0; i < 2; ++i) { goff[h][i] = (unsigned)(g.gidx[cur.pm * 256 + h * 128 + stR[i]] * K + stC[i]) * 2u; ngoff[h][i] = goff[h][i]; }
    }
    S.a_ready(cur);
    if constexpr (SP2) {
        PG8_STAGE(PG8_SB(0, 0), cB, voffB); PG8_STAGE(PG8_SB(0, 1), cB + hstep, voffB); PG8_STAGE_A(PG8_SA(0, 0), false, 0, 0); PG8_STAGE_A(PG8_SA(0, 1), false, 0, 1);
        if (wr == 1) PG8_BAR;
        PG8_WAIT_V(2); PG8_BAR;
        PG8_STAGE(PG8_SB(1, 0), cB + kstep, voffB); PG8_STAGE_A(PG8_SA(1, 0), false, 1, 0); PG8_STAGE(PG8_SB(1, 1), cB + hstep + kstep, voffB);
        PG8_WAIT_V(6); PG8_BAR;
    } else {
        PG8_STAGE(PG8_SB(0, 0), cB, voffB); PG8_STAGE(PG8_SA(0, 0), cA, voffA); PG8_STAGE(PG8_SB(0, 1), cB + hstep, voffB); PG8_STAGE(PG8_SA(0, 1), cA + hstep, voffA);
        if (wr == 1) PG8_BAR;
        PG8_WAIT_V(4); PG8_BAR;
        PG8_STAGE(PG8_SB(1, 0), cB + kstep, voffB); PG8_STAGE(PG8_SA(1, 0), cA + kstep, voffA); PG8_STAGE(PG8_SB(1, 1), cB + hstep + kstep, voffB);
        PG8_WAIT_V(6); PG8_BAR;
    }
    for (;;) {
        const bool has_next = S.next(ui + 1, nxt);
        nA = has_next ? (const char*)g.A + (size_t)nxt.pm * tstep : cA; const char* nB = has_next ? (const char*)g.Bt + (size_t)nxt.pn * tstep : cB;
        if constexpr (GATH) {
            if (has_next) {
#pragma unroll
                for (int h = 0; h < 2; ++h)
#pragma unroll
                    for (int i = 0; i < 2; ++i)
                        __builtin_amdgcn_global_load_lds((const unsigned*)(g.gidx + nxt.pm * 256 + h * 128 + stR[i]), (PG8_LAS unsigned*)(lds + g.islot + ((ui + 1) & 1) * 8192 + (h * 2 + i) * 2048 + wid * 256), 4, 0, 0);
            }
        }
        for (int t = 0; t < nt; t += 2) {
            const bool last = (t == nt - 2);
            if constexpr (GATH) {
                if (last) {
                    if (has_next) {
#pragma unroll
                        for (int h = 0; h < 2; ++h)
#pragma unroll
                            for (int i = 0; i < 2; ++i) { const int ix = *(const PG8_LAS int*)(lds + g.islot + ((ui + 1) & 1) * 8192 + (h * 2 + i) * 2048 + wid * 256 + lane * 4); ngoff[h][i] = (unsigned)(ix * K + stC[i]) * 2u; }
                    } else {
#pragma unroll
                        for (int h = 0; h < 2; ++h)
#pragma unroll
                            for (int i = 0; i < 2; ++i) ngoff[h][i] = goff[h][i];
                    }
                }
            }
            const char* a1 = cA + (size_t)(t + 1) * kstep;
            const char* a2 = last ? nA : cA + (size_t)(t + 2) * kstep; const char* b2 = last ? nB : cB + (size_t)(t + 2) * kstep;
            const char* a3 = a2 + kstep; const char* b3 = b2 + kstep;
            if (last && has_next) S.a_ready(nxt);
            if constexpr (SP2) {
            PG8_LDB(B0, 0, 0); PG8_LDB(B1, 0, 1); PG8_SCHED; PG8_LDA(At, 0, 0); PG8_STAGE_A(PG8_SA(1, 1), false, t + 1, 1);
            PG8_WAIT_V(8); PG8_WAIT_L(0); PG8_BAR; PG8_MMA(0, 0, At, B0); PG8_MMA(0, 1, At, B1); PG8_BAR; PG8_SCHED;
            PG8_LDA(At, 0, 1); PG8_STAGE(PG8_SB(0, 0), b2, voffB); PG8_STAGE(PG8_SB(0, 1), b2 + hstep, voffB); PG8_STAGE_A(PG8_SA(0, 0), last, last ? 0 : t + 2, 0);
            PG8_WAIT_V(8); PG8_WAIT_L(0); PG8_BAR; PG8_MMA(1, 0, At, B0); PG8_MMA(1, 1, At, B1); PG8_BAR; PG8_SCHED;
            PG8_LDB(B0, 1, 0); PG8_LDB(B1, 1, 1); PG8_SCHED; PG8_LDA(At, 1, 0); PG8_STAGE_A(PG8_SA(0, 1), last, last ? 0 : t + 2, 1);
            PG8_WAIT_V(8); PG8_WAIT_L(0); PG8_BAR; PG8_MMA(0, 0, At, B0); PG8_MMA(0, 1, At, B1); PG8_BAR; PG8_SCHED;
            PG8_LDA(At, 1, 1); PG8_STAGE(PG8_SB(1, 0), b3, voffB); PG8_STAGE(PG8_SB(1, 1), b3 + hstep, voffB); PG8_STAGE_A(PG8_SA(1, 0), last, last ? 1 : t + 3, 0);
            PG8_WAIT_V(8); PG8_WAIT_L(0); PG8_BAR; PG8_MMA(1, 0, At, B0); PG8_MMA(1, 1, At, B1); PG8_BAR; PG8_SCHED;
            } else {
            PG8_LDB(B0, 0, 0); PG8_SCHED; PG8_LDA(At, 0, 0); PG8_STAGE(PG8_SA(1, 1), a1 + hstep, voffA);
            PG8_WAIT_L(8); PG8_BAR; PG8_WAIT_L(0); PG8_MMA(0, 0, At, B0); PG8_BAR; PG8_SCHED;
            PG8_LDB(B1, 0, 1); PG8_STAGE(PG8_SB(0, 0), b2, voffB);
            PG8_BAR; PG8_WAIT_L(0); PG8_MMA(0, 1, At, B1); PG8_BAR;
            PG8_LDA(At, 0, 1); PG8_STAGE(PG8_SA(0, 0), a2, voffA);
            PG8_BAR; PG8_WAIT_L(0); PG8_MMA(1, 0, At, B0); PG8_BAR; PG8_SCHED;
            PG8_STAGE(PG8_SB(0, 1), b2 + hstep, voffB);
            PG8_WAIT_V(6); PG8_BAR; PG8_MMA(1, 1, At, B1); PG8_BAR;
            PG8_LDB(B0, 1, 0); PG8_SCHED; PG8_LDA(At, 1, 0); PG8_STAGE(PG8_SA(0, 1), a2 + hstep, voffA);
            PG8_WAIT_L(8); PG8_BAR; PG8_WAIT_L(0); PG8_MMA(0, 0, At, B0); PG8_BAR; PG8_SCHED;
            PG8_LDB(B1, 1, 1); PG8_STAGE(PG8_SB(1, 0), b3, voffB);
            PG8_BAR; PG8_WAIT_L(0); PG8_MMA(0, 1, At, B1); PG8_BAR;
            PG8_LDA(At, 1, 1); PG8_STAGE(PG8_SA(1, 0), a3, voffA);
            PG8_BAR; PG8_WAIT_L(0); PG8_MMA(1, 0, At, B0); PG8_BAR; PG8_SCHED;
            PG8_STAGE(PG8_SB(1, 1), b3 + hstep, voffB);
            PG8_WAIT_V(6); PG8_BAR; PG8_MMA(1, 1, At, B1); PG8_BAR;
            }
        }
        if constexpr (ALIGN_EPI) { if (wr == 0) PG8_BAR; }
        if constexpr (!Epi::AFTER_DRAIN) { E(acc, cur, wr, wc, fr, fq); S.done(cur); }
        if (!has_next) break;
#pragma unroll
        for (int a = 0; a < 2; ++a)
#pragma unroll
            for (int b = 0; b < 2; ++b)
#pragma unroll
                for (int m = 0; m < 4; ++m)
#pragma unroll
                    for (int n = 0; n < 2; ++n) acc[a][b][m][n] = (f32x4){0.f, 0.f, 0.f, 0.f};
        cur = nxt; cA = nA; cB = nB; ++ui;
        if constexpr (GATH) {
#pragma unroll
            for (int h = 0; h < 2; ++h)
#pragma unroll
                for (int i = 0; i < 2; ++i) goff[h][i] = ngoff[h][i];
        }
        if constexpr (ALIGN_EPI) { if (wr == 1) PG8_BAR; }
    }
    PG8_WAIT_V(0);
    if constexpr (!ALIGN_EPI) { if (wr == 0) PG8_BAR; }
    PG8_BAR;
    if constexpr (Epi::AFTER_DRAIN) { E.fused(acc, cur, wr, wc, fr, fq, lds, wid, lane); S.done(cur); }
#undef PG8_SA
#undef PG8_SB
#undef PG8_STAGE
#undef PG8_STAGE_A
#undef PG8_LDA
#undef PG8_LDB
#undef PG8_MMA
#undef PG8_WAIT_V
#undef PG8_WAIT_L
#undef PG8_BAR
#undef PG8_SCHED
}
}


struct TileOrder {
    int nunits, G, c, npm, npn, pn_gs, pm_gs, pm_off, blk48 = 0;
    DEVI bool next(int i, pg8::Unit& u) const {
        const int L = i * G + c; if (L >= nunits) return false;
        const int per = npm * npn, e = L / per, v = L - e * per; int pml = v / npn, pnl = v - pml * npn;
        if (blk48 && v < 256) { const int blk = v >> 5, w = v & 31; pml = (blk >> 1) * 4 + (w >> 3); pnl = (blk & 1) * 8 + (w & 7); }
        u.pm = e * pm_gs + pm_off + pml; u.pn = e * pn_gs + pnl; return true;
    }
    DEVI void a_ready(const pg8::Unit&) const {}
    DEVI void done(const pg8::Unit&) const {}
};

struct Epi8Inproj { static constexpr bool PERM = false, AFTER_DRAIN = false;
    bf16_t* QK; bf16_t* VT; bf16_t* UG; const float* rope;
    DEVI void operator()(const f32x4 (&acc)[2][2][4][2], const pg8::Unit& u, int wr, int wc, int fr, int fq) const {
        const int pn = u.pn;
#pragma unroll
        for (int ai = 0; ai < 2; ++ai)
#pragma unroll
            for (int m = 0; m < 4; ++m) {
                const int r = u.pm * 256 + ai * 128 + wr * 64 + m * 16 + fr, b = r / LP, p = r - b * LP; const bool latent = p >= CTXL; const int t = p - CTXL;
#pragma unroll
                for (int bj = 0; bj < 2; ++bj) {
                    const int cb = bj * 128 + wc * 32;
                    if (pn < 4) {
                        const int head = cb >> 6, dbase = cb & 63, pos = dbase == 0 ? (t >> 6) : (t & 63);
                        const float sc = pn < 2 ? QSCALE : 1.f;
                        f32x4 cs0 = {1.f, 0.f, 1.f, 0.f}, cs1 = {1.f, 0.f, 1.f, 0.f};
                        if (latent) { cs0 = *(const f32x4*)(rope + (pos * 16 + 4 * fq) * 2); cs1 = *(const f32x4*)(rope + (pos * 16 + 4 * fq + 2) * 2); }
                        const float cc[4] = {cs0.x, cs0.z, cs1.x, cs1.z}, sn[4] = {cs0.y, cs0.w, cs1.y, cs1.w};
                        bf16_t* dst = QK + ((size_t)((pn * NB + b) * NH + head) * LP + p) * 64 + dbase + 4 * fq;
#pragma unroll
                        for (int n = 0; n < 2; ++n) {
                            float o[4];
#pragma unroll
                            for (int j = 0; j < 4; ++j) { const float x = acc[ai][bj][m][n][j], y = acc[ai][bj][m][n ^ 1][j]; o[j] = (n == 0 ? x * cc[j] - y * sn[j] : x * cc[j] + y * sn[j]) * sc; }
                            u32x2 w; w.x = pk2(o[0], o[1]); w.y = pk2(o[2], o[3]);
                            *(u32x2*)(dst + 16 * n) = w;
                        }
                    } else if (pn < 6) {
                        const int cv = (pn - 4) * 256 + cb, head = cv >> 7, dv0 = (cv & 127) + 4 * fq;
                        const int pp = (p & ~15) | perm16(p & 15);
                        bf16_t* dst = VT + ((size_t)(b * NH + head) * 128 + dv0) * LP + pp;
#pragma unroll
                        for (int n = 0; n < 2; ++n)
#pragma unroll
                            for (int j = 0; j < 4; ++j) dst[(size_t)(16 * n + j) * LP] = f2bf(acc[ai][bj][m][n][j]);
                    } else {
                        const int ch0 = (pn - 6) * 256 + cb;
                        bf16_t* dst = UG + (size_t)chunk_row(b, p >> 4) * 512 + (p & 15) * 16 + 4 * fq;
#pragma unroll
                        for (int n = 0; n < 2; ++n) {
                            const int g = (ch0 + 16 * n) >> 4;
                            u32x2 w; w.x = pk2(acc[ai][bj][m][n][0], acc[ai][bj][m][n][1]); w.y = pk2(acc[ai][bj][m][n][2], acc[ai][bj][m][n][3]);
                            *(u32x2*)(dst + (size_t)g * NCHP * 512) = w;
                        }
                    }
                }
            }
    }
};

struct Epi8Out { static constexpr bool PERM = true, AFTER_DRAIN = false;
    bf16_t* X; const float* mod;
    DEVI void operator()(const f32x4 (&acc)[2][2][4][2], const pg8::Unit& u, int wr, int wc, int fr, int fq) const {
#pragma unroll
        for (int ai = 0; ai < 2; ++ai)
#pragma unroll
            for (int m = 0; m < 4; ++m) {
                const int r = u.pm * 256 + ai * 128 + wr * 64 + m * 16 + fr, b = r / LP, p = r - b * LP, jm = p < CTXL ? 8 : b;
                const float* g1 = mod + (size_t)jm * 6144 + 2 * 1024;
#pragma unroll
                for (int bj = 0; bj < 2; ++bj) {
                    const int c = u.pn * 256 + bj * 128 + wc * 32 + 8 * fq;
                    bf16_t* xp = X + (size_t)r * 1024 + c;
                    const u32x4 xw = *(const u32x4*)xp;
                    const f32x4 g0 = *(const f32x4*)(g1 + c), g4 = *(const f32x4*)(g1 + c + 4);
                    const f32x4 o0 = hf4((u32x2){xw.x, xw.y}) + g0 * acc[ai][bj][m][0], o1 = hf4((u32x2){xw.z, xw.w}) + g4 * acc[ai][bj][m][1];
                    u32x4 w; w.x = hpk2(o0.x, o0.y); w.y = hpk2(o0.z, o0.w); w.z = hpk2(o1.x, o1.y); w.w = hpk2(o1.z, o1.w);
                    *(u32x4*)xp = w;
                }
            }
    }
};

struct Epi8Moe1 { static constexpr bool PERM = true, AFTER_DRAIN = false;
    bf16_t* HG;
    DEVI void operator()(const f32x4 (&acc)[2][2][4][2], const pg8::Unit& u, int wr, int wc, int fr, int fq) const {
        const int t = u.pn & 15;
#pragma unroll
        for (int ai = 0; ai < 2; ++ai)
#pragma unroll
            for (int m = 0; m < 4; ++m) {
                const size_t row = (size_t)u.pm * 256 + ai * 128 + wr * 64 + m * 16 + fr;
                float o[8];
#pragma unroll
                for (int n = 0; n < 2; ++n)
#pragma unroll
                    for (int j = 0; j < 4; ++j) { const float a1 = acc[ai][0][m][n][j], a3 = acc[ai][1][m][n][j]; o[4 * n + j] = a1 * sigmoidf_(a1) * a3; }
                u32x4 w; w.x = pk2(o[0], o[1]); w.y = pk2(o[2], o[3]); w.z = pk2(o[4], o[5]); w.w = pk2(o[6], o[7]);
                *(u32x4*)(HG + row * FF + t * 128 + wc * 32 + 8 * fq) = w;
            }
    }
};

struct Epi8Moe2 { static constexpr bool PERM = true, AFTER_DRAIN = false;
    bf16_t* OG; const float* gate;
    DEVI void operator()(const f32x4 (&acc)[2][2][4][2], const pg8::Unit& u, int wr, int wc, int fr, int fq) const {
        const int t = u.pn & 3;
#pragma unroll
        for (int ai = 0; ai < 2; ++ai)
#pragma unroll
            for (int m = 0; m < 4; ++m) {
                const size_t row = (size_t)u.pm * 256 + ai * 128 + wr * 64 + m * 16 + fr; const float gt = gate[row];
#pragma unroll
                for (int bj = 0; bj < 2; ++bj) {
                    const f32x4 a = acc[ai][bj][m][0] * gt, c = acc[ai][bj][m][1] * gt;
                    u32x4 w; w.x = pk2(a.x, a.y); w.y = pk2(a.z, a.w); w.z = pk2(c.x, c.y); w.w = pk2(c.z, c.w);
                    *(u32x4*)(OG + row * 1024 + t * 256 + bj * 128 + wc * 32 + 8 * fq) = w;
                }
            }
    }
};

struct Epi8S1 { static constexpr bool PERM = true, AFTER_DRAIN = false;
    unsigned short* E;
    DEVI void operator()(const f32x4 (&acc)[2][2][4][2], const pg8::Unit& u, int wr, int wc, int fr, int fq) const {
        const int g = u.pn, r0 = (u.pm - g * 9) * 256 + wr * 64 + fr;
#pragma unroll
        for (int ai = 0; ai < 2; ++ai)
#pragma unroll
            for (int m = 0; m < 4; ++m) {
                const int cr = r0 + ai * 128 + m * 16;
                if (cr < NCH) {
                    unsigned short* dst = E + ((size_t)g * NCHP + cr) * 256 + wc * 32 + 8 * fq;
#pragma unroll
                    for (int bj = 0; bj < 2; ++bj) {
                        const f32x4 a = acc[ai][bj][m][0], d = acc[ai][bj][m][1];
                        u32x4 w; w.x = hpk2(a.x, a.y); w.y = hpk2(a.z, a.w); w.z = hpk2(d.x, d.y); w.w = hpk2(d.z, d.w);
                        *(u32x4*)(dst + bj * 128) = w;
                    }
                }
            }
    }
};
struct Epi8S2 { static constexpr bool PERM = true, AFTER_DRAIN = false;
    bf16_t* YG;
    DEVI void operator()(const f32x4 (&acc)[2][2][4][2], const pg8::Unit& u, int wr, int wc, int fr, int fq) const {
        const int g = u.pn, r0 = (u.pm - g * 9) * 256 + wr * 64 + fr;
#pragma unroll
        for (int ai = 0; ai < 2; ++ai)
#pragma unroll
            for (int m = 0; m < 4; ++m) {
                const int cr = r0 + ai * 128 + m * 16;
                if (cr < NCH) {
                    const size_t tok0 = (size_t)chunk_row_token(cr);
#pragma unroll
                    for (int bj = 0; bj < 2; ++bj) {
                        const int col = bj * 128 + wc * 32 + 8 * fq, j = col >> 4, h = col & 15;
                        const f32x4 a = acc[ai][bj][m][0], d = acc[ai][bj][m][1];
                        u32x4 w; w.x = pk2(gelu_tanh(a.x), gelu_tanh(a.y)); w.y = pk2(gelu_tanh(a.z), gelu_tanh(a.w)); w.z = pk2(gelu_tanh(d.x), gelu_tanh(d.y)); w.w = pk2(gelu_tanh(d.z), gelu_tanh(d.w));
                        *(u32x4*)(YG + (tok0 + j) * 512 + g * 16 + h) = w;
                    }
                }
            }
    }
};
struct Epi8Glu { static constexpr bool PERM = true, AFTER_DRAIN = false;
    const bf16_t* YG; bf16_t* MIX; const float* bglu;
    DEVI void operator()(const f32x4 (&acc)[2][2][4][2], const pg8::Unit& u, int wr, int wc, int fr, int fq) const {
#pragma unroll
        for (int ai = 0; ai < 2; ++ai)
#pragma unroll
            for (int m = 0; m < 4; ++m) {
                const size_t tok = (size_t)u.pm * 256 + ai * 128 + wr * 64 + m * 16 + fr;
#pragma unroll
                for (int bj = 0; bj < 2; ++bj) {
                    const int n0 = u.pn * 256 + bj * 128 + wc * 32 + 8 * fq;
                    const u32x4 y = *(const u32x4*)(YG + tok * 512 + n0);
                    const f32x4 b0 = *(const f32x4*)(bglu + n0), b1 = *(const f32x4*)(bglu + n0 + 4);
                    const f32x4 a = acc[ai][bj][m][0] + b0, d = acc[ai][bj][m][1] + b1;
                    u32x4 w; w.x = pk2(bflo(y.x) * sigmoidf_(a.x), bfhi(y.x) * sigmoidf_(a.y)); w.y = pk2(bflo(y.y) * sigmoidf_(a.z), bfhi(y.y) * sigmoidf_(a.w));
                    w.z = pk2(bflo(y.z) * sigmoidf_(d.x), bfhi(y.z) * sigmoidf_(d.y)); w.w = pk2(bflo(y.w) * sigmoidf_(d.z), bfhi(y.w) * sigmoidf_(d.w));
                    *(u32x4*)(MIX + tok * 1024 + 512 + n0) = w;
                }
            }
    }
};

struct Params {
    const float* in[30];
    float* out;
    unsigned char* ws;
    int lo, hi;
};

DEVI int swz(int row, int kc) { return row * 128 + ((kc ^ ((row >> 1) & 7)) << 4); }

struct APlain { const bf16_t* A; int lda; DEVI const bf16_t* ptr(int row, int k) const { return A + (size_t)row * lda + k; } };
struct AS2 { const bf16_t* U; const bf16_t* S; DEVI const bf16_t* ptr(int row, int k) const { return (k < 256 ? U : S) + (size_t)row * 8192 + (k & 255); } };

template <int BM, class AF, class Epi>
DEVI void gemm_unit(char* lds, const AF& af, const bf16_t* __restrict__ Bt, int ldb, int K, int m0, int n0, const Epi& epi) {
    constexpr int MT = BM / 128, ACH = BM / 64, A_BYTES = BM * 128, STAGE = A_BYTES + 16384, WM = BM / 4;
    const int tid = tid_l(), lane = tid & 63, wid = tid >> 6, wm = wid >> 1, wn = wid & 1, r32 = lane & 31, hi = lane >> 5;
    f32x16 acc[MT][2];
#pragma unroll
    for (int a = 0; a < MT; ++a)
#pragma unroll
        for (int b = 0; b < 2; ++b)
#pragma unroll
            for (int i = 0; i < 16; ++i) acc[a][b][i] = 0.f;
    u32x4 ra[ACH], rb[2];
    const int nk = K >> 6;
    const int crow = tid >> 3, ckc = tid & 7;
#define G_LOAD(kt) do { \
        _Pragma("unroll") for (int i = 0; i < ACH; ++i) ra[i] = *(const u32x4*)af.ptr(m0 + crow + 64 * i, (kt) * 64 + ckc * 8); \
        _Pragma("unroll") for (int i = 0; i < 2; ++i) rb[i] = *(const u32x4*)(Bt + (size_t)(n0 + crow + 64 * i) * ldb + (kt) * 64 + ckc * 8); } while (0)
#define G_STORE(s) do { char* _a = lds + (s) * STAGE; char* _b = _a + A_BYTES; \
        _Pragma("unroll") for (int i = 0; i < ACH; ++i) *(u32x4*)(_a + swz(crow + 64 * i, ckc)) = ra[i]; \
        _Pragma("unroll") for (int i = 0; i < 2; ++i) *(u32x4*)(_b + swz(crow + 64 * i, ckc)) = rb[i]; } while (0)
    G_LOAD(0); G_STORE(0); __syncthreads();
    for (int kt = 0; kt < nk; ++kt) {
        if (kt + 1 < nk) G_LOAD(kt + 1);
        const char* a = lds + (kt & 1) * STAGE; const char* b = a + A_BYTES;
#pragma unroll
        for (int ks = 0; ks < 4; ++ks) {
            bf16x8 wf[2], xf[MT];
#pragma unroll
            for (int nt = 0; nt < 2; ++nt) wf[nt] = *(const bf16x8*)(b + swz(wn * 64 + nt * 32 + r32, ks * 2 + hi));
#pragma unroll
            for (int mt = 0; mt < MT; ++mt) xf[mt] = *(const bf16x8*)(a + swz(wm * WM + mt * 32 + r32, ks * 2 + hi));
#pragma unroll
            for (int mt = 0; mt < MT; ++mt)
#pragma unroll
                for (int nt = 0; nt < 2; ++nt) acc[mt][nt] = MFMA32(wf[nt], xf[mt], acc[mt][nt]);
        }
        if (kt + 1 < nk) G_STORE((kt + 1) & 1);
        __syncthreads();
    }
#undef G_LOAD
#undef G_STORE
    epi.template run<MT>(acc, m0 + wm * WM + r32, n0 + wn * 64, hi);
}

template <class AF, class Epi>
DEVI void gemm_unit_dma(char* lds, const AF& af, const bf16_t* __restrict__ Bt, int ldb, int K, int m0, int n0, const Epi& epi) {
    const int tid = tid_l(), lane = tid & 63, wid = tid >> 6, wm = wid >> 1, wn = wid & 1, r32 = lane & 31, hi = lane >> 5;
    f32x16 acc[1][2];
#pragma unroll
    for (int b = 0; b < 2; ++b)
#pragma unroll
        for (int i = 0; i < 16; ++i) acc[0][b][i] = 0.f;
    const int nk = K >> 6;
    const int drow0 = wid * 16 + (lane >> 3), drow1 = drow0 + 8;
    const int kc0 = (lane & 7) ^ ((drow0 >> 1) & 7), kc1 = (lane & 7) ^ ((drow1 >> 1) & 7);
    const bf16_t* ga0 = af.ptr(m0 + drow0, kc0 * 8); const bf16_t* ga1 = af.ptr(m0 + drow1, kc1 * 8);
    const bf16_t* gb0 = Bt + (size_t)(n0 + drow0) * ldb + kc0 * 8; const bf16_t* gb1 = Bt + (size_t)(n0 + drow1) * ldb + kc1 * 8;
    LAS unsigned char* dl = (LAS unsigned char*)lds + wid * 2048;
#define GD_LDS(g, off) __builtin_amdgcn_global_load_lds((const unsigned*)(g), (LAS unsigned*)(dl + (off)), 16, 0, 0)
#define GD_ISSUE(kt) do { const int _s = ((kt) & 3) * 32768; GD_LDS(ga0 + (kt) * 64, _s); GD_LDS(ga1 + (kt) * 64, _s + 1024); GD_LDS(gb0 + (kt) * 64, _s + 16384); GD_LDS(gb1 + (kt) * 64, _s + 16384 + 1024); } while (0)
#define GD_WAITBAR(N) asm volatile("s_waitcnt vmcnt(" #N ") lgkmcnt(0)\n\ts_barrier" ::: "memory")
    GD_ISSUE(0); GD_ISSUE(1); GD_ISSUE(2);
    for (int kt = 0; kt < nk; ++kt) {
        if (kt + 2 < nk) GD_WAITBAR(8); else if (kt + 1 < nk) GD_WAITBAR(4); else GD_WAITBAR(0);
        if (kt + 3 < nk) GD_ISSUE(kt + 3);
        const char* a = lds + (kt & 3) * 32768; const char* b = a + 16384;
#pragma unroll
        for (int ks = 0; ks < 4; ++ks) {
            bf16x8 wf[2], xf;
#pragma unroll
            for (int nt = 0; nt < 2; ++nt) wf[nt] = *(const bf16x8*)(b + swz(wn * 64 + nt * 32 + r32, ks * 2 + hi));
            xf = *(const bf16x8*)(a + swz(wm * 32 + r32, ks * 2 + hi));
#pragma unroll
            for (int nt = 0; nt < 2; ++nt) acc[0][nt] = MFMA32(wf[nt], xf, acc[0][nt]);
        }
    }
#undef GD_LDS
#undef GD_ISSUE
#undef GD_WAITBAR
    __syncthreads();
    epi.template run<1>(acc, m0 + wm * 32 + r32, n0 + wn * 64, hi);
}


struct EpiInproj {
    bf16_t* QK; bf16_t* VT; bf16_t* UG; const float* rope;
    template <int MT> DEVI void run(const f32x16 (&acc)[MT][2], int mrow0, int ncol0, int hi) const {
#pragma unroll
        for (int mt = 0; mt < MT; ++mt) {
            const int r = mrow0 + mt * 32, b = r / LP, p = r - b * LP; const bool latent = p >= CTXL; const int t = p - CTXL;
#pragma unroll
            for (int nt = 0; nt < 2; ++nt) {
                const int nb = ncol0 + nt * 32; const f32x16& v = acc[mt][nt];
                if (nb < 1024) {
                    const int which = nb >> 8, head = (nb >> 6) & 3, dbase = nb & 63;
                    const int pos = dbase == 0 ? (t >> 6) : (t & 63);
                    bf16_t* dst = QK + ((size_t)((which * NB + b) * NH + head) * LP + p) * 64 + dbase + 4 * hi;
                    const float sc = which < 2 ? QSCALE : 1.f;
#pragma unroll
                    for (int i4 = 0; i4 < 4; ++i4) {
                        float o[4];
#pragma unroll
                        for (int j = 0; j < 4; ++j) {
                            float x = v[4 * i4 + j];
                            if (latent) {
                                const float y = v[4 * (i4 ^ 2) + j];
                                const f32x2 cs = *(const f32x2*)(rope + (pos * 16 + 8 * (i4 & 1) + 4 * hi + j) * 2);
                                x = (i4 < 2) ? (x * cs.x - y * cs.y) : (x * cs.x + y * cs.y);
                            }
                            o[j] = x * sc;
                        }
                        u32x2 w; w.x = pk2(o[0], o[1]); w.y = pk2(o[2], o[3]);
                        *(u32x2*)(dst + 8 * i4) = w;
                    }
                } else if (nb < 1536) {
                    const int n1 = nb - 1024, head = n1 >> 7, dv0 = n1 & 127;
                    const int pp = (p & ~15) | perm16(p & 15);
                    bf16_t* dst = VT + ((size_t)(b * NH + head) * 128 + dv0 + 4 * hi) * LP + pp;
#pragma unroll
                    for (int i = 0; i < 16; ++i) dst[(size_t)((i & 3) + 8 * (i >> 2)) * LP] = f2bf(v[i]);
                } else {
                    const int n1 = nb - 1536;
                    bf16_t* dst = UG + (size_t)chunk_row(b, p >> 4) * 512 + (p & 15) * 16;
#pragma unroll
                    for (int i4 = 0; i4 < 4; ++i4) {
                        const int ch = n1 + 8 * i4 + 4 * hi, g = ch >> 4, hc = ch & 15;
                        u32x2 w; w.x = pk2(v[4 * i4], v[4 * i4 + 1]); w.y = pk2(v[4 * i4 + 2], v[4 * i4 + 3]);
                        *(u32x2*)(dst + (size_t)g * NCHP * 512 + hc) = w;
                    }
                }
            }
        }
    }
};

struct EpiS1 {
    unsigned short* E;
    template <int MT> DEVI void run(const f32x16 (&acc)[MT][2], int mrow0, int ncol0, int hi) const {
#pragma unroll
        for (int mt = 0; mt < MT; ++mt) {
            unsigned short* dst = E + (size_t)(mrow0 + mt * 32) * 256 + ncol0 + 4 * hi;
#pragma unroll
            for (int nt = 0; nt < 2; ++nt)
#pragma unroll
                for (int i4 = 0; i4 < 4; ++i4) {
                    u32x2 w; w.x = hpk2(acc[mt][nt][4 * i4], acc[mt][nt][4 * i4 + 1]); w.y = hpk2(acc[mt][nt][4 * i4 + 2], acc[mt][nt][4 * i4 + 3]);
                    *(u32x2*)(dst + nt * 32 + 8 * i4) = w;
                }
        }
    }
};

struct EpiS2 {
    bf16_t* YG; int g;
    template <int MT> DEVI void run(const f32x16 (&acc)[MT][2], int mrow0, int ncol0, int hi) const {
#pragma unroll
        for (int mt = 0; mt < MT; ++mt) {
            const size_t tok0 = (size_t)chunk_row_token(mrow0 + mt * 32);
#pragma unroll
            for (int nt = 0; nt < 2; ++nt)
#pragma unroll
                for (int i4 = 0; i4 < 4; ++i4) {
                    const int n = ncol0 + nt * 32 + 8 * i4 + 4 * hi, j = n >> 4, h = n & 15;
                    u32x2 w; w.x = pk2(gelu_tanh(acc[mt][nt][4 * i4]), gelu_tanh(acc[mt][nt][4 * i4 + 1]));
                    w.y = pk2(gelu_tanh(acc[mt][nt][4 * i4 + 2]), gelu_tanh(acc[mt][nt][4 * i4 + 3]));
                    *(u32x2*)(YG + (tok0 + j) * 512 + g * 16 + h) = w;
                }
        }
    }
};

struct EpiGlu {
    const bf16_t* YG; bf16_t* MIX; const float* bglu;
    template <int MT> DEVI void run(const f32x16 (&acc)[MT][2], int mrow0, int ncol0, int hi) const {
#pragma unroll
        for (int mt = 0; mt < MT; ++mt) {
            const size_t tok = mrow0 + mt * 32;
#pragma unroll
            for (int nt = 0; nt < 2; ++nt)
#pragma unroll
                for (int i4 = 0; i4 < 4; ++i4) {
                    const int n = ncol0 + nt * 32 + 8 * i4 + 4 * hi;
                    const u32x2 y = *(const u32x2*)(YG + tok * 512 + n);
                    const f32x4 bb = *(const f32x4*)(bglu + n);
                    const float o0 = bflo(y.x) * sigmoidf_(acc[mt][nt][4 * i4] + bb.x), o1 = bfhi(y.x) * sigmoidf_(acc[mt][nt][4 * i4 + 1] + bb.y);
                    const float o2 = bflo(y.y) * sigmoidf_(acc[mt][nt][4 * i4 + 2] + bb.z), o3 = bfhi(y.y) * sigmoidf_(acc[mt][nt][4 * i4 + 3] + bb.w);
                    u32x2 w; w.x = pk2(o0, o1); w.y = pk2(o2, o3);
                    *(u32x2*)(MIX + tok * 1024 + 512 + n) = w;
                }
        }
    }
};

struct EpiOut {
    bf16_t* X; const float* mod;
    template <int MT> DEVI void run(const f32x16 (&acc)[MT][2], int mrow0, int ncol0, int hi) const {
#pragma unroll
        for (int mt = 0; mt < MT; ++mt) {
            const int r = mrow0 + mt * 32, b = r / LP, p = r - b * LP, j = p < CTXL ? 8 : b;
            const float* g1 = mod + (size_t)j * 6144 + 2 * 1024;
#pragma unroll
            for (int nt = 0; nt < 2; ++nt)
#pragma unroll
                for (int i4 = 0; i4 < 4; ++i4) {
                    const int n = ncol0 + nt * 32 + 8 * i4 + 4 * hi;
                    bf16_t* xp = X + (size_t)r * 1024 + n;
                    f32x4 x = hf4(*(const u32x2*)xp); const f32x4 g = *(const f32x4*)(g1 + n);
                    x.x += g.x * acc[mt][nt][4 * i4]; x.y += g.y * acc[mt][nt][4 * i4 + 1]; x.z += g.z * acc[mt][nt][4 * i4 + 2]; x.w += g.w * acc[mt][nt][4 * i4 + 3];
                    u32x2 w; w.x = hpk2(x.x, x.y); w.y = hpk2(x.z, x.w);
                    *(u32x2*)xp = w;
                }
        }
    }
};

struct EpiMoe1 {
    bf16_t* HG;
    template <int MT> DEVI void run(const f32x16 (&acc)[MT][2], int mrow0, int ncol0, int hi) const {
#pragma unroll
        for (int mt = 0; mt < MT; ++mt) {
            bf16_t* dst = HG + (size_t)(mrow0 + mt * 32) * FF + (ncol0 >> 1) + 4 * hi;
#pragma unroll
            for (int i4 = 0; i4 < 4; ++i4) {
                float o[4];
#pragma unroll
                for (int j = 0; j < 4; ++j) { const float a1 = acc[mt][0][4 * i4 + j], a3 = acc[mt][1][4 * i4 + j]; o[j] = a1 * sigmoidf_(a1) * a3; }
                u32x2 w; w.x = pk2(o[0], o[1]); w.y = pk2(o[2], o[3]);
                *(u32x2*)(dst + 8 * i4) = w;
            }
        }
    }
};

struct EpiMoe2 {
    bf16_t* OG; const float* gate;
    template <int MT> DEVI void run(const f32x16 (&acc)[MT][2], int mrow0, int ncol0, int hi) const {
#pragma unroll
        for (int mt = 0; mt < MT; ++mt) {
            const int row = mrow0 + mt * 32; const float gt = gate[row];
            bf16_t* dst = OG + (size_t)row * 1024 + ncol0 + 4 * hi;
#pragma unroll
            for (int nt = 0; nt < 2; ++nt)
#pragma unroll
                for (int i4 = 0; i4 < 4; ++i4) {
                    u32x2 w; w.x = pk2(acc[mt][nt][4 * i4] * gt, acc[mt][nt][4 * i4 + 1] * gt); w.y = pk2(acc[mt][nt][4 * i4 + 2] * gt, acc[mt][nt][4 * i4 + 3] * gt);
                    *(u32x2*)(dst + nt * 32 + 8 * i4) = w;
                }
        }
    }
};

DEVI void transpose_unit(char* lds, const float* __restrict__ W, int K, int N, bf16_t* __restrict__ out, int k0, int n0, int mode  ) {
    float* tile = (float*)lds;
    const int tid = tid_l();
    f32x4 v[8];
#pragma unroll
    for (int i = 0; i < 8; ++i) { const int c = tid + 512 * i, k = c >> 6, n4 = (c & 63) * 4; v[i] = *(const f32x4*)(W + (size_t)(k0 + k) * N + n0 + n4); }
#pragma unroll
    for (int i = 0; i < 8; ++i) { const int c = tid + 512 * i, k = c >> 6, n4 = (c & 63) * 4; float* t = tile + k * 257 + n4; t[0] = v[i].x; t[1] = v[i].y; t[2] = v[i].z; t[3] = v[i].w; }
    __syncthreads();
#pragma unroll
    for (int i = 0; i < 4; ++i) {
        const int c = tid + 512 * i, n = c >> 3, k8 = (c & 7) * 8;
        float f[8];
#pragma unroll
        for (int j = 0; j < 8; ++j) f[j] = tile[(k8 + j) * 257 + n];
        u32x4 w; w.x = pk2(f[0], f[1]); w.y = pk2(f[2], f[3]); w.z = pk2(f[4], f[5]); w.w = pk2(f[6], f[7]);
        const int ng = n0 + n; const int orow = mode == 0 ? ng : ((ng >> 7) * 256 + (mode - 1) * 128 + (ng & 127));
        *(u32x4*)(out + (size_t)orow * K + k0 + k8) = w;
    }
    __syncthreads();
}

DEVI void adaln_unit(char* lds, const Params& P, int l, int n0) {
    float* sc = (float*)lds;
    float* red = sc + 9 * 1024;
    const int tid = tid_l(), lane = tid & 63, wid = tid >> 6;
    for (int i = tid; i < 9 * 1024; i += 512) { const float c = i < 8192 ? P.in[1][i] : P.in[3][i - 8192]; sc[i] = c / (1.f + __expf(-c)); }
    __syncthreads();
    const float* W = P.in[4] + (size_t)l * 1024 * 6144 + n0 + lane;
    float a[9];
#pragma unroll
    for (int j = 0; j < 9; ++j) a[j] = 0.f;
    for (int kk = 0; kk < 128; kk += 16) {
        float w[16];
#pragma unroll
        for (int u = 0; u < 16; ++u) w[u] = W[(size_t)(wid * 128 + kk + u) * 6144];
#pragma unroll
        for (int u = 0; u < 16; ++u)
#pragma unroll
            for (int j = 0; j < 9; ++j) a[j] += sc[j * 1024 + wid * 128 + kk + u] * w[u];
    }
#pragma unroll
    for (int j = 0; j < 9; ++j) red[(wid * 9 + j) * 64 + lane] = a[j];
    __syncthreads();
    for (int i = tid; i < 9 * 64; i += 512) {
        const int j = i >> 6, n = i & 63; float s = 0.f;
#pragma unroll
        for (int w = 0; w < 8; ++w) s += red[(w * 9 + j) * 64 + n];
        ((float*)(ptr_l(P.ws) + WS_MOD))[((size_t)l * 9 + j) * 6144 + n0 + n] = s + P.in[5][(size_t)l * 6144 + n0 + n];
    }
    __syncthreads();
}

DEVI void ssm_tab_unit(char* lds, const Params& P, int l, int d, int g) {
    float* pw = (float*)lds;
    float* bb = pw + 64 * 17 * 2;
    float* cc = bb + 64 * 16 * 2;
    const int tid = tid_l();
    const size_t ldg = ((size_t)l * 2 + d) * 32 + g;
    const float dt = expf(P.in[16][ldg]);
    float* PW = (float*)(ptr_l(P.ws) + WS_PW) + ldg * 64 * 17 * 2;
    float* BB = (float*)(ptr_l(P.ws) + WS_BBAR) + ldg * 64 * 16 * 2;
    for (int i = tid; i < 64 * 17; i += 512) {
        const int p = i / 17, n = i - p * 17;
        const float lr = P.in[14][ldg * 64 + p], li = P.in[15][ldg * 64 + p];
        const float mag = expf(lr * dt * n); float s, c; sincosf(li * dt * n, &s, &c);
        pw[i * 2] = mag * c; pw[i * 2 + 1] = mag * s; PW[i * 2] = mag * c; PW[i * 2 + 1] = mag * s;
    }
    for (int i = tid; i < 64 * 16; i += 512) {
        const int p = i >> 4, h = i & 15;
        const float lr = P.in[14][ldg * 64 + p], li = P.in[15][ldg * 64 + p];
        const float mag = expf(lr * dt); float s, c; sincosf(li * dt, &s, &c);
        const float nr = mag * c - 1.f, ni = mag * s;
        const float den = lr * lr + li * li;
        const float qr = (nr * lr + ni * li) / den, qi = (ni * lr - nr * li) / den;
        const float br = P.in[17][(ldg * 64 + p) * 16 + h], bi = P.in[18][(ldg * 64 + p) * 16 + h];
        const float xr = qr * br - qi * bi, xi = qr * bi + qi * br;
        bb[i * 2] = xr; bb[i * 2 + 1] = xi; BB[i * 2] = xr; BB[i * 2 + 1] = xi;
    }
    for (int i = tid; i < 16 * 64; i += 512) { cc[i * 2] = P.in[19][ldg * 1024 + i]; cc[i * 2 + 1] = P.in[20][ldg * 1024 + i]; }
    __syncthreads();
    float* KT = (float*)(ptr_l(P.ws) + WS_KTAB) + ldg * 4096;
    for (int i = tid; i < 4096; i += 512) {
        const int dl = i >> 8, h = (i >> 4) & 15, h2 = i & 15;
        float s = 0.f;
        for (int p = 0; p < 64; ++p) {
            const float cr = cc[(h * 64 + p) * 2], ci = cc[(h * 64 + p) * 2 + 1];
            const float wr = pw[(p * 17 + dl) * 2], wi = pw[(p * 17 + dl) * 2 + 1];
            const float br = bb[(p * 16 + h2) * 2], bi = bb[(p * 16 + h2) * 2 + 1];
            const float tr = cr * wr - ci * wi, ti = cr * wi + ci * wr;
            s += tr * br - ti * bi;
        }
        KT[i] = s;
    }
    __syncthreads();
}

template <bool FIRST>
DEVI void rowpass1(const Params& P, int l) {
    const int tid = tid_l(), lane = tid & 63, wid = tid >> 6;
    bf16_t* X = (bf16_t*)(ptr_l(P.ws) + WS_X); bf16_t* HX = (bf16_t*)(ptr_l(P.ws) + WS_HX);
    const bf16_t* OG = (const bf16_t*)(ptr_l(P.ws) + WS_OG); const int* SLOT = (const int*)(ptr_l(P.ws) + WS_SLOT);
    const float* MOD = (const float*)(ptr_l(P.ws) + WS_MOD);
    const int stride = gridDim.x * 8;
    int r = blockIdx.x * 8 + wid;
    f32x4 xf[4]; u32x2 xb[4]; int svn = -1;
    auto issue = [&](int rr) {
        if constexpr (FIRST) {
            const int b = rr / LP, p = rr - b * LP;
            const float* src = p < CTXL ? P.in[2] + ((size_t)b * CTXL + p) * 1024 : P.in[0] + ((size_t)b * SEQ + (p - CTXL)) * 1024;
#pragma unroll
            for (int i = 0; i < 4; ++i) xf[i] = *(const f32x4*)(src + lane * 4 + 256 * i);
        } else {
#pragma unroll
            for (int i = 0; i < 4; ++i) xb[i] = *(const u32x2*)(X + (size_t)rr * 1024 + lane * 4 + 256 * i);
            svn = SLOT[(size_t)rr * 16 + (lane & 15)];
        }
    };
    if (r < R) issue(r);
    for (; r < R; r += stride) {
        const int b = r / LP, p = r - b * LP, j = p < CTXL ? 8 : b;
        f32x4 x[4]; const int sv = svn;
#pragma unroll
        for (int i = 0; i < 4; ++i) { if constexpr (FIRST) x[i] = xf[i]; else x[i] = hf4(xb[i]); }
        if (r + stride < R) issue(r + stride);
        if (l == DEPTH && p < CTXL) continue;
        if constexpr (!FIRST) {
            const float* g2 = MOD + ((size_t)(l - 1) * 9 + j) * 6144 + 5 * 1024;
            f32x4 m[4];
#pragma unroll
            for (int i = 0; i < 4; ++i) m[i] = (f32x4){0.f, 0.f, 0.f, 0.f};
            unsigned mask = (unsigned)__ballot(sv >= 0 && lane < 16) & 0xffffu;
            while (mask) {
                const int e0 = __builtin_ctz(mask); mask &= mask - 1;
                const int s0 = __builtin_amdgcn_readlane(sv, e0);
                const bool two = mask != 0u;
                const int e1 = two ? __builtin_ctz(mask) : e0; if (two) mask &= mask - 1;
                const int s1 = __builtin_amdgcn_readlane(sv, e1);
                const bf16_t* o0 = OG + ((size_t)e0 * ROWS_E + s0) * 1024 + lane * 4; const bf16_t* o1 = OG + ((size_t)e1 * ROWS_E + s1) * 1024 + lane * 4;
                u32x2 w0[4], w1[4];
#pragma unroll
                for (int i = 0; i < 4; ++i) { w0[i] = *(const u32x2*)(o0 + 256 * i); w1[i] = *(const u32x2*)(o1 + 256 * i); }
                const float f1 = two ? 1.f : 0.f;
#pragma unroll
                for (int i = 0; i < 4; ++i) m[i] += bf4(w0[i]) + f1 * bf4(w1[i]);
            }
#pragma unroll
            for (int i = 0; i < 4; ++i) { const f32x4 g = *(const f32x4*)(g2 + lane * 4 + 256 * i); x[i] += g * m[i]; }
        }
        float ss = 0.f;
#pragma unroll
        for (int i = 0; i < 4; ++i) ss += x[i].x * x[i].x + x[i].y * x[i].y + x[i].z * x[i].z + x[i].w * x[i].w;
        ss = wave_sum(ss);
        const float rstd = rsqrtf(ss * (1.f / 1024.f) + EPS);
        if (l < DEPTH) {
            const float* ng = P.in[6] + (size_t)l * 1024; const float* sh = MOD + ((size_t)l * 9 + j) * 6144; const float* scl = sh + 1024;
#pragma unroll
            for (int i = 0; i < 4; ++i) {
                const int c = lane * 4 + 256 * i;
                u32x2 xw; xw.x = hpk2(x[i].x, x[i].y); xw.y = hpk2(x[i].z, x[i].w);
                *(u32x2*)(X + (size_t)r * 1024 + c) = xw;
                const f32x4 g = *(const f32x4*)(ng + c), s1 = *(const f32x4*)(scl + c), s0 = *(const f32x4*)(sh + c);
                const f32x4 h = (x[i] * rstd * g) * (1.f + s1) + s0;
                u32x2 w; w.x = pk2(h.x, h.y); w.y = pk2(h.z, h.w);
                *(u32x2*)(HX + (size_t)r * 1024 + c) = w;
            }
        } else {
            float* o = P.out + ((size_t)b * SEQ + (p - CTXL)) * 1024;
#pragma unroll
            for (int i = 0; i < 4; ++i) { const int c = lane * 4 + 256 * i; const f32x4 g = *(const f32x4*)(P.in[29] + c); *(f32x4*)(o + c) = x[i] * rstd * g; }
        }
    }
}

DEVI float router_fold_softmax(const float (&pa)[16], int lane) {
    float q8[8], q4[4], q2[2];
#pragma unroll
    for (int i = 0; i < 8; ++i) { float r0, r1; swap32(pa[i], pa[i + 8], r0, r1); q8[i] = r0 + r1; }
#pragma unroll
    for (int i = 0; i < 4; ++i) { float r0, r1; swap16(q8[i], q8[i + 4], r0, r1); q4[i] = r0 + r1; }
    { const bool hb = (lane & 8) != 0;
#pragma unroll
      for (int i = 0; i < 2; ++i) { const float snd = hb ? q4[i] : q4[i + 2], kp = hb ? q4[i + 2] : q4[i]; q2[i] = kp + dppmov<0x128>(snd); } }
    float lg;
    { const bool hb = (lane & 4) != 0; const float snd = hb ? q2[0] : q2[1], kp = hb ? q2[1] : q2[0];
      const float up = dppmov<0x104>(snd), dn = dppmov<0x114>(snd);
      lg = kp + (hb ? dn : up); }
    lg += dppmov<0x4E>(lg); lg += dppmov<0xB1>(lg);
    float mx = fmaxf(lg, dppmov<0x124>(lg)); mx = fmaxf(mx, dppmov<0x128>(mx));
    { float r0, r1; swap16(mx, mx, r0, r1); mx = fmaxf(r0, r1); swap32(mx, mx, r0, r1); mx = fmaxf(r0, r1); }
    const float ex = expf(lg - mx);
    float sum = ex + dppmov<0x124>(ex); sum += dppmov<0x128>(sum);
    { float r0, r1; swap16(sum, sum, r0, r1); sum = r0 + r1; swap32(sum, sum, r0, r1); sum = r0 + r1; }
    return ex / sum;
}
DEVI void rowpass2(char* lds, const Params& P, int l) {
    const int tid = tid_l(), lane = tid & 63, wid = tid >> 6;
    float* wrT = (float*)lds;
    const float* wr = P.in[25] + (size_t)l * 1024 * 16;
    for (int i = tid; i < 16384; i += 512) { const int k = i >> 4, e = i & 15; wrT[e * 1024 + k] = wr[i]; }
    __syncthreads();
    const bf16_t* X = (const bf16_t*)(ptr_l(P.ws) + WS_X); bf16_t* HX = (bf16_t*)(ptr_l(P.ws) + WS_HX);
    const float* MOD = (const float*)(ptr_l(P.ws) + WS_MOD); float* AFFT = (float*)(ptr_l(P.ws) + WS_AFFT);
    const float* ng = P.in[7] + (size_t)l * 1024;
    const int nw = gridDim.x * 8, nrw = (R + nw - 1) / nw;
    int r = (blockIdx.x * 8 + wid) * nrw;
    const int rend = r + nrw < R ? r + nrw : R;
    u32x2 xn[2][4];
#pragma unroll
    for (int q = 0; q < 2; ++q) if (r + q < rend) {
#pragma unroll
        for (int i = 0; i < 4; ++i) xn[q][i] = *(const u32x2*)(X + (size_t)(r + q) * 1024 + lane * 4 + 256 * i);
    }
    f32x4 ma[4], mb[4]; int jc = -1;
    for (; r < rend; r += 2) {
        const bool two = r + 1 < rend;
        f32x4 h[2][4]; int bb[2], pp[2];
#pragma unroll
        for (int q = 0; q < 2; ++q) {
            const int rq = (q == 0 || two) ? r + q : r;
            const int b = rq / LP, p = rq - b * LP, j = p < CTXL ? 8 : b; bb[q] = b; pp[q] = p;
            if (j != jc) {
                jc = j;
                const float* sh = MOD + ((size_t)l * 9 + j) * 6144 + 3 * 1024; const float* scl = sh + 1024;
#pragma unroll
                for (int i = 0; i < 4; ++i) { const int c = lane * 4 + 256 * i; const f32x4 g = *(const f32x4*)(ng + c), s1 = *(const f32x4*)(scl + c); ma[i] = g * (1.f + s1); mb[i] = *(const f32x4*)(sh + c); }
            }
            float ss = 0.f;
#pragma unroll
            for (int i = 0; i < 4; ++i) { h[q][i] = hf4(xn[q][i]); ss += h[q][i].x * h[q][i].x + h[q][i].y * h[q][i].y + h[q][i].z * h[q][i].z + h[q][i].w * h[q][i].w; }
            ss = wave_sum(ss);
            const float rstd = rsqrtf(ss * (1.f / 1024.f) + EPS);
#pragma unroll
            for (int i = 0; i < 4; ++i) {
                const int c = lane * 4 + 256 * i;
                h[q][i] = (h[q][i] * rstd) * ma[i] + mb[i];
                if (q == 0 || two) { u32x2 w; w.x = pk2(h[q][i].x, h[q][i].y); w.y = pk2(h[q][i].z, h[q][i].w); *(u32x2*)(HX + (size_t)rq * 1024 + c) = w; }
            }
        }
#pragma unroll
        for (int q = 0; q < 2; ++q) if (r + 2 + q < rend) {
#pragma unroll
            for (int i = 0; i < 4; ++i) xn[q][i] = *(const u32x2*)(X + (size_t)(r + 2 + q) * 1024 + lane * 4 + 256 * i);
        }
        float pa[2][16];
#pragma unroll
        for (int eg = 0; eg < 4; ++eg) {
#pragma unroll
            for (int e = 4 * eg; e < 4 * eg + 4; ++e) {
                f32x2 s0 = {0.f, 0.f}, s1 = {0.f, 0.f};
#pragma unroll
                for (int i = 0; i < 4; ++i) { const f32x4 w = *(const f32x4*)(wrT + e * 1024 + lane * 4 + 256 * i);
                    const f32x2 wl = __builtin_shufflevector(w, w, 0, 1), wh = __builtin_shufflevector(w, w, 2, 3);
                    s0 = __builtin_elementwise_fma(__builtin_shufflevector(h[0][i], h[0][i], 0, 1), wl, s0); s0 = __builtin_elementwise_fma(__builtin_shufflevector(h[0][i], h[0][i], 2, 3), wh, s0);
                    s1 = __builtin_elementwise_fma(__builtin_shufflevector(h[1][i], h[1][i], 0, 1), wl, s1); s1 = __builtin_elementwise_fma(__builtin_shufflevector(h[1][i], h[1][i], 2, 3), wh, s1); }
                pa[0][e] = s0.x + s0.y; pa[1][e] = s1.x + s1.y;
            }
            asm volatile("" ::: "memory");
        }
        const float a0 = router_fold_softmax(pa[0], lane), a1 = router_fold_softmax(pa[1], lane);
        if ((lane & 3) == 0) {
            AFFT[((size_t)bb[0] * 16 + (lane >> 2)) * LP + pp[0]] = a0;
            if (two) AFFT[((size_t)bb[1] * 16 + (lane >> 2)) * LP + pp[1]] = a1;
        }
    }
    __syncthreads();
}

DEVI int block_sum_i(int v, volatile int* red, int par, int wid, int lane) {
    if (lane == 0) red[par * 8 + wid] = v;
    __syncthreads();
    int s = 0;
#pragma unroll
    for (int w = 0; w < 8; ++w) s += red[par * 8 + w];
    return s;
}
DEVI int wave_incl_scan_i(int v, int lane) {
#pragma unroll
    for (int o = 1; o < 64; o <<= 1) { const int t = __shfl_up(v, o); if (lane >= o) v += t; }
    return v;
}
DEVI void select_unit(char* lds, const Params& P, int b, int e, bool lat) {
    volatile int* red = (volatile int*)lds;
    volatile int* wtot = (volatile int*)(lds + 64);
    const int tid = tid_l(), lane = tid & 63, wid = tid >> 6;
    const int n = lat ? SEQ : CTXL, K = lat ? CAPL : CAPC, p0 = lat ? CTXL : 0;
    const bool act = 8 * tid < n;
    const float* src = (const float*)(ptr_l(P.ws) + WS_AFFT) + ((size_t)b * 16 + e) * LP + p0 + 8 * tid;
    unsigned bits[8];
    if (act) { const u32x4 v0 = *(const u32x4*)src, v1 = *(const u32x4*)(src + 4); bits[0] = v0.x; bits[1] = v0.y; bits[2] = v0.z; bits[3] = v0.w; bits[4] = v1.x; bits[5] = v1.y; bits[6] = v1.z; bits[7] = v1.w; }
    else {
#pragma unroll
        for (int j = 0; j < 8; ++j) bits[j] = 0u;
    }
    unsigned prefix = 0u; int par = 0;
    for (int bit = 30; bit >= 0; --bit) {
        const unsigned cand = prefix | (1u << bit);
        int c = 0;
#pragma unroll
        for (int j = 0; j < 8; ++j) c += (int)__popcll(__ballot(bits[j] >= cand));
        const int tot = block_sum_i(c, red, par, wid, lane); par ^= 1;
        if (tot >= K) prefix = cand;
    }
    int cg = 0, ceq = 0;
#pragma unroll
    for (int j = 0; j < 8; ++j) { cg += (int)__popcll(__ballot(bits[j] > prefix)); ceq += (bits[j] == prefix) ? 1 : 0; }
    const int need = K - block_sum_i(cg, red, par, wid, lane); par ^= 1;
    int inc = wave_incl_scan_i(ceq, lane);
    if (lane == 63) wtot[par * 8 + wid] = inc;
    __syncthreads();
    int eqb = inc - ceq;
    for (int w = 0; w < wid; ++w) eqb += wtot[par * 8 + w];
    par ^= 1;
    bool sel[8]; int ns = 0;
#pragma unroll
    for (int j = 0; j < 8; ++j) { const bool eq = bits[j] == prefix; sel[j] = (bits[j] > prefix) || (eq && eqb < need); eqb += eq ? 1 : 0; ns += sel[j] ? 1 : 0; }
    inc = wave_incl_scan_i(ns, lane);
    if (lane == 63) wtot[par * 8 + wid] = inc;
    __syncthreads();
    int sb = inc - ns;
    for (int w = 0; w < wid; ++w) sb += wtot[par * 8 + w];
    if (act) {
        int* SLOT = (int*)(ptr_l(P.ws) + WS_SLOT); float* GATE = (float*)(ptr_l(P.ws) + WS_GATE); int* IDX = (int*)(ptr_l(P.ws) + WS_IDX);
#pragma unroll
        for (int j = 0; j < 8; ++j) {
            const int tok = b * LP + p0 + 8 * tid + j;
            if (sel[j]) {
                const int row = (lat ? b * CAPL : NB * CAPL + b * CAPC) + sb; ++sb;
                SLOT[(size_t)tok * 16 + e] = row; GATE[(size_t)e * ROWS_E + row] = __builtin_bit_cast(float, bits[j]); IDX[(size_t)e * ROWS_E + row] = tok;
            } else SLOT[(size_t)tok * 16 + e] = -1;
        }
    }
    __syncthreads();
}
DEVI void gather_rows(const Params& P, bool last) {
    const int tid = tid_l(), lane = tid & 63, wid = tid >> 6;
    const bf16_t* HX = (const bf16_t*)(ptr_l(P.ws) + WS_HX); bf16_t* XG = (bf16_t*)(ptr_l(P.ws) + WS_XG); const int* IDX = (const int*)(ptr_l(P.ws) + WS_IDX);
    const int stride = gridDim.x * 8;
    for (int r0 = blockIdx.x * 8 + wid; r0 < 16 * ROWS_E; r0 += 4 * stride) {
        u32x4 v[4][2];
#pragma unroll
        for (int q = 0; q < 4; ++q) { const int r = r0 + q * stride; if (r < 16 * ROWS_E && !(last && (r % ROWS_E) >= NB * CAPL)) { const u32x4* s = (const u32x4*)(HX + (size_t)IDX[r] * 1024); v[q][0] = s[lane]; v[q][1] = s[lane + 64]; } }
#pragma unroll
        for (int q = 0; q < 4; ++q) { const int r = r0 + q * stride; if (r < 16 * ROWS_E && !(last && (r % ROWS_E) >= NB * CAPL)) { u32x4* d = (u32x4*)(XG + (size_t)r * 1024); d[lane] = v[q][0]; d[lane + 64] = v[q][1]; } }
    }
}

DEVI int scan_ci(int d, int k) { return d == 0 ? k : (k < 16 ? 15 - k : 287 - k); }
DEVI void scan_block(char* lds, const Params& P, int l, int unit0) {
    const int tid = tid_l(), lane = tid & 63, wid = tid >> 6, seg = wid & 3, unit = unit0 + (wid >> 2);
    const int d = unit & 1, g = (unit >> 1) & 31, b = unit >> 6;
    const size_t ldg = ((size_t)l * 2 + d) * 32 + g;
    const float dt = expf(P.in[16][ldg]);
    const float lr = P.in[14][ldg * 64 + lane], li = P.in[15][ldg * 64 + lane];
    const float mag = expf(lr * dt * 16.f); float sn, cs; sincosf(li * dt * 16.f, &sn, &cs);
    const float ar = mag * cs, ai = mag * sn;
    const unsigned short* E = (const unsigned short*)(ptr_l(P.ws) + WS_EB) + (size_t)g * NCHP * 256 + d * 128 + lane * 2;
    bf16_t* S = (bf16_t*)(ptr_l(P.ws) + WS_US) + (size_t)g * NCHP * 512 + 256 + d * 128 + lane * 2;
    f32x2* ends = (f32x2*)lds + (size_t)(wid >> 2) * 4 * 64;
    const int k0 = seg * 68;
    float sr = 0.f, si = 0.f;
    for (int kk = 0; kk < 68; kk += 17) {
        unsigned ev[17];
#pragma unroll
        for (int u = 0; u < 17; ++u) ev[u] = *(const unsigned*)(E + (size_t)chunk_row(b, scan_ci(d, k0 + kk + u)) * 256);
#pragma unroll
        for (int u = 0; u < 17; ++u) { const float nr = ar * sr - ai * si + hlo(ev[u]), ni = ar * si + ai * sr + hhi(ev[u]); sr = nr; si = ni; }
    }
    ends[seg * 64 + lane] = (f32x2){sr, si};
    float pr = ar, pi = ai, p4r = 0.f, p4i = 0.f;
#pragma unroll
    for (int q = 0; q < 6; ++q) { const float nr = pr * pr - pi * pi, ni = 2.f * pr * pi; pr = nr; pi = ni; if (q == 1) { p4r = pr; p4i = pi; } }
    const float br = pr * p4r - pi * p4i, bi = pr * p4i + pi * p4r;
    __syncthreads();
    sr = 0.f; si = 0.f;
    for (int j = 0; j < seg; ++j) { const f32x2 e = ends[j * 64 + lane]; const float nr = br * sr - bi * si + e.x, ni = br * si + bi * sr + e.y; sr = nr; si = ni; }
    for (int kk = 0; kk < 68; kk += 17) {
        unsigned ev[17];
#pragma unroll
        for (int u = 0; u < 17; ++u) ev[u] = *(const unsigned*)(E + (size_t)chunk_row(b, scan_ci(d, k0 + kk + u)) * 256);
#pragma unroll
        for (int u = 0; u < 17; ++u) {
            *(unsigned*)(S + (size_t)chunk_row(b, scan_ci(d, k0 + kk + u)) * 512) = pk2(sr, si);
            const float nr = ar * sr - ai * si + hlo(ev[u]), ni = ar * si + ai * sr + hhi(ev[u]); sr = nr; si = ni;
        }
    }
    __syncthreads();
}

DEVI float max3f(float a, float b, float c) { return fmaxf(fmaxf(a, b), c); }
DEVI float xhalf_max(float x) { const unsigned u = __builtin_bit_cast(unsigned, x); const auto r = __builtin_amdgcn_permlane32_swap(u, u, false, false); return fmaxf(__builtin_bit_cast(float, (unsigned)r[0]), __builtin_bit_cast(float, (unsigned)r[1])); }
DEVI float xhalf_sum(float x) { const unsigned u = __builtin_bit_cast(unsigned, x); const auto r = __builtin_amdgcn_permlane32_swap(u, u, false, false); return __builtin_bit_cast(float, (unsigned)r[0]) + __builtin_bit_cast(float, (unsigned)r[1]); }
DEVI void attn_unit(char* lds, const Params& P, int l, int b, int head, int q0  , int nkeys, float lam, float lam_init) {
    const int tid = tid_l(), lane = tid & 63, wid = tid >> 6, qg = wid >> 1, which = wid & 1, r32 = lane & 31, hi = lane >> 5;
    const bf16_t* QK = (const bf16_t*)(ptr_l(P.ws) + WS_QK);
    const bf16_t* Qs = QK + ((size_t)((which * NB + b) * NH + head) * LP) * 64;
    const bf16_t* K1 = QK + ((size_t)((2 * NB + b) * NH + head) * LP) * 64;
    const bf16_t* K2 = QK + ((size_t)((3 * NB + b) * NH + head) * LP) * 64;
    const bf16_t* Vt = (const bf16_t*)(ptr_l(P.ws) + WS_VT) + (size_t)(b * NH + head) * 128 * LP;
    bf16x8 qf[4];
#pragma unroll
    for (int ks = 0; ks < 4; ++ks) qf[ks] = *(const bf16x8*)(Qs + (size_t)(q0 + qg * 32 + r32) * 64 + ks * 16 + hi * 8);
    f32x16 o[4];
#pragma unroll
    for (int t = 0; t < 4; ++t)
#pragma unroll
        for (int i = 0; i < 16; ++i) o[t][i] = 0.f;
    float m = 0.f, lsum = 0.f;
    const int nt = nkeys >> 6;
    const int drow = wid * 8 + (lane >> 3), dkc = (lane & 7) ^ ((drow >> 1) & 7);
    const unsigned koff = (unsigned)(drow * 64 + dkc * 8), voff = (unsigned)(drow * LP + dkc * 8);
    LAS unsigned char* dl = (LAS unsigned char*)lds + wid * 1024;
#define GLDS(g, off) __builtin_amdgcn_global_load_lds((const unsigned*)(g), (LAS unsigned*)(dl + (off)), 16, 0, 0)
#define K_DMA(kt, s) do { GLDS((K1 + (size_t)(kt) * 4096) + koff, (s) * 16384); GLDS((K2 + (size_t)(kt) * 4096) + koff, (s) * 16384 + 8192); } while (0)
#define V_DMA(kt, s) do { GLDS((Vt + (kt) * 64) + voff, 32768 + (s) * 16384); GLDS((Vt + (kt) * 64 + 64 * LP) + voff, 32768 + (s) * 16384 + 8192); } while (0)
#define QKT(dst, s, init) do { const char* _k = lds + (s) * 16384 + which * 8192; \
        _Pragma("unroll") for (int t2 = 0; t2 < 2; ++t2) _Pragma("unroll") for (int i = 0; i < 16; ++i) dst[t2][i] = (init); \
        _Pragma("unroll") for (int ks = 0; ks < 4; ++ks) _Pragma("unroll") for (int t2 = 0; t2 < 2; ++t2) { \
            const bf16x8 kf = *(const bf16x8*)(_k + swz(t2 * 32 + r32, ks * 2 + hi)); dst[t2] = MFMA32(kf, qf[ks], dst[t2]); } } while (0)
    K_DMA(0, 0); V_DMA(0, 0); K_DMA(1, 1);
    __syncthreads();
    f32x16 sc[2], sn[2];
    QKT(sc, 0, 0.f);
    __syncthreads();
    {
        float tm = max3f(sc[0][0], sc[0][1], sc[0][2]);
#pragma unroll
        for (int i = 3; i < 15; i += 2) tm = max3f(tm, sc[0][i], sc[0][i + 1]);
        tm = fmaxf(tm, sc[0][15]);
#pragma unroll
        for (int i = 0; i < 16; i += 2) tm = max3f(tm, sc[1][i], sc[1][i + 1]);
        tm = xhalf_max(tm);
        m = tm;
#pragma unroll
        for (int t2 = 0; t2 < 2; ++t2)
#pragma unroll
            for (int i = 0; i < 16; ++i) sc[t2][i] -= m;
    }
#define SB() __builtin_amdgcn_sched_barrier(0)
#define SGB(mask, n) __builtin_amdgcn_sched_group_barrier(mask, n, 0)
    int fo[4];
#pragma unroll
    for (int j = 0; j < 4; ++j) fo[j] = swz(r32, 2 * j + hi);
    const char* kbase = lds + which * 8192;
    const char* vbase = lds + 32768;
#define ATT_STEP(KT, PAR, SC, SN) do { \
        const bool has1 = (KT) + 1 < nt, has2 = (KT) + 2 < nt; \
        if (has2) K_DMA((KT) + 2, PAR); \
        if (has1) V_DMA((KT) + 1, 1 - (PAR)); \
        const char* kst = kbase + (1 - (PAR)) * 16384; \
        const char* vs = vbase + (PAR) * 16384; \
        bf16x8 kf[8]; \
        _Pragma("unroll") for (int ks = 0; ks < 4; ++ks) _Pragma("unroll") for (int t2 = 0; t2 < 2; ++t2) kf[ks * 2 + t2] = *(const bf16x8*)(kst + fo[ks] + t2 * 4096); \
        SB(); \
        _Pragma("unroll") for (int t2 = 0; t2 < 2; ++t2) _Pragma("unroll") for (int i = 0; i < 16; ++i) SN[t2][i] = -m; \
        _Pragma("unroll") for (int ks = 0; ks < 4; ++ks) _Pragma("unroll") for (int t2 = 0; t2 < 2; ++t2) SN[t2] = MFMA32(kf[ks * 2 + t2], qf[ks], SN[t2]); \
        bf16x8 va[4], vb[4]; \
        _Pragma("unroll") for (int t = 0; t < 4; ++t) va[t] = *(const bf16x8*)(vs + fo[0] + t * 4096); \
        SGB(0x002, 16); SGB(0x008, 8); SGB(0x100, 4); SB(); \
        if (__any(pprev > 4096.f)) {        \
            const float pr = xhalf_sum(pprev); \
            const float dl = pr > 4096.f ? (float)((int)((__builtin_bit_cast(unsigned, pr) >> 23) & 255u) - 127) : 0.f, al = fast_exp2(-dl); \
            m += dl; lsum *= al; \
            _Pragma("unroll") for (int t = 0; t < 4; ++t) _Pragma("unroll") for (int i = 0; i < 16; ++i) o[t][i] *= al; \
            _Pragma("unroll") for (int t2 = 0; t2 < 2; ++t2) _Pragma("unroll") for (int i = 0; i < 16; ++i) { SC[t2][i] -= dl; SN[t2][i] -= dl; } \
        } \
        float ps = 0.f; \
        _Pragma("unroll") for (int t2 = 0; t2 < 2; ++t2) _Pragma("unroll") for (int i = 0; i < 16; ++i) { SC[t2][i] = fast_exp2(SC[t2][i]); ps += SC[t2][i]; } \
        lsum += ps; pprev = ps; \
        bf16x8 pf[4]; \
        _Pragma("unroll") for (int t2 = 0; t2 < 2; ++t2) _Pragma("unroll") for (int sh = 0; sh < 2; ++sh) { \
            u32x4 pw; pw.x = pk2(SC[t2][8 * sh], SC[t2][8 * sh + 1]); pw.y = pk2(SC[t2][8 * sh + 2], SC[t2][8 * sh + 3]); \
            pw.z = pk2(SC[t2][8 * sh + 4], SC[t2][8 * sh + 5]); pw.w = pk2(SC[t2][8 * sh + 6], SC[t2][8 * sh + 7]); \
            pf[t2 * 2 + sh] = __builtin_bit_cast(bf16x8, pw); } \
        SB(); \
        _Pragma("unroll") for (int t = 0; t < 4; ++t) vb[t] = *(const bf16x8*)(vs + fo[1] + t * 4096); \
        _Pragma("unroll") for (int t = 0; t < 4; ++t) o[t] = MFMA32(va[t], pf[0], o[t]); \
        SGB(0x100, 4); SGB(0x008, 4); SB(); \
        _Pragma("unroll") for (int t = 0; t < 4; ++t) va[t] = *(const bf16x8*)(vs + fo[2] + t * 4096); \
        _Pragma("unroll") for (int t = 0; t < 4; ++t) o[t] = MFMA32(vb[t], pf[1], o[t]); \
        SGB(0x100, 4); SGB(0x008, 4); SB(); \
        _Pragma("unroll") for (int t = 0; t < 4; ++t) vb[t] = *(const bf16x8*)(vs + fo[3] + t * 4096); \
        _Pragma("unroll") for (int t = 0; t < 4; ++t) o[t] = MFMA32(va[t], pf[2], o[t]); \
        SGB(0x100, 4); SGB(0x008, 4); SB(); \
        _Pragma("unroll") for (int t = 0; t < 4; ++t) o[t] = MFMA32(vb[t], pf[3], o[t]); \
        SB(); \
        __syncthreads(); \
    } while (0)
    float pprev = 0.f;
    for (int kt = 0; kt < nt; kt += 2) {
        ATT_STEP(kt, 0, sc, sn);
        ATT_STEP(kt + 1, 1, sn, sc);
    }
#undef ATT_STEP
#undef SB
#undef SGB
#undef GLDS
#undef K_DMA
#undef V_DMA
#undef QKT
    lsum = xhalf_sum(lsum);
    const float inv = 1.f / lsum;
    float* xb = (float*)lds + (size_t)qg * 4096;
    if (which == 1) {
#pragma unroll
        for (int t = 0; t < 4; ++t)
#pragma unroll
            for (int i = 0; i < 16; ++i) xb[(t * 16 + i) * 64 + lane] = o[t][i] * inv;
    }
    __syncthreads();
    if (which == 0) {
        float ss = 0.f;
#pragma unroll
        for (int t = 0; t < 4; ++t)
#pragma unroll
            for (int i = 0; i < 16; ++i) { const float v = o[t][i] * inv - lam * xb[(t * 16 + i) * 64 + lane]; o[t][i] = v; ss += v * v; }
        ss = xhalf_sum(ss);
        const float rs = rsqrtf(ss * (1.f / 128.f) + EPS) * (1.f - lam_init);
        const float* sg = P.in[13] + (size_t)l * 128;
        bf16_t* dst = (bf16_t*)(ptr_l(P.ws) + WS_MIX) + ((size_t)b * LP + q0 + qg * 32 + r32) * 1024 + head * 128 + 4 * hi;
#pragma unroll
        for (int t = 0; t < 4; ++t)
#pragma unroll
            for (int i4 = 0; i4 < 4; ++i4) {
                const f32x4 g = *(const f32x4*)(sg + t * 32 + 8 * i4 + 4 * hi);
                u32x2 w; w.x = pk2(o[t][4 * i4] * rs * g.x, o[t][4 * i4 + 1] * rs * g.y); w.y = pk2(o[t][4 * i4 + 2] * rs * g.z, o[t][4 * i4 + 3] * rs * g.w);
                *(u32x2*)(dst + t * 32 + 8 * i4) = w;
            }
    }
    __syncthreads();
}

struct ConvTile { const float* src; bf16_t* dst; int K, N, mode; };
DEVI ConvTile conv_tile(const Params& P, unsigned char* w, int l, int u) {
    if (u < 4096) { const int w3 = u >= 2048; const int v = u & 2047, le = l * 16 + (v >> 7), k = (v >> 3) & 15, n = v & 7;
        return {P.in[w3 ? 27 : 26] + (size_t)le * 1024 * 2048 + (size_t)(k * 64) * 2048 + n * 256, (bf16_t*)(w + WS_W13T) + (size_t)le * 4096 * 1024 + k * 64, 1024, 2048, (n * 256) | ((1 + w3) << 16)}; }
    const int v = u - 4096, le = l * 16 + (v >> 7), k = (v >> 2) & 31, n = v & 3;
    return {P.in[28] + (size_t)le * 2048 * 1024 + (size_t)(k * 64) * 1024 + n * 256, (bf16_t*)(w + WS_W2T) + (size_t)le * 1024 * 2048 + k * 64, 2048, 1024, n * 256};
}
#define CV_LOAD(v, t) do { const unsigned voff_ = (unsigned)((2 * (tid >> 6)) * (t).N + (tid & 63) * 4) * 4u; \
        _Pragma("unroll") for (int i = 0; i < 8; ++i) { const float* sb_ = (t).src + (size_t)((i >> 1) * 16 + (i & 1)) * (t).N; \
        asm volatile("s_nop 4\n\tglobal_load_dwordx4 %0, %1, %2\n\ts_nop 1" : "=&v"(v[i]) : "v"(voff_), "s"(sb_) : "memory"); } } while (0)
#define CV_WAIT(v, N) asm volatile("s_waitcnt vmcnt(" #N ")" : "+v"(v[0]), "+v"(v[1]), "+v"(v[2]), "+v"(v[3]), "+v"(v[4]), "+v"(v[5]), "+v"(v[6]), "+v"(v[7]) :: "memory")
#define CV_STEP(v, t, N, UNEXT) do { \
        unsigned* tile = (unsigned*)lds + par * (32 * 256); par ^= 1; \
        CV_WAIT(v, N); \
        _Pragma("unroll") for (int j = 0; j < 4; ++j) { const int kp = (tid >> 6) + 8 * j; \
            u32x4 wv; wv.x = pk2(v[2 * j].x, v[2 * j + 1].x); wv.y = pk2(v[2 * j].y, v[2 * j + 1].y); wv.z = pk2(v[2 * j].z, v[2 * j + 1].z); wv.w = pk2(v[2 * j].w, v[2 * j + 1].w); \
            *(u32x4*)(tile + kp * 256 + (((tid & 63) * 4) ^ (((kp >> 2) & 7) << 3))) = wv; } \
        const ConvTile cur = t; \
        if ((UNEXT) >= 0) { t = conv_tile(P, w, l, (UNEXT)); CV_LOAD(v, t); } \
        asm volatile("s_waitcnt lgkmcnt(0)\n\ts_barrier" ::: "memory"); \
        const int n0 = cur.mode & 0xffff, mode = cur.mode >> 16; \
        _Pragma("unroll") for (int i = 0; i < 4; ++i) { \
            const int c = tid + 512 * i, n = c >> 3, kq = c & 7; \
            u32x4 o; o.x = tile[(4 * kq) * 256 + (n ^ (kq << 3))]; o.y = tile[(4 * kq + 1) * 256 + (n ^ (kq << 3))]; o.z = tile[(4 * kq + 2) * 256 + (n ^ (kq << 3))]; o.w = tile[(4 * kq + 3) * 256 + (n ^ (kq << 3))]; \
            const int ng = n0 + n; const int orow = mode == 0 ? ng : ((ng >> 7) * 256 + (mode - 1) * 128 + (ng & 127)); \
            const unsigned so_ = (unsigned)(orow * cur.K + 8 * kq) * 2u; \
            asm volatile("s_nop 4\n\tglobal_store_dwordx4 %0, %1, %2\n\ts_nop 1" :: "v"(so_), "v"(o), "s"(cur.dst) : "memory"); \
        } } while (0)
DEVI void conv_share(char* lds, const Params& P, int l, int bid, int G) {
    unsigned char* w = ptr_l(P.ws);
    const int tid = tid_l();
    if (G != 256) {
        for (int u = bid; u < 3 * 2048; u += G) {
            if (u < 4096) { const int w3 = u >= 2048; const int v = u & 2047, le = l * 16 + (v >> 7), k = (v >> 3) & 15, n = v & 7;
                transpose_unit(lds, P.in[w3 ? 27 : 26] + (size_t)le * 1024 * 2048, 1024, 2048, (bf16_t*)(w + WS_W13T) + (size_t)le * 4096 * 1024, k * 64, n * 256, 1 + w3); }
            else { const int v = u - 4096, le = l * 16 + (v >> 7), k = (v >> 2) & 31, n = v & 3;
                transpose_unit(lds, P.in[28] + (size_t)le * 2048 * 1024, 2048, 1024, (bf16_t*)(w + WS_W2T) + (size_t)le * 1024 * 2048, k * 64, n * 256, 0); }
        }
        return;
    }
    f32x4 va[8], vb[8], vc[8];
    ConvTile ta = conv_tile(P, w, l, bid), tb = conv_tile(P, w, l, bid + 256), tc = conv_tile(P, w, l, bid + 512);
    int par = 0;
    CV_LOAD(va, ta); CV_LOAD(vb, tb); CV_LOAD(vc, tc);
    CV_STEP(va, ta, 16, bid + 3 * 256); CV_STEP(vb, tb, 20, bid + 4 * 256); CV_STEP(vc, tc, 24, bid + 5 * 256);
    for (int r = 2; r < 8; ++r) {
        const int u = bid + (3 * r) * 256;
        CV_STEP(va, ta, 28, u); CV_STEP(vb, tb, 28, u + 256); CV_STEP(vc, tc, 28, u + 512);
    }
    CV_STEP(va, ta, 28, -1); CV_STEP(vb, tb, 20, -1); CV_STEP(vc, tc, 12, -1);
    asm volatile("s_waitcnt vmcnt(0)" ::: "memory");
    __syncthreads();
}
#undef CV_LOAD
#undef CV_WAIT
#undef CV_STEP
constexpr int PH_PER_LAYER = 11, PH_LAYER0 = 2, PH_FINAL = PH_LAYER0 + DEPTH * PH_PER_LAYER, N_PHASES = PH_FINAL + 1;

__global__ void __launch_bounds__(512, 2) fwd_kernel(Params P) {
    extern __shared__ __attribute__((aligned(16))) char lds[];
    volatile LAS unsigned* xbw = (volatile LAS unsigned*)(lds + 131072);
    if (threadIdx.x == 0) { xbw[0] = 0u; xbw[1] = 0u; }
    __syncthreads();
    XcdBarrier bar = xcd_barrier_post((unsigned*)(P.ws + WS_CTL), xbw);
    const int G = gridDim.x, bid = blockIdx.x;
    const int vcu = (G % 8 == 0) ? (bid % 8) * (G / 8) + bid / 8 : bid;
    LAS unsigned char* ldsp = (LAS unsigned char*)lds;
    const int lo = P.lo, hi = P.hi;
#ifndef EN_MASK
#define EN_MASK 0xFFFFFFFFu
#endif
#define PHASE(id) if ((id) >= lo && (id) < hi)
#ifndef REP_MASK
#define REP_MASK 0x0u
#endif
#define PHASE_K(k, id) if (((EN_MASK >> (k)) & 1u) && (id) >= lo && (id) < hi) for (int rep_ = 0; rep_ <= (int)((REP_MASK >> (k)) & 1u); ++rep_)
#define SEAM(id) do { if ((id) >= lo && (id) + 1 < hi) xcd_barrier(bar); } while (0)
    unsigned char* ws0 = P.ws;
#define ws ptr_l(ws0)

    PHASE_K(0, 0) {
        constexpr int U_SSM = 256, U_ROPE = 1, U_ADA = 4 * 96;
        constexpr int T_WIN = 4 * 16 * 8, T_WOUT = 4 * 16 * 4, T_WGLU = 4 * 8 * 2, T_W1 = 64 * 16 * 8, T_W2 = 64 * 32 * 4;
        constexpr int U0 = U_SSM + U_ROPE + U_ADA, U1 = U0 + T_WIN, U2 = U1 + T_WOUT, U3 = U2 + T_WGLU, U4 = U3 + T_W1, U5 = U4 + T_W1, U6 = U5 + T_W2;
        for (int u = bid; u < U3; u += G) {
            if (u < U_SSM) { ssm_tab_unit(lds, P, u >> 6, (u >> 5) & 1, u & 31); }
            else if (u == U_SSM) {
                const int tid = tid_l(), wid = tid >> 6, lane = tid & 63;
                float* rope = (float*)(ws + WS_ROPE);
                for (int i = tid; i < 64 * 16; i += 512) {
                    const int pos = i >> 4, f = i & 15; const float inv = powf(10000.f, -(float)(2 * f) / 32.f);
                    float s, c; sincosf((float)pos * inv, &s, &c); rope[i * 2] = c; rope[i * 2 + 1] = s;
                }
                if (wid < 4) {
                    const float a = P.in[9][wid * 64 + lane] * P.in[10][wid * 64 + lane], c2 = P.in[11][wid * 64 + lane] * P.in[12][wid * 64 + lane];
                    const float s1 = wave_sum(a), s2 = wave_sum(c2);
                    if (lane == 0) ((float*)(ws + WS_LAM))[wid] = expf(s1) - expf(s2) + (0.8f - 0.6f * expf(-0.3f * (float)wid));
                }
            }
            else if (u < U0) { const int v = u - U_SSM - U_ROPE; adaln_unit(lds, P, v / 96, (v % 96) * 64); }
            else if (u < U1) { const int v = u - U0, l = v >> 7, k = (v >> 3) & 15, n = v & 7; transpose_unit(lds, P.in[8] + (size_t)l * 1024 * 2048, 1024, 2048, (bf16_t*)(ws + WS_WINT) + (size_t)l * 2048 * 1024, k * 64, n * 256, 0); }
            else if (u < U2) { const int v = u - U1, l = v >> 6, k = (v >> 2) & 15, n = v & 3; transpose_unit(lds, P.in[24] + (size_t)l * 1024 * 1024, 1024, 1024, (bf16_t*)(ws + WS_WOUTT) + (size_t)l * 1024 * 1024, k * 64, n * 256, 0); }
            else { const int v = u - U2, l = v >> 4, k = (v >> 1) & 7, n = v & 1; transpose_unit(lds, P.in[22] + (size_t)l * 512 * 512, 512, 512, (bf16_t*)(ws + WS_WGLUT) + (size_t)l * 512 * 512, k * 64, n * 256, 0); }
        }
        (void)U4; (void)U5; (void)U6;
    }
    SEAM(0);
    PHASE_K(1, 1) {
        const float* KT = (const float*)(ws + WS_KTAB); const float* PW = (const float*)(ws + WS_PW); const float* BB = (const float*)(ws + WS_BBAR);
        bf16_t* WE = (bf16_t*)(ws + WS_WENDT); bf16_t* B2 = (bf16_t*)(ws + WS_BT2);
        const int tid = tid_l();
        for (size_t idx = (size_t)bid * 512 + tid; idx < (size_t)4 * 32 * 256 * 256; idx += (size_t)G * 512) {
            const int kp = idx & 255, n = (idx >> 8) & 255, g = (idx >> 16) & 31, l = (int)(idx >> 21);
            if (kp >= 128) { *(unsigned*)(WE + (((size_t)l * 32 + g) * 256 + n) * 512 + kp * 2) = 0u; continue; }
            const int d = n >> 7, p = (n >> 1) & 63, ri = n & 1, k = kp * 2, i = k >> 4, h = k & 15;
            const size_t ldg = ((size_t)l * 2 + d) * 32 + g;
            const int e = d == 0 ? 15 - i : i;
            const float wr = PW[((ldg * 64 + p) * 17 + e) * 2], wi = PW[((ldg * 64 + p) * 17 + e) * 2 + 1];
            float o[2];
#pragma unroll
            for (int q = 0; q < 2; ++q) { const float br = BB[((ldg * 64 + p) * 16 + h + q) * 2], bi = BB[((ldg * 64 + p) * 16 + h + q) * 2 + 1]; o[q] = ri == 0 ? wr * br - wi * bi : wr * bi + wi * br; }
            *(unsigned*)(WE + (((size_t)l * 32 + g) * 256 + n) * 512 + k) = pk2(o[0], o[1]);
        }
        for (size_t idx = (size_t)bid * 512 + tid; idx < (size_t)4 * 32 * 256 * 256; idx += (size_t)G * 512) {
            const int kp = idx & 255, n2 = (idx >> 8) & 255, g = (idx >> 16) & 31, l = (int)(idx >> 21);
            const int j = n2 >> 4, h = n2 & 15, k = kp * 2;
            float o[2];
            if (k < 256) {
                const int i = k >> 4;
#pragma unroll
                for (int q = 0; q < 2; ++q) {
                    const int h2 = (k & 15) + q; float v = 0.f;
                    if (i <= j) v += KT[((((size_t)l * 2 + 0) * 32 + g) * 16 + (j - i)) * 256 + h * 16 + h2];
                    if (i >= j) v += KT[((((size_t)l * 2 + 1) * 32 + g) * 16 + (i - j)) * 256 + h * 16 + h2];
                    if (i == j && h == h2) v += P.in[21][(size_t)l * 512 + g * 16 + h];
                    o[q] = v;
                }
            } else {
                const int n = k - 256, d = n >> 7, p = (n >> 1) & 63;
                const size_t ldg = ((size_t)l * 2 + d) * 32 + g;
                const int e = d == 0 ? j + 1 : 16 - j;
                const float wr = PW[((ldg * 64 + p) * 17 + e) * 2], wi = PW[((ldg * 64 + p) * 17 + e) * 2 + 1];
                const float cr = P.in[19][(ldg * 16 + h) * 64 + p], ci = P.in[20][(ldg * 16 + h) * 64 + p];
                o[0] = cr * wr - ci * wi; o[1] = -(cr * wi + ci * wr);
            }
            *(unsigned*)(B2 + (((size_t)l * 32 + g) * 256 + n2) * 512 + k) = pk2(o[0], o[1]);
        }
    }
    SEAM(1);

    for (int l = 0; l < DEPTH; ++l) {
        const int ph = PH_LAYER0 + l * PH_PER_LAYER;
        const bool last = l == DEPTH - 1;
        const float* MODl = (const float*)(ws + WS_MOD) + (size_t)l * 9 * 6144;
        PHASE_K(2, ph + 0) { if (l == 0) rowpass1<true>(P, 0); else rowpass1<false>(P, l); }
        SEAM(ph + 0);
        PHASE_K(3, ph + 1) {
            {
                Epi8Inproj ep{(bf16_t*)(ws + WS_QK), (bf16_t*)(ws + WS_VT), (bf16_t*)(ws + WS_US), (const float*)(ws + WS_ROPE)};
                const pg8::Gemm g{(const bf16_t*)(ws + WS_HX), (const bf16_t*)(ws + WS_WINT) + (size_t)l * 2048 * 1024, R, 2048, 1024};
                const TileOrder S{128 * 8, G, vcu, 16, 8, 0, 17, 1};
                pg8::gemm_phase<Epi8Inproj, TileOrder, true, true>(ldsp, g, S, ep);
            }
            for (int u = vcu; u < 16 * 16; u += G) {
                EpiInproj ep{(bf16_t*)(ws + WS_QK), (bf16_t*)(ws + WS_VT), (bf16_t*)(ws + WS_US), (const float*)(ws + WS_ROPE)};
                APlain af{(const bf16_t*)(ws + WS_HX), 1024};
                const int mt = u >> 4, nt = u & 15;
                gemm_unit_dma(lds, af, (const bf16_t*)(ws + WS_WINT) + (size_t)l * 2048 * 1024, 1024, 1024, (mt >> 1) * LP + (mt & 1) * 128, nt * 128, ep);
            }
        }
        SEAM(ph + 1);
        PHASE_K(4, ph + 2) {
            {
                Epi8S1 ep{(unsigned short*)(ws + WS_EB)};
                const pg8::Gemm g{(const bf16_t*)(ws + WS_US), (const bf16_t*)(ws + WS_WENDT) + (size_t)l * 32 * 256 * 512, 32 * NCHP, 32 * 256, 512};
                const TileOrder S{32 * 8, G, vcu, 8, 1, 1, 9, 0};
                pg8::gemm_phase<Epi8S1, TileOrder, true, true>(ldsp, g, S, ep);
            }
            for (int u = vcu; u < 64; u += G) {
                const int g = u >> 1, nt = u & 1;
                EpiS1 ep{(unsigned short*)(ws + WS_EB) + (size_t)g * NCHP * 256};
                APlain af{(const bf16_t*)(ws + WS_US) + (size_t)g * NCHP * 512, 512};
                gemm_unit_dma(lds, af, (const bf16_t*)(ws + WS_WENDT) + ((size_t)l * 32 + g) * 256 * 512, 512, 256, 2048, nt * 128, ep);
            }
        }
        SEAM(ph + 2);
        PHASE_K(15, ph + 3) {
            for (int u = bid * 2; u < NB * 32 * 2; u += G * 2) scan_block(lds, P, l, u);
        }
        SEAM(ph + 3);
        PHASE_K(5, ph + 4) {
            const float lam = ((const float*)(ws + WS_LAM))[l], lam_init = 0.8f - 0.6f * expf(-0.3f * (float)l);
            int rnd = 0;
            for (int u = vcu; u < (last ? 1024 : 1024 + 64); u += G, ++rnd) {
                if (rnd == ((bid >> 3) & 3)) conv_share(lds, P, l, bid, G);
                if (u < 1024) { const int qb = u & 31, bh = u >> 5; attn_unit(lds, P, l, bh >> 2, bh & 3, CTXL + qb * 128, LP, lam, lam_init); }
                else { const int v = u - 1024, qb = v & 1, bh = v >> 1; attn_unit(lds, P, l, bh >> 2, bh & 3, qb * 128, CTXL, lam, lam_init); }
            }
        }
        PHASE_K(6, ph + 4) {
            {
                Epi8S2 ep{(bf16_t*)(ws + WS_YG)};
                const pg8::Gemm g{(const bf16_t*)(ws + WS_US), (const bf16_t*)(ws + WS_BT2) + (size_t)l * 32 * 256 * 512, 32 * NCHP, 32 * 256, 512};
                const TileOrder S{32 * 8, G, vcu, 8, 1, 1, 9, 0};
                pg8::gemm_phase<Epi8S2, TileOrder, true, true>(ldsp, g, S, ep);
            }
            if (!last) for (int u = (vcu + G / 2) % G; u < 64; u += G) {
                const int g = u >> 1, nt = u & 1;
                EpiS2 ep{(bf16_t*)(ws + WS_YG), g};
                APlain af{(const bf16_t*)(ws + WS_US) + (size_t)g * NCHP * 512, 512};
                gemm_unit_dma(lds, af, (const bf16_t*)(ws + WS_BT2) + ((size_t)l * 32 + g) * 256 * 512, 512, 512, 2048, nt * 128, ep);
            }
        }
        SEAM(ph + 4);
        PHASE_K(7, ph + 5) {
            {
                Epi8Glu ep{(const bf16_t*)(ws + WS_YG), (bf16_t*)(ws + WS_MIX), P.in[23] + (size_t)l * 512};
                const pg8::Gemm g{(const bf16_t*)(ws + WS_YG), (const bf16_t*)(ws + WS_WGLUT) + (size_t)l * 512 * 512, R, 512, 512};
                const TileOrder S{128 * 2, G, vcu, 16, 2, 0, 17, 1};
                pg8::gemm_phase<Epi8Glu, TileOrder, true, true>(ldsp, g, S, ep);
            }
            if (!last) for (int u = vcu; u < 8 * 4; u += G) {
                EpiGlu ep{(const bf16_t*)(ws + WS_YG), (bf16_t*)(ws + WS_MIX), P.in[23] + (size_t)l * 512};
                APlain af{(const bf16_t*)(ws + WS_YG), 512};
                gemm_unit<256>(lds, af, (const bf16_t*)(ws + WS_WGLUT) + (size_t)l * 512 * 512, 512, 512, (u >> 2) * LP, (u & 3) * 128, ep);
            }
        }
        SEAM(ph + 5);
        PHASE_K(8, ph + 6) {
            {
                Epi8Out ep{(bf16_t*)(ws + WS_X), MODl};
                const pg8::Gemm g{(const bf16_t*)(ws + WS_MIX), (const bf16_t*)(ws + WS_WOUTT) + (size_t)l * 1024 * 1024, R, 1024, 1024};
                const TileOrder S{128 * 4, G, vcu, 16, 4, 0, 17, 1};
                pg8::gemm_phase<Epi8Out, TileOrder, true, true>(ldsp, g, S, ep);
            }
            if (!last) for (int u = vcu; u < 16 * 8; u += G) {
                EpiOut ep{(bf16_t*)(ws + WS_X), MODl};
                APlain af{(const bf16_t*)(ws + WS_MIX), 1024};
                const int mt = u >> 3, nt = u & 7;
                gemm_unit_dma(lds, af, (const bf16_t*)(ws + WS_WOUTT) + (size_t)l * 1024 * 1024, 1024, 1024, (mt >> 1) * LP + (mt & 1) * 128, nt * 128, ep);
            }
        }
        SEAM(ph + 6);
        PHASE_K(9, ph + 7) { rowpass2(lds, P, l); }
        SEAM(ph + 7);
        PHASE_K(10, ph + 8) {
            for (int u = bid; u < (last ? 128 : 256); u += G) select_unit(lds, P, (u & 127) >> 4, u & 15, u < 128);
        }
        SEAM(ph + 8);
        PHASE_K(11, ph + 9) {
            Epi8Moe1 ep{(bf16_t*)(ws + WS_HG)};
            const pg8::Gemm g{(const bf16_t*)(ws + WS_HX), (const bf16_t*)(ws + WS_W13T) + (size_t)l * 16 * 4096 * 1024, 16 * ROWS_E, 16 * 4096, 1024, (const int*)(ws + WS_IDX), 131072 + 64};
            const TileOrder S = last ? TileOrder{16 * 16 * 16, G, vcu, 16, 16, 16, 17, 0, 1} : TileOrder{16 * 17 * 16, G, vcu, 17, 16, 16, 17, 0, 1};
            pg8::gemm_phase<Epi8Moe1, TileOrder, true, true, true>(ldsp, g, S, ep);
        }
        SEAM(ph + 9);
        PHASE_K(12, ph + 10) {
            {
                Epi8Moe2 ep{(bf16_t*)(ws + WS_OG), (const float*)(ws + WS_GATE)};
                const pg8::Gemm g{(const bf16_t*)(ws + WS_HG), (const bf16_t*)(ws + WS_W2T) + (size_t)l * 16 * 1024 * 2048, 16 * ROWS_E, 16 * 1024, 2048};
                const TileOrder S{16 * 16 * 4, G, vcu, 16, 4, 4, 17, 0};
                pg8::gemm_phase<Epi8Moe2, TileOrder, true, true>(ldsp, g, S, ep);
            }
            if (!last) for (int u = vcu; u < 16 * 2 * 8; u += G) {
                const int e = u >> 4, mt = (u >> 3) & 1, nt = u & 7;
                EpiMoe2 ep{(bf16_t*)(ws + WS_OG) + (size_t)e * ROWS_E * 1024, (const float*)(ws + WS_GATE) + (size_t)e * ROWS_E};
                APlain af{(const bf16_t*)(ws + WS_HG) + (size_t)e * ROWS_E * FF, FF};
                gemm_unit_dma(lds, af, (const bf16_t*)(ws + WS_W2T) + ((size_t)l * 16 + e) * 1024 * 2048, 2048, 2048, NB * CAPL + mt * 128, nt * 128, ep);
            }
        }
        SEAM(ph + 10);
    }
    PHASE_K(13, PH_FINAL) { rowpass1<false>(P, DEPTH); }
#undef ws
}

#ifndef MK_MULTI
#define MK_MULTI 0
#endif

extern "C" void kernel_launch(void* const* d_in, const int* in_sizes, int n_in, void* d_out, int out_size, void* d_ws, size_t ws_size, hipStream_t stream) {
    static int grid = 0;
    if (!grid) {
        int dev = 0, cus = 0, per_cu = 0;
        hipGetDevice(&dev);
        hipDeviceGetAttribute(&cus, hipDeviceAttributeMultiprocessorCount, dev);
        hipFuncSetAttribute((const void*)fwd_kernel, hipFuncAttributeMaxDynamicSharedMemorySize, LDS_BYTES);
        hipOccupancyMaxActiveBlocksPerMultiprocessor(&per_cu, fwd_kernel, 512, LDS_BYTES);
        grid = cus * (per_cu < 1 ? per_cu : 1);
        if (grid <= 0) { fprintf(stderr, "occupancy query failed (per_cu=%d cus=%d)\n", per_cu, cus); grid = 256; }
        if (ws_size < WS_END) fprintf(stderr, "workspace too small: %zu < %zu\n", ws_size, (size_t)WS_END);
    }
    Params p{};
    for (int i = 0; i < 30; ++i) p.in[i] = (const float*)d_in[i];
    p.out = (float*)d_out; p.ws = (unsigned char*)d_ws;
    hipMemsetAsync(d_ws, 0, CTL_BYTES, stream);
#if MK_MULTI
    for (int ph = 0; ph < N_PHASES; ++ph) {
        p.lo = ph; p.hi = ph + 1;
        hipLaunchKernelGGL(fwd_kernel, dim3(grid), dim3(512), LDS_BYTES, stream, p);
    }
#else
    p.lo = 0; p.hi = N_PHASES;
    hipLaunchKernelGGL(fwd_kernel, dim3(grid), dim3(512), LDS_BYTES, stream, p);
#endif
}
```

```cpp
#include <hip/hip_runtime.h>
#include <cstdio>
#include <cstdint>
#include <cmath>

#define DEVI __device__ __forceinline__
#define LAS __attribute__((address_space(3)))

typedef unsigned short bf16_t;
typedef short bf16x8 __attribute__((ext_vector_type(8)));
typedef float f32x2 __attribute__((ext_vector_type(2)));
typedef float f32x4 __attribute__((ext_vector_type(4)));
typedef float f32x16 __attribute__((ext_vector_type(16)));
typedef unsigned u32x2 __attribute__((ext_vector_type(2)));
typedef unsigned u32x4 __attribute__((ext_vector_type(4)));
typedef __bf16 bf16x2_t __attribute__((ext_vector_type(2)));

constexpr int NB = 8, SEQ = 4096, CTXL = 256, DM = 1024, DEPTH = 4;
constexpr int LP = CTXL + SEQ;
constexpr int R = NB * LP;
constexpr int NCHB = LP / 16;
constexpr int NCH = NB * NCHB;
constexpr int NE = 16, CAPL = 512, CAPC = 32, ROWS_BE = CAPL + CAPC  , ROWS_E = NB * ROWS_BE  , FF = 2048;
constexpr int NH = 4;
constexpr float EPS = 1e-6f;
constexpr float QSCALE = 0.125f * 1.4426950408889634f;

constexpr size_t al256(size_t x) { return (x + 255) & ~(size_t)255; }
constexpr size_t WS_CTL = 0, CTL_BYTES = 65536;
constexpr size_t WS_MOD = WS_CTL + CTL_BYTES;
constexpr size_t WS_ROPE = WS_MOD + al256((size_t)4 * 9 * 6144 * 4);
constexpr size_t WS_LAM = WS_ROPE + al256(64 * 16 * 2 * 4);
constexpr size_t WS_KTAB = WS_LAM + 256;
constexpr size_t WS_PW = WS_KTAB + (size_t)4 * 2 * 32 * 4096 * 4;
constexpr size_t WS_BBAR = WS_PW + al256((size_t)4 * 2 * 32 * 64 * 17 * 2 * 4);
constexpr size_t WS_WENDT = WS_BBAR + al256((size_t)4 * 2 * 32 * 64 * 16 * 2 * 4);
constexpr size_t WS_BT2 = WS_WENDT + (size_t)4 * 32 * 256 * 512 * 2;
constexpr size_t WS_WINT = WS_BT2 + (size_t)4 * 32 * 256 * 512 * 2;
constexpr size_t WS_WOUTT = WS_WINT + (size_t)4 * 2048 * 1024 * 2;
constexpr size_t WS_WGLUT = WS_WOUTT + (size_t)4 * 1024 * 1024 * 2;
constexpr size_t WS_W13T = WS_WGLUT + (size_t)4 * 512 * 512 * 2;
constexpr size_t WS_W2T = WS_W13T + (size_t)4 * 16 * 4096 * 1024 * 2;
constexpr size_t WS_X = WS_W2T + (size_t)4 * 16 * 1024 * 2048 * 2;
constexpr size_t WS_HX = WS_X + (size_t)R * 1024 * 4;
constexpr size_t WS_QK = WS_HX + (size_t)R * 1024 * 2;
constexpr size_t WS_VT = WS_QK + (size_t)R * 1024 * 2;
constexpr int NCHP = 2304;
constexpr size_t WS_US = WS_VT + (size_t)R * 512 * 2;
constexpr size_t WS_EB = WS_US + (size_t)32 * NCHP * 512 * 2;
constexpr size_t WS_MIX = WS_EB + (size_t)32 * NCHP * 256 * 4;
constexpr size_t WS_YG = WS_MIX + (size_t)R * 1024 * 2;
constexpr size_t WS_AFFT = WS_YG + (size_t)R * 512 * 2;
constexpr size_t WS_SLOT = WS_AFFT + (size_t)NB * 16 * LP * 4;
constexpr size_t WS_GATE = WS_SLOT + (size_t)R * 16 * 4;
constexpr size_t WS_IDX = WS_GATE + al256((size_t)16 * ROWS_E * 4);
constexpr size_t WS_XG = WS_IDX + al256((size_t)16 * ROWS_E * 4);
constexpr size_t WS_HG = WS_XG + (size_t)16 * ROWS_E * 1024 * 2;
constexpr size_t WS_OG = WS_HG + (size_t)16 * ROWS_E * 2048 * 2;
constexpr size_t WS_END = WS_OG + (size_t)16 * ROWS_E * 1024 * 2;

constexpr int LDS_BYTES = 131072 + 64 + 16384;

DEVI unsigned pk2(float lo, float hi) { f32x2 v = {lo, hi}; bf16x2_t b = __builtin_convertvector(v, bf16x2_t); return __builtin_bit_cast(unsigned, b); }
DEVI bf16_t f2bf(float f) { return (bf16_t)(pk2(f, 0.f) & 0xffffu); }
DEVI float bflo(unsigned u) { return __builtin_bit_cast(float, u << 16); }
DEVI float bfhi(unsigned u) { return __builtin_bit_cast(float, u & 0xffff0000u); }
DEVI f32x4 bf4(u32x2 w) { return (f32x4){bflo(w.x), bfhi(w.x), bflo(w.y), bfhi(w.y)}; }
typedef _Float16 h16x2 __attribute__((ext_vector_type(2)));
DEVI unsigned hpk2(float lo, float hi) { unsigned r; asm("v_cvt_pk_f16_f32 %0, %1, %2" : "=v"(r) : "v"(lo), "v"(hi)); return r; }
DEVI float hlo(unsigned u) { return (float)__builtin_bit_cast(_Float16, (unsigned short)(u & 0xffffu)); }
DEVI float hhi(unsigned u) { return (float)__builtin_bit_cast(_Float16, (unsigned short)(u >> 16)); }
DEVI f32x4 hf4(u32x2 w) { return (f32x4){hlo(w.x), hhi(w.x), hlo(w.y), hhi(w.y)}; }
DEVI int tid_l() { int t = threadIdx.x; asm volatile("" : "+v"(t)); return t; }
#define GAS __attribute__((address_space(1)))
DEVI unsigned char* ptr_l(unsigned char* w) { GAS unsigned char* g = (GAS unsigned char*)w; asm volatile("" : "+s"(g)); return (unsigned char*)g; }
template <int CTRL> DEVI float dppmov(float x) { return __builtin_bit_cast(float, __builtin_amdgcn_update_dpp(0, __builtin_bit_cast(int, x), CTRL, 0xf, 0xf, true)); }
DEVI void swap16(float a, float b, float& r0, float& r1) { const auto r = __builtin_amdgcn_permlane16_swap(__builtin_bit_cast(unsigned, a), __builtin_bit_cast(unsigned, b), false, false); r0 = __builtin_bit_cast(float, (unsigned)r[0]); r1 = __builtin_bit_cast(float, (unsigned)r[1]); }
DEVI void swap32(float a, float b, float& r0, float& r1) { const auto r = __builtin_amdgcn_permlane32_swap(__builtin_bit_cast(unsigned, a), __builtin_bit_cast(unsigned, b), false, false); r0 = __builtin_bit_cast(float, (unsigned)r[0]); r1 = __builtin_bit_cast(float, (unsigned)r[1]); }
DEVI float wave_sum(float v) {
    v += dppmov<0xB1>(v);
    v += dppmov<0x4E>(v);
    v += dppmov<0x124>(v);
    v += dppmov<0x128>(v);
    float r0, r1; swap16(v, v, r0, r1); v = r0 + r1;
    swap32(v, v, r0, r1); return r0 + r1;
}
DEVI float fast_exp2(float x) { return __builtin_amdgcn_exp2f(x); }
DEVI float sigmoidf_(float x) { return __builtin_amdgcn_rcpf(1.f + __expf(-x)); }
DEVI float gelu_tanh(float x) { const float z = 0.7978845608028654f * (x + 0.044715f * x * x * x); const float t = 1.f - 2.f * __builtin_amdgcn_rcpf(__expf(2.f * z) + 1.f); return 0.5f * x * (1.f + t); }
#define MFMA32(a, b, c) __builtin_amdgcn_mfma_f32_32x32x16_bf16(a, b, c, 0, 0, 0)

#define XB_TMO      128
#define XB_XCNT(j)  (256  + 64 * (j))
#define XB_XSUB(j)  (1280 + 64 * (j))
#define XB_XGEN(j)  (2304 + 64 * (j))
#define XB_TOP      3328
#define XB_TOPGEN   3392
#define XCD_BAR_WORDS 3456
#define XB_SPIN_CAP (1u << 20)
DEVI unsigned xb_ld(unsigned* p)              { return __hip_atomic_load(p, __ATOMIC_RELAXED, __HIP_MEMORY_SCOPE_AGENT); }
DEVI unsigned xb_add(unsigned* p, unsigned v) { return __hip_atomic_fetch_add(p, v, __ATOMIC_RELAXED, __HIP_MEMORY_SCOPE_AGENT); }
DEVI unsigned xb_xcc_id() { return (unsigned)__builtin_amdgcn_s_getreg((3 << 11) | 20) & 0xFu; }
#define XB_SPIN(cond, bar) do { unsigned _sp = 0; while (cond) { __builtin_amdgcn_s_sleep(1); \
    if ((++_sp & 255u) == 0u) { if (xb_ld(&(bar)[XB_TMO])) break; if (_sp > XB_SPIN_CAP) { atomicAdd(&(bar)[XB_TMO], 1u); break; } } } } while (0)
struct XcdBarrier { unsigned* bar; unsigned x; volatile LAS unsigned* st; };
DEVI XcdBarrier xcd_barrier_post(unsigned* bar, volatile LAS unsigned* st) {
    XcdBarrier b; b.bar = bar; b.x = xb_xcc_id(); b.st = st;
    if (threadIdx.x == 0) (void)xb_add(&bar[XB_XCNT(b.x)], 1u);
    return b;
}
DEVI void xcd_barrier_complete(unsigned* bar, unsigned x, unsigned& nloc, unsigned& nx) {
    const unsigned G = gridDim.x * gridDim.y * gridDim.z;
    unsigned sum, cnt, mine, sp = 0u;
    for (;;) {
        sum = 0u; cnt = 0u; mine = 0u;
#pragma unroll
        for (unsigned j = 0; j < 16; ++j) { const unsigned c = xb_ld(&bar[XB_XCNT(j)]); sum += c; cnt += (c > 0u) ? 1u : 0u; mine = (j == x) ? c : mine; }
        if (sum == G) break;
        __builtin_amdgcn_s_sleep(1);
        if ((++sp & 255u) == 0u) { if (xb_ld(&bar[XB_TMO])) break; if (sp > XB_SPIN_CAP) { atomicAdd(&bar[XB_TMO], 1u); break; } }
    }
    nloc = mine > 0u ? mine : 1u; nx = cnt > 0u ? cnt : 1u;
}
DEVI void xcd_barrier(const XcdBarrier& b) {
    asm volatile("s_waitcnt vmcnt(0)" ::: "memory");
    __syncthreads();
    if (threadIdx.x == 0) {
        unsigned* bar = b.bar;
        __builtin_amdgcn_s_waitcnt(0);
        unsigned nloc = b.st[0], nx = b.st[1];
        if (nloc == 0u) { xcd_barrier_complete(bar, b.x, nloc, nx); b.st[0] = nloc; b.st[1] = nx; }
        const unsigned old = xb_add(&bar[XB_XSUB(b.x)], 1u);
        const unsigned gen = old / nloc;
        if (old + 1u == (gen + 1u) * nloc) {
            __builtin_amdgcn_fence(__ATOMIC_RELEASE, "agent");
            asm volatile("s_waitcnt vmcnt(0)" ::: "memory");
            const unsigned og = xb_add(&bar[XB_TOP], 1u);
            const unsigned tg = og / nx;
            if (og + 1u == (tg + 1u) * nx) xb_add(&bar[XB_TOPGEN], 1u);
            else XB_SPIN(xb_ld(&bar[XB_TOPGEN]) == tg, bar);
            __builtin_amdgcn_fence(__ATOMIC_ACQUIRE, "agent");
            xb_add(&bar[XB_XGEN(b.x)], 1u);
            asm volatile("s_waitcnt vmcnt(0)" ::: "memory");
        } else {
            XB_SPIN(xb_ld(&bar[XB_XGEN(b.x)]) == gen, bar);
            __builtin_amdgcn_fence(__ATOMIC_ACQUIRE, "agent");
            asm volatile("s_waitcnt vmcnt(0)" ::: "memory");
        }
    }
    __syncthreads();
}

DEVI int chunk_row(int b, int c) { return c >= 16 ? b * 256 + (c - 16) : 2048 + b * 16 + c; }
DEVI int chunk_row_token(int cr) { return cr < 2048 ? (cr >> 8) * LP + (16 + (cr & 255)) * 16 : ((cr - 2048) >> 4) * LP + ((cr - 2048) & 15) * 16; }
DEVI int perm16(int k) { return (k & 3) | ((k & 4) << 1) | ((k & 8) >> 1); }

namespace pg8 {
#define PG8_LAS __attribute__((address_space(3)))
typedef unsigned short bf16_t;
typedef short bf16x8 __attribute__((ext_vector_type(8)));
typedef float f32x4 __attribute__((ext_vector_type(4)));
typedef unsigned u32x4 __attribute__((ext_vector_type(4)));
constexpr int BM = 256, BK = 64, HALF = 128, HTB = HALF * BK * 2  , STAGE_BYTES = 8 * HTB, NXCD = 8, WGM = 8;

__host__ __device__ __forceinline__ int lds_byte(int r, int c) { const int st = (r >> 4) * 2 + (c >> 5), rr = r & 15, cc = c & 31, ob = rr * 64 + cc * 2; return st * 1024 + (ob ^ (((ob >> 9) & 1) << 5)); }
__host__ __device__ __forceinline__ void stage_rc(int b, int& R, int& C) { const int st = b / 1024, sb = b % 1024, swz = sb ^ (((sb >> 9) & 1) << 5); R = (st >> 1) * 16 + swz / 64; C = (st & 1) * 32 + (swz % 64) / 2; }
__host__ __device__ __forceinline__ int perm32(int rho) { const int n = rho >> 4, i = rho & 15; return 8 * (i >> 2) + 4 * n + (i & 3); }

struct Unit { int pm, pn; };
struct Gemm { const bf16_t* A; const bf16_t* Bt; int M, N, K; const int* gidx = nullptr; int islot = 0; };
__device__ __forceinline__ unsigned cvt_pk_bf16(float lo, float hi) { unsigned r; asm volatile("v_cvt_pk_bf16_f32 %0, %1, %2" : "=v"(r) : "v"(lo), "v"(hi)); return r; }
template <class Epi, class Sched, bool ALIGN_EPI = false, bool SP2 = false, bool GATH = false>
__device__ __forceinline__ void gemm_phase(PG8_LAS unsigned char* lds, const Gemm g, const Sched& S, const Epi& E) {
    static_assert(!GATH || SP2, "the gathered-A form is written for the SP2 loop only");
    const int tid = tid_l(), wid = __builtin_amdgcn_readfirstlane(tid >> 6), lane = tid & 63, wr = wid >> 2, wc = wid & 3, fr = lane & 15, fq = lane >> 4;
    const int K = g.K, nt = K / BK;
    unsigned voffA[2], voffB[2];
    int stR[2], stC[2];
#pragma unroll
    for (int i = 0; i < 2; ++i) { int R, C; stage_rc(tid * 16 + i * 8192, R, C); const int Rb = Epi::PERM ? ((R & ~31) + perm32(R & 31)) : R; stR[i] = R; stC[i] = C;
        voffA[i] = (unsigned)(R * K + C) * 2u; voffB[i] = (unsigned)(Rb * K + C) * 2u; }
    unsigned goff[2][2], ngoff[2][2];
    const char* gA = (const char*)g.A;
    const size_t kstep = (size_t)(BK * 2);
    const size_t hstep = (size_t)HALF * K * 2;
    const size_t tstep = 2 * hstep;
    const unsigned ldsw = (unsigned)wid * 1024u;
    const int aoff = lds_byte(wr * 64 + fr, fq * 8), boff = lds_byte(wc * 32 + fr, fq * 8);
#define PG8_SA(b, h) (((b) * 2 + (h)) * HTB)
#define PG8_SB(b, h) ((4 + (b) * 2 + (h)) * HTB)
#define PG8_STAGE(bufoff, gbase, voff) do { _Pragma("unroll") for (int _i = 0; _i < 2; ++_i) \
        __builtin_amdgcn_global_load_lds((const unsigned*)((const char*)(gbase) + (voff)[_i]), (PG8_LAS unsigned*)(lds + (bufoff) + ldsw + _i * 8192), 16, 0, 0); } while (0)
#define PG8_STAGE_A(bufoff, selnext, kt, h) do { if constexpr (GATH) PG8_STAGE(bufoff, gA + (size_t)(kt) * kstep, ((selnext) ? ngoff[h] : goff[h])); \
        else PG8_STAGE(bufoff, ((selnext) ? nA : cA) + (size_t)(kt) * kstep + (size_t)(h) * hstep, voffA); } while (0)
#define PG8_LDA(dst, b, h) do { _Pragma("unroll") for (int m = 0; m < 4; ++m) _Pragma("unroll") for (int k = 0; k < 2; ++k) dst[m][k] = *(const PG8_LAS bf16x8*)(lds + PG8_SA(b, h) + aoff + m * 2048 + k * 1024); } while (0)
#define PG8_LDB(dst, b, h) do { _Pragma("unroll") for (int n = 0; n < 2; ++n) _Pragma("unroll") for (int k = 0; k < 2; ++k) dst[n][k] = *(const PG8_LAS bf16x8*)(lds + PG8_SB(b, h) + boff + n * 2048 + k * 1024); } while (0)
#define PG8_MMA(ai, bj, At, Bt) do { __builtin_amdgcn_s_setprio(1); _Pragma("unroll") for (int m = 0; m < 4; ++m) _Pragma("unroll") for (int n = 0; n < 2; ++n) _Pragma("unroll") for (int k = 0; k < 2; ++k) \
        acc[ai][bj][m][n] = __builtin_amdgcn_mfma_f32_16x16x32_bf16(Bt[n][k], At[m][k], acc[ai][bj][m][n], 0, 0, 0); __builtin_amdgcn_s_setprio(0); } while (0)
#define PG8_WAIT_V(n) asm volatile("s_waitcnt vmcnt(" #n ")" ::: "memory")
#define PG8_WAIT_L(n) asm volatile("s_waitcnt lgkmcnt(" #n ")" ::: "memory")
#define PG8_BAR __builtin_amdgcn_s_barrier()
#define PG8_SCHED __builtin_amdgcn_sched_barrier(0)
    Unit cur, nxt; int ui = 0;
    if (!S.next(0, cur)) return;
    f32x4 acc[2][2][4][2];
#pragma unroll
    for (int a = 0; a < 2; ++a)
#pragma unroll
        for (int b = 0; b < 2; ++b)
#pragma unroll
            for (int m = 0; m < 4; ++m)
#pragma unroll
                for (int n = 0; n < 2; ++n) acc[a][b][m][n] = (f32x4){0.f, 0.f, 0.f, 0.f};
    bf16x8 At[4][2], B0[2][2], B1[2][2];
    const char* cA = (const char*)g.A + (size_t)cur.pm * tstep; const char* cB = (const char*)g.Bt + (size_t)cur.pn * tstep;
    const char* nA = cA;
    if constexpr (GATH) {
#pragma unroll
        for (int h = 0; h < 2; ++h)
#pragma unroll
            for (int i = 0; i < 2; ++i) { goff[h][i] = (unsigned)(g.gidx[cur.pm * 256 + h * 128 + stR[i]] * K + stC[i]) * 2u; ngoff[h][i] = goff[h][i]; }
    }
    S.a_ready(cur);
    if constexpr (SP2) {
        PG8_STAGE(PG8_SB(0, 0), cB, voffB); PG8_STAGE(PG8_SB(0, 1), cB + hstep, voffB); PG8_STAGE_A(PG8_SA(0, 0), false, 0, 0); PG8_STAGE_A(PG8_SA(0, 1), false, 0, 1);
        if (wr == 1) PG8_BAR;
        PG8_WAIT_V(2); PG8_BAR;
        PG8_STAGE(PG8_SB(1, 0), cB + kstep, voffB); PG8_STAGE_A(PG8_SA(1, 0), false, 1, 0); PG8_STAGE(PG8_SB(1, 1), cB + hstep + kstep, voffB);
        PG8_WAIT_V(6); PG8_BAR;
    } else {
        PG8_STAGE(PG8_SB(0, 0), cB, voffB); PG8_STAGE(PG8_SA(0, 0), cA, voffA); PG8_STAGE(PG8_SB(0, 1), cB + hstep, voffB); PG8_STAGE(PG8_SA(0, 1), cA + hstep, voffA);
        if (wr == 1) PG8_BAR;
        PG8_WAIT_V(4); PG8_BAR;
        PG8_STAGE(PG8_SB(1, 0), cB + kstep, voffB); PG8_STAGE(PG8_SA(1, 0), cA + kstep, voffA); PG8_STAGE(PG8_SB(1, 1), cB + hstep + kstep, voffB);
        PG8_WAIT_V(6); PG8_BAR;
    }
    for (;;) {
        const bool has_next = S.next(ui + 1, nxt);
        nA = has_next ? (const char*)g.A + (size_t)nxt.pm * tstep : cA; const char* nB = has_next ? (const char*)g.Bt + (size_t)nxt.pn * tstep : cB;
        if constexpr (GATH) {
            if (has_next) {
#pragma unroll
                for (int h = 0; h < 2; ++h)
#pragma unroll
                    for (int i = 0; i < 2; ++i)
                        __builtin_amdgcn_global_load_lds((const unsigned*)(g.gidx + nxt.pm * 256 + h * 128 + stR[i]), (PG8_LAS unsigned*)(lds + g.islot + ((ui + 1) & 1) * 8192 + (h * 2 + i) * 2048 + wid * 256), 4, 0, 0);
            }
        }
        for (int t = 0; t < nt; t += 2) {
            const bool last = (t == nt - 2);
            if constexpr (GATH) {
                if (last) {
                    if (has_next) {
#pragma unroll
                        for (int h = 0; h < 2; ++h)
#pragma unroll
                            for (int i = 0; i < 2; ++i) { const int ix = *(const PG8_LAS int*)(lds + g.islot + ((ui + 1) & 1) * 8192 + (h * 2 + i) * 2048 + wid * 256 + lane * 4); ngoff[h][i] = (unsigned)(ix * K + stC[i]) * 2u; }
                    } else {
#pragma unroll
                        for (int h = 0; h < 2; ++h)
#pragma unroll
                            for (int i = 0; i < 2; ++i) ngoff[h][i] = goff[h][i];
                    }
                }
            }
            const char* a1 = cA + (size_t)(t + 1) * kstep;
            const char* a2 = last ? nA : cA + (size_t)(t + 2) * kstep; const char* b2 = last ? nB : cB + (size_t)(t + 2) * kstep;
            const char* a3 = a2 + kstep; const char* b3 = b2 + kstep;
            if (last && has_next) S.a_ready(nxt);
            if constexpr (SP2) {
            PG8_LDB(B0, 0, 0); PG8_LDB(B1, 0, 1); PG8_SCHED; PG8_LDA(At, 0, 0); PG8_STAGE_A(PG8_SA(1, 1), false, t + 1, 1);
            PG8_WAIT_V(8); PG8_WAIT_L(0); PG8_BAR; PG8_MMA(0, 0, At, B0); PG8_MMA(0, 1, At, B1); PG8_BAR; PG8_SCHED;
            PG8_LDA(At, 0, 1); PG8_STAGE(PG8_SB(0, 0), b2, voffB); PG8_STAGE(PG8_SB(0, 1), b2 + hstep, voffB); PG8_STAGE_A(PG8_SA(0, 0), last, last ? 0 : t + 2, 0);
            PG8_WAIT_V(8); PG8_WAIT_L(0); PG8_BAR; PG8_MMA(1, 0, At, B0); PG8_MMA(1, 1, At, B1); PG8_BAR; PG8_SCHED;
            PG8_LDB(B0, 1, 0); PG8_LDB(B1, 1, 1); PG8_SCHED; PG8_LDA(At, 1, 0); PG8_STAGE_A(PG8_SA(0, 1), last, last ? 0 : t + 2, 1);
            PG8_WAIT_V(8); PG8_WAIT_L(0); PG8_BAR; PG8_MMA(0, 0, At, B0); PG8_MMA(0, 1, At, B1); PG8_BAR; PG8_SCHED;
            PG8_LDA(At, 1, 1); PG8_STAGE(PG8_SB(1, 0), b3, voffB); PG8_STAGE(PG8_SB(1, 1), b3 + hstep, voffB); PG8_STAGE_A(PG8_SA(1, 0), last, last ? 1 : t + 3, 0);
            PG8_WAIT_V(8); PG8_WAIT_L(0); PG8_BAR; PG8_MMA(1, 0, At, B0); PG8_MMA(1, 1, At, B1); PG8_BAR; PG8_SCHED;
            } else {
            PG8_LDB(B0, 0, 0); PG8_SCHED; PG8_LDA(At, 0, 0); PG8_STAGE(PG8_SA(1, 1), a1 + hstep, voffA);
            PG8_WAIT_L(8); PG8_BAR; PG8_WAIT_L(0); PG8_MMA(0, 0, At, B0); PG8_BAR; PG8_SCHED;
            PG8_LDB(B1, 0, 1); PG8_STAGE(PG8_SB(0, 0), b2, voffB);
            PG8_BAR; PG8_WAIT_L(0); PG8_MMA(0, 1, At, B1); PG8_BAR;
            PG8_LDA(At, 0, 1); PG8_STAGE(PG8_SA(0, 0), a2, voffA);
            PG8_BAR; PG8_WAIT_L(0); PG8_MMA(1, 0, At, B0); PG8_BAR; PG8_SCHED;
            PG8_STAGE(PG8_SB(0, 1), b2 + hstep, voffB);
            PG8_WAIT_V(6); PG8_BAR; PG8_MMA(1, 1, At, B1); PG8_BAR;
            PG8_LDB(B0, 1, 0); PG8_SCHED; PG8_LDA(At, 1, 0); PG8_STAGE(PG8_SA(0, 1), a2 + hstep, voffA);
            PG8_WAIT_L(8); PG8_BAR; PG8_WAIT_L(0); PG8_MMA(0, 0, At, B0); PG8_BAR; PG8_SCHED;
            PG8_LDB(B1, 1, 1); PG8_STAGE(PG8_SB(1, 0), b3, voffB);
            PG8_BAR; PG8_WAIT_L(0); PG8_MMA(0, 1, At, B1); PG8_BAR;
            PG8_LDA(At, 1, 1); PG8_STAGE(PG8_SA(1, 0), a3, voffA);
            PG8_BAR; PG8_WAIT_L(0); PG8_MMA(1, 0, At, B0); PG8_BAR; PG8_SCHED;
            PG8_STAGE(PG8_SB(1, 1), b3 + hstep, voffB);
            PG8_WAIT_V(6); PG8_BAR; PG8_MMA(1, 1, At, B1); PG8_BAR;
            }
        }
        if constexpr (ALIGN_EPI) { if (wr == 0) PG8_BAR; }
        if constexpr (!Epi::AFTER_DRAIN) { E(acc, cur, wr, wc, fr, fq); S.done(cur); }
        if (!has_next) break;
#pragma unroll
        for (int a = 0; a < 2; ++a)
#pragma unroll
            for (int b = 0; b < 2; ++b)
#pragma unroll
                for (int m = 0; m < 4; ++m)
#pragma unroll
                    for (int n = 0; n < 2; ++n) acc[a][b][m][n] = (f32x4){0.f, 0.f, 0.f, 0.f};
        cur = nxt; cA = nA; cB = nB; ++ui;
        if constexpr (GATH) {
#pragma unroll
            for (int h = 0; h < 2; ++h)
#pragma unroll
                for (int i = 0; i < 2; ++i) goff[h][i] = ngoff[h][i];
        }
        if constexpr (ALIGN_EPI) { if (wr == 1) PG8_BAR; }
    }
    PG8_WAIT_V(0);
    if constexpr (!ALIGN_EPI) { if (wr == 0) PG8_BAR; }
    PG8_BAR;
    if constexpr (Epi::AFTER_DRAIN) { E.fused(acc, cur, wr, wc, fr, fq, lds, wid, lane); S.done(cur); }
#undef PG8_SA
#undef PG8_SB
#undef PG8_STAGE
#undef PG8_STAGE_A
#undef PG8_LDA
#undef PG8_LDB
#undef PG8_MMA
#undef PG8_WAIT_V
#undef PG8_WAIT_L
#undef PG8_BAR
#undef PG8_SCHED
}
}


struct TileOrder {
    int nunits, G, c, npm, npn, pn_gs, pm_gs, pm_off, blk48 = 0;
    DEVI bool next(int i, pg8::Unit& u) const {
        const int L = i * G + c; if (L >= nunits) return false;
        const int per = npm * npn, e = L / per, v = L - e * per; int pml = v / npn, pnl = v - pml * npn;
        if (blk48 && v < 256) { const int blk = v >> 5, w = v & 31; pml = (blk >> 1) * 4 + (w >> 3); pnl = (blk & 1) * 8 + (w & 7); }
        u.pm = e * pm_gs + pm_off + pml; u.pn = e * pn_gs + pnl; return true;
    }
    DEVI void a_ready(const pg8::Unit&) const {}
    DEVI void done(const pg8::Unit&) const {}
};

struct Epi8Inproj { static constexpr bool PERM = false, AFTER_DRAIN = false;
    bf16_t* QK; bf16_t* VT; bf16_t* UG; const float* rope;
    DEVI void operator()(const f32x4 (&acc)[2][2][4][2], const pg8::Unit& u, int wr, int wc, int fr, int fq) const {
        const int pn = u.pn;
#pragma unroll
        for (int ai = 0; ai < 2; ++ai)
#pragma unroll
            for (int m = 0; m < 4; ++m) {
                const int r = u.pm * 256 + ai * 128 + wr * 64 + m * 16 + fr, b = r / LP, p = r - b * LP; const bool latent = p >= CTXL; const int t = p - CTXL;
#pragma unroll
                for (int bj = 0; bj < 2; ++bj) {
                    const int cb = bj * 128 + wc * 32;
                    if (pn < 4) {
                        const int head = cb >> 6, dbase = cb & 63, pos = dbase == 0 ? (t >> 6) : (t & 63);
                        const float sc = pn < 2 ? QSCALE : 1.f;
                        f32x4 cs0 = {1.f, 0.f, 1.f, 0.f}, cs1 = {1.f, 0.f, 1.f, 0.f};
                        if (latent) { cs0 = *(const f32x4*)(rope + (pos * 16 + 4 * fq) * 2); cs1 = *(const f32x4*)(rope + (pos * 16 + 4 * fq + 2) * 2); }
                        const float cc[4] = {cs0.x, cs0.z, cs1.x, cs1.z}, sn[4] = {cs0.y, cs0.w, cs1.y, cs1.w};
                        bf16_t* dst = QK + ((size_t)((pn * NB + b) * NH + head) * LP + p) * 64 + dbase + 4 * fq;
#pragma unroll
                        for (int n = 0; n < 2; ++n) {
                            float o[4];
#pragma unroll
                            for (int j = 0; j < 4; ++j) { const float x = acc[ai][bj][m][n][j], y = acc[ai][bj][m][n ^ 1][j]; o[j] = (n == 0 ? x * cc[j] - y * sn[j] : x * cc[j] + y * sn[j]) * sc; }
                            u32x2 w; w.x = pk2(o[0], o[1]); w.y = pk2(o[2], o[3]);
                            *(u32x2*)(dst + 16 * n) = w;
                        }
                    } else if (pn < 6) {
                        const int cv = (pn - 4) * 256 + cb, head = cv >> 7, dv0 = (cv & 127) + 4 * fq;
                        const int pp = (p & ~15) | perm16(p & 15);
                        bf16_t* dst = VT + ((size_t)(b * NH + head) * 128 + dv0) * LP + pp;
#pragma unroll
                        for (int n = 0; n < 2; ++n)
#pragma unroll
                            for (int j = 0; j < 4; ++j) dst[(size_t)(16 * n + j) * LP] = f2bf(acc[ai][bj][m][n][j]);
                    } else {
                        const int ch0 = (pn - 6) * 256 + cb;
                        bf16_t* dst = UG + (size_t)chunk_row(b, p >> 4) * 512 + (p & 15) * 16 + 4 * fq;
#pragma unroll
                        for (int n = 0; n < 2; ++n) {
                            const int g = (ch0 + 16 * n) >> 4;
                            u32x2 w; w.x = pk2(acc[ai][bj][m][n][0], acc[ai][bj][m][n][1]); w.y = pk2(acc[ai][bj][m][n][2], acc[ai][bj][m][n][3]);
                            *(u32x2*)(dst + (size_t)g * NCHP * 512) = w;
                        }
                    }
                }
            }
    }
};

struct Epi8Out { static constexpr bool PERM = true, AFTER_DRAIN = false;
    bf16_t* X; const float* mod;
    DEVI void operator()(const f32x4 (&acc)[2][2][4][2], const pg8::Unit& u, int wr, int wc, int fr, int fq) const {
#pragma unroll
        for (int ai = 0; ai < 2; ++ai)
#pragma unroll
            for (int m = 0; m < 4; ++m) {
                const int r = u.pm * 256 + ai * 128 + wr * 64 + m * 16 + fr, b = r / LP, p = r - b * LP, jm = p < CTXL ? 8 : b;
                const float* g1 = mod + (size_t)jm * 6144 + 2 * 1024;
#pragma unroll
                for (int bj = 0; bj < 2; ++bj) {
                    const int c = u.pn * 256 + bj * 128 + wc * 32 + 8 * fq;
                    bf16_t* xp = X + (size_t)r * 1024 + c;
                    const u32x4 xw = *(const u32x4*)xp;
                    const f32x4 g0 = *(const f32x4*)(g1 + c), g4 = *(const f32x4*)(g1 + c + 4);
                    const f32x4 o0 = hf4((u32x2){xw.x, xw.y}) + g0 * acc[ai][bj][m][0], o1 = hf4((u32x2){xw.z, xw.w}) + g4 * acc[ai][bj][m][1];
                    u32x4 w; w.x = hpk2(o0.x, o0.y); w.y = hpk2(o0.z, o0.w); w.z = hpk2(o1.x, o1.y); w.w = hpk2(o1.z, o1.w);
                    *(u32x4*)xp = w;
                }
            }
    }
};

struct Epi8Moe1 { static constexpr bool PERM = true, AFTER_DRAIN = false;
    bf16_t* HG;
    DEVI void operator()(const f32x4 (&acc)[2][2][4][2], const pg8::Unit& u, int wr, int wc, int fr, int fq) const {
        const int t = u.pn & 15;
#pragma unroll
        for (int ai = 0; ai < 2; ++ai)
#pragma unroll
            for (int m = 0; m < 4; ++m) {
                const size_t row = (size_t)u.pm * 256 + ai * 128 + wr * 64 + m * 16 + fr;
                float o[8];
#pragma unroll
                for (int n = 0; n < 2; ++n)
#pragma unroll
                    for (int j = 0; j < 4; ++j) { const float a1 = acc[ai][0][m][n][j], a3 = acc[ai][1][m][n][j]; o[4 * n + j] = a1 * sigmoidf_(a1) * a3; }
                u32x4 w; w.x = pk2(o[0], o[1]); w.y = pk2(o[2], o[3]); w.z = pk2(o[4], o[5]); w.w = pk2(o[6], o[7]);
                *(u32x4*)(HG + row * FF + t * 128 + wc * 32 + 8 * fq) = w;
            }
    }
};

struct Epi8Moe2 { static constexpr bool PERM = true, AFTER_DRAIN = false;
    bf16_t* OG; const float* gate;
    DEVI void operator()(const f32x4 (&acc)[2][2][4][2], const pg8::Unit& u, int wr, int wc, int fr, int fq) const {
        const int t = u.pn & 3;
#pragma unroll
        for (int ai = 0; ai < 2; ++ai)
#pragma unroll
            for (int m = 0; m < 4; ++m) {
                const size_t row = (size_t)u.pm * 256 + ai * 128 + wr * 64 + m * 16 + fr; const float gt = gate[row];
#pragma unroll
                for (int bj = 0; bj < 2; ++bj) {
                    const f32x4 a = acc[ai][bj][m][0] * gt, c = acc[ai][bj][m][1] * gt;
                    u32x4 w; w.x = pk2(a.x, a.y); w.y = pk2(a.z, a.w); w.z = pk2(c.x, c.y); w.w = pk2(c.z, c.w);
                    *(u32x4*)(OG + row * 1024 + t * 256 + bj * 128 + wc * 32 + 8 * fq) = w;
                }
            }
    }
};

struct Epi8S1 { static constexpr bool PERM = true, AFTER_DRAIN = false;
    unsigned short* E;
    DEVI void operator()(const f32x4 (&acc)[2][2][4][2], const pg8::Unit& u, int wr, int wc, int fr, int fq) const {
        const int g = u.pn, r0 = (u.pm - g * 9) * 256 + wr * 64 + fr;
#pragma unroll
        for (int ai = 0; ai < 2; ++ai)
#pragma unroll
            for (int m = 0; m < 4; ++m) {
                const int cr = r0 + ai * 128 + m * 16;
                if (cr < NCH) {
                    unsigned short* dst = E + ((size_t)g * NCHP + cr) * 256 + wc * 32 + 8 * fq;
#pragma unroll
                    for (int bj = 0; bj < 2; ++bj) {
                        const f32x4 a = acc[ai][bj][m][0], d = acc[ai][bj][m][1];
                        u32x4 w; w.x = hpk2(a.x, a.y); w.y = hpk2(a.z, a.w); w.z = hpk2(d.x, d.y); w.w = hpk2(d.z, d.w);
                        *(u32x4*)(dst + bj * 128) = w;
                    }
                }
            }
    }
};
struct Epi8S2 { static constexpr bool PERM = true, AFTER_DRAIN = false;
    bf16_t* YG;
    DEVI void operator()(const f32x4 (&acc)[2][2][4][2], const pg8::Unit& u, int wr, int wc, int fr, int fq) const {
        const int g = u.pn, r0 = (u.pm - g * 9) * 256 + wr * 64 + fr;
#pragma unroll
        for (int ai = 0; ai < 2; ++ai)
#pragma unroll
            for (int m = 0; m < 4; ++m) {
                const int cr = r0 + ai * 128 + m * 16;
                if (cr < NCH) {
                    const size_t tok0 = (size_t)chunk_row_token(cr);
#pragma unroll
                    for (int bj = 0; bj < 2; ++bj) {
                        const int col = bj * 128 + wc * 32 + 8 * fq, j = col >> 4, h = col & 15;
                        const f32x4 a = acc[ai][bj][m][0], d = acc[ai][bj][m][1];
                        u32x4 w; w.x = pk2(gelu_tanh(a.x), gelu_tanh(a.y)); w.y = pk2(gelu_tanh(a.z), gelu_tanh(a.w)); w.z = pk2(gelu_tanh(d.x), gelu_tanh(d.y)); w.w = pk2(gelu_tanh(d.z), gelu_tanh(d.w));
                        *(u32x4*)(YG + (tok0 + j) * 512 + g * 16 + h) = w;
                    }
                }
            }
    }
};
struct Epi8Glu { static constexpr bool PERM = true, AFTER_DRAIN = false;
    const bf16_t* YG; bf16_t* MIX; const float* bglu;
    DEVI void operator()(const f32x4 (&acc)[2][2][4][2], const pg8::Unit& u, int wr, int wc, int fr, int fq) const {
#pragma unroll
        for (int ai = 0; ai < 2; ++ai)
#pragma unroll
            for (int m = 0; m < 4; ++m) {
                const size_t tok = (size_t)u.pm * 256 + ai * 128 + wr * 64 + m * 16 + fr;
#pragma unroll
                for (int bj = 0; bj < 2; ++bj) {
                    const int n0 = u.pn * 256 + bj * 128 + wc * 32 + 8 * fq;
                    const u32x4 y = *(const u32x4*)(YG + tok * 512 + n0);
                    const f32x4 b0 = *(const f32x4*)(bglu + n0), b1 = *(const f32x4*)(bglu + n0 + 4);
                    const f32x4 a = acc[ai][bj][m][0] + b0, d = acc[ai][bj][m][1] + b1;
                    u32x4 w; w.x = pk2(bflo(y.x) * sigmoidf_(a.x), bfhi(y.x) * sigmoidf_(a.y)); w.y = pk2(bflo(y.y) * sigmoidf_(a.z), bfhi(y.y) * sigmoidf_(a.w));
                    w.z = pk2(bflo(y.z) * sigmoidf_(d.x), bfhi(y.z) * sigmoidf_(d.y)); w.w = pk2(bflo(y.w) * sigmoidf_(d.z), bfhi(y.w) * sigmoidf_(d.w));
                    *(u32x4*)(MIX + tok * 1024 + 512 + n0) = w;
                }
            }
    }
};

struct Params {
    const float* in[30];
    float* out;
    unsigned char* ws;
    int lo, hi;
};

DEVI int swz(int row, int kc) { return row * 128 + ((kc ^ ((row >> 1) & 7)) << 4); }

struct APlain { const bf16_t* A; int lda; DEVI const bf16_t* ptr(int row, int k) const { return A + (size_t)row * lda + k; } };
struct AS2 { const bf16_t* U; const bf16_t* S; DEVI const bf16_t* ptr(int row, int k) const { return (k < 256 ? U : S) + (size_t)row * 8192 + (k & 255); } };

template <int BM, class AF, class Epi>
DEVI void gemm_unit(char* lds, const AF& af, const bf16_t* __restrict__ Bt, int ldb, int K, int m0, int n0, const Epi& epi) {
    constexpr int MT = BM / 128, ACH = BM / 64, A_BYTES = BM * 128, STAGE = A_BYTES + 16384, WM = BM / 4;
    const int tid = tid_l(), lane = tid & 63, wid = tid >> 6, wm = wid >> 1, wn = wid & 1, r32 = lane & 31, hi = lane >> 5;
    f32x16 acc[MT][2];
#pragma unroll
    for (int a = 0; a < MT; ++a)
#pragma unroll
        for (int b = 0; b < 2; ++b)
#pragma unroll
            for (int i = 0; i < 16; ++i) acc[a][b][i] = 0.f;
    u32x4 ra[ACH], rb[2];
    const int nk = K >> 6;
    const int crow = tid >> 3, ckc = tid & 7;
#define G_LOAD(kt) do { \
        _Pragma("unroll") for (int i = 0; i < ACH; ++i) ra[i] = *(const u32x4*)af.ptr(m0 + crow + 64 * i, (kt) * 64 + ckc * 8); \
        _Pragma("unroll") for (int i = 0; i < 2; ++i) rb[i] = *(const u32x4*)(Bt + (size_t)(n0 + crow + 64 * i) * ldb + (kt) * 64 + ckc * 8); } while (0)
#define G_STORE(s) do { char* _a = lds + (s) * STAGE; char* _b = _a + A_BYTES; \
        _Pragma("unroll") for (int i = 0; i < ACH; ++i) *(u32x4*)(_a + swz(crow + 64 * i, ckc)) = ra[i]; \
        _Pragma("unroll") for (int i = 0; i < 2; ++i) *(u32x4*)(_b + swz(crow + 64 * i, ckc)) = rb[i]; } while (0)
    G_LOAD(0); G_STORE(0); __syncthreads();
    for (int kt = 0; kt < nk; ++kt) {
        if (kt + 1 < nk) G_LOAD(kt + 1);
        const char* a = lds + (kt & 1) * STAGE; const char* b = a + A_BYTES;
#pragma unroll
        for (int ks = 0; ks < 4; ++ks) {
            bf16x8 wf[2], xf[MT];
#pragma unroll
            for (int nt = 0; nt < 2; ++nt) wf[nt] = *(const bf16x8*)(b + swz(wn * 64 + nt * 32 + r32, ks * 2 + hi));
#pragma unroll
            for (int mt = 0; mt < MT; ++mt) xf[mt] = *(const bf16x8*)(a + swz(wm * WM + mt * 32 + r32, ks * 2 + hi));
#pragma unroll
            for (int mt = 0; mt < MT; ++mt)
#pragma unroll
                for (int nt = 0; nt < 2; ++nt) acc[mt][nt] = MFMA32(wf[nt], xf[mt], acc[mt][nt]);
        }
        if (kt + 1 < nk) G_STORE((kt + 1) & 1);
        __syncthreads();
    }
#undef G_LOAD
#undef G_STORE
    epi.template run<MT>(acc, m0 + wm * WM + r32, n0 + wn * 64, hi);
}

template <class AF, class Epi>
DEVI void gemm_unit_dma(char* lds, const AF& af, const bf16_t* __restrict__ Bt, int ldb, int K, int m0, int n0, const Epi& epi) {
    const int tid = tid_l(), lane = tid & 63, wid = tid >> 6, wm = wid >> 1, wn = wid & 1, r32 = lane & 31, hi = lane >> 5;
    f32x16 acc[1][2];
#pragma unroll
    for (int b = 0; b < 2; ++b)
#pragma unroll
        for (int i = 0; i < 16; ++i) acc[0][b][i] = 0.f;
    const int nk = K >> 6;
    const int drow0 = wid * 16 + (lane >> 3), drow1 = drow0 + 8;
    const int kc0 = (lane & 7) ^ ((drow0 >> 1) & 7), kc1 = (lane & 7) ^ ((drow1 >> 1) & 7);
    const bf16_t* ga0 = af.ptr(m0 + drow0, kc0 * 8); const bf16_t* ga1 = af.ptr(m0 + drow1, kc1 * 8);
    const bf16_t* gb0 = Bt + (size_t)(n0 + drow0) * ldb + kc0 * 8; const bf16_t* gb1 = Bt + (size_t)(n0 + drow1) * ldb + kc1 * 8;
    LAS unsigned char* dl = (LAS unsigned char*)lds + wid * 2048;
#define GD_LDS(g, off) __builtin_amdgcn_global_load_lds((const unsigned*)(g), (LAS unsigned*)(dl + (off)), 16, 0, 0)
#define GD_ISSUE(kt) do { const int _s = ((kt) & 3) * 32768; GD_LDS(ga0 + (kt) * 64, _s); GD_LDS(ga1 + (kt) * 64, _s + 1024); GD_LDS(gb0 + (kt) * 64, _s + 16384); GD_LDS(gb1 + (kt) * 64, _s + 16384 + 1024); } while (0)
#define GD_WAITBAR(N) asm volatile("s_waitcnt vmcnt(" #N ") lgkmcnt(0)\n\ts_barrier" ::: "memory")
    GD_ISSUE(0); GD_ISSUE(1); GD_ISSUE(2);
    for (int kt = 0; kt < nk; ++kt) {
        if (kt + 2 < nk) GD_WAITBAR(8); else if (kt + 1 < nk) GD_WAITBAR(4); else GD_WAITBAR(0);
        if (kt + 3 < nk) GD_ISSUE(kt + 3);
        const char* a = lds + (kt & 3) * 32768; const char* b = a + 16384;
#pragma unroll
        for (int ks = 0; ks < 4; ++ks) {
            bf16x8 wf[2], xf;
#pragma unroll
            for (int nt = 0; nt < 2; ++nt) wf[nt] = *(const bf16x8*)(b + swz(wn * 64 + nt * 32 + r32, ks * 2 + hi));
            xf = *(const bf16x8*)(a + swz(wm * 32 + r32, ks * 2 + hi));
#pragma unroll
            for (int nt = 0; nt < 2; ++nt) acc[0][nt] = MFMA32(wf[nt], xf, acc[0][nt]);
        }
    }
#undef GD_LDS
#undef GD_ISSUE
#undef GD_WAITBAR
    __syncthreads();
    epi.template run<1>(acc, m0 + wm * 32 + r32, n0 + wn * 64, hi);
}


struct EpiInproj {
    bf16_t* QK; bf16_t* VT; bf16_t* UG; const float* rope;
    template <int MT> DEVI void run(const f32x16 (&acc)[MT][2], int mrow0, int ncol0, int hi) const {
#pragma unroll
        for (int mt = 0; mt < MT; ++mt) {
            const int r = mrow0 + mt * 32, b = r / LP, p = r - b * LP; const bool latent = p >= CTXL; const int t = p - CTXL;
#pragma unroll
            for (int nt = 0; nt < 2; ++nt) {
                const int nb = ncol0 + nt * 32; const f32x16& v = acc[mt][nt];
                if (nb < 1024) {
                    const int which = nb >> 8, head = (nb >> 6) & 3, dbase = nb & 63;
                    const int pos = dbase == 0 ? (t >> 6) : (t & 63);
                    bf16_t* dst = QK + ((size_t)((which * NB + b) * NH + head) * LP + p) * 64 + dbase + 4 * hi;
                    const float sc = which < 2 ? QSCALE : 1.f;
#pragma unroll
                    for (int i4 = 0; i4 < 4; ++i4) {
                        float o[4];
#pragma unroll
                        for (int j = 0; j < 4; ++j) {
                            float x = v[4 * i4 + j];
                            if (latent) {
                                const float y = v[4 * (i4 ^ 2) + j];
                                const f32x2 cs = *(const f32x2*)(rope + (pos * 16 + 8 * (i4 & 1) + 4 * hi + j) * 2);
                                x = (i4 < 2) ? (x * cs.x - y * cs.y) : (x * cs.x + y * cs.y);
                            }
                            o[j] = x * sc;
                        }
                        u32x2 w; w.x = pk2(o[0], o[1]); w.y = pk2(o[2], o[3]);
                        *(u32x2*)(dst + 8 * i4) = w;
                    }
                } else if (nb < 1536) {
                    const int n1 = nb - 1024, head = n1 >> 7, dv0 = n1 & 127;
                    const int pp = (p & ~15) | perm16(p & 15);
                    bf16_t* dst = VT + ((size_t)(b * NH + head) * 128 + dv0 + 4 * hi) * LP + pp;
#pragma unroll
                    for (int i = 0; i < 16; ++i) dst[(size_t)((i & 3) + 8 * (i >> 2)) * LP] = f2bf(v[i]);
                } else {
                    const int n1 = nb - 1536;
                    bf16_t* dst = UG + (size_t)chunk_row(b, p >> 4) * 512 + (p & 15) * 16;
#pragma unroll
                    for (int i4 = 0; i4 < 4; ++i4) {
                        const int ch = n1 + 8 * i4 + 4 * hi, g = ch >> 4, hc = ch & 15;
                        u32x2 w; w.x = pk2(v[4 * i4], v[4 * i4 + 1]); w.y = pk2(v[4 * i4 + 2], v[4 * i4 + 3]);
                        *(u32x2*)(dst + (size_t)g * NCHP * 512 + hc) = w;
                    }
                }
            }
        }
    }
};

struct EpiS1 {
    unsigned short* E;
    template <int MT> DEVI void run(const f32x16 (&acc)[MT][2], int mrow0, int ncol0, int hi) const {
#pragma unroll
        for (int mt = 0; mt < MT; ++mt) {
            unsigned short* dst = E + (size_t)(mrow0 + mt * 32) * 256 + ncol0 + 4 * hi;
#pragma unroll
            for (int nt = 0; nt < 2; ++nt)
#pragma unroll
                for (int i4 = 0; i4 < 4; ++i4) {
                    u32x2 w; w.x = hpk2(acc[mt][nt][4 * i4], acc[mt][nt][4 * i4 + 1]); w.y = hpk2(acc[mt][nt][4 * i4 + 2], acc[mt][nt][4 * i4 + 3]);
                    *(u32x2*)(dst + nt * 32 + 8 * i4) = w;
                }
        }
    }
};

struct EpiS2 {
    bf16_t* YG; int g;
    template <int MT> DEVI void run(const f32x16 (&acc)[MT][2], int mrow0, int ncol0, int hi) const {
#pragma unroll
        for (int mt = 0; mt < MT; ++mt) {
            const size_t tok0 = (size_t)chunk_row_token(mrow0 + mt * 32);
#pragma unroll
            for (int nt = 0; nt < 2; ++nt)
#pragma unroll
                for (int i4 = 0; i4 < 4; ++i4) {
                    const int n = ncol0 + nt * 32 + 8 * i4 + 4 * hi, j = n >> 4, h = n & 15;
                    u32x2 w; w.x = pk2(gelu_tanh(acc[mt][nt][4 * i4]), gelu_tanh(acc[mt][nt][4 * i4 + 1]));
                    w.y = pk2(gelu_tanh(acc[mt][nt][4 * i4 + 2]), gelu_tanh(acc[mt][nt][4 * i4 + 3]));
                    *(u32x2*)(YG + (tok0 + j) * 512 + g * 16 + h) = w;
                }
        }
    }
};

struct EpiGlu {
    const bf16_t* YG; bf16_t* MIX; const float* bglu;
    template <int MT> DEVI void run(const f32x16 (&acc)[MT][2], int mrow0, int ncol0, int hi) const {
#pragma unroll
        for (int mt = 0; mt < MT; ++mt) {
            const size_t tok = mrow0 + mt * 32;
#pragma unroll
            for (int nt = 0; nt < 2; ++nt)
#pragma unroll
                for (int i4 = 0; i4 < 4; ++i4) {
                    const int n = ncol0 + nt * 32 + 8 * i4 + 4 * hi;
                    const u32x2 y = *(const u32x2*)(YG + tok * 512 + n);
                    const f32x4 bb = *(const f32x4*)(bglu + n);
                    const float o0 = bflo(y.x) * sigmoidf_(acc[mt][nt][4 * i4] + bb.x), o1 = bfhi(y.x) * sigmoidf_(acc[mt][nt][4 * i4 + 1] + bb.y);
                    const float o2 = bflo(y.y) * sigmoidf_(acc[mt][nt][4 * i4 + 2] + bb.z), o3 = bfhi(y.y) * sigmoidf_(acc[mt][nt][4 * i4 + 3] + bb.w);
                    u32x2 w; w.x = pk2(o0, o1); w.y = pk2(o2, o3);
                    *(u32x2*)(MIX + tok * 1024 + 512 + n) = w;
                }
        }
    }
};

struct EpiOut {
    bf16_t* X; const float* mod;
    template <int MT> DEVI void run(const f32x16 (&acc)[MT][2], int mrow0, int ncol0, int hi) const {
#pragma unroll
        for (int mt = 0; mt < MT; ++mt) {
            const int r = mrow0 + mt * 32, b = r / LP, p = r - b * LP, j = p < CTXL ? 8 : b;
            const float* g1 = mod + (size_t)j * 6144 + 2 * 1024;
#pragma unroll
            for (int nt = 0; nt < 2; ++nt)
#pragma unroll
                for (int i4 = 0; i4 < 4; ++i4) {
                    const int n = ncol0 + nt * 32 + 8 * i4 + 4 * hi;
                    bf16_t* xp = X + (size_t)r * 1024 + n;
                    f32x4 x = hf4(*(const u32x2*)xp); const f32x4 g = *(const f32x4*)(g1 + n);
                    x.x += g.x * acc[mt][nt][4 * i4]; x.y += g.y * acc[mt][nt][4 * i4 + 1]; x.z += g.z * acc[mt][nt][4 * i4 + 2]; x.w += g.w * acc[mt][nt][4 * i4 + 3];
                    u32x2 w; w.x = hpk2(x.x, x.y); w.y = hpk2(x.z, x.w);
                    *(u32x2*)xp = w;
                }
        }
    }
};

struct EpiMoe1 {
    bf16_t* HG;
    template <int MT> DEVI void run(const f32x16 (&acc)[MT][2], int mrow0, int ncol0, int hi) const {
#pragma unroll
        for (int mt = 0; mt < MT; ++mt) {
            bf16_t* dst = HG + (size_t)(mrow0 + mt * 32) * FF + (ncol0 >> 1) + 4 * hi;
#pragma unroll
            for (int i4 = 0; i4 < 4; ++i4) {
                float o[4];
#pragma unroll
                for (int j = 0; j < 4; ++j) { const float a1 = acc[mt][0][4 * i4 + j], a3 = acc[mt][1][4 * i4 + j]; o[j] = a1 * sigmoidf_(a1) * a3; }
                u32x2 w; w.x = pk2(o[0], o[1]); w.y = pk2(o[2], o[3]);
                *(u32x2*)(dst + 8 * i4) = w;
            }
        }
    }
};

struct EpiMoe2 {
    bf16_t* OG; const float* gate;
    template <int MT> DEVI void run(const f32x16 (&acc)[MT][2], int mrow0, int ncol0, int hi) const {
#pragma unroll
        for (int mt = 0; mt < MT; ++mt) {
            const int row = mrow0 + mt * 32; const float gt = gate[row];
            bf16_t* dst = OG + (size_t)row * 1024 + ncol0 + 4 * hi;
#pragma unroll
            for (int nt = 0; nt < 2; ++nt)
#pragma unroll
                for (int i4 = 0; i4 < 4; ++i4) {
                    u32x2 w; w.x = pk2(acc[mt][nt][4 * i4] * gt, acc[mt][nt][4 * i4 + 1] * gt); w.y = pk2(acc[mt][nt][4 * i4 + 2] * gt, acc[mt][nt][4 * i4 + 3] * gt);
                    *(u32x2*)(dst + nt * 32 + 8 * i4) = w;
                }
        }
    }
};

DEVI void transpose_unit(char* lds, const float* __restrict__ W, int K, int N, bf16_t* __restrict__ out, int k0, int n0, int mode  ) {
    float* tile = (float*)lds;
    const int tid = tid_l();
    f32x4 v[8];
#pragma unroll
    for (int i = 0; i < 8; ++i) { const int c = tid + 512 * i, k = c >> 6, n4 = (c & 63) * 4; v[i] = *(const f32x4*)(W + (size_t)(k0 + k) * N + n0 + n4); }
#pragma unroll
    for (int i = 0; i < 8; ++i) { const int c = tid + 512 * i, k = c >> 6, n4 = (c & 63) * 4; float* t = tile + k * 257 + n4; t[0] = v[i].x; t[1] = v[i].y; t[2] = v[i].z; t[3] = v[i].w; }
    __syncthreads();
#pragma unroll
    for (int i = 0; i < 4; ++i) {
        const int c = tid + 512 * i, n = c >> 3, k8 = (c & 7) * 8;
        float f[8];
#pragma unroll
        for (int j = 0; j < 8; ++j) f[j] = tile[(k8 + j) * 257 + n];
        u32x4 w; w.x = pk2(f[0], f[1]); w.y = pk2(f[2], f[3]); w.z = pk2(f[4], f[5]); w.w = pk2(f[6], f[7]);
        const int ng = n0 + n; const int orow = mode == 0 ? ng : ((ng >> 7) * 256 + (mode - 1) * 128 + (ng & 127));
        *(u32x4*)(out + (size_t)orow * K + k0 + k8) = w;
    }
    __syncthreads();
}

DEVI void adaln_unit(char* lds, const Params& P, int l, int n0) {
    float* sc = (float*)lds;
    float* red = sc + 9 * 1024;
    const int tid = tid_l(), lane = tid & 63, wid = tid >> 6;
    for (int i = tid; i < 9 * 1024; i += 512) { const float c = i < 8192 ? P.in[1][i] : P.in[3][i - 8192]; sc[i] = c / (1.f + __expf(-c)); }
    __syncthreads();
    const float* W = P.in[4] + (size_t)l * 1024 * 6144 + n0 + lane;
    float a[9];
#pragma unroll
    for (int j = 0; j < 9; ++j) a[j] = 0.f;
    for (int kk = 0; kk < 128; kk += 16) {
        float w[16];
#pragma unroll
        for (int u = 0; u < 16; ++u) w[u] = W[(size_t)(wid * 128 + kk + u) * 6144];
#pragma unroll
        for (int u = 0; u < 16; ++u)
#pragma unroll
            for (int j = 0; j < 9; ++j) a[j] += sc[j * 1024 + wid * 128 + kk + u] * w[u];
    }
#pragma unroll
    for (int j = 0; j < 9; ++j) red[(wid * 9 + j) * 64 + lane] = a[j];
    __syncthreads();
    for (int i = tid; i < 9 * 64; i += 512) {
        const int j = i >> 6, n = i & 63; float s = 0.f;
#pragma unroll
        for (int w = 0; w < 8; ++w) s += red[(w * 9 + j) * 64 + n];
        ((float*)(ptr_l(P.ws) + WS_MOD))[((size_t)l * 9 + j) * 6144 + n0 + n] = s + P.in[5][(size_t)l * 6144 + n0 + n];
    }
    __syncthreads();
}

DEVI void ssm_tab_unit(char* lds, const Params& P, int l, int d, int g) {
    float* pw = (float*)lds;
    float* bb = pw + 64 * 17 * 2;
    float* cc = bb + 64 * 16 * 2;
    const int tid = tid_l();
    const size_t ldg = ((size_t)l * 2 + d) * 32 + g;
    const float dt = expf(P.in[16][ldg]);
    float* PW = (float*)(ptr_l(P.ws) + WS_PW) + ldg * 64 * 17 * 2;
    float* BB = (float*)(ptr_l(P.ws) + WS_BBAR) + ldg * 64 * 16 * 2;
    for (int i = tid; i < 64 * 17; i += 512) {
        const int p = i / 17, n = i - p * 17;
        const float lr = P.in[14][ldg * 64 + p], li = P.in[15][ldg * 64 + p];
        const float mag = expf(lr * dt * n); float s, c; sincosf(li * dt * n, &s, &c);
        pw[i * 2] = mag * c; pw[i * 2 + 1] = mag * s; PW[i * 2] = mag * c; PW[i * 2 + 1] = mag * s;
    }
    for (int i = tid; i < 64 * 16; i += 512) {
        const int p = i >> 4, h = i & 15;
        const float lr = P.in[14][ldg * 64 + p], li = P.in[15][ldg * 64 + p];
        const float mag = expf(lr * dt); float s, c; sincosf(li * dt, &s, &c);
        const float nr = mag * c - 1.f, ni = mag * s;
        const float den = lr * lr + li * li;
        const float qr = (nr * lr + ni * li) / den, qi = (ni * lr - nr * li) / den;
        const float br = P.in[17][(ldg * 64 + p) * 16 + h], bi = P.in[18][(ldg * 64 + p) * 16 + h];
        const float xr = qr * br - qi * bi, xi = qr * bi + qi * br;
        bb[i * 2] = xr; bb[i * 2 + 1] = xi; BB[i * 2] = xr; BB[i * 2 + 1] = xi;
    }
    for (int i = tid; i < 16 * 64; i += 512) { cc[i * 2] = P.in[19][ldg * 1024 + i]; cc[i * 2 + 1] = P.in[20][ldg * 1024 + i]; }
    __syncthreads();
    float* KT = (float*)(ptr_l(P.ws) + WS_KTAB) + ldg * 4096;
    for (int i = tid; i < 4096; i += 512) {
        const int dl = i >> 8, h = (i >> 4) & 15, h2 = i & 15;
        float s = 0.f;
        for (int p = 0; p < 64; ++p) {
            const float cr = cc[(h * 64 + p) * 2], ci = cc[(h * 64 + p) * 2 + 1];
            const float wr = pw[(p * 17 + dl) * 2], wi = pw[(p * 17 + dl) * 2 + 1];
            const float br = bb[(p * 16 + h2) * 2], bi = bb[(p * 16 + h2) * 2 + 1];
            const float tr = cr * wr - ci * wi, ti = cr * wi + ci * wr;
            s += tr * br - ti * bi;
        }
        KT[i] = s;
    }
    __syncthreads();
}

template <bool FIRST>
DEVI void rowpass1(const Params& P, int l) {
    const int tid = tid_l(), lane = tid & 63, wid = tid >> 6;
    bf16_t* X = (bf16_t*)(ptr_l(P.ws) + WS_X); bf16_t* HX = (bf16_t*)(ptr_l(P.ws) + WS_HX);
    const bf16_t* OG = (const bf16_t*)(ptr_l(P.ws) + WS_OG); const int* SLOT = (const int*)(ptr_l(P.ws) + WS_SLOT);
    const float* MOD = (const float*)(ptr_l(P.ws) + WS_MOD);
    const int stride = gridDim.x * 8;
    int r = blockIdx.x * 8 + wid;
    f32x4 xf[4]; u32x2 xb[4]; int svn = -1;
    auto issue = [&](int rr) {
        if constexpr (FIRST) {
            const int b = rr / LP, p = rr - b * LP;
            const float* src = p < CTXL ? P.in[2] + ((size_t)b * CTXL + p) * 1024 : P.in[0] + ((size_t)b * SEQ + (p - CTXL)) * 1024;
#pragma unroll
            for (int i = 0; i < 4; ++i) xf[i] = *(const f32x4*)(src + lane * 4 + 256 * i);
        } else {
#pragma unroll
            for (int i = 0; i < 4; ++i) xb[i] = *(const u32x2*)(X + (size_t)rr * 1024 + lane * 4 + 256 * i);
            svn = SLOT[(size_t)rr * 16 + (lane & 15)];
        }
    };
    if (r < R) issue(r);
    for (; r < R; r += stride) {
        const int b = r / LP, p = r - b * LP, j = p < CTXL ? 8 : b;
        f32x4 x[4]; const int sv = svn;
#pragma unroll
        for (int i = 0; i < 4; ++i) { if constexpr (FIRST) x[i] = xf[i]; else x[i] = hf4(xb[i]); }
        if (r + stride < R) issue(r + stride);
        if (l == DEPTH && p < CTXL) continue;
        if constexpr (!FIRST) {
            const float* g2 = MOD + ((size_t)(l - 1) * 9 + j) * 6144 + 5 * 1024;
            f32x4 m[4];
#pragma unroll
            for (int i = 0; i < 4; ++i) m[i] = (f32x4){0.f, 0.f, 0.f, 0.f};
            unsigned mask = (unsigned)__ballot(sv >= 0 && lane < 16) & 0xffffu;
            while (mask) {
                const int e0 = __builtin_ctz(mask); mask &= mask - 1;
                const int s0 = __builtin_amdgcn_readlane(sv, e0);
                const bool two = mask != 0u;
                const int e1 = two ? __builtin_ctz(mask) : e0; if (two) mask &= mask - 1;
                const int s1 = __builtin_amdgcn_readlane(sv, e1);
                const bf16_t* o0 = OG + ((size_t)e0 * ROWS_E + s0) * 1024 + lane * 4; const bf16_t* o1 = OG + ((size_t)e1 * ROWS_E + s1) * 1024 + lane * 4;
                u32x2 w0[4], w1[4];
#pragma unroll
                for (int i = 0; i < 4; ++i) { w0[i] = *(const u32x2*)(o0 + 256 * i); w1[i] = *(const u32x2*)(o1 + 256 * i); }
                const float f1 = two ? 1.f : 0.f;
#pragma unroll
                for (int i = 0; i < 4; ++i) m[i] += bf4(w0[i]) + f1 * bf4(w1[i]);
            }
#pragma unroll
            for (int i = 0; i < 4; ++i) { const f32x4 g = *(const f32x4*)(g2 + lane * 4 + 256 * i); x[i] += g * m[i]; }
        }
        float ss = 0.f;
#pragma unroll
        for (int i = 0; i < 4; ++i) ss += x[i].x * x[i].x + x[i].y * x[i].y + x[i].z * x[i].z + x[i].w * x[i].w;
        ss = wave_sum(ss);
        const float rstd = rsqrtf(ss * (1.f / 1024.f) + EPS);
        if (l < DEPTH) {
            const float* ng = P.in[6] + (size_t)l * 1024; const float* sh = MOD + ((size_t)l * 9 + j) * 6144; const float* scl = sh + 1024;
#pragma unroll
            for (int i = 0; i < 4; ++i) {
                const int c = lane * 4 + 256 * i;
                u32x2 xw; xw.x = hpk2(x[i].x, x[i].y); xw.y = hpk2(x[i].z, x[i].w);
                *(u32x2*)(X + (size_t)r * 1024 + c) = xw;
                const f32x4 g = *(const f32x4*)(ng + c), s1 = *(const f32x4*)(scl + c), s0 = *(const f32x4*)(sh + c);
                const f32x4 h = (x[i] * rstd * g) * (1.f + s1) + s0;
                u32x2 w; w.x = pk2(h.x, h.y); w.y = pk2(h.z, h.w);
                *(u32x2*)(HX + (size_t)r * 1024 + c) = w;
            }
        } else {
            float* o = P.out + ((size_t)b * SEQ + (p - CTXL)) * 1024;
#pragma unroll
            for (int i = 0; i < 4; ++i) { const int c = lane * 4 + 256 * i; const f32x4 g = *(const f32x4*)(P.in[29] + c); *(f32x4*)(o + c) = x[i] * rstd * g; }
        }
    }
}

DEVI float router_fold_softmax(const float (&pa)[16], int lane) {
    float q8[8], q4[4], q2[2];
#pragma unroll
    for (int i = 0; i < 8; ++i) { float r0, r1; swap32(pa[i], pa[i + 8], r0, r1); q8[i] = r0 + r1; }
#pragma unroll
    for (int i = 0; i < 4; ++i) { float r0, r1; swap16(q8[i], q8[i + 4], r0, r1); q4[i] = r0 + r1; }
    { const bool hb = (lane & 8) != 0;
#pragma unroll
      for (int i = 0; i < 2; ++i) { const float snd = hb ? q4[i] : q4[i + 2], kp = hb ? q4[i + 2] : q4[i]; q2[i] = kp + dppmov<0x128>(snd); } }
    float lg;
    { const bool hb = (lane & 4) != 0; const float snd = hb ? q2[0] : q2[1], kp = hb ? q2[1] : q2[0];
      const float up = dppmov<0x104>(snd), dn = dppmov<0x114>(snd);
      lg = kp + (hb ? dn : up); }
    lg += dppmov<0x4E>(lg); lg += dppmov<0xB1>(lg);
    float mx = fmaxf(lg, dppmov<0x124>(lg)); mx = fmaxf(mx, dppmov<0x128>(mx));
    { float r0, r1; swap16(mx, mx, r0, r1); mx = fmaxf(r0, r1); swap32(mx, mx, r0, r1); mx = fmaxf(r0, r1); }
    const float ex = expf(lg - mx);
    float sum = ex + dppmov<0x124>(ex); sum += dppmov<0x128>(sum);
    { float r0, r1; swap16(sum, sum, r0, r1); sum = r0 + r1; swap32(sum, sum, r0, r1); sum = r0 + r1; }
    return ex / sum;
}
DEVI void rowpass2(char* lds, const Params& P, int l) {
    const int tid = tid_l(), lane = tid & 63, wid = tid >> 6;
    float* wrT = (float*)lds;
    const float* wr = P.in[25] + (size_t)l * 1024 * 16;
    for (int i = tid; i < 16384; i += 512) { const int k = i >> 4, e = i & 15; wrT[e * 1024 + k] = wr[i]; }
    __syncthreads();
    const bf16_t* X = (const bf16_t*)(ptr_l(P.ws) + WS_X); bf16_t* HX = (bf16_t*)(ptr_l(P.ws) + WS_HX);
    const float* MOD = (const float*)(ptr_l(P.ws) + WS_MOD); float* AFFT = (float*)(ptr_l(P.ws) + WS_AFFT);
    const float* ng = P.in[7] + (size_t)l * 1024;
    const int stride = gridDim.x * 8;
    int r = blockIdx.x * 8 + wid;
    u32x2 xn[2][4];
#pragma unroll
    for (int q = 0; q < 2; ++q) if (r + q * stride < R) {
#pragma unroll
        for (int i = 0; i < 4; ++i) xn[q][i] = *(const u32x2*)(X + (size_t)(r + q * stride) * 1024 + lane * 4 + 256 * i);
    }
    for (; r < R; r += 2 * stride) {
        const bool two = r + stride < R;
        f32x4 h[2][4]; int bb[2], pp[2];
#pragma unroll
        for (int q = 0; q < 2; ++q) {
            const int rq = (q == 0 || two) ? r + q * stride : r;
            const int b = rq / LP, p = rq - b * LP, j = p < CTXL ? 8 : b; bb[q] = b; pp[q] = p;
            float ss = 0.f;
#pragma unroll
            for (int i = 0; i < 4; ++i) { h[q][i] = hf4(xn[q][i]); ss += h[q][i].x * h[q][i].x + h[q][i].y * h[q][i].y + h[q][i].z * h[q][i].z + h[q][i].w * h[q][i].w; }
            ss = wave_sum(ss);
            const float rstd = rsqrtf(ss * (1.f / 1024.f) + EPS);
            const float* sh = MOD + ((size_t)l * 9 + j) * 6144 + 3 * 1024; const float* scl = sh + 1024;
#pragma unroll
            for (int i = 0; i < 4; ++i) {
                const int c = lane * 4 + 256 * i;
                const f32x4 g = *(const f32x4*)(ng + c), s1 = *(const f32x4*)(scl + c), s0 = *(const f32x4*)(sh + c);
                h[q][i] = (h[q][i] * rstd * g) * (1.f + s1) + s0;
                if (q == 0 || two) { u32x2 w; w.x = pk2(h[q][i].x, h[q][i].y); w.y = pk2(h[q][i].z, h[q][i].w); *(u32x2*)(HX + (size_t)rq * 1024 + c) = w; }
            }
        }
#pragma unroll
        for (int q = 0; q < 2; ++q) if (r + (2 + q) * stride < R) {
#pragma unroll
            for (int i = 0; i < 4; ++i) xn[q][i] = *(const u32x2*)(X + (size_t)(r + (2 + q) * stride) * 1024 + lane * 4 + 256 * i);
        }
        float pa[2][16];
#pragma unroll
        for (int eg = 0; eg < 4; ++eg) {
#pragma unroll
            for (int e = 4 * eg; e < 4 * eg + 4; ++e) {
                f32x2 s0 = {0.f, 0.f}, s1 = {0.f, 0.f};
#pragma unroll
                for (int i = 0; i < 4; ++i) { const f32x4 w = *(const f32x4*)(wrT + e * 1024 + lane * 4 + 256 * i);
                    const f32x2 wl = __builtin_shufflevector(w, w, 0, 1), wh = __builtin_shufflevector(w, w, 2, 3);
                    s0 = __builtin_elementwise_fma(__builtin_shufflevector(h[0][i], h[0][i], 0, 1), wl, s0); s0 = __builtin_elementwise_fma(__builtin_shufflevector(h[0][i], h[0][i], 2, 3), wh, s0);
                    s1 = __builtin_elementwise_fma(__builtin_shufflevector(h[1][i], h[1][i], 0, 1), wl, s1); s1 = __builtin_elementwise_fma(__builtin_shufflevector(h[1][i], h[1][i], 2, 3), wh, s1); }
                pa[0][e] = s0.x + s0.y; pa[1][e] = s1.x + s1.y;
            }
            asm volatile("" ::: "memory");
        }
        const float a0 = router_fold_softmax(pa[0], lane), a1 = router_fold_softmax(pa[1], lane);
        if ((lane & 3) == 0) {
            AFFT[((size_t)bb[0] * 16 + (lane >> 2)) * LP + pp[0]] = a0;
            if (two) AFFT[((size_t)bb[1] * 16 + (lane >> 2)) * LP + pp[1]] = a1;
        }
    }
    __syncthreads();
}

DEVI int block_sum_i(int v, volatile int* red, int par, int wid, int lane) {
    if (lane == 0) red[par * 8 + wid] = v;
    __syncthreads();
    int s = 0;
#pragma unroll
    for (int w = 0; w < 8; ++w) s += red[par * 8 + w];
    return s;
}
DEVI int wave_incl_scan_i(int v, int lane) {
#pragma unroll
    for (int o = 1; o < 64; o <<= 1) { const int t = __shfl_up(v, o); if (lane >= o) v += t; }
    return v;
}
DEVI void select_unit(char* lds, const Params& P, int b, int e, bool lat) {
    volatile int* red = (volatile int*)lds;
    volatile int* wtot = (volatile int*)(lds + 64);
    const int tid = tid_l(), lane = tid & 63, wid = tid >> 6;
    const int n = lat ? SEQ : CTXL, K = lat ? CAPL : CAPC, p0 = lat ? CTXL : 0;
    const bool act = 8 * tid < n;
    const float* src = (const float*)(ptr_l(P.ws) + WS_AFFT) + ((size_t)b * 16 + e) * LP + p0 + 8 * tid;
    unsigned bits[8];
    if (act) { const u32x4 v0 = *(const u32x4*)src, v1 = *(const u32x4*)(src + 4); bits[0] = v0.x; bits[1] = v0.y; bits[2] = v0.z; bits[3] = v0.w; bits[4] = v1.x; bits[5] = v1.y; bits[6] = v1.z; bits[7] = v1.w; }
    else {
#pragma unroll
        for (int j = 0; j < 8; ++j) bits[j] = 0u;
    }
    unsigned prefix = 0u; int par = 0;
    for (int bit = 30; bit >= 0; --bit) {
        const unsigned cand = prefix | (1u << bit);
        int c = 0;
#pragma unroll
        for (int j = 0; j < 8; ++j) c += (int)__popcll(__ballot(bits[j] >= cand));
        const int tot = block_sum_i(c, red, par, wid, lane); par ^= 1;
        if (tot >= K) prefix = cand;
    }
    int cg = 0, ceq = 0;
#pragma unroll
    for (int j = 0; j < 8; ++j) { cg += (int)__popcll(__ballot(bits[j] > prefix)); ceq += (bits[j] == prefix) ? 1 : 0; }
    const int need = K - block_sum_i(cg, red, par, wid, lane); par ^= 1;
    int inc = wave_incl_scan_i(ceq, lane);
    if (lane == 63) wtot[par * 8 + wid] = inc;
    __syncthreads();
    int eqb = inc - ceq;
    for (int w = 0; w < wid; ++w) eqb += wtot[par * 8 + w];
    par ^= 1;
    bool sel[8]; int ns = 0;
#pragma unroll
    for (int j = 0; j < 8; ++j) { const bool eq = bits[j] == prefix; sel[j] = (bits[j] > prefix) || (eq && eqb < need); eqb += eq ? 1 : 0; ns += sel[j] ? 1 : 0; }
    inc = wave_incl_scan_i(ns, lane);
    if (lane == 63) wtot[par * 8 + wid] = inc;
    __syncthreads();
    int sb = inc - ns;
    for (int w = 0; w < wid; ++w) sb += wtot[par * 8 + w];
    if (act) {
        int* SLOT = (int*)(ptr_l(P.ws) + WS_SLOT); float* GATE = (float*)(ptr_l(P.ws) + WS_GATE); int* IDX = (int*)(ptr_l(P.ws) + WS_IDX);
#pragma unroll
        for (int j = 0; j < 8; ++j) {
            const int tok = b * LP + p0 + 8 * tid + j;
            if (sel[j]) {
                const int row = (lat ? b * CAPL : NB * CAPL + b * CAPC) + sb; ++sb;
                SLOT[(size_t)tok * 16 + e] = row; GATE[(size_t)e * ROWS_E + row] = __builtin_bit_cast(float, bits[j]); IDX[(size_t)e * ROWS_E + row] = tok;
            } else SLOT[(size_t)tok * 16 + e] = -1;
        }
    }
    __syncthreads();
}
DEVI void gather_rows(const Params& P, bool last) {
    const int tid = tid_l(), lane = tid & 63, wid = tid >> 6;
    const bf16_t* HX = (const bf16_t*)(ptr_l(P.ws) + WS_HX); bf16_t* XG = (bf16_t*)(ptr_l(P.ws) + WS_XG); const int* IDX = (const int*)(ptr_l(P.ws) + WS_IDX);
    const int stride = gridDim.x * 8;
    for (int r0 = blockIdx.x * 8 + wid; r0 < 16 * ROWS_E; r0 += 4 * stride) {
        u32x4 v[4][2];
#pragma unroll
        for (int q = 0; q < 4; ++q) { const int r = r0 + q * stride; if (r < 16 * ROWS_E && !(last && (r % ROWS_E) >= NB * CAPL)) { const u32x4* s = (const u32x4*)(HX + (size_t)IDX[r] * 1024); v[q][0] = s[lane]; v[q][1] = s[lane + 64]; } }
#pragma unroll
        for (int q = 0; q < 4; ++q) { const int r = r0 + q * stride; if (r < 16 * ROWS_E && !(last && (r % ROWS_E) >= NB * CAPL)) { u32x4* d = (u32x4*)(XG + (size_t)r * 1024); d[lane] = v[q][0]; d[lane + 64] = v[q][1]; } }
    }
}

DEVI int scan_ci(int d, int k) { return d == 0 ? k : (k < 16 ? 15 - k : 287 - k); }
DEVI void scan_block(char* lds, const Params& P, int l, int unit0) {
    const int tid = tid_l(), lane = tid & 63, wid = tid >> 6, seg = wid & 3, unit = unit0 + (wid >> 2);
    const int d = unit & 1, g = (unit >> 1) & 31, b = unit >> 6;
    const size_t ldg = ((size_t)l * 2 + d) * 32 + g;
    const float dt = expf(P.in[16][ldg]);
    const float lr = P.in[14][ldg * 64 + lane], li = P.in[15][ldg * 64 + lane];
    const float mag = expf(lr * dt * 16.f); float sn, cs; sincosf(li * dt * 16.f, &sn, &cs);
    const float ar = mag * cs, ai = mag * sn;
    const unsigned short* E = (const unsigned short*)(ptr_l(P.ws) + WS_EB) + (size_t)g * NCHP * 256 + d * 128 + lane * 2;
    bf16_t* S = (bf16_t*)(ptr_l(P.ws) + WS_US) + (size_t)g * NCHP * 512 + 256 + d * 128 + lane * 2;
    f32x2* ends = (f32x2*)lds + (size_t)(wid >> 2) * 4 * 64;
    const int k0 = seg * 68;
    float sr = 0.f, si = 0.f;
    for (int kk = 0; kk < 68; kk += 17) {
        unsigned ev[17];
#pragma unroll
        for (int u = 0; u < 17; ++u) ev[u] = *(const unsigned*)(E + (size_t)chunk_row(b, scan_ci(d, k0 + kk + u)) * 256);
#pragma unroll
        for (int u = 0; u < 17; ++u) { const float nr = ar * sr - ai * si + hlo(ev[u]), ni = ar * si + ai * sr + hhi(ev[u]); sr = nr; si = ni; }
    }
    ends[seg * 64 + lane] = (f32x2){sr, si};
    float pr = ar, pi = ai, p4r = 0.f, p4i = 0.f;
#pragma unroll
    for (int q = 0; q < 6; ++q) { const float nr = pr * pr - pi * pi, ni = 2.f * pr * pi; pr = nr; pi = ni; if (q == 1) { p4r = pr; p4i = pi; } }
    const float br = pr * p4r - pi * p4i, bi = pr * p4i + pi * p4r;
    __syncthreads();
    sr = 0.f; si = 0.f;
    for (int j = 0; j < seg; ++j) { const f32x2 e = ends[j * 64 + lane]; const float nr = br * sr - bi * si + e.x, ni = br * si + bi * sr + e.y; sr = nr; si = ni; }
    for (int kk = 0; kk < 68; kk += 17) {
        unsigned ev[17];
#pragma unroll
        for (int u = 0; u < 17; ++u) ev[u] = *(const unsigned*)(E + (size_t)chunk_row(b, scan_ci(d, k0 + kk + u)) * 256);
#pragma unroll
        for (int u = 0; u < 17; ++u) {
            *(unsigned*)(S + (size_t)chunk_row(b, scan_ci(d, k0 + kk + u)) * 512) = pk2(sr, si);
            const float nr = ar * sr - ai * si + hlo(ev[u]), ni = ar * si + ai * sr + hhi(ev[u]); sr = nr; si = ni;
        }
    }
    __syncthreads();
}

DEVI float max3f(float a, float b, float c) { return fmaxf(fmaxf(a, b), c); }
DEVI float xhalf_max(float x) { const unsigned u = __builtin_bit_cast(unsigned, x); const auto r = __builtin_amdgcn_permlane32_swap(u, u, false, false); return fmaxf(__builtin_bit_cast(float, (unsigned)r[0]), __builtin_bit_cast(float, (unsigned)r[1])); }
DEVI float xhalf_sum(float x) { const unsigned u = __builtin_bit_cast(unsigned, x); const auto r = __builtin_amdgcn_permlane32_swap(u, u, false, false); return __builtin_bit_cast(float, (unsigned)r[0]) + __builtin_bit_cast(float, (unsigned)r[1]); }
DEVI void attn_unit(char* lds, const Params& P, int l, int b, int head, int q0  , int nkeys, float lam, float lam_init) {
    const int tid = tid_l(), lane = tid & 63, wid = tid >> 6, qg = wid >> 1, which = wid & 1, r32 = lane & 31, hi = lane >> 5;
    const bf16_t* QK = (const bf16_t*)(ptr_l(P.ws) + WS_QK);
    const bf16_t* Qs = QK + ((size_t)((which * NB + b) * NH + head) * LP) * 64;
    const bf16_t* K1 = QK + ((size_t)((2 * NB + b) * NH + head) * LP) * 64;
    const bf16_t* K2 = QK + ((size_t)((3 * NB + b) * NH + head) * LP) * 64;
    const bf16_t* Vt = (const bf16_t*)(ptr_l(P.ws) + WS_VT) + (size_t)(b * NH + head) * 128 * LP;
    bf16x8 qf[4];
#pragma unroll
    for (int ks = 0; ks < 4; ++ks) qf[ks] = *(const bf16x8*)(Qs + (size_t)(q0 + qg * 32 + r32) * 64 + ks * 16 + hi * 8);
    f32x16 o[4];
#pragma unroll
    for (int t = 0; t < 4; ++t)
#pragma unroll
        for (int i = 0; i < 16; ++i) o[t][i] = 0.f;
    float m = 0.f, lsum = 0.f;
    const int nt = nkeys >> 6;
    const int drow = wid * 8 + (lane >> 3), dkc = (lane & 7) ^ ((drow >> 1) & 7);
    const unsigned koff = (unsigned)(drow * 64 + dkc * 8), voff = (unsigned)(drow * LP + dkc * 8);
    LAS unsigned char* dl = (LAS unsigned char*)lds + wid * 1024;
#define GLDS(g, off) __builtin_amdgcn_global_load_lds((const unsigned*)(g), (LAS unsigned*)(dl + (off)), 16, 0, 0)
#define K_DMA(kt, s) do { GLDS((K1 + (size_t)(kt) * 4096) + koff, (s) * 16384); GLDS((K2 + (size_t)(kt) * 4096) + koff, (s) * 16384 + 8192); } while (0)
#define V_DMA(kt, s) do { GLDS((Vt + (kt) * 64) + voff, 32768 + (s) * 16384); GLDS((Vt + (kt) * 64 + 64 * LP) + voff, 32768 + (s) * 16384 + 8192); } while (0)
#define QKT(dst, s, init) do { const char* _k = lds + (s) * 16384 + which * 8192; \
        _Pragma("unroll") for (int t2 = 0; t2 < 2; ++t2) _Pragma("unroll") for (int i = 0; i < 16; ++i) dst[t2][i] = (init); \
        _Pragma("unroll") for (int ks = 0; ks < 4; ++ks) _Pragma("unroll") for (int t2 = 0; t2 < 2; ++t2) { \
            const bf16x8 kf = *(const bf16x8*)(_k + swz(t2 * 32 + r32, ks * 2 + hi)); dst[t2] = MFMA32(kf, qf[ks], dst[t2]); } } while (0)
    K_DMA(0, 0); V_DMA(0, 0); K_DMA(1, 1);
    __syncthreads();
    f32x16 sc[2], sn[2];
    QKT(sc, 0, 0.f);
    __syncthreads();
    {
        float tm = max3f(sc[0][0], sc[0][1], sc[0][2]);
#pragma unroll
        for (int i = 3; i < 15; i += 2) tm = max3f(tm, sc[0][i], sc[0][i + 1]);
        tm = fmaxf(tm, sc[0][15]);
#pragma unroll
        for (int i = 0; i < 16; i += 2) tm = max3f(tm, sc[1][i], sc[1][i + 1]);
        tm = xhalf_max(tm);
        m = tm;
#pragma unroll
        for (int t2 = 0; t2 < 2; ++t2)
#pragma unroll
            for (int i = 0; i < 16; ++i) sc[t2][i] -= m;
    }
#define SB() __builtin_amdgcn_sched_barrier(0)
#define SGB(mask, n) __builtin_amdgcn_sched_group_barrier(mask, n, 0)
    int fo[4];
#pragma unroll
    for (int j = 0; j < 4; ++j) fo[j] = swz(r32, 2 * j + hi);
    const char* kbase = lds + which * 8192;
    const char* vbase = lds + 32768;
#define ATT_STEP(KT, PAR, SC, SN) do { \
        const bool has1 = (KT) + 1 < nt, has2 = (KT) + 2 < nt; \
        if (has2) K_DMA((KT) + 2, PAR); \
        if (has1) V_DMA((KT) + 1, 1 - (PAR)); \
        const char* kst = kbase + (1 - (PAR)) * 16384; \
        const char* vs = vbase + (PAR) * 16384; \
        bf16x8 kf[8]; \
        _Pragma("unroll") for (int ks = 0; ks < 4; ++ks) _Pragma("unroll") for (int t2 = 0; t2 < 2; ++t2) kf[ks * 2 + t2] = *(const bf16x8*)(kst + fo[ks] + t2 * 4096); \
        SB(); \
        _Pragma("unroll") for (int t2 = 0; t2 < 2; ++t2) _Pragma("unroll") for (int i = 0; i < 16; ++i) SN[t2][i] = -m; \
        _Pragma("unroll") for (int ks = 0; ks < 4; ++ks) _Pragma("unroll") for (int t2 = 0; t2 < 2; ++t2) SN[t2] = MFMA32(kf[ks * 2 + t2], qf[ks], SN[t2]); \
        bf16x8 va[4], vb[4]; \
        _Pragma("unroll") for (int t = 0; t < 4; ++t) va[t] = *(const bf16x8*)(vs + fo[0] + t * 4096); \
        SGB(0x002, 16); SGB(0x008, 8); SGB(0x100, 4); SB(); \
        if (__any(pprev > 4096.f)) {        \
            const float pr = xhalf_sum(pprev); \
            const float dl = pr > 4096.f ? (float)((int)((__builtin_bit_cast(unsigned, pr) >> 23) & 255u) - 127) : 0.f, al = fast_exp2(-dl); \
            m += dl; lsum *= al; \
            _Pragma("unroll") for (int t = 0; t < 4; ++t) _Pragma("unroll") for (int i = 0; i < 16; ++i) o[t][i] *= al; \
            _Pragma("unroll") for (int t2 = 0; t2 < 2; ++t2) _Pragma("unroll") for (int i = 0; i < 16; ++i) { SC[t2][i] -= dl; SN[t2][i] -= dl; } \
        } \
        float ps = 0.f; \
        _Pragma("unroll") for (int t2 = 0; t2 < 2; ++t2) _Pragma("unroll") for (int i = 0; i < 16; ++i) { SC[t2][i] = fast_exp2(SC[t2][i]); ps += SC[t2][i]; } \
        lsum += ps; pprev = ps; \
        bf16x8 pf[4]; \
        _Pragma("unroll") for (int t2 = 0; t2 < 2; ++t2) _Pragma("unroll") for (int sh = 0; sh < 2; ++sh) { \
            u32x4 pw; pw.x = pk2(SC[t2][8 * sh], SC[t2][8 * sh + 1]); pw.y = pk2(SC[t2][8 * sh + 2], SC[t2][8 * sh + 3]); \
            pw.z = pk2(SC[t2][8 * sh + 4], SC[t2][8 * sh + 5]); pw.w = pk2(SC[t2][8 * sh + 6], SC[t2][8 * sh + 7]); \
            pf[t2 * 2 + sh] = __builtin_bit_cast(bf16x8, pw); } \
        SB(); \
        _Pragma("unroll") for (int t = 0; t < 4; ++t) vb[t] = *(const bf16x8*)(vs + fo[1] + t * 4096); \
        _Pragma("unroll") for (int t = 0; t < 4; ++t) o[t] = MFMA32(va[t], pf[0], o[t]); \
        SGB(0x100, 4); SGB(0x008, 4); SB(); \
        _Pragma("unroll") for (int t = 0; t < 4; ++t) va[t] = *(const bf16x8*)(vs + fo[2] + t * 4096); \
        _Pragma("unroll") for (int t = 0; t < 4; ++t) o[t] = MFMA32(vb[t], pf[1], o[t]); \
        SGB(0x100, 4); SGB(0x008, 4); SB(); \
        _Pragma("unroll") for (int t = 0; t < 4; ++t) vb[t] = *(const bf16x8*)(vs + fo[3] + t * 4096); \
        _Pragma("unroll") for (int t = 0; t < 4; ++t) o[t] = MFMA32(va[t], pf[2], o[t]); \
        SGB(0x100, 4); SGB(0x008, 4); SB(); \
        _Pragma("unroll") for (int t = 0; t < 4; ++t) o[t] = MFMA32(vb[t], pf[3], o[t]); \
        SB(); \
        __syncthreads(); \
    } while (0)
    float pprev = 0.f;
    for (int kt = 0; kt < nt; kt += 2) {
        ATT_STEP(kt, 0, sc, sn);
        ATT_STEP(kt + 1, 1, sn, sc);
    }
#undef ATT_STEP
#undef SB
#undef SGB
#undef GLDS
#undef K_DMA
#undef V_DMA
#undef QKT
    lsum = xhalf_sum(lsum);
    const float inv = 1.f / lsum;
    float* xb = (float*)lds + (size_t)qg * 4096;
    if (which == 1) {
#pragma unroll
        for (int t = 0; t < 4; ++t)
#pragma unroll
            for (int i = 0; i < 16; ++i) xb[(t * 16 + i) * 64 + lane] = o[t][i] * inv;
    }
    __syncthreads();
    if (which == 0) {
        float ss = 0.f;
#pragma unroll
        for (int t = 0; t < 4; ++t)
#pragma unroll
            for (int i = 0; i < 16; ++i) { const float v = o[t][i] * inv - lam * xb[(t * 16 + i) * 64 + lane]; o[t][i] = v; ss += v * v; }
        ss = xhalf_sum(ss);
        const float rs = rsqrtf(ss * (1.f / 128.f) + EPS) * (1.f - lam_init);
        const float* sg = P.in[13] + (size_t)l * 128;
        bf16_t* dst = (bf16_t*)(ptr_l(P.ws) + WS_MIX) + ((size_t)b * LP + q0 + qg * 32 + r32) * 1024 + head * 128 + 4 * hi;
#pragma unroll
        for (int t = 0; t < 4; ++t)
#pragma unroll
            for (int i4 = 0; i4 < 4; ++i4) {
                const f32x4 g = *(const f32x4*)(sg + t * 32 + 8 * i4 + 4 * hi);
                u32x2 w; w.x = pk2(o[t][4 * i4] * rs * g.x, o[t][4 * i4 + 1] * rs * g.y); w.y = pk2(o[t][4 * i4 + 2] * rs * g.z, o[t][4 * i4 + 3] * rs * g.w);
                *(u32x2*)(dst + t * 32 + 8 * i4) = w;
            }
    }
    __syncthreads();
}

struct ConvTile { const float* src; bf16_t* dst; int K, N, mode; };
DEVI ConvTile conv_tile(const Params& P, unsigned char* w, int l, int u) {
    if (u < 4096) { const int w3 = u >= 2048; const int v = u & 2047, le = l * 16 + (v >> 7), k = (v >> 3) & 15, n = v & 7;
        return {P.in[w3 ? 27 : 26] + (size_t)le * 1024 * 2048 + (size_t)(k * 64) * 2048 + n * 256, (bf16_t*)(w + WS_W13T) + (size_t)le * 4096 * 1024 + k * 64, 1024, 2048, (n * 256) | ((1 + w3) << 16)}; }
    const int v = u - 4096, le = l * 16 + (v >> 7), k = (v >> 2) & 31, n = v & 3;
    return {P.in[28] + (size_t)le * 2048 * 1024 + (size_t)(k * 64) * 1024 + n * 256, (bf16_t*)(w + WS_W2T) + (size_t)le * 1024 * 2048 + k * 64, 2048, 1024, n * 256};
}
#define CV_LOAD(v, t) do { const unsigned voff_ = (unsigned)((2 * (tid >> 6)) * (t).N + (tid & 63) * 4) * 4u; \
        _Pragma("unroll") for (int i = 0; i < 8; ++i) { const float* sb_ = (t).src + (size_t)((i >> 1) * 16 + (i & 1)) * (t).N; \
        asm volatile("s_nop 4\n\tglobal_load_dwordx4 %0, %1, %2\n\ts_nop 1" : "=&v"(v[i]) : "v"(voff_), "s"(sb_) : "memory"); } } while (0)
#define CV_WAIT(v, N) asm volatile("s_waitcnt vmcnt(" #N ")" : "+v"(v[0]), "+v"(v[1]), "+v"(v[2]), "+v"(v[3]), "+v"(v[4]), "+v"(v[5]), "+v"(v[6]), "+v"(v[7]) :: "memory")
#define CV_STEP(v, t, N, UNEXT) do { \
        unsigned* tile = (unsigned*)lds + par * (32 * 256); par ^= 1; \
        CV_WAIT(v, N); \
        _Pragma("unroll") for (int j = 0; j < 4; ++j) { const int kp = (tid >> 6) + 8 * j; \
            u32x4 wv; wv.x = pk2(v[2 * j].x, v[2 * j + 1].x); wv.y = pk2(v[2 * j].y, v[2 * j + 1].y); wv.z = pk2(v[2 * j].z, v[2 * j + 1].z); wv.w = pk2(v[2 * j].w, v[2 * j + 1].w); \
            *(u32x4*)(tile + kp * 256 + (((tid & 63) * 4) ^ (((kp >> 2) & 7) << 3))) = wv; } \
        const ConvTile cur = t; \
        if ((UNEXT) >= 0) { t = conv_tile(P, w, l, (UNEXT)); CV_LOAD(v, t); } \
        asm volatile("s_waitcnt lgkmcnt(0)\n\ts_barrier" ::: "memory"); \
        const int n0 = cur.mode & 0xffff, mode = cur.mode >> 16; \
        _Pragma("unroll") for (int i = 0; i < 4; ++i) { \
            const int c = tid + 512 * i, n = c >> 3, kq = c & 7; \
            u32x4 o; o.x = tile[(4 * kq) * 256 + (n ^ (kq << 3))]; o.y = tile[(4 * kq + 1) * 256 + (n ^ (kq << 3))]; o.z = tile[(4 * kq + 2) * 256 + (n ^ (kq << 3))]; o.w = tile[(4 * kq + 3) * 256 + (n ^ (kq << 3))]; \
            const int ng = n0 + n; const int orow = mode == 0 ? ng : ((ng >> 7) * 256 + (mode - 1) * 128 + (ng & 127)); \
            const unsigned so_ = (unsigned)(orow * cur.K + 8 * kq) * 2u; \
            asm volatile("s_nop 4\n\tglobal_store_dwordx4 %0, %1, %2\n\ts_nop 1" :: "v"(so_), "v"(o), "s"(cur.dst) : "memory"); \
        } } while (0)
DEVI void conv_share(char* lds, const Params& P, int l, int bid, int G) {
    unsigned char* w = ptr_l(P.ws);
    const int tid = tid_l();
    if (G != 256) {
        for (int u = bid; u < 3 * 2048; u += G) {
            if (u < 4096) { const int w3 = u >= 2048; const int v = u & 2047, le = l * 16 + (v >> 7), k = (v >> 3) & 15, n = v & 7;
                transpose_unit(lds, P.in[w3 ? 27 : 26] + (size_t)le * 1024 * 2048, 1024, 2048, (bf16_t*)(w + WS_W13T) + (size_t)le * 4096 * 1024, k * 64, n * 256, 1 + w3); }
            else { const int v = u - 4096, le = l * 16 + (v >> 7), k = (v >> 2) & 31, n = v & 3;
                transpose_unit(lds, P.in[28] + (size_t)le * 2048 * 1024, 2048, 1024, (bf16_t*)(w + WS_W2T) + (size_t)le * 1024 * 2048, k * 64, n * 256, 0); }
        }
        return;
    }
    f32x4 va[8], vb[8], vc[8];
    ConvTile ta = conv_tile(P, w, l, bid), tb = conv_tile(P, w, l, bid + 256), tc = conv_tile(P, w, l, bid + 512);
    int par = 0;
    CV_LOAD(va, ta); CV_LOAD(vb, tb); CV_LOAD(vc, tc);
    CV_STEP(va, ta, 16, bid + 3 * 256); CV_STEP(vb, tb, 20, bid + 4 * 256); CV_STEP(vc, tc, 24, bid + 5 * 256);
    for (int r = 2; r < 8; ++r) {
        const int u = bid + (3 * r) * 256;
        CV_STEP(va, ta, 28, u); CV_STEP(vb, tb, 28, u + 256); CV_STEP(vc, tc, 28, u + 512);
    }
    CV_STEP(va, ta, 28, -1); CV_STEP(vb, tb, 20, -1); CV_STEP(vc, tc, 12, -1);
    asm volatile("s_waitcnt vmcnt(0)" ::: "memory");
    __syncthreads();
}
#undef CV_LOAD
#undef CV_WAIT
#undef CV_STEP
constexpr int PH_PER_LAYER = 11, PH_LAYER0 = 2, PH_FINAL = PH_LAYER0 + DEPTH * PH_PER_LAYER, N_PHASES = PH_FINAL + 1;

__global__ void __launch_bounds__(512, 2) fwd_kernel(Params P) {
    extern __shared__ __attribute__((aligned(16))) char lds[];
    volatile LAS unsigned* xbw = (volatile LAS unsigned*)(lds + 131072);
    if (threadIdx.x == 0) { xbw[0] = 0u; xbw[1] = 0u; }
    __syncthreads();
    XcdBarrier bar = xcd_barrier_post((unsigned*)(P.ws + WS_CTL), xbw);
    const int G = gridDim.x, bid = blockIdx.x;
    const int vcu = (G % 8 == 0) ? (bid % 8) * (G / 8) + bid / 8 : bid;
    LAS unsigned char* ldsp = (LAS unsigned char*)lds;
    const int lo = P.lo, hi = P.hi;
#ifndef EN_MASK
#define EN_MASK 0xFFFFFFFFu
#endif
#define PHASE(id) if ((id) >= lo && (id) < hi)
#ifndef REP_MASK
#define REP_MASK 0x0u
#endif
#define PHASE_K(k, id) if (((EN_MASK >> (k)) & 1u) && (id) >= lo && (id) < hi) for (int rep_ = 0; rep_ <= (int)((REP_MASK >> (k)) & 1u); ++rep_)
#define SEAM(id) do { if ((id) >= lo && (id) + 1 < hi) xcd_barrier(bar); } while (0)
    unsigned char* ws0 = P.ws;
#define ws ptr_l(ws0)

    PHASE_K(0, 0) {
        constexpr int U_SSM = 256, U_ROPE = 1, U_ADA = 4 * 96;
        constexpr int T_WIN = 4 * 16 * 8, T_WOUT = 4 * 16 * 4, T_WGLU = 4 * 8 * 2, T_W1 = 64 * 16 * 8, T_W2 = 64 * 32 * 4;
        constexpr int U0 = U_SSM + U_ROPE + U_ADA, U1 = U0 + T_WIN, U2 = U1 + T_WOUT, U3 = U2 + T_WGLU, U4 = U3 + T_W1, U5 = U4 + T_W1, U6 = U5 + T_W2;
        for (int u = bid; u < U3; u += G) {
            if (u < U_SSM) { ssm_tab_unit(lds, P, u >> 6, (u >> 5) & 1, u & 31); }
            else if (u == U_SSM) {
                const int tid = tid_l(), wid = tid >> 6, lane = tid & 63;
                float* rope = (float*)(ws + WS_ROPE);
                for (int i = tid; i < 64 * 16; i += 512) {
                    const int pos = i >> 4, f = i & 15; const float inv = powf(10000.f, -(float)(2 * f) / 32.f);
                    float s, c; sincosf((float)pos * inv, &s, &c); rope[i * 2] = c; rope[i * 2 + 1] = s;
                }
                if (wid < 4) {
                    const float a = P.in[9][wid * 64 + lane] * P.in[10][wid * 64 + lane], c2 = P.in[11][wid * 64 + lane] * P.in[12][wid * 64 + lane];
                    const float s1 = wave_sum(a), s2 = wave_sum(c2);
                    if (lane == 0) ((float*)(ws + WS_LAM))[wid] = expf(s1) - expf(s2) + (0.8f - 0.6f * expf(-0.3f * (float)wid));
                }
            }
            else if (u < U0) { const int v = u - U_SSM - U_ROPE; adaln_unit(lds, P, v / 96, (v % 96) * 64); }
            else if (u < U1) { const int v = u - U0, l = v >> 7, k = (v >> 3) & 15, n = v & 7; transpose_unit(lds, P.in[8] + (size_t)l * 1024 * 2048, 1024, 2048, (bf16_t*)(ws + WS_WINT) + (size_t)l * 2048 * 1024, k * 64, n * 256, 0); }
            else if (u < U2) { const int v = u - U1, l = v >> 6, k = (v >> 2) & 15, n = v & 3; transpose_unit(lds, P.in[24] + (size_t)l * 1024 * 1024, 1024, 1024, (bf16_t*)(ws + WS_WOUTT) + (size_t)l * 1024 * 1024, k * 64, n * 256, 0); }
            else { const int v = u - U2, l = v >> 4, k = (v >> 1) & 7, n = v & 1; transpose_unit(lds, P.in[22] + (size_t)l * 512 * 512, 512, 512, (bf16_t*)(ws + WS_WGLUT) + (size_t)l * 512 * 512, k * 64, n * 256, 0); }
        }
        (void)U4; (void)U5; (void)U6;
    }
    SEAM(0);
    PHASE_K(1, 1) {
        const float* KT = (const float*)(ws + WS_KTAB); const float* PW = (const float*)(ws + WS_PW); const float* BB = (const float*)(ws + WS_BBAR);
        bf16_t* WE = (bf16_t*)(ws + WS_WENDT); bf16_t* B2 = (bf16_t*)(ws + WS_BT2);
        const int tid = tid_l();
        for (size_t idx = (size_t)bid * 512 + tid; idx < (size_t)4 * 32 * 256 * 256; idx += (size_t)G * 512) {
            const int kp = idx & 255, n = (idx >> 8) & 255, g = (idx >> 16) & 31, l = (int)(idx >> 21);
            if (kp >= 128) { *(unsigned*)(WE + (((size_t)l * 32 + g) * 256 + n) * 512 + kp * 2) = 0u; continue; }
            const int d = n >> 7, p = (n >> 1) & 63, ri = n & 1, k = kp * 2, i = k >> 4, h = k & 15;
            const size_t ldg = ((size_t)l * 2 + d) * 32 + g;
            const int e = d == 0 ? 15 - i : i;
            const float wr = PW[((ldg * 64 + p) * 17 + e) * 2], wi = PW[((ldg * 64 + p) * 17 + e) * 2 + 1];
            float o[2];
#pragma unroll
            for (int q = 0; q < 2; ++q) { const float br = BB[((ldg * 64 + p) * 16 + h + q) * 2], bi = BB[((ldg * 64 + p) * 16 + h + q) * 2 + 1]; o[q] = ri == 0 ? wr * br - wi * bi : wr * bi + wi * br; }
            *(unsigned*)(WE + (((size_t)l * 32 + g) * 256 + n) * 512 + k) = pk2(o[0], o[1]);
        }
        for (size_t idx = (size_t)bid * 512 + tid; idx < (size_t)4 * 32 * 256 * 256; idx += (size_t)G * 512) {
            const int kp = idx & 255, n2 = (idx >> 8) & 255, g = (idx >> 16) & 31, l = (int)(idx >> 21);
            const int j = n2 >> 4, h = n2 & 15, k = kp * 2;
            float o[2];
            if (k < 256) {
                const int i = k >> 4;
#pragma unroll
                for (int q = 0; q < 2; ++q) {
                    const int h2 = (k & 15) + q; float v = 0.f;
                    if (i <= j) v += KT[((((size_t)l * 2 + 0) * 32 + g) * 16 + (j - i)) * 256 + h * 16 + h2];
                    if (i >= j) v += KT[((((size_t)l * 2 + 1) * 32 + g) * 16 + (i - j)) * 256 + h * 16 + h2];
                    if (i == j && h == h2) v += P.in[21][(size_t)l * 512 + g * 16 + h];
                    o[q] = v;
                }
            } else {
                const int n = k - 256, d = n >> 7, p = (n >> 1) & 63;
                const size_t ldg = ((size_t)l * 2 + d) * 32 + g;
                const int e = d == 0 ? j + 1 : 16 - j;
                const float wr = PW[((ldg * 64 + p) * 17 + e) * 2], wi = PW[((ldg * 64 + p) * 17 + e) * 2 + 1];
                const float cr = P.in[19][(ldg * 16 + h) * 64 + p], ci = P.in[20][(ldg * 16 + h) * 64 + p];
                o[0] = cr * wr - ci * wi; o[1] = -(cr * wi + ci * wr);
            }
            *(unsigned*)(B2 + (((size_t)l * 32 + g) * 256 + n2) * 512 + k) = pk2(o[0], o[1]);
        }
    }
    SEAM(1);

    for (int l = 0; l < DEPTH; ++l) {
        const int ph = PH_LAYER0 + l * PH_PER_LAYER;
        const bool last = l == DEPTH - 1;
        const float* MODl = (const float*)(ws + WS_MOD) + (size_t)l * 9 * 6144;
        PHASE_K(2, ph + 0) { if (l == 0) rowpass1<true>(P, 0); else rowpass1<false>(P, l); }
        SEAM(ph + 0);
        PHASE_K(3, ph + 1) {
            {
                Epi8Inproj ep{(bf16_t*)(ws + WS_QK), (bf16_t*)(ws + WS_VT), (bf16_t*)(ws + WS_US), (const float*)(ws + WS_ROPE)};
                const pg8::Gemm g{(const bf16_t*)(ws + WS_HX), (const bf16_t*)(ws + WS_WINT) + (size_t)l * 2048 * 1024, R, 2048, 1024};
                const TileOrder S{128 * 8, G, vcu, 16, 8, 0, 17, 1};
                pg8::gemm_phase<Epi8Inproj, TileOrder, true, true>(ldsp, g, S, ep);
            }
            for (int u = vcu; u < 16 * 16; u += G) {
                EpiInproj ep{(bf16_t*)(ws + WS_QK), (bf16_t*)(ws + WS_VT), (bf16_t*)(ws + WS_US), (const float*)(ws + WS_ROPE)};
                APlain af{(const bf16_t*)(ws + WS_HX), 1024};
                const int mt = u >> 4, nt = u & 15;
                gemm_unit_dma(lds, af, (const bf16_t*)(ws + WS_WINT) + (size_t)l * 2048 * 1024, 1024, 1024, (mt >> 1) * LP + (mt & 1) * 128, nt * 128, ep);
            }
        }
        SEAM(ph + 1);
        PHASE_K(4, ph + 2) {
            {
                Epi8S1 ep{(unsigned short*)(ws + WS_EB)};
                const pg8::Gemm g{(const bf16_t*)(ws + WS_US), (const bf16_t*)(ws + WS_WENDT) + (size_t)l * 32 * 256 * 512, 32 * NCHP, 32 * 256, 512};
                const TileOrder S{32 * 8, G, vcu, 8, 1, 1, 9, 0};
                pg8::gemm_phase<Epi8S1, TileOrder, true, true>(ldsp, g, S, ep);
            }
            for (int u = vcu; u < 64; u += G) {
                const int g = u >> 1, nt = u & 1;
                EpiS1 ep{(unsigned short*)(ws + WS_EB) + (size_t)g * NCHP * 256};
                APlain af{(const bf16_t*)(ws + WS_US) + (size_t)g * NCHP * 512, 512};
                gemm_unit_dma(lds, af, (const bf16_t*)(ws + WS_WENDT) + ((size_t)l * 32 + g) * 256 * 512, 512, 256, 2048, nt * 128, ep);
            }
        }
        SEAM(ph + 2);
        PHASE_K(15, ph + 3) {
            for (int u = bid * 2; u < NB * 32 * 2; u += G * 2) scan_block(lds, P, l, u);
        }
        SEAM(ph + 3);
        PHASE_K(5, ph + 4) {
            const float lam = ((const float*)(ws + WS_LAM))[l], lam_init = 0.8f - 0.6f * expf(-0.3f * (float)l);
            int rnd = 0;
            for (int u = vcu; u < (last ? 1024 : 1024 + 64); u += G, ++rnd) {
                if (rnd == ((bid >> 3) & 3)) conv_share(lds, P, l, bid, G);
                if (u < 1024) { const int qb = u & 31, bh = u >> 5; attn_unit(lds, P, l, bh >> 2, bh & 3, CTXL + qb * 128, LP, lam, lam_init); }
                else { const int v = u - 1024, qb = v & 1, bh = v >> 1; attn_unit(lds, P, l, bh >> 2, bh & 3, qb * 128, CTXL, lam, lam_init); }
            }
        }
        PHASE_K(6, ph + 4) {
            {
                Epi8S2 ep{(bf16_t*)(ws + WS_YG)};
                const pg8::Gemm g{(const bf16_t*)(ws + WS_US), (const bf16_t*)(ws + WS_BT2) + (size_t)l * 32 * 256 * 512, 32 * NCHP, 32 * 256, 512};
                const TileOrder S{32 * 8, G, vcu, 8, 1, 1, 9, 0};
                pg8::gemm_phase<Epi8S2, TileOrder, true, true>(ldsp, g, S, ep);
            }
            if (!last) for (int u = (vcu + G / 2) % G; u < 64; u += G) {
                const int g = u >> 1, nt = u & 1;
                EpiS2 ep{(bf16_t*)(ws + WS_YG), g};
                APlain af{(const bf16_t*)(ws + WS_US) + (size_t)g * NCHP * 512, 512};
                gemm_unit_dma(lds, af, (const bf16_t*)(ws + WS_BT2) + ((size_t)l * 32 + g) * 256 * 512, 512, 512, 2048, nt * 128, ep);
            }
        }
        SEAM(ph + 4);
        PHASE_K(7, ph + 5) {
            {
                Epi8Glu ep{(const bf16_t*)(ws + WS_YG), (bf16_t*)(ws + WS_MIX), P.in[23] + (size_t)l * 512};
                const pg8::Gemm g{(const bf16_t*)(ws + WS_YG), (const bf16_t*)(ws + WS_WGLUT) + (size_t)l * 512 * 512, R, 512, 512};
                const TileOrder S{128 * 2, G, vcu, 16, 2, 0, 17, 1};
                pg8::gemm_phase<Epi8Glu, TileOrder, true, true>(ldsp, g, S, ep);
            }
            if (!last) for (int u = vcu; u < 8 * 4; u += G) {
                EpiGlu ep{(const bf16_t*)(ws + WS_YG), (bf16_t*)(ws + WS_MIX), P.in[23] + (size_t)l * 512};
                APlain af{(const bf16_t*)(ws + WS_YG), 512};
                gemm_unit<256>(lds, af, (const bf16_t*)(ws + WS_WGLUT) + (size_t)l * 512 * 512, 512, 512, (u >> 2) * LP, (u & 3) * 128, ep);
            }
        }
        SEAM(ph + 5);
        PHASE_K(8, ph + 6) {
            {
                Epi8Out ep{(bf16_t*)(ws + WS_X), MODl};
                const pg8::Gemm g{(const bf16_t*)(ws + WS_MIX), (const bf16_t*)(ws + WS_WOUTT) + (size_t)l * 1024 * 1024, R, 1024, 1024};
                const TileOrder S{128 * 4, G, vcu, 16, 4, 0, 17, 1};
                pg8::gemm_phase<Epi8Out, TileOrder, true, true>(ldsp, g, S, ep);
            }
            if (!last) for (int u = vcu; u < 16 * 8; u += G) {
                EpiOut ep{(bf16_t*)(ws + WS_X), MODl};
                APlain af{(const bf16_t*)(ws + WS_MIX), 1024};
                const int mt = u >> 3, nt = u & 7;
                gemm_unit_dma(lds, af, (const bf16_t*)(ws + WS_WOUTT) + (size_t)l * 1024 * 1024, 1024, 1024, (mt >> 1) * LP + (mt & 1) * 128, nt * 128, ep);
            }
        }
        SEAM(ph + 6);
        PHASE_K(9, ph + 7) { rowpass2(lds, P, l); }
        SEAM(ph + 7);
        PHASE_K(10, ph + 8) {
            for (int u = bid; u < (last ? 128 : 256); u += G) select_unit(lds, P, (u & 127) >> 4, u & 15, u < 128);
        }
        SEAM(ph + 8);
        PHASE_K(11, ph + 9) {
            Epi8Moe1 ep{(bf16_t*)(ws + WS_HG)};
            const pg8::Gemm g{(const bf16_t*)(ws + WS_HX), (const bf16_t*)(ws + WS_W13T) + (size_t)l * 16 * 4096 * 1024, 16 * ROWS_E, 16 * 4096, 1024, (const int*)(ws + WS_IDX), 131072 + 64};
            const TileOrder S = last ? TileOrder{16 * 16 * 16, G, vcu, 16, 16, 16, 17, 0, 1} : TileOrder{16 * 17 * 16, G, vcu, 17, 16, 16, 17, 0, 1};
            pg8::gemm_phase<Epi8Moe1, TileOrder, true, true, true>(ldsp, g, S, ep);
        }
        SEAM(ph + 9);
        PHASE_K(12, ph + 10) {
            {
                Epi8Moe2 ep{(bf16_t*)(ws + WS_OG), (const float*)(ws + WS_GATE)};
                const pg8::Gemm g{(const bf16_t*)(ws + WS_HG), (const bf16_t*)(ws + WS_W2T) + (size_t)l * 16 * 1024 * 2048, 16 * ROWS_E, 16 * 1024, 2048};
                const TileOrder S{16 * 16 * 4, G, vcu, 16, 4, 4, 17, 0};
                pg8::gemm_phase<Epi8Moe2, TileOrder, true, true>(ldsp, g, S, ep);
            }
            if (!last) for (int u = vcu; u < 16 * 2 * 8; u += G) {
                const int e = u >> 4, mt = (u >> 3) & 1, nt = u & 7;
                EpiMoe2 ep{(bf16_t*)(ws + WS_OG) + (size_t)e * ROWS_E * 1024, (const float*)(ws + WS_GATE) + (size_t)e * ROWS_E};
                APlain af{(const bf16_t*)(ws + WS_HG) + (size_t)e * ROWS_E * FF, FF};
                gemm_unit_dma(lds, af, (const bf16_t*)(ws + WS_W2T) + ((size_t)l * 16 + e) * 1024 * 2048, 2048, 2048, NB * CAPL + mt * 128, nt * 128, ep);
            }
        }
        SEAM(ph + 10);
    }
    PHASE_K(13, PH_FINAL) { rowpass1<false>(P, DEPTH); }
#undef ws
}

#ifndef MK_MULTI
#define MK_MULTI 0
#endif

extern "C" void kernel_launch(void* const* d_in, const int* in_sizes, int n_in, void* d_out, int out_size, void* d_ws, size_t ws_size, hipStream_t stream) {
    static int grid = 0;
    if (!grid) {
        int dev = 0, cus = 0, per_cu = 0;
        hipGetDevice(&dev);
        hipDeviceGetAttribute(&cus, hipDeviceAttributeMultiprocessorCount, dev);
        hipFuncSetAttribute((const void*)fwd_kernel, hipFuncAttributeMaxDynamicSharedMemorySize, LDS_BYTES);
        hipOccupancyMaxActiveBlocksPerMultiprocessor(&per_cu, fwd_kernel, 512, LDS_BYTES);
        grid = cus * (per_cu < 1 ? per_cu : 1);
        if (grid <= 0) { fprintf(stderr, "occupancy query failed (per_cu=%d cus=%d)\n", per_cu, cus); grid = 256; }
        if (ws_size < WS_END) fprintf(stderr, "workspace too small: %zu < %zu\n", ws_size, (size_t)WS_END);
    }
    Params p{};
    for (int i = 0; i < 30; ++i) p.in[i] = (const float*)d_in[i];
    p.out = (float*)d_out; p.ws = (unsigned char*)d_ws;
    hipMemsetAsync(d_ws, 0, CTL_BYTES, stream);
#if MK_MULTI
    for (int ph = 0; ph < N_PHASES; ++ph) {
        p.lo = ph; p.hi = ph + 1;
        hipLaunchKernelGGL(fwd_kernel, dim3(grid), dim3(512), LDS_BYTES, stream, p);
    }
#else
    p.lo = 0; p.hi = N_PHASES;
    hipLaunchKernelGGL(fwd_kernel, dim3(grid), dim3(512), LDS_BYTES, stream, p);
#endif
}
```

```cpp
#include <hip/hip_runtime.h>
#include <cstdio>
#include <cstdint>
#include <cmath>

#define DEVI __device__ __forceinline__
#define LAS __attribute__((address_space(3)))

typedef unsigned short bf16_t;
typedef short bf16x8 __attribute__((ext_vector_type(8)));
typedef float f32x2 __attribute__((ext_vector_type(2)));
typedef float f32x4 __attribute__((ext_vector_type(4)));
typedef float f32x16 __attribute__((ext_vector_type(16)));
typedef unsigned u32x2 __attribute__((ext_vector_type(2)));
typedef unsigned u32x4 __attribute__((ext_vector_type(4)));
typedef __bf16 bf16x2_t __attribute__((ext_vector_type(2)));

constexpr int NB = 8, SEQ = 4096, CTXL = 256, DM = 1024, DEPTH = 4;
constexpr int LP = CTXL + SEQ;
constexpr int R = NB * LP;
constexpr int NCHB = LP / 16;
constexpr int NCH = NB * NCHB;
constexpr int NE = 16, CAPL = 512, CAPC = 32, ROWS_BE = CAPL + CAPC  , ROWS_E = NB * ROWS_BE  , FF = 2048;
constexpr int NH = 4;
constexpr float EPS = 1e-6f;
constexpr float QSCALE = 0.125f * 1.4426950408889634f;

constexpr size_t al256(size_t x) { return (x + 255) & ~(size_t)255; }
constexpr size_t WS_CTL = 0, CTL_BYTES = 65536;
constexpr size_t WS_MOD = WS_CTL + CTL_BYTES;
constexpr size_t WS_ROPE = WS_MOD + al256((size_t)4 * 9 * 6144 * 4);
constexpr size_t WS_LAM = WS_ROPE + al256(64 * 16 * 2 * 4);
constexpr size_t WS_KTAB = WS_LAM + 256;
constexpr size_t WS_PW = WS_KTAB + (size_t)4 * 2 * 32 * 4096 * 4;
constexpr size_t WS_BBAR = WS_PW + al256((size_t)4 * 2 * 32 * 64 * 17 * 2 * 4);
constexpr size_t WS_WENDT = WS_BBAR + al256((size_t)4 * 2 * 32 * 64 * 16 * 2 * 4);
constexpr size_t WS_BT2 = WS_WENDT + (size_t)4 * 32 * 256 * 512 * 2;
constexpr size_t WS_WINT = WS_BT2 + (size_t)4 * 32 * 256 * 512 * 2;
constexpr size_t WS_WOUTT = WS_WINT + (size_t)4 * 2048 * 1024 * 2;
constexpr size_t WS_WGLUT = WS_WOUTT + (size_t)4 * 1024 * 1024 * 2;
constexpr size_t WS_W13T = WS_WGLUT + (size_t)4 * 512 * 512 * 2;
constexpr size_t WS_W2T = WS_W13T + (size_t)4 * 16 * 4096 * 1024 * 2;
constexpr size_t WS_X = WS_W2T + (size_t)4 * 16 * 1024 * 2048 * 2;
constexpr size_t WS_HX = WS_X + (size_t)R * 1024 * 4;
constexpr size_t WS_QK = WS_HX + (size_t)R * 1024 * 2;
constexpr size_t WS_VT = WS_QK + (size_t)R * 1024 * 2;
constexpr int NCHP = 2304;
constexpr size_t WS_US = WS_VT + (size_t)R * 512 * 2;
constexpr size_t WS_EB = WS_US + (size_t)32 * NCHP * 512 * 2;
constexpr size_t WS_MIX = WS_EB + (size_t)32 * NCHP * 256 * 4;
constexpr size_t WS_YG = WS_MIX + (size_t)R * 1024 * 2;
constexpr size_t WS_AFFT = WS_YG + (size_t)R * 512 * 2;
constexpr size_t WS_SLOT = WS_AFFT + (size_t)NB * 16 * LP * 4;
constexpr size_t WS_GATE = WS_SLOT + (size_t)R * 16 * 4;
constexpr size_t WS_IDX = WS_GATE + al256((size_t)16 * ROWS_E * 4);
constexpr size_t WS_XG = WS_IDX + al256((size_t)16 * ROWS_E * 4);
constexpr size_t WS_HG = WS_XG + (size_t)16 * ROWS_E * 1024 * 2;
constexpr size_t WS_OG = WS_HG + (size_t)16 * ROWS_E * 2048 * 2;
constexpr size_t WS_END = WS_OG + (size_t)16 * ROWS_E * 1024 * 2;

constexpr int LDS_BYTES = 131072 + 64 + 16384;

DEVI unsigned pk2(float lo, float hi) { f32x2 v = {lo, hi}; bf16x2_t b = __builtin_convertvector(v, bf16x2_t); return __builtin_bit_cast(unsigned, b); }
DEVI bf16_t f2bf(float f) { return (bf16_t)(pk2(f, 0.f) & 0xffffu); }
DEVI float bflo(unsigned u) { return __builtin_bit_cast(float, u << 16); }
DEVI float bfhi(unsigned u) { return __builtin_bit_cast(float, u & 0xffff0000u); }
DEVI f32x4 bf4(u32x2 w) { return (f32x4){bflo(w.x), bfhi(w.x), bflo(w.y), bfhi(w.y)}; }
typedef _Float16 h16x2 __attribute__((ext_vector_type(2)));
DEVI unsigned hpk2(float lo, float hi) { unsigned r; asm("v_cvt_pk_f16_f32 %0, %1, %2" : "=v"(r) : "v"(lo), "v"(hi)); return r; }
DEVI float hlo(unsigned u) { return (float)__builtin_bit_cast(_Float16, (unsigned short)(u & 0xffffu)); }
DEVI float hhi(unsigned u) { return (float)__builtin_bit_cast(_Float16, (unsigned short)(u >> 16)); }
DEVI f32x4 hf4(u32x2 w) { return (f32x4){hlo(w.x), hhi(w.x), hlo(w.y), hhi(w.y)}; }
DEVI int tid_l() { int t = threadIdx.x; asm volatile("" : "+v"(t)); return t; }
#define GAS __attribute__((address_space(1)))
DEVI unsigned char* ptr_l(unsigned char* w) { GAS unsigned char* g = (GAS unsigned char*)w; asm volatile("" : "+s"(g)); return (unsigned char*)g; }
template <int CTRL> DEVI float dppmov(float x) { return __builtin_bit_cast(float, __builtin_amdgcn_update_dpp(0, __builtin_bit_cast(int, x), CTRL, 0xf, 0xf, true)); }
DEVI void swap16(float a, float b, float& r0, float& r1) { const auto r = __builtin_amdgcn_permlane16_swap(__builtin_bit_cast(unsigned, a), __builtin_bit_cast(unsigned, b), false, false); r0 = __builtin_bit_cast(float, (unsigned)r[0]); r1 = __builtin_bit_cast(float, (unsigned)r[1]); }
DEVI void swap32(float a, float b, float& r0, float& r1) { const auto r = __builtin_amdgcn_permlane32_swap(__builtin_bit_cast(unsigned, a), __builtin_bit_cast(unsigned, b), false, false); r0 = __builtin_bit_cast(float, (unsigned)r[0]); r1 = __builtin_bit_cast(float, (unsigned)r[1]); }
DEVI float wave_sum(float v) {
    v += dppmov<0xB1>(v);
    v += dppmov<0x4E>(v);
    v += dppmov<0x124>(v);
    v += dppmov<0x128>(v);
    float r0, r1; swap16(v, v, r0, r1); v = r0 + r1;
    swap32(v, v, r0, r1); return r0 + r1;
}
DEVI float fast_exp2(float x) { return __builtin_amdgcn_exp2f(x); }
DEVI float sigmoidf_(float x) { return __builtin_amdgcn_rcpf(1.f + __expf(-x)); }
DEVI float gelu_tanh(float x) { const float z = 0.7978845608028654f * (x + 0.044715f * x * x * x); const float t = 1.f - 2.f * __builtin_amdgcn_rcpf(__expf(2.f * z) + 1.f); return 0.5f * x * (1.f + t); }
#define MFMA32(a, b, c) __builtin_amdgcn_mfma_f32_32x32x16_bf16(a, b, c, 0, 0, 0)

#define XB_TMO      128
#define XB_XCNT(j)  (256  + 64 * (j))
#define XB_XSUB(j)  (1280 + 64 * (j))
#define XB_XGEN(j)  (2304 + 64 * (j))
#define XB_TOP      3328
#define XB_TOPGEN   3392
#define XCD_BAR_WORDS 3456
#define XB_SPIN_CAP (1u << 20)
DEVI unsigned xb_ld(unsigned* p)              { return __hip_atomic_load(p, __ATOMIC_RELAXED, __HIP_MEMORY_SCOPE_AGENT); }
DEVI unsigned xb_add(unsigned* p, unsigned v) { return __hip_atomic_fetch_add(p, v, __ATOMIC_RELAXED, __HIP_MEMORY_SCOPE_AGENT); }
DEVI unsigned xb_xcc_id() { return (unsigned)__builtin_amdgcn_s_getreg((3 << 11) | 20) & 0xFu; }
#define XB_SPIN(cond, bar) do { unsigned _sp = 0; while (cond) { __builtin_amdgcn_s_sleep(1); \
    if ((++_sp & 255u) == 0u) { if (xb_ld(&(bar)[XB_TMO])) break; if (_sp > XB_SPIN_CAP) { atomicAdd(&(bar)[XB_TMO], 1u); break; } } } } while (0)
struct XcdBarrier { unsigned* bar; unsigned x; volatile LAS unsigned* st; };
DEVI XcdBarrier xcd_barrier_post(unsigned* bar, volatile LAS unsigned* st) {
    XcdBarrier b; b.bar = bar; b.x = xb_xcc_id(); b.st = st;
    if (threadIdx.x == 0) (void)xb_add(&bar[XB_XCNT(b.x)], 1u);
    return b;
}
DEVI void xcd_barrier_complete(unsigned* bar, unsigned x, unsigned& nloc, unsigned& nx) {
    const unsigned G = gridDim.x * gridDim.y * gridDim.z;
    unsigned sum, cnt, mine, sp = 0u;
    for (;;) {
        sum = 0u; cnt = 0u; mine = 0u;
#pragma unroll
        for (unsigned j = 0; j < 16; ++j) { const unsigned c = xb_ld(&bar[XB_XCNT(j)]); sum += c; cnt += (c > 0u) ? 1u : 0u; mine = (j == x) ? c : mine; }
        if (sum == G) break;
        __builtin_amdgcn_s_sleep(1);
        if ((++sp & 255u) == 0u) { if (xb_ld(&bar[XB_TMO])) break; if (sp > XB_SPIN_CAP) { atomicAdd(&bar[XB_TMO], 1u); break; } }
    }
    nloc = mine > 0u ? mine : 1u; nx = cnt > 0u ? cnt : 1u;
}
DEVI void xcd_barrier(const XcdBarrier& b) {
    asm volatile("s_waitcnt vmcnt(0)" ::: "memory");
    __syncthreads();
    if (threadIdx.x == 0) {
        unsigned* bar = b.bar;
        __builtin_amdgcn_s_waitcnt(0);
        unsigned nloc = b.st[0], nx = b.st[1];
        if (nloc == 0u) { xcd_barrier_complete(bar, b.x, nloc, nx); b.st[0] = nloc; b.st[1] = nx; }
        const unsigned old = xb_add(&bar[XB_XSUB(b.x)], 1u);
        const unsigned gen = old / nloc;
        if (old + 1u == (gen + 1u) * nloc) {
            __builtin_amdgcn_fence(__ATOMIC_RELEASE, "agent");
            asm volatile("s_waitcnt vmcnt(0)" ::: "memory");
            const unsigned og = xb_add(&bar[XB_TOP], 1u);
            const unsigned tg = og / nx;
            if (og + 1u == (tg + 1u) * nx) xb_add(&bar[XB_TOPGEN], 1u);
            else XB_SPIN(xb_ld(&bar[XB_TOPGEN]) == tg, bar);
            __builtin_amdgcn_fence(__ATOMIC_ACQUIRE, "agent");
            xb_add(&bar[XB_XGEN(b.x)], 1u);
            asm volatile("s_waitcnt vmcnt(0)" ::: "memory");
        } else {
            XB_SPIN(xb_ld(&bar[XB_XGEN(b.x)]) == gen, bar);
            __builtin_amdgcn_fence(__ATOMIC_ACQUIRE, "agent");
            asm volatile("s_waitcnt vmcnt(0)" ::: "memory");
        }
    }
    __syncthreads();
}

DEVI int chunk_row(int b, int c) { return c >= 16 ? b * 256 + (c - 16) : 2048 + b * 16 + c; }
DEVI int chunk_row_token(int cr) { return cr < 2048 ? (cr >> 8) * LP + (16 + (cr & 255)) * 16 : ((cr - 2048) >> 4) * LP + ((cr - 2048) & 15) * 16; }
DEVI int perm16(int k) { return (k & 3) | ((k & 4) << 1) | ((k & 8) >> 1); }

namespace pg8 {
#define PG8_LAS __attribute__((address_space(3)))
typedef unsigned short bf16_t;
typedef short bf16x8 __attribute__((ext_vector_type(8)));
typedef float f32x4 __attribute__((ext_vector_type(4)));
typedef unsigned u32x4 __attribute__((ext_vector_type(4)));
constexpr int BM = 256, BK = 64, HALF = 128, HTB = HALF * BK * 2  , STAGE_BYTES = 8 * HTB, NXCD = 8, WGM = 8;

__host__ __device__ __forceinline__ int lds_byte(int r, int c) { const int st = (r >> 4) * 2 + (c >> 5), rr = r & 15, cc = c & 31, ob = rr * 64 + cc * 2; return st * 1024 + (ob ^ (((ob >> 9) & 1) << 5)); }
__host__ __device__ __forceinline__ void stage_rc(int b, int& R, int& C) { const int st = b / 1024, sb = b % 1024, swz = sb ^ (((sb >> 9) & 1) << 5); R = (st >> 1) * 16 + swz / 64; C = (st & 1) * 32 + (swz % 64) / 2; }
__host__ __device__ __forceinline__ int perm32(int rho) { const int n = rho >> 4, i = rho & 15; return 8 * (i >> 2) + 4 * n + (i & 3); }

struct Unit { int pm, pn; };
struct Gemm { const bf16_t* A; const bf16_t* Bt; int M, N, K; const int* gidx = nullptr; int islot = 0; };
__device__ __forceinline__ unsigned cvt_pk_bf16(float lo, float hi) { unsigned r; asm volatile("v_cvt_pk_bf16_f32 %0, %1, %2" : "=v"(r) : "v"(lo), "v"(hi)); return r; }
template <class Epi, class Sched, bool ALIGN_EPI = false, bool SP2 = false, bool GATH = false>
__device__ __forceinline__ void gemm_phase(PG8_LAS unsigned char* lds, const Gemm g, const Sched& S, const Epi& E) {
    static_assert(!GATH || SP2, "the gathered-A form is written for the SP2 loop only");
    const int tid = tid_l(), wid = __builtin_amdgcn_readfirstlane(tid >> 6), lane = tid & 63, wr = wid >> 2, wc = wid & 3, fr = lane & 15, fq = lane >> 4;
    const int K = g.K, nt = K / BK;
    unsigned voffA[2], voffB[2];
    int stR[2], stC[2];
#pragma unroll
    for (int i = 0; i < 2; ++i) { int R, C; stage_rc(tid * 16 + i * 8192, R, C); const int Rb = Epi::PERM ? ((R & ~31) + perm32(R & 31)) : R; stR[i] = R; stC[i] = C;
        voffA[i] = (unsigned)(R * K + C) * 2u; voffB[i] = (unsigned)(Rb * K + C) * 2u; }
    unsigned goff[2][2], ngoff[2][2];
    const char* gA = (const char*)g.A;
    const size_t kstep = (size_t)(BK * 2);
    const size_t hstep = (size_t)HALF * K * 2;
    const size_t tstep = 2 * hstep;
    const unsigned ldsw = (unsigned)wid * 1024u;
    const int aoff = lds_byte(wr * 64 + fr, fq * 8), boff = lds_byte(wc * 32 + fr, fq * 8);
#define PG8_SA(b, h) (((b) * 2 + (h)) * HTB)
#define PG8_SB(b, h) ((4 + (b) * 2 + (h)) * HTB)
#define PG8_STAGE(bufoff, gbase, voff) do { _Pragma("unroll") for (int _i = 0; _i < 2; ++_i) \
        __builtin_amdgcn_global_load_lds((const unsigned*)((const char*)(gbase) + (voff)[_i]), (PG8_LAS unsigned*)(lds + (bufoff) + ldsw + _i * 8192), 16, 0, 0); } while (0)
#define PG8_STAGE_A(bufoff, selnext, kt, h) do { if constexpr (GATH) PG8_STAGE(bufoff, gA + (size_t)(kt) * kstep, ((selnext) ? ngoff[h] : goff[h])); \
        else PG8_STAGE(bufoff, ((selnext) ? nA : cA) + (size_t)(kt) * kstep + (size_t)(h) * hstep, voffA); } while (0)
#define PG8_LDA(dst, b, h) do { _Pragma("unroll") for (int m = 0; m < 4; ++m) _Pragma("unroll") for (int k = 0; k < 2; ++k) dst[m][k] = *(const PG8_LAS bf16x8*)(lds + PG8_SA(b, h) + aoff + m * 2048 + k * 1024); } while (0)
#define PG8_LDB(dst, b, h) do { _Pragma("unroll") for (int n = 0; n < 2; ++n) _Pragma("unroll") for (int k = 0; k < 2; ++k) dst[n][k] = *(const PG8_LAS bf16x8*)(lds + PG8_SB(b, h) + boff + n * 2048 + k * 1024); } while (0)
#define PG8_MMA(ai, bj, At, Bt) do { __builtin_amdgcn_s_setprio(1); _Pragma("unroll") for (int m = 0; m < 4; ++m) _Pragma("unroll") for (int n = 0; n < 2; ++n) _Pragma("unroll") for (int k = 0; k < 2; ++k) \
        acc[ai][bj][m][n] = __builtin_amdgcn_mfma_f32_16x16x32_bf16(Bt[n][k], At[m][k], acc[ai][bj][m][n], 0, 0, 0); __builtin_amdgcn_s_setprio(0); } while (0)
#define PG8_WAIT_V(n) asm volatile("s_waitcnt vmcnt(" #n ")" ::: "memory")
#define PG8_WAIT_L(n) asm volatile("s_waitcnt lgkmcnt(" #n ")" ::: "memory")
#define PG8_BAR __builtin_amdgcn_s_barrier()
#define PG8_SCHED __builtin_amdgcn_sched_barrier(0)
    Unit cur, nxt; int ui = 0;
    if (!S.next(0, cur)) return;
    f32x4 acc[2][2][4][2];
#pragma unroll
    for (int a = 0; a < 2; ++a)
#pragma unroll
        for (int b = 0; b < 2; ++b)
#pragma unroll
            for (int m = 0; m < 4; ++m)
#pragma unroll
                for (int n = 0; n < 2; ++n) acc[a][b][m][n] = (f32x4){0.f, 0.f, 0.f, 0.f};
    bf16x8 At[4][2], B0[2][2], B1[2][2];
    const char* cA = (const char*)g.A + (size_t)cur.pm * tstep; const char* cB = (const char*)g.Bt + (size_t)cur.pn * tstep;
    const char* nA = cA;
    if constexpr (GATH) {
#pragma unroll
        for (int h = 0; h < 2; ++h)
#pragma unroll
            for (int i = 0; i < 2; ++i) { goff[h][i] = (unsigned)(g.gidx[cur.pm * 256 + h * 128 + stR[i]] * K + stC[i]) * 2u; ngoff[h][i] = goff[h][i]; }
    }
    S.a_ready(cur);
    if constexpr (SP2) {
        PG8_STAGE(PG8_SB(0, 0), cB, voffB); PG8_STAGE(PG8_SB(0, 1), cB + hstep, voffB); PG8_STAGE_A(PG8_SA(0, 0), false, 0, 0); PG8_STAGE_A(PG8_SA(0, 1), false, 0, 1);
        if (wr == 1) PG8_BAR;
        PG8_WAIT_V(2); PG8_BAR;
        PG8_STAGE(PG8_SB(1, 0), cB + kstep, voffB); PG8_STAGE_A(PG8_SA(1, 0), false, 1, 0); PG8_STAGE(PG8_SB(1, 1), cB + hstep + kstep, voffB);
        PG8_WAIT_V(6); PG8_BAR;
    } else {
        PG8_STAGE(PG8_SB(0, 0), cB, voffB); PG8_STAGE(PG8_SA(0, 0), cA, voffA); PG8_STAGE(PG8_SB(0, 1), cB + hstep, voffB); PG8_STAGE(PG8_SA(0, 1), cA + hstep, voffA);
        if (wr == 1) PG8_BAR;
        PG8_WAIT_V(4); PG8_BAR;
        PG8_STAGE(PG8_SB(1, 0), cB + kstep, voffB); PG8_STAGE(PG8_SA(1, 0), cA + kstep, voffA); PG8_STAGE(PG8_SB(1, 1), cB + hstep + kstep, voffB);
        PG8_WAIT_V(6); PG8_BAR;
    }
    for (;;) {
        const bool has_next = S.next(ui + 1, nxt);
        nA = has_next ? (const char*)g.A + (size_t)nxt.pm * tstep : cA; const char* nB = has_next ? (const char*)g.Bt + (size_t)nxt.pn * tstep : cB;
        if constexpr (GATH) {
            if (has_next) {
#pragma unroll
                for (int h = 0; h < 2; ++h)
#pragma unroll
                    for (int i = 0; i < 2; ++i)
                        __builtin_amdgcn_global_load_lds((const unsigned*)(g.gidx + nxt.pm * 256 + h * 128 + stR[i]), (PG8_LAS unsigned*)(lds + g.islot + ((ui + 1) & 1) * 8192 + (h * 2 + i) * 2048 + wid * 256), 4, 0, 0);
            }
        }
        for (int t = 0; t < nt; t += 2) {
            const bool last = (t == nt - 2);
            if constexpr (GATH) {
                if (last) {
                    if (has_next) {
#pragma unroll
                        for (int h = 0; h < 2; ++h)
#pragma unroll
                            for (int i = 0; i < 2; ++i) { const int ix = *(const PG8_LAS int*)(lds + g.islot + ((ui + 1) & 1) * 8192 + (h * 2 + i) * 2048 + wid * 256 + lane * 4); ngoff[h][i] = (unsigned)(ix * K + stC[i]) * 2u; }
                    } else {
#pragma unroll
                        for (int h = 0; h < 2; ++h)
#pragma unroll
                            for (int i = 0; i < 2; ++i) ngoff[h][i] = goff[h][i];
                    }
                }
            }
            const char* a1 = cA + (size_t)(t + 1) * kstep;
            const char* a2 = last ? nA : cA + (size_t)(t + 2) * kstep; const char* b2 = last ? nB : cB + (size_t)(t + 2) * kstep;
            const char* a3 = a2 + kstep; const char* b3 = b2 + kstep;
            if (last && has_next) S.a_ready(nxt);
            if constexpr (SP2) {
            PG8_LDB(B0, 0, 0); PG8_LDB(B1, 0, 1); PG8_SCHED; PG8_LDA(At, 0, 0); PG8_STAGE_A(PG8_SA(1, 1), false, t + 1, 1);
            PG8_WAIT_V(8); PG8_WAIT_L(0); PG8_BAR; PG8_MMA(0, 0, At, B0); PG8_MMA(0, 1, At, B1); PG8_BAR; PG8_SCHED;
            PG8_LDA(At, 0, 1); PG8_STAGE(PG8_SB(0, 0), b2, voffB); PG8_STAGE(PG8_SB(0, 1), b2 + hstep, voffB); PG8_STAGE_A(PG8_SA(0, 0), last, last ? 0 : t + 2, 0);
            PG8_WAIT_V(8); PG8_WAIT_L(0); PG8_BAR; PG8_MMA(1, 0, At, B0); PG8_MMA(1, 1, At, B1); PG8_BAR; PG8_SCHED;
            PG8_LDB(B0, 1, 0); PG8_LDB(B1, 1, 1); PG8_SCHED; PG8_LDA(At, 1, 0); PG8_STAGE_A(PG8_SA(0, 1), last, last ? 0 : t + 2, 1);
            PG8_WAIT_V(8); PG8_WAIT_L(0); PG8_BAR; PG8_MMA(0, 0, At, B0); PG8_MMA(0, 1, At, B1); PG8_BAR; PG8_SCHED;
            PG8_LDA(At, 1, 1); PG8_STAGE(PG8_SB(1, 0), b3, voffB); PG8_STAGE(PG8_SB(1, 1), b3 + hstep, voffB); PG8_STAGE_A(PG8_SA(1, 0), last, last ? 1 : t + 3, 0);
            PG8_WAIT_V(8); PG8_WAIT_L(0); PG8_BAR; PG8_MMA(1, 0, At, B0); PG8_MMA(1, 1, At, B1); PG8_BAR; PG8_SCHED;
            } else {
            PG8_LDB(B0, 0, 0); PG8_SCHED; PG8_LDA(At, 0, 0); PG8_STAGE(PG8_SA(1, 1), a1 + hstep, voffA);
            PG8_WAIT_L(8); PG8_BAR; PG8_WAIT_L(0); PG8_MMA(0, 0, At, B0); PG8_BAR; PG8_SCHED;
            PG8_LDB(B1, 0, 1); PG8_STAGE(PG8_SB(0, 0), b2, voffB);
            PG8_BAR; PG8_WAIT_L(0); PG8_MMA(0, 1, At, B1); PG8_BAR;
            PG8_LDA(At, 0, 1); PG8_STAGE(PG8_SA(0, 0), a2, voffA);
            PG8_BAR; PG8_WAIT_L(0); PG8_MMA(1, 0, At, B0); PG8_BAR; PG8_SCHED;
            PG8_STAGE(PG8_SB(0, 1), b2 + hstep, voffB);
            PG8_WAIT_V(6); PG8_BAR; PG8_MMA(1, 1, At, B1); PG8_BAR;
            PG8_LDB(B0, 1, 0); PG8_SCHED; PG8_LDA(At, 1, 0); PG8_STAGE(PG8_SA(0, 1), a2 + hstep, voffA);
            PG8_WAIT_L(8); PG8_BAR; PG8_WAIT_L(0); PG8_MMA(0, 0, At, B0); PG8_BAR; PG8_SCHED;
            PG8_LDB(B1, 1, 1); PG8_STAGE(PG8_SB(1, 0), b3, voffB);
            PG8_BAR; PG8_WAIT_L(0); PG8_MMA(0, 1, At, B1); PG8_BAR;
            PG8_LDA(At, 1, 1); PG8_STAGE(PG8_SA(1, 0), a3, voffA);
            PG8_BAR; PG8_WAIT_L(0); PG8_MMA(1, 0, At, B0); PG8_BAR; PG8_SCHED;
            PG8_STAGE(PG8_SB(1, 1), b3 + hstep, voffB);
            PG8_WAIT_V(6); PG8_BAR; PG8_MMA(1, 1, At, B1); PG8_BAR;
            }
        }
        if constexpr (ALIGN_EPI) { if (wr == 0) PG8_BAR; }
        if constexpr (!Epi::AFTER_DRAIN) { E(acc, cur, wr, wc, fr, fq); S.done(cur); }
        if (!has_next) break;
#pragma unroll
        for (int a = 0; a < 2; ++a)
#pragma unroll
            for (int b = 0; b < 2; ++b)
#pragma unroll
                for (int m = 0; m < 4; ++m)
#pragma unroll
                    for (int n = 0; n < 2; ++n) acc[a][b][m][n] = (f32x4){0.f, 0.f, 0.f, 0.f};
        cur = nxt; cA = nA; cB = nB; ++ui;
        if constexpr (GATH) {
#pragma unroll
            for (int h = 0; h < 2; ++h)
#pragma unroll
                for (int i = 0; i < 2; ++i) goff[h][i] = ngoff[h][i];
        }
        if constexpr (ALIGN_EPI) { if (wr == 1) PG8_BAR; }
    }
    PG8_WAIT_V(0);
    if constexpr (!ALIGN_EPI) { if (wr == 0) PG8_BAR; }
    PG8_BAR;
    if constexpr (Epi::AFTER_DRAIN) { E.fused(acc, cur, wr, wc, fr, fq, lds, wid, lane); S.done(cur); }
#undef PG8_SA
#undef PG8_SB
#undef PG8_STAGE
#undef PG8_STAGE_A
#undef PG8_LDA
#undef PG8_LDB
#undef PG8_MMA
#undef PG8_WAIT_V
#undef PG8_WAIT_L
#undef PG8_BAR
#undef PG8_SCHED
}
}


struct TileOrder {
    int nunits, G, c, npm, npn, pn_gs, pm_gs, pm_off, blk48 = 0;
    DEVI bool next(int i, pg8::Unit& u) const {
        const int L = i * G + c; if (L >= nunits) return false;
        const int per = npm * npn, e = L / per, v = L - e * per; int pml = v / npn, pnl = v - pml * npn;
        if (blk48 && v < 256) { const int blk = v >> 5, w = v & 31; pml = (blk >> 1) * 4 + (w >> 3); pnl = (blk & 1) * 8 + (w & 7); }
        u.pm = e * pm_gs + pm_off + pml; u.pn = e * pn_gs + pnl; return true;
    }
    DEVI void a_ready(const pg8::Unit&) const {}
    DEVI void done(const pg8::Unit&) const {}
};

struct Epi8Inproj { static constexpr bool PERM = false, AFTER_DRAIN = false;
    bf16_t* QK; bf16_t* VT; bf16_t* UG; const float* rope;
    DEVI void operator()(const f32x4 (&acc)[2][2][4][2], const pg8::Unit& u, int wr, int wc, int fr, int fq) const {
        const int pn = u.pn;
#pragma unroll
        for (int ai = 0; ai < 2; ++ai)
#pragma unroll
            for (int m = 0; m < 4; ++m) {
                const int r = u.pm * 256 + ai * 128 + wr * 64 + m * 16 + fr, b = r / LP, p = r - b * LP; const bool latent = p >= CTXL; const int t = p - CTXL;
#pragma unroll
                for (int bj = 0; bj < 2; ++bj) {
                    const int cb = bj * 128 + wc * 32;
                    if (pn < 4) {
                        const int head = cb >> 6, dbase = cb & 63, pos = dbase == 0 ? (t >> 6) : (t & 63);
                        const float sc = pn < 2 ? QSCALE : 1.f;
                        f32x4 cs0 = {1.f, 0.f, 1.f, 0.f}, cs1 = {1.f, 0.f, 1.f, 0.f};
                        if (latent) { cs0 = *(const f32x4*)(rope + (pos * 16 + 4 * fq) * 2); cs1 = *(const f32x4*)(rope + (pos * 16 + 4 * fq + 2) * 2); }
                        const float cc[4] = {cs0.x, cs0.z, cs1.x, cs1.z}, sn[4] = {cs0.y, cs0.w, cs1.y, cs1.w};
                        bf16_t* dst = QK + ((size_t)((pn * NB + b) * NH + head) * LP + p) * 64 + dbase + 4 * fq;
#pragma unroll
                        for (int n = 0; n < 2; ++n) {
                            float o[4];
#pragma unroll
                            for (int j = 0; j < 4; ++j) { const float x = acc[ai][bj][m][n][j], y = acc[ai][bj][m][n ^ 1][j]; o[j] = (n == 0 ? x * cc[j] - y * sn[j] : x * cc[j] + y * sn[j]) * sc; }
                            u32x2 w; w.x = pk2(o[0], o[1]); w.y = pk2(o[2], o[3]);
                            *(u32x2*)(dst + 16 * n) = w;
                        }
                    } else if (pn < 6) {
                        const int cv = (pn - 4) * 256 + cb, head = cv >> 7, dv0 = (cv & 127) + 4 * fq;
                        const int pp = (p & ~15) | perm16(p & 15);
                        bf16_t* dst = VT + ((size_t)(b * NH + head) * 128 + dv0) * LP + pp;
#pragma unroll
                        for (int n = 0; n < 2; ++n)
#pragma unroll
                            for (int j = 0; j < 4; ++j) dst[(size_t)(16 * n + j) * LP] = f2bf(acc[ai][bj][m][n][j]);
                    } else {
                        const int ch0 = (pn - 6) * 256 + cb;
                        bf16_t* dst = UG + (size_t)chunk_row(b, p >> 4) * 512 + (p & 15) * 16 + 4 * fq;
#pragma unroll
                        for (int n = 0; n < 2; ++n) {
                            const int g = (ch0 + 16 * n) >> 4;
                            u32x2 w; w.x = pk2(acc[ai][bj][m][n][0], acc[ai][bj][m][n][1]); w.y = pk2(acc[ai][bj][m][n][2], acc[ai][bj][m][n][3]);
                            *(u32x2*)(dst + (size_t)g * NCHP * 512) = w;
                        }
                    }
                }
            }
    }
};

struct Epi8Out { static constexpr bool PERM = true, AFTER_DRAIN = false;
    bf16_t* X; const float* mod;
    DEVI void operator()(const f32x4 (&acc)[2][2][4][2], const pg8::Unit& u, int wr, int wc, int fr, int fq) const {
#pragma unroll
        for (int ai = 0; ai < 2; ++ai)
#pragma unroll
            for (int m = 0; m < 4; ++m) {
                const int r = u.pm * 256 + ai * 128 + wr * 64 + m * 16 + fr, b = r / LP, p = r - b * LP, jm = p < CTXL ? 8 : b;
                const float* g1 = mod + (size_t)jm * 6144 + 2 * 1024;
#pragma unroll
                for (int bj = 0; bj < 2; ++bj) {
                    const int c = u.pn * 256 + bj * 128 + wc * 32 + 8 * fq;
                    bf16_t* xp = X + (size_t)r * 1024 + c;
                    const u32x4 xw = *(const u32x4*)xp;
                    const f32x4 g0 = *(const f32x4*)(g1 + c), g4 = *(const f32x4*)(g1 + c + 4);
                    const f32x4 o0 = hf4((u32x2){xw.x, xw.y}) + g0 * acc[ai][bj][m][0], o1 = hf4((u32x2){xw.z, xw.w}) + g4 * acc[ai][bj][m][1];
                    u32x4 w; w.x = hpk2(o0.x, o0.y); w.y = hpk2(o0.z, o0.w); w.z = hpk2(o1.x, o1.y); w.w = hpk2(o1.z, o1.w);
                    *(u32x4*)xp = w;
                }
            }
    }
};

struct Epi8Moe1 { static constexpr bool PERM = true, AFTER_DRAIN = false;
    bf16_t* HG;
    DEVI void operator()(const f32x4 (&acc)[2][2][4][2], const pg8::Unit& u, int wr, int wc, int fr, int fq) const {
        const int t = u.pn & 15;
#pragma unroll
        for (int ai = 0; ai < 2; ++ai)
#pragma unroll
            for (int m = 0; m < 4; ++m) {
                const size_t row = (size_t)u.pm * 256 + ai * 128 + wr * 64 + m * 16 + fr;
                float o[8];
#pragma unroll
                for (int n = 0; n < 2; ++n)
#pragma unroll
                    for (int j = 0; j < 4; ++j) { const float a1 = acc[ai][0][m][n][j], a3 = acc[ai][1][m][n][j]; o[4 * n + j] = a1 * sigmoidf_(a1) * a3; }
                u32x4 w; w.x = pk2(o[0], o[1]); w.y = pk2(o[2], o[3]); w.z = pk2(o[4], o[5]); w.w = pk2(o[6], o[7]);
                *(u32x4*)(HG + row * FF + t * 128 + wc * 32 + 8 * fq) = w;
            }
    }
};

struct Epi8Moe2 { static constexpr bool PERM = true, AFTER_DRAIN = false;
    bf16_t* OG; const float* gate;
    DEVI void operator()(const f32x4 (&acc)[2][2][4][2], const pg8::Unit& u, int wr, int wc, int fr, int fq) const {
        const int t = u.pn & 3;
#pragma unroll
        for (int ai = 0; ai < 2; ++ai)
#pragma unroll
            for (int m = 0; m < 4; ++m) {
                const size_t row = (size_t)u.pm * 256 + ai * 128 + wr * 64 + m * 16 + fr; const float gt = gate[row];
#pragma unroll
                for (int bj = 0; bj < 2; ++bj) {
                    const f32x4 a = acc[ai][bj][m][0] * gt, c = acc[ai][bj][m][1] * gt;
                    u32x4 w; w.x = pk2(a.x, a.y); w.y = pk2(a.z, a.w); w.z = pk2(c.x, c.y); w.w = pk2(c.z, c.w);
                    *(u32x4*)(OG + row * 1024 + t * 256 + bj * 128 + wc * 32 + 8 * fq) = w;
                }
            }
    }
};

struct Epi8S1 { static constexpr bool PERM = true, AFTER_DRAIN = false;
    unsigned short* E;
    DEVI void operator()(const f32x4 (&acc)[2][2][4][2], const pg8::Unit& u, int wr, int wc, int fr, int fq) const {
        const int g = u.pn, r0 = (u.pm - g * 9) * 256 + wr * 64 + fr;
#pragma unroll
        for (int ai = 0; ai < 2; ++ai)
#pragma unroll
            for (int m = 0; m < 4; ++m) {
                const int cr = r0 + ai * 128 + m * 16;
                if (cr < NCH) {
                    unsigned short* dst = E + ((size_t)g * NCHP + cr) * 256 + wc * 32 + 8 * fq;
#pragma unroll
                    for (int bj = 0; bj < 2; ++bj) {
                        const f32x4 a = acc[ai][bj][m][0], d = acc[ai][bj][m][1];
                        u32x4 w; w.x = hpk2(a.x, a.y); w.y = hpk2(a.z, a.w); w.z = hpk2(d.x, d.y); w.w = hpk2(d.z, d.w);
                        *(u32x4*)(dst + bj * 128) = w;
                    }
                }
            }
    }
};
struct Epi8S2 { static constexpr bool PERM = true, AFTER_DRAIN = false;
    bf16_t* YG;
    DEVI void operator()(const f32x4 (&acc)[2][2][4][2], const pg8::Unit& u, int wr, int wc, int fr, int fq) const {
        const int g = u.pn, r0 = (u.pm - g * 9) * 256 + wr * 64 + fr;
#pragma unroll
        for (int ai = 0; ai < 2; ++ai)
#pragma unroll
            for (int m = 0; m < 4; ++m) {
                const int cr = r0 + ai * 128 + m * 16;
                if (cr < NCH) {
                    const size_t tok0 = (size_t)chunk_row_token(cr);
#pragma unroll
                    for (int bj = 0; bj < 2; ++bj) {
                        const int col = bj * 128 + wc * 32 + 8 * fq, j = col >> 4, h = col & 15;
                        const f32x4 a = acc[ai][bj][m][0], d = acc[ai][bj][m][1];
                        u32x4 w; w.x = pk2(gelu_tanh(a.x), gelu_tanh(a.y)); w.y = pk2(gelu_tanh(a.z), gelu_tanh(a.w)); w.z = pk2(gelu_tanh(d.x), gelu_tanh(d.y)); w.w = pk2(gelu_tanh(d.z), gelu_tanh(d.w));
                        *(u32x4*)(YG + (tok0 + j) * 512 + g * 16 + h) = w;
                    }
                }
            }
    }
};
struct Epi8Glu { static constexpr bool PERM = true, AFTER_DRAIN = false;
    const bf16_t* YG; bf16_t* MIX; const float* bglu;
    DEVI void operator()(const f32x4 (&acc)[2][2][4][2], const pg8::Unit& u, int wr, int wc, int fr, int fq) const {
#pragma unroll
        for (int ai = 0; ai < 2; ++ai)
#pragma unroll
            for (int m = 0; m < 4; ++m) {
                const size_t tok = (size_t)u.pm * 256 + ai * 128 + wr * 64 + m * 16 + fr;
#pragma unroll
                for (int bj = 0; bj < 2; ++bj) {
                    const int n0 = u.pn * 256 + bj * 128 + wc * 32 + 8 * fq;
                    const u32x4 y = *(const u32x4*)(YG + tok * 512 + n0);
                    const f32x4 b0 = *(const f32x4*)(bglu + n0), b1 = *(const f32x4*)(bglu + n0 + 4);
                    const f32x4 a = acc[ai][bj][m][0] + b0, d = acc[ai][bj][m][1] + b1;
                    u32x4 w; w.x = pk2(bflo(y.x) * sigmoidf_(a.x), bfhi(y.x) * sigmoidf_(a.y)); w.y = pk2(bflo(y.y) * sigmoidf_(a.z), bfhi(y.y) * sigmoidf_(a.w));
                    w.z = pk2(bflo(y.z) * sigmoidf_(d.x), bfhi(y.z) * sigmoidf_(d.y)); w.w = pk2(bflo(y.w) * sigmoidf_(d.z), bfhi(y.w) * sigmoidf_(d.w));
                    *(u32x4*)(MIX + tok * 1024 + 512 + n0) = w;
                }
            }
    }
};

struct Params {
    const float* in[30];
    float* out;
    unsigned char* ws;
    int lo, hi;
};

DEVI int swz(int row, int kc) { return row * 128 + ((kc ^ ((row >> 1) & 7)) << 4); }

struct APlain { const bf16_t* A; int lda; DEVI const bf16_t* ptr(int row, int k) const { return A + (size_t)row * lda + k; } };
struct AS2 { const bf16_t* U; const bf16_t* S; DEVI const bf16_t* ptr(int row, int k) const { return (k < 256 ? U : S) + (size_t)row * 8192 + (k & 255); } };

template <int BM, class AF, class Epi>
DEVI void gemm_unit(char* lds, const AF& af, const bf16_t* __restrict__ Bt, int ldb, int K, int m0, int n0, const Epi& epi) {
    constexpr int MT = BM / 128, ACH = BM / 64, A_BYTES = BM * 128, STAGE = A_BYTES + 16384, WM = BM / 4;
    const int tid = tid_l(), lane = tid & 63, wid = tid >> 6, wm = wid >> 1, wn = wid & 1, r32 = lane & 31, hi = lane >> 5;
    f32x16 acc[MT][2];
#pragma unroll
    for (int a = 0; a < MT; ++a)
#pragma unroll
        for (int b = 0; b < 2; ++b)
#pragma unroll
            for (int i = 0; i < 16; ++i) acc[a][b][i] = 0.f;
    u32x4 ra[ACH], rb[2];
    const int nk = K >> 6;
    const int crow = tid >> 3, ckc = tid & 7;
#define G_LOAD(kt) do { \
        _Pragma("unroll") for (int i = 0; i < ACH; ++i) ra[i] = *(const u32x4*)af.ptr(m0 + crow + 64 * i, (kt) * 64 + ckc * 8); \
        _Pragma("unroll") for (int i = 0; i < 2; ++i) rb[i] = *(const u32x4*)(Bt + (size_t)(n0 + crow + 64 * i) * ldb + (kt) * 64 + ckc * 8); } while (0)
#define G_STORE(s) do { char* _a = lds + (s) * STAGE; char* _b = _a + A_BYTES; \
        _Pragma("unroll") for (int i = 0; i < ACH; ++i) *(u32x4*)(_a + swz(crow + 64 * i, ckc)) = ra[i]; \
        _Pragma("unroll") for (int i = 0; i < 2; ++i) *(u32x4*)(_b + swz(crow + 64 * i, ckc)) = rb[i]; } while (0)
    G_LOAD(0); G_STORE(0); __syncthreads();
    for (int kt = 0; kt < nk; ++kt) {
        if (kt + 1 < nk) G_LOAD(kt + 1);
        const char* a = lds + (kt & 1) * STAGE; const char* b = a + A_BYTES;
#pragma unroll
        for (int ks = 0; ks < 4; ++ks) {
            bf16x8 wf[2], xf[MT];
#pragma unroll
            for (int nt = 0; nt < 2; ++nt) wf[nt] = *(const bf16x8*)(b + swz(wn * 64 + nt * 32 + r32, ks * 2 + hi));
#pragma unroll
            for (int mt = 0; mt < MT; ++mt) xf[mt] = *(const bf16x8*)(a + swz(wm * WM + mt * 32 + r32, ks * 2 + hi));
#pragma unroll
            for (int mt = 0; mt < MT; ++mt)
#pragma unroll
                for (int nt = 0; nt < 2; ++nt) acc[mt][nt] = MFMA32(wf[nt], xf[mt], acc[mt][nt]);
        }
        if (kt + 1 < nk) G_STORE((kt + 1) & 1);
        __syncthreads();
    }
#undef G_LOAD
#undef G_STORE
    epi.template run<MT>(acc, m0 + wm * WM + r32, n0 + wn * 64, hi);
}

template <class AF, class Epi>
DEVI void gemm_unit_dma(char* lds, const AF& af, const bf16_t* __restrict__ Bt, int ldb, int K, int m0, int n0, const Epi& epi) {
    const int tid = tid_l(), lane = tid & 63, wid = tid >> 6, wm = wid >> 1, wn = wid & 1, r32 = lane & 31, hi = lane >> 5;
    f32x16 acc[1][2];
#pragma unroll
    for (int b = 0; b < 2; ++b)
#pragma unroll
        for (int i = 0; i < 16; ++i) acc[0][b][i] = 0.f;
    const int nk = K >> 6;
    const int drow0 = wid * 16 + (lane >> 3), drow1 = drow0 + 8;
    const int kc0 = (lane & 7) ^ ((drow0 >> 1) & 7), kc1 = (lane & 7) ^ ((drow1 >> 1) & 7);
    const bf16_t* ga0 = af.ptr(m0 + drow0, kc0 * 8); const bf16_t* ga1 = af.ptr(m0 + drow1, kc1 * 8);
    const bf16_t* gb0 = Bt + (size_t)(n0 + drow0) * ldb + kc0 * 8; const bf16_t* gb1 = Bt + (size_t)(n0 + drow1) * ldb + kc1 * 8;
    LAS unsigned char* dl = (LAS unsigned char*)lds + wid * 2048;
#define GD_LDS(g, off) __builtin_amdgcn_global_load_lds((const unsigned*)(g), (LAS unsigned*)(dl + (off)), 16, 0, 0)
#define GD_ISSUE(kt) do { const int _s = ((kt) & 3) * 32768; GD_LDS(ga0 + (kt) * 64, _s); GD_LDS(ga1 + (kt) * 64, _s + 1024); GD_LDS(gb0 + (kt) * 64, _s + 16384); GD_LDS(gb1 + (kt) * 64, _s + 16384 + 1024); } while (0)
#define GD_WAITBAR(N) asm volatile("s_waitcnt vmcnt(" #N ") lgkmcnt(0)\n\ts_barrier" ::: "memory")
    GD_ISSUE(0); GD_ISSUE(1); GD_ISSUE(2);
    for (int kt = 0; kt < nk; ++kt) {
        if (kt + 2 < nk) GD_WAITBAR(8); else if (kt + 1 < nk) GD_WAITBAR(4); else GD_WAITBAR(0);
        if (kt + 3 < nk) GD_ISSUE(kt + 3);
        const char* a = lds + (kt & 3) * 32768; const char* b = a + 16384;
#pragma unroll
        for (int ks = 0; ks < 4; ++ks) {
            bf16x8 wf[2], xf;
#pragma unroll
            for (int nt = 0; nt < 2; ++nt) wf[nt] = *(const bf16x8*)(b + swz(wn * 64 + nt * 32 + r32, ks * 2 + hi));
            xf = *(const bf16x8*)(a + swz(wm * 32 + r32, ks * 2 + hi));
#pragma unroll
            for (int nt = 0; nt < 2; ++nt) acc[0][nt] = MFMA32(wf[nt], xf, acc[0][nt]);
        }
    }
#undef GD_LDS
#undef GD_ISSUE
#undef GD_WAITBAR
    __syncthreads();
    epi.template run<1>(acc, m0 + wm * 32 + r32, n0 + wn * 64, hi);
}


struct EpiInproj {
    bf16_t* QK; bf16_t* VT; bf16_t* UG; const float* rope;
    template <int MT> DEVI void run(const f32x16 (&acc)[MT][2], int mrow0, int ncol0, int hi) const {
#pragma unroll
        for (int mt = 0; mt < MT; ++mt) {
            const int r = mrow0 + mt * 32, b = r / LP, p = r - b * LP; const bool latent = p >= CTXL; const int t = p - CTXL;
#pragma unroll
            for (int nt = 0; nt < 2; ++nt) {
                const int nb = ncol0 + nt * 32; const f32x16& v = acc[mt][nt];
                if (nb < 1024) {
                    const int which = nb >> 8, head = (nb >> 6) & 3, dbase = nb & 63;
                    const int pos = dbase == 0 ? (t >> 6) : (t & 63);
                    bf16_t* dst = QK + ((size_t)((which * NB + b) * NH + head) * LP + p) * 64 + dbase + 4 * hi;
                    const float sc = which < 2 ? QSCALE : 1.f;
#pragma unroll
                    for (int i4 = 0; i4 < 4; ++i4) {
                        float o[4];
#pragma unroll
                        for (int j = 0; j < 4; ++j) {
                            float x = v[4 * i4 + j];
                            if (latent) {
                                const float y = v[4 * (i4 ^ 2) + j];
                                const f32x2 cs = *(const f32x2*)(rope + (pos * 16 + 8 * (i4 & 1) + 4 * hi + j) * 2);
                                x = (i4 < 2) ? (x * cs.x - y * cs.y) : (x * cs.x + y * cs.y);
                            }
                            o[j] = x * sc;
                        }
                        u32x2 w; w.x = pk2(o[0], o[1]); w.y = pk2(o[2], o[3]);
                        *(u32x2*)(dst + 8 * i4) = w;
                    }
                } else if (nb < 1536) {
                    const int n1 = nb - 1024, head = n1 >> 7, dv0 = n1 & 127;
                    const int pp = (p & ~15) | perm16(p & 15);
                    bf16_t* dst = VT + ((size_t)(b * NH + head) * 128 + dv0 + 4 * hi) * LP + pp;
#pragma unroll
                    for (int i = 0; i < 16; ++i) dst[(size_t)((i & 3) + 8 * (i >> 2)) * LP] = f2bf(v[i]);
                } else {
                    const int n1 = nb - 1536;
                    bf16_t* dst = UG + (size_t)chunk_row(b, p >> 4) * 512 + (p & 15) * 16;
#pragma unroll
                    for (int i4 = 0; i4 < 4; ++i4) {
                        const int ch = n1 + 8 * i4 + 4 * hi, g = ch >> 4, hc = ch & 15;
                        u32x2 w; w.x = pk2(v[4 * i4], v[4 * i4 + 1]); w.y = pk2(v[4 * i4 + 2], v[4 * i4 + 3]);
                        *(u32x2*)(dst + (size_t)g * NCHP * 512 + hc) = w;
                    }
                }
            }
        }
    }
};

struct EpiS1 {
    unsigned short* E;
    template <int MT> DEVI void run(const f32x16 (&acc)[MT][2], int mrow0, int ncol0, int hi) const {
#pragma unroll
        for (int mt = 0; mt < MT; ++mt) {
            unsigned short* dst = E + (size_t)(mrow0 + mt * 32) * 256 + ncol0 + 4 * hi;
#pragma unroll
            for (int nt = 0; nt < 2; ++nt)
#pragma unroll
                for (int i4 = 0; i4 < 4; ++i4) {
                    u32x2 w; w.x = hpk2(acc[mt][nt][4 * i4], acc[mt][nt][4 * i4 + 1]); w.y = hpk2(acc[mt][nt][4 * i4 + 2], acc[mt][nt][4 * i4 + 3]);
                    *(u32x2*)(dst + nt * 32 + 8 * i4) = w;
                }
        }
    }
};

struct EpiS2 {
    bf16_t* YG; int g;
    template <int MT> DEVI void run(const f32x16 (&acc)[MT][2], int mrow0, int ncol0, int hi) const {
#pragma unroll
        for (int mt = 0; mt < MT; ++mt) {
            const size_t tok0 = (size_t)chunk_row_token(mrow0 + mt * 32);
#pragma unroll
            for (int nt = 0; nt < 2; ++nt)
#pragma unroll
                for (int i4 = 0; i4 < 4; ++i4) {
                    const int n = ncol0 + nt * 32 + 8 * i4 + 4 * hi, j = n >> 4, h = n & 15;
                    u32x2 w; w.x = pk2(gelu_tanh(acc[mt][nt][4 * i4]), gelu_tanh(acc[mt][nt][4 * i4 + 1]));
                    w.y = pk2(gelu_tanh(acc[mt][nt][4 * i4 + 2]), gelu_tanh(acc[mt][nt][4 * i4 + 3]));
                    *(u32x2*)(YG + (tok0 + j) * 512 + g * 16 + h) = w;
                }
        }
    }
};

struct EpiGlu {
    const bf16_t* YG; bf16_t* MIX; const float* bglu;
    template <int MT> DEVI void run(const f32x16 (&acc)[MT][2], int mrow0, int ncol0, int hi) const {
#pragma unroll
        for (int mt = 0; mt < MT; ++mt) {
            const size_t tok = mrow0 + mt * 32;
#pragma unroll
            for (int nt = 0; nt < 2; ++nt)
#pragma unroll
                for (int i4 = 0; i4 < 4; ++i4) {
                    const int n = ncol0 + nt * 32 + 8 * i4 + 4 * hi;
                    const u32x2 y = *(const u32x2*)(YG + tok * 512 + n);
                    const f32x4 bb = *(const f32x4*)(bglu + n);
                    const float o0 = bflo(y.x) * sigmoidf_(acc[mt][nt][4 * i4] + bb.x), o1 = bfhi(y.x) * sigmoidf_(acc[mt][nt][4 * i4 + 1] + bb.y);
                    const float o2 = bflo(y.y) * sigmoidf_(acc[mt][nt][4 * i4 + 2] + bb.z), o3 = bfhi(y.y) * sigmoidf_(acc[mt][nt][4 * i4 + 3] + bb.w);
                    u32x2 w; w.x = pk2(o0, o1); w.y = pk2(o2, o3);
                    *(u32x2*)(MIX + tok * 1024 + 512 + n) = w;
                }
        }
    }
};

struct EpiOut {
    bf16_t* X; const float* mod;
    template <int MT> DEVI void run(const f32x16 (&acc)[MT][2], int mrow0, int ncol0, int hi) const {
#pragma unroll
        for (int mt = 0; mt < MT; ++mt) {
            const int r = mrow0 + mt * 32, b = r / LP, p = r - b * LP, j = p < CTXL ? 8 : b;
            const float* g1 = mod + (size_t)j * 6144 + 2 * 1024;
#pragma unroll
            for (int nt = 0; nt < 2; ++nt)
#pragma unroll
                for (int i4 = 0; i4 < 4; ++i4) {
                    const int n = ncol0 + nt * 32 + 8 * i4 + 4 * hi;
                    bf16_t* xp = X + (size_t)r * 1024 + n;
                    f32x4 x = hf4(*(const u32x2*)xp); const f32x4 g = *(const f32x4*)(g1 + n);
                    x.x += g.x * acc[mt][nt][4 * i4]; x.y += g.y * acc[mt][nt][4 * i4 + 1]; x.z += g.z * acc[mt][nt][4 * i4 + 2]; x.w += g.w * acc[mt][nt][4 * i4 + 3];
                    u32x2 w; w.x = hpk2(x.x, x.y); w.y = hpk2(x.z, x.w);
                    *(u32x2*)xp = w;
                }
        }
    }
};

struct EpiMoe1 {
    bf16_t* HG;
    template <int MT> DEVI void run(const f32x16 (&acc)[MT][2], int mrow0, int ncol0, int hi) const {
#pragma unroll
        for (int mt = 0; mt < MT; ++mt) {
            bf16_t* dst = HG + (size_t)(mrow0 + mt * 32) * FF + (ncol0 >> 1) + 4 * hi;
#pragma unroll
            for (int i4 = 0; i4 < 4; ++i4) {
                float o[4];
#pragma unroll
                for (int j = 0; j < 4; ++j) { const float a1 = acc[mt][0][4 * i4 + j], a3 = acc[mt][1][4 * i4 + j]; o[j] = a1 * sigmoidf_(a1) * a3; }
                u32x2 w; w.x = pk2(o[0], o[1]); w.y = pk2(o[2], o[3]);
                *(u32x2*)(dst + 8 * i4) = w;
            }
        }
    }
};

struct EpiMoe2 {
    bf16_t* OG; const float* gate;
    template <int MT> DEVI void run(const f32x16 (&acc)[MT][2], int mrow0, int ncol0, int hi) const {
#pragma unroll
        for (int mt = 0; mt < MT; ++mt) {
            const int row = mrow0 + mt * 32; const float gt = gate[row];
            bf16_t* dst = OG + (size_t)row * 1024 + ncol0 + 4 * hi;
#pragma unroll
            for (int nt = 0; nt < 2; ++nt)
#pragma unroll
                for (int i4 = 0; i4 < 4; ++i4) {
                    u32x2 w; w.x = pk2(acc[mt][nt][4 * i4] * gt, acc[mt][nt][4 * i4 + 1] * gt); w.y = pk2(acc[mt][nt][4 * i4 + 2] * gt, acc[mt][nt][4 * i4 + 3] * gt);
                    *(u32x2*)(dst + nt * 32 + 8 * i4) = w;
                }
        }
    }
};

DEVI void transpose_unit(char* lds, const float* __restrict__ W, int K, int N, bf16_t* __restrict__ out, int k0, int n0, int mode  ) {
    float* tile = (float*)lds;
    const int tid = tid_l();
    f32x4 v[8];
#pragma unroll
    for (int i = 0; i < 8; ++i) { const int c = tid + 512 * i, k = c >> 6, n4 = (c & 63) * 4; v[i] = *(const f32x4*)(W + (size_t)(k0 + k) * N + n0 + n4); }
#pragma unroll
    for (int i = 0; i < 8; ++i) { const int c = tid + 512 * i, k = c >> 6, n4 = (c & 63) * 4; float* t = tile + k * 257 + n4; t[0] = v[i].x; t[1] = v[i].y; t[2] = v[i].z; t[3] = v[i].w; }
    __syncthreads();
#pragma unroll
    for (int i = 0; i < 4; ++i) {
        const int c = tid + 512 * i, n = c >> 3, k8 = (c & 7) * 8;
        float f[8];
#pragma unroll
        for (int j = 0; j < 8; ++j) f[j] = tile[(k8 + j) * 257 + n];
        u32x4 w; w.x = pk2(f[0], f[1]); w.y = pk2(f[2], f[3]); w.z = pk2(f[4], f[5]); w.w = pk2(f[6], f[7]);
        const int ng = n0 + n; const int orow = mode == 0 ? ng : ((ng >> 7) * 256 + (mode - 1) * 128 + (ng & 127));
        *(u32x4*)(out + (size_t)orow * K + k0 + k8) = w;
    }
    __syncthreads();
}

DEVI void adaln_unit(char* lds, const Params& P, int l, int n0) {
    float* sc = (float*)lds;
    float* red = sc + 9 * 1024;
    const int tid = tid_l(), lane = tid & 63, wid = tid >> 6;
    for (int i = tid; i < 9 * 1024; i += 512) { const float c = i < 8192 ? P.in[1][i] : P.in[3][i - 8192]; sc[i] = c / (1.f + __expf(-c)); }
    __syncthreads();
    const float* W = P.in[4] + (size_t)l * 1024 * 6144 + n0 + lane;
    float a[9];
#pragma unroll
    for (int j = 0; j < 9; ++j) a[j] = 0.f;
    for (int kk = 0; kk < 128; kk += 16) {
        float w[16];
#pragma unroll
        for (int u = 0; u < 16; ++u) w[u] = W[(size_t)(wid * 128 + kk + u) * 6144];
#pragma unroll
        for (int u = 0; u < 16; ++u)
#pragma unroll
            for (int j = 0; j < 9; ++j) a[j] += sc[j * 1024 + wid * 128 + kk + u] * w[u];
    }
#pragma unroll
    for (int j = 0; j < 9; ++j) red[(wid * 9 + j) * 64 + lane] = a[j];
    __syncthreads();
    for (int i = tid; i < 9 * 64; i += 512) {
        const int j = i >> 6, n = i & 63; float s = 0.f;
#pragma unroll
        for (int w = 0; w < 8; ++w) s += red[(w * 9 + j) * 64 + n];
        ((float*)(ptr_l(P.ws) + WS_MOD))[((size_t)l * 9 + j) * 6144 + n0 + n] = s + P.in[5][(size_t)l * 6144 + n0 + n];
    }
    __syncthreads();
}

DEVI void ssm_tab_unit(char* lds, const Params& P, int l, int d, int g) {
    float* pw = (float*)lds;
    float* bb = pw + 64 * 17 * 2;
    float* cc = bb + 64 * 16 * 2;
    const int tid = tid_l();
    const size_t ldg = ((size_t)l * 2 + d) * 32 + g;
    const float dt = expf(P.in[16][ldg]);
    float* PW = (float*)(ptr_l(P.ws) + WS_PW) + ldg * 64 * 17 * 2;
    float* BB = (float*)(ptr_l(P.ws) + WS_BBAR) + ldg * 64 * 16 * 2;
    for (int i = tid; i < 64 * 17; i += 512) {
        const int p = i / 17, n = i - p * 17;
        const float lr = P.in[14][ldg * 64 + p], li = P.in[15][ldg * 64 + p];
        const float mag = expf(lr * dt * n); float s, c; sincosf(li * dt * n, &s, &c);
        pw[i * 2] = mag * c; pw[i * 2 + 1] = mag * s; PW[i * 2] = mag * c; PW[i * 2 + 1] = mag * s;
    }
    for (int i = tid; i < 64 * 16; i += 512) {
        const int p = i >> 4, h = i & 15;
        const float lr = P.in[14][ldg * 64 + p], li = P.in[15][ldg * 64 + p];
        const float mag = expf(lr * dt); float s, c; sincosf(li * dt, &s, &c);
        const float nr = mag * c - 1.f, ni = mag * s;
        const float den = lr * lr + li * li;
        const float qr = (nr * lr + ni * li) / den, qi = (ni * lr - nr * li) / den;
        const float br = P.in[17][(ldg * 64 + p) * 16 + h], bi = P.in[18][(ldg * 64 + p) * 16 + h];
        const float xr = qr * br - qi * bi, xi = qr * bi + qi * br;
        bb[i * 2] = xr; bb[i * 2 + 1] = xi; BB[i * 2] = xr; BB[i * 2 + 1] = xi;
    }
    for (int i = tid; i < 16 * 64; i += 512) { cc[i * 2] = P.in[19][ldg * 1024 + i]; cc[i * 2 + 1] = P.in[20][ldg * 1024 + i]; }
    __syncthreads();
    float* KT = (float*)(ptr_l(P.ws) + WS_KTAB) + ldg * 4096;
    for (int i = tid; i < 4096; i += 512) {
        const int dl = i >> 8, h = (i >> 4) & 15, h2 = i & 15;
        float s = 0.f;
        for (int p = 0; p < 64; ++p) {
            const float cr = cc[(h * 64 + p) * 2], ci = cc[(h * 64 + p) * 2 + 1];
            const float wr = pw[(p * 17 + dl) * 2], wi = pw[(p * 17 + dl) * 2 + 1];
            const float br = bb[(p * 16 + h2) * 2], bi = bb[(p * 16 + h2) * 2 + 1];
            const float tr = cr * wr - ci * wi, ti = cr * wi + ci * wr;
            s += tr * br - ti * bi;
        }
        KT[i] = s;
    }
    __syncthreads();
}

template <bool FIRST>
DEVI void rowpass1(const Params& P, int l) {
    const int tid = tid_l(), lane = tid & 63, wid = tid >> 6;
    bf16_t* X = (bf16_t*)(ptr_l(P.ws) + WS_X); bf16_t* HX = (bf16_t*)(ptr_l(P.ws) + WS_HX);
    const bf16_t* OG = (const bf16_t*)(ptr_l(P.ws) + WS_OG); const int* SLOT = (const int*)(ptr_l(P.ws) + WS_SLOT);
    const float* MOD = (const float*)(ptr_l(P.ws) + WS_MOD);
    const int stride = gridDim.x * 8;
    int r = blockIdx.x * 8 + wid;
    f32x4 xf[4]; u32x2 xb[4]; int svn = -1;
    auto issue = [&](int rr) {
        if constexpr (FIRST) {
            const int b = rr / LP, p = rr - b * LP;
            const float* src = p < CTXL ? P.in[2] + ((size_t)b * CTXL + p) * 1024 : P.in[0] + ((size_t)b * SEQ + (p - CTXL)) * 1024;
#pragma unroll
            for (int i = 0; i < 4; ++i) xf[i] = *(const f32x4*)(src + lane * 4 + 256 * i);
        } else {
#pragma unroll
            for (int i = 0; i < 4; ++i) xb[i] = *(const u32x2*)(X + (size_t)rr * 1024 + lane * 4 + 256 * i);
            svn = SLOT[(size_t)rr * 16 + (lane & 15)];
        }
    };
    if (r < R) issue(r);
    for (; r < R; r += stride) {
        const int b = r / LP, p = r - b * LP, j = p < CTXL ? 8 : b;
        f32x4 x[4]; const int sv = svn;
#pragma unroll
        for (int i = 0; i < 4; ++i) { if constexpr (FIRST) x[i] = xf[i]; else x[i] = hf4(xb[i]); }
        if (r + stride < R) issue(r + stride);
        if (l == DEPTH && p < CTXL) continue;
        if constexpr (!FIRST) {
            const float* g2 = MOD + ((size_t)(l - 1) * 9 + j) * 6144 + 5 * 1024;
            f32x4 m[4];
#pragma unroll
            for (int i = 0; i < 4; ++i) m[i] = (f32x4){0.f, 0.f, 0.f, 0.f};
            unsigned mask = (unsigned)__ballot(sv >= 0 && lane < 16) & 0xffffu;
            while (mask) {
                const int e0 = __builtin_ctz(mask); mask &= mask - 1;
                const int s0 = __builtin_amdgcn_readlane(sv, e0);
                const bool two = mask != 0u;
                const int e1 = two ? __builtin_ctz(mask) : e0; if (two) mask &= mask - 1;
                const int s1 = __builtin_amdgcn_readlane(sv, e1);
                const bf16_t* o0 = OG + ((size_t)e0 * ROWS_E + s0) * 1024 + lane * 4; const bf16_t* o1 = OG + ((size_t)e1 * ROWS_E + s1) * 1024 + lane * 4;
                u32x2 w0[4], w1[4];
#pragma unroll
                for (int i = 0; i < 4; ++i) { w0[i] = *(const u32x2*)(o0 + 256 * i); w1[i] = *(const u32x2*)(o1 + 256 * i); }
                const float f1 = two ? 1.f : 0.f;
#pragma unroll
                for (int i = 0; i < 4; ++i) m[i] += bf4(w0[i]) + f1 * bf4(w1[i]);
            }
#pragma unroll
            for (int i = 0; i < 4; ++i) { const f32x4 g = *(const f32x4*)(g2 + lane * 4 + 256 * i); x[i] += g * m[i]; }
        }
        float ss = 0.f;
#pragma unroll
        for (int i = 0; i < 4; ++i) ss += x[i].x * x[i].x + x[i].y * x[i].y + x[i].z * x[i].z + x[i].w * x[i].w;
        ss = wave_sum(ss);
        const float rstd = rsqrtf(ss * (1.f / 1024.f) + EPS);
        if (l < DEPTH) {
            const float* ng = P.in[6] + (size_t)l * 1024; const float* sh = MOD + ((size_t)l * 9 + j) * 6144; const float* scl = sh + 1024;
#pragma unroll
            for (int i = 0; i < 4; ++i) {
                const int c = lane * 4 + 256 * i;
                u32x2 xw; xw.x = hpk2(x[i].x, x[i].y); xw.y = hpk2(x[i].z, x[i].w);
                *(u32x2*)(X + (size_t)r * 1024 + c) = xw;
                const f32x4 g = *(const f32x4*)(ng + c), s1 = *(const f32x4*)(scl + c), s0 = *(const f32x4*)(sh + c);
                const f32x4 h = (x[i] * rstd * g) * (1.f + s1) + s0;
                u32x2 w; w.x = pk2(h.x, h.y); w.y = pk2(h.z, h.w);
                *(u32x2*)(HX + (size_t)r * 1024 + c) = w;
            }
        } else {
            float* o = P.out + ((size_t)b * SEQ + (p - CTXL)) * 1024;
#pragma unroll
            for (int i = 0; i < 4; ++i) { const int c = lane * 4 + 256 * i; const f32x4 g = *(const f32x4*)(P.in[29] + c); *(f32x4*)(o + c) = x[i] * rstd * g; }
        }
    }
}

DEVI float router_fold_softmax(const float (&pa)[16], int lane) {
    float q8[8], q4[4], q2[2];
#pragma unroll
    for (int i = 0; i < 8; ++i) { float r0, r1; swap32(pa[i], pa[i + 8], r0, r1); q8[i] = r0 + r1; }
#pragma unroll
    for (int i = 0; i < 4; ++i) { float r0, r1; swap16(q8[i], q8[i + 4], r0, r1); q4[i] = r0 + r1; }
    { const bool hb = (lane & 8) != 0;
#pragma unroll
      for (int i = 0; i < 2; ++i) { const float snd = hb ? q4[i] : q4[i + 2], kp = hb ? q4[i + 2] : q4[i]; q2[i] = kp + dppmov<0x128>(snd); } }
    float lg;
    { const bool hb = (lane & 4) != 0; const float snd = hb ? q2[0] : q2[1], kp = hb ? q2[1] : q2[0];
      const float up = dppmov<0x104>(snd), dn = dppmov<0x114>(snd);
      lg = kp + (hb ? dn : up); }
    lg += dppmov<0x4E>(lg); lg += dppmov<0xB1>(lg);
    float mx = fmaxf(lg, dppmov<0x124>(lg)); mx = fmaxf(mx, dppmov<0x128>(mx));
    { float r0, r1; swap16(mx, mx, r0, r1); mx = fmaxf(r0, r1); swap32(mx, mx, r0, r1); mx = fmaxf(r0, r1); }
    const float ex = expf(lg - mx);
    float sum = ex + dppmov<0x124>(ex); sum += dppmov<0x128>(sum);
    { float r0, r1; swap16(sum, sum, r0, r1); sum = r0 + r1; swap32(sum, sum, r0, r1); sum = r0 + r1; }
    return ex / sum;
}
DEVI void rowpass2(char* lds, const Params& P, int l) {
    const int tid = tid_l(), lane = tid & 63, wid = tid >> 6;
    float* wrT = (float*)lds;
    const float* wr = P.in[25] + (size_t)l * 1024 * 16;
    for (int i = tid; i < 16384; i += 512) { const int k = i >> 4, e = i & 15; wrT[e * 1024 + k] = wr[i]; }
    __syncthreads();
    const bf16_t* X = (const bf16_t*)(ptr_l(P.ws) + WS_X); bf16_t* HX = (bf16_t*)(ptr_l(P.ws) + WS_HX);
    const float* MOD = (const float*)(ptr_l(P.ws) + WS_MOD); float* AFFT = (float*)(ptr_l(P.ws) + WS_AFFT);
    const float* ng = P.in[7] + (size_t)l * 1024;
    const int stride = gridDim.x * 8;
    int r = blockIdx.x * 8 + wid;
    u32x2 xn[2][4];
#pragma unroll
    for (int q = 0; q < 2; ++q) if (r + q * stride < R) {
#pragma unroll
        for (int i = 0; i < 4; ++i) xn[q][i] = *(const u32x2*)(X + (size_t)(r + q * stride) * 1024 + lane * 4 + 256 * i);
    }
    for (; r < R; r += 2 * stride) {
        const bool two = r + stride < R;
        f32x4 h[2][4]; int bb[2], pp[2];
#pragma unroll
        for (int q = 0; q < 2; ++q) {
            const int rq = (q == 0 || two) ? r + q * stride : r;
            const int b = rq / LP, p = rq - b * LP, j = p < CTXL ? 8 : b; bb[q] = b; pp[q] = p;
            float ss = 0.f;
#pragma unroll
            for (int i = 0; i < 4; ++i) { h[q][i] = hf4(xn[q][i]); ss += h[q][i].x * h[q][i].x + h[q][i].y * h[q][i].y + h[q][i].z * h[q][i].z + h[q][i].w * h[q][i].w; }
            ss = wave_sum(ss);
            const float rstd = rsqrtf(ss * (1.f / 1024.f) + EPS);
            const float* sh = MOD + ((size_t)l * 9 + j) * 6144 + 3 * 1024; const float* scl = sh + 1024;
#pragma unroll
            for (int i = 0; i < 4; ++i) {
                const int c = lane * 4 + 256 * i;
                const f32x4 g = *(const f32x4*)(ng + c), s1 = *(const f32x4*)(scl + c), s0 = *(const f32x4*)(sh + c);
                h[q][i] = (h[q][i] * rstd * g) * (1.f + s1) + s0;
                if (q == 0 || two) { u32x2 w; w.x = pk2(h[q][i].x, h[q][i].y); w.y = pk2(h[q][i].z, h[q][i].w); *(u32x2*)(HX + (size_t)rq * 1024 + c) = w; }
            }
        }
#pragma unroll
        for (int q = 0; q < 2; ++q) if (r + (2 + q) * stride < R) {
#pragma unroll
            for (int i = 0; i < 4; ++i) xn[q][i] = *(const u32x2*)(X + (size_t)(r + (2 + q) * stride) * 1024 + lane * 4 + 256 * i);
        }
        float pa[2][16];
#pragma unroll
        for (int eg = 0; eg < 4; ++eg) {
#pragma unroll
            for (int e = 4 * eg; e < 4 * eg + 4; ++e) {
                f32x2 s0 = {0.f, 0.f}, s1 = {0.f, 0.f};
#pragma unroll
                for (int i = 0; i < 4; ++i) { const f32x4 w = *(const f32x4*)(wrT + e * 1024 + lane * 4 + 256 * i);
                    const f32x2 wl = __builtin_shufflevector(w, w, 0, 1), wh = __builtin_shufflevector(w, w, 2, 3);
                    s0 = __builtin_elementwise_fma(__builtin_shufflevector(h[0][i], h[0][i], 0, 1), wl, s0); s0 = __builtin_elementwise_fma(__builtin_shufflevector(h[0][i], h[0][i], 2, 3), wh, s0);
                    s1 = __builtin_elementwise_fma(__builtin_shufflevector(h[1][i], h[1][i], 0, 1), wl, s1); s1 = __builtin_elementwise_fma(__builtin_shufflevector(h[1][i], h[1][i], 2, 3), wh, s1); }
                pa[0][e] = s0.x + s0.y; pa[1][e] = s1.x + s1.y;
            }
            asm volatile("" ::: "memory");
        }
        const float a0 = router_fold_softmax(pa[0], lane), a1 = router_fold_softmax(pa[1], lane);
        if ((lane & 3) == 0) {
            AFFT[((size_t)bb[0] * 16 + (lane >> 2)) * LP + pp[0]] = a0;
            if (two) AFFT[((size_t)bb[1] * 16 + (lane >> 2)) * LP + pp[1]] = a1;
        }
    }
    __syncthreads();
}

DEVI int block_sum_i(int v, volatile int* red, int par, int wid, int lane) {
    if (lane == 0) red[par * 8 + wid] = v;
    __syncthreads();
    int s = 0;
#pragma unroll
    for (int w = 0; w < 8; ++w) s += red[par * 8 + w];
    return s;
}
DEVI int wave_incl_scan_i(int v, int lane) {
#pragma unroll
    for (int o = 1; o < 64; o <<= 1) { const int t = __shfl_up(v, o); if (lane >= o) v += t; }
    return v;
}
DEVI void select_unit(char* lds, const Params& P, int b, int e, bool lat) {
    volatile int* red = (volatile int*)lds;
    volatile int* wtot = (volatile int*)(lds + 64);
    const int tid = tid_l(), lane = tid & 63, wid = tid >> 6;
    const int n = lat ? SEQ : CTXL, K = lat ? CAPL : CAPC, p0 = lat ? CTXL : 0;
    const bool act = 8 * tid < n;
    const float* src = (const float*)(ptr_l(P.ws) + WS_AFFT) + ((size_t)b * 16 + e) * LP + p0 + 8 * tid;
    unsigned bits[8];
    if (act) { const u32x4 v0 = *(const u32x4*)src, v1 = *(const u32x4*)(src + 4); bits[0] = v0.x; bits[1] = v0.y; bits[2] = v0.z; bits[3] = v0.w; bits[4] = v1.x; bits[5] = v1.y; bits[6] = v1.z; bits[7] = v1.w; }
    else {
#pragma unroll
        for (int j = 0; j < 8; ++j) bits[j] = 0u;
    }
    unsigned prefix = 0u; int par = 0;
    for (int bit = 30; bit >= 0; --bit) {
        const unsigned cand = prefix | (1u << bit);
        int c = 0;
#pragma unroll
        for (int j = 0; j < 8; ++j) c += (int)__popcll(__ballot(bits[j] >= cand));
        const int tot = block_sum_i(c, red, par, wid, lane); par ^= 1;
        if (tot >= K) prefix = cand;
    }
    int cg = 0, ceq = 0;
#pragma unroll
    for (int j = 0; j < 8; ++j) { cg += (int)__popcll(__ballot(bits[j] > prefix)); ceq += (bits[j] == prefix) ? 1 : 0; }
    const int need = K - block_sum_i(cg, red, par, wid, lane); par ^= 1;
    int inc = wave_incl_scan_i(ceq, lane);
    if (lane == 63) wtot[par * 8 + wid] = inc;
    __syncthreads();
    int eqb = inc - ceq;
    for (int w = 0; w < wid; ++w) eqb += wtot[par * 8 + w];
    par ^= 1;
    bool sel[8]; int ns = 0;
#pragma unroll
    for (int j = 0; j < 8; ++j) { const bool eq = bits[j] == prefix; sel[j] = (bits[j] > prefix) || (eq && eqb < need); eqb += eq ? 1 : 0; ns += sel[j] ? 1 : 0; }
    inc = wave_incl_scan_i(ns, lane);
    if (lane == 63) wtot[par * 8 + wid] = inc;
    __syncthreads();
    int sb = inc - ns;
    for (int w = 0; w < wid; ++w) sb += wtot[par * 8 + w];
    if (act) {
        int* SLOT = (int*)(ptr_l(P.ws) + WS_SLOT); float* GATE = (float*)(ptr_l(P.ws) + WS_GATE); int* IDX = (int*)(ptr_l(P.ws) + WS_IDX);
#pragma unroll
        for (int j = 0; j < 8; ++j) {
            const int tok = b * LP + p0 + 8 * tid + j;
            if (sel[j]) {
                const int row = (lat ? b * CAPL : NB * CAPL + b * CAPC) + sb; ++sb;
                SLOT[(size_t)tok * 16 + e] = row; GATE[(size_t)e * ROWS_E + row] = __builtin_bit_cast(float, bits[j]); IDX[(size_t)e * ROWS_E + row] = tok;
            } else SLOT[(size_t)tok * 16 + e] = -1;
        }
    }
    __syncthreads();
}
DEVI void gather_rows(const Params& P, bool last) {
    const int tid = tid_l(), lane = tid & 63, wid = tid >> 6;
    const bf16_t* HX = (const bf16_t*)(ptr_l(P.ws) + WS_HX); bf16_t* XG = (bf16_t*)(ptr_l(P.ws) + WS_XG); const int* IDX = (const int*)(ptr_l(P.ws) + WS_IDX);
    const int stride = gridDim.x * 8;
    for (int r0 = blockIdx.x * 8 + wid; r0 < 16 * ROWS_E; r0 += 4 * stride) {
        u32x4 v[4][2];
#pragma unroll
        for (int q = 0; q < 4; ++q) { const int r = r0 + q * stride; if (r < 16 * ROWS_E && !(last && (r % ROWS_E) >= NB * CAPL)) { const u32x4* s = (const u32x4*)(HX + (size_t)IDX[r] * 1024); v[q][0] = s[lane]; v[q][1] = s[lane + 64]; } }
#pragma unroll
        for (int q = 0; q < 4; ++q) { const int r = r0 + q * stride; if (r < 16 * ROWS_E && !(last && (r % ROWS_E) >= NB * CAPL)) { u32x4* d = (u32x4*)(XG + (size_t)r * 1024); d[lane] = v[q][0]; d[lane + 64] = v[q][1]; } }
    }
}

DEVI int scan_ci(int d, int k) { return d == 0 ? k : (k < 16 ? 15 - k : 287 - k); }
DEVI void scan_block(char* lds, const Params& P, int l, int unit0) {
    const int tid = tid_l(), lane = tid & 63, wid = tid >> 6, seg = wid & 3, unit = unit0 + (wid >> 2);
    const int d = unit & 1, g = (unit >> 1) & 31, b = unit >> 6;
    const size_t ldg = ((size_t)l * 2 + d) * 32 + g;
    const float dt = expf(P.in[16][ldg]);
    const float lr = P.in[14][ldg * 64 + lane], li = P.in[15][ldg * 64 + lane];
    const float mag = expf(lr * dt * 16.f); float sn, cs; sincosf(li * dt * 16.f, &sn, &cs);
    const float ar = mag * cs, ai = mag * sn;
    const unsigned short* E = (const unsigned short*)(ptr_l(P.ws) + WS_EB) + (size_t)g * NCHP * 256 + d * 128 + lane * 2;
    bf16_t* S = (bf16_t*)(ptr_l(P.ws) + WS_US) + (size_t)g * NCHP * 512 + 256 + d * 128 + lane * 2;
    f32x2* ends = (f32x2*)lds + (size_t)(wid >> 2) * 4 * 64;
    const int k0 = seg * 68;
    float sr = 0.f, si = 0.f;
    for (int kk = 0; kk < 68; kk += 17) {
        unsigned ev[17];
#pragma unroll
        for (int u = 0; u < 17; ++u) ev[u] = *(const unsigned*)(E + (size_t)chunk_row(b, scan_ci(d, k0 + kk + u)) * 256);
#pragma unroll
        for (int u = 0; u < 17; ++u) { const float nr = ar * sr - ai * si + hlo(ev[u]), ni = ar * si + ai * sr + hhi(ev[u]); sr = nr; si = ni; }
    }
    ends[seg * 64 + lane] = (f32x2){sr, si};
    float pr = ar, pi = ai, p4r = 0.f, p4i = 0.f;
#pragma unroll
    for (int q = 0; q < 6; ++q) { const float nr = pr * pr - pi * pi, ni = 2.f * pr * pi; pr = nr; pi = ni; if (q == 1) { p4r = pr; p4i = pi; } }
    const float br = pr * p4r - pi * p4i, bi = pr * p4i + pi * p4r;
    __syncthreads();
    sr = 0.f; si = 0.f;
    for (int j = 0; j < seg; ++j) { const f32x2 e = ends[j * 64 + lane]; const float nr = br * sr - bi * si + e.x, ni = br * si + bi * sr + e.y; sr = nr; si = ni; }
    for (int kk = 0; kk < 68; kk += 17) {
        unsigned ev[17];
#pragma unroll
        for (int u = 0; u < 17; ++u) ev[u] = *(const unsigned*)(E + (size_t)chunk_row(b, scan_ci(d, k0 + kk + u)) * 256);
#pragma unroll
        for (int u = 0; u < 17; ++u) {
            *(unsigned*)(S + (size_t)chunk_row(b, scan_ci(d, k0 + kk + u)) * 512) = pk2(sr, si);
            const float nr = ar * sr - ai * si + hlo(ev[u]), ni = ar * si + ai * sr + hhi(ev[u]); sr = nr; si = ni;
        }
    }
    __syncthreads();
}

DEVI float max3f(float a, float b, float c) { return fmaxf(fmaxf(a, b), c); }
DEVI float xhalf_max(float x) { const unsigned u = __builtin_bit_cast(unsigned, x); const auto r = __builtin_amdgcn_permlane32_swap(u, u, false, false); return fmaxf(__builtin_bit_cast(float, (unsigned)r[0]), __builtin_bit_cast(float, (unsigned)r[1])); }
DEVI float xhalf_sum(float x) { const unsigned u = __builtin_bit_cast(unsigned, x); const auto r = __builtin_amdgcn_permlane32_swap(u, u, false, false); return __builtin_bit_cast(float, (unsigned)r[0]) + __builtin_bit_cast(float, (unsigned)r[1]); }
DEVI void attn_unit(char* lds, const Params& P, int l, int b, int head, int q0  , int nkeys, float lam, float lam_init) {
    const int tid = tid_l(), lane = tid & 63, wid = tid >> 6, qg = wid >> 1, which = wid & 1, r32 = lane & 31, hi = lane >> 5;
    const bf16_t* QK = (const bf16_t*)(ptr_l(P.ws) + WS_QK);
    const bf16_t* Qs = QK + ((size_t)((which * NB + b) * NH + head) * LP) * 64;
    const bf16_t* K1 = QK + ((size_t)((2 * NB + b) * NH + head) * LP) * 64;
    const bf16_t* K2 = QK + ((size_t)((3 * NB + b) * NH + head) * LP) * 64;
    const bf16_t* Vt = (const bf16_t*)(ptr_l(P.ws) + WS_VT) + (size_t)(b * NH + head) * 128 * LP;
    bf16x8 qf[4];
#pragma unroll
    for (int ks = 0; ks < 4; ++ks) qf[ks] = *(const bf16x8*)(Qs + (size_t)(q0 + qg * 32 + r32) * 64 + ks * 16 + hi * 8);
    f32x16 o[4];
#pragma unroll
    for (int t = 0; t < 4; ++t)
#pragma unroll
        for (int i = 0; i < 16; ++i) o[t][i] = 0.f;
    float m = 0.f, lsum = 0.f;
    const int nt = nkeys >> 6;
    const int drow = wid * 8 + (lane >> 3), dkc = (lane & 7) ^ ((drow >> 1) & 7);
    const unsigned koff = (unsigned)(drow * 64 + dkc * 8), voff = (unsigned)(drow * LP + dkc * 8);
    LAS unsigned char* dl = (LAS unsigned char*)lds + wid * 1024;
#define GLDS(g, off) __builtin_amdgcn_global_load_lds((const unsigned*)(g), (LAS unsigned*)(dl + (off)), 16, 0, 0)
#define K_DMA(kt, s) do { GLDS((K1 + (size_t)(kt) * 4096) + koff, (s) * 16384); GLDS((K2 + (size_t)(kt) * 4096) + koff, (s) * 16384 + 8192); } while (0)
#define V_DMA(kt, s) do { GLDS((Vt + (kt) * 64) + voff, 32768 + (s) * 16384); GLDS((Vt + (kt) * 64 + 64 * LP) + voff, 32768 + (s) * 16384 + 8192); } while (0)
#define QKT(dst, s, init) do { const char* _k = lds + (s) * 16384 + which * 8192; \
        _Pragma("unroll") for (int t2 = 0; t2 < 2; ++t2) _Pragma("unroll") for (int i = 0; i < 16; ++i) dst[t2][i] = (init); \
        _Pragma("unroll") for (int ks = 0; ks < 4; ++ks) _Pragma("unroll") for (int t2 = 0; t2 < 2; ++t2) { \
            const bf16x8 kf = *(const bf16x8*)(_k + swz(t2 * 32 + r32, ks * 2 + hi)); dst[t2] = MFMA32(kf, qf[ks], dst[t2]); } } while (0)
    K_DMA(0, 0); V_DMA(0, 0); K_DMA(1, 1);
    __syncthreads();
    f32x16 sc[2], sn[2];
    QKT(sc, 0, 0.f);
    __syncthreads();
    {
        float tm = max3f(sc[0][0], sc[0][1], sc[0][2]);
#pragma unroll
        for (int i = 3; i < 15; i += 2) tm = max3f(tm, sc[0][i], sc[0][i + 1]);
        tm = fmaxf(tm, sc[0][15]);
#pragma unroll
        for (int i = 0; i < 16; i += 2) tm = max3f(tm, sc[1][i], sc[1][i + 1]);
        tm = xhalf_max(tm);
        m = tm;
#pragma unroll
        for (int t2 = 0; t2 < 2; ++t2)
#pragma unroll
            for (int i = 0; i < 16; ++i) sc[t2][i] -= m;
    }
#define SB() __builtin_amdgcn_sched_barrier(0)
#define SGB(mask, n) __builtin_amdgcn_sched_group_barrier(mask, n, 0)
    int fo[4];
#pragma unroll
    for (int j = 0; j < 4; ++j) fo[j] = swz(r32, 2 * j + hi);
    const char* kbase = lds + which * 8192;
    const char* vbase = lds + 32768;
#define ATT_STEP(KT, PAR, SC, SN) do { \
        const bool has1 = (KT) + 1 < nt, has2 = (KT) + 2 < nt; \
        if (has2) K_DMA((KT) + 2, PAR); \
        if (has1) V_DMA((KT) + 1, 1 - (PAR)); \
        const char* kst = kbase + (1 - (PAR)) * 16384; \
        const char* vs = vbase + (PAR) * 16384; \
        bf16x8 kf[8]; \
        _Pragma("unroll") for (int ks = 0; ks < 4; ++ks) _Pragma("unroll") for (int t2 = 0; t2 < 2; ++t2) kf[ks * 2 + t2] = *(const bf16x8*)(kst + fo[ks] + t2 * 4096); \
        SB(); \
        _Pragma("unroll") for (int t2 = 0; t2 < 2; ++t2) _Pragma("unroll") for (int i = 0; i < 16; ++i) SN[t2][i] = -m; \
        _Pragma("unroll") for (int ks = 0; ks < 4; ++ks) _Pragma("unroll") for (int t2 = 0; t2 < 2; ++t2) SN[t2] = MFMA32(kf[ks * 2 + t2], qf[ks], SN[t2]); \
        bf16x8 va[4], vb[4]; \
        _Pragma("unroll") for (int t = 0; t < 4; ++t) va[t] = *(const bf16x8*)(vs + fo[0] + t * 4096); \
        SGB(0x002, 16); SGB(0x008, 8); SGB(0x100, 4); SB(); \
        if (__any(pprev > 4096.f)) {        \
            const float pr = xhalf_sum(pprev); \
            const float dl = pr > 4096.f ? (float)((int)((__builtin_bit_cast(unsigned, pr) >> 23) & 255u) - 127) : 0.f, al = fast_exp2(-dl); \
            m += dl; lsum *= al; \
            _Pragma("unroll") for (int t = 0; t < 4; ++t) _Pragma("unroll") for (int i = 0; i < 16; ++i) o[t][i] *= al; \
            _Pragma("unroll") for (int t2 = 0; t2 < 2; ++t2) _Pragma("unroll") for (int i = 0; i < 16; ++i) { SC[t2][i] -= dl; SN[t2][i] -= dl; } \
        } \
        float ps = 0.f; \
        _Pragma("unroll") for (int t2 = 0; t2 < 2; ++t2) _Pragma("unroll") for (int i = 0; i < 16; ++i) { SC[t2][i] = fast_exp2(SC[t2][i]); ps += SC[t2][i]; } \
        lsum += ps; pprev = ps; \
        bf16x8 pf[4]; \
        _Pragma("unroll") for (int t2 = 0; t2 < 2; ++t2) _Pragma("unroll") for (int sh = 0; sh < 2; ++sh) { \
            u32x4 pw; pw.x = pk2(SC[t2][8 * sh], SC[t2][8 * sh + 1]); pw.y = pk2(SC[t2][8 * sh + 2], SC[t2][8 * sh + 3]); \
            pw.z = pk2(SC[t2][8 * sh + 4], SC[t2][8 * sh + 5]); pw.w = pk2(SC[t2][8 * sh + 6], SC[t2][8 * sh + 7]); \
            pf[t2 * 2 + sh] = __builtin_bit_cast(bf16x8, pw); } \
        SB(); \
        _Pragma("unroll") for (int t = 0; t < 4; ++t) vb[t] = *(const bf16x8*)(vs + fo[1] + t * 4096); \
        _Pragma("unroll") for (int t = 0; t < 4; ++t) o[t] = MFMA32(va[t], pf[0], o[t]); \
        SGB(0x100, 4); SGB(0x008, 4); SB(); \
        _Pragma("unroll") for (int t = 0; t < 4; ++t) va[t] = *(const bf16x8*)(vs + fo[2] + t * 4096); \
        _Pragma("unroll") for (int t = 0; t < 4; ++t) o[t] = MFMA32(vb[t], pf[1], o[t]); \
        SGB(0x100, 4); SGB(0x008, 4); SB(); \
        _Pragma("unroll") for (int t = 0; t < 4; ++t) vb[t] = *(const bf16x8*)(vs + fo[3] + t * 4096); \
        _Pragma("unroll") for (int t = 0; t < 4; ++t) o[t] = MFMA32(va[t], pf[2], o[t]); \
        SGB(0x100, 4); SGB(0x008, 4); SB(); \
        _Pragma("unroll") for (int t = 0; t < 4; ++t) o[t] = MFMA32(vb[t], pf[3], o[t]); \
        SB(); \
        __syncthreads(); \
    } while (0)
    float pprev = 0.f;
    for (int kt = 0; kt < nt; kt += 2) {
        ATT_STEP(kt, 0, sc, sn);
        ATT_STEP(kt + 1, 1, sn, sc);
    }
#undef ATT_STEP
#undef SB
#undef SGB
#undef GLDS
#undef K_DMA
#undef V_DMA
#undef QKT
    lsum = xhalf_sum(lsum);
    const float inv = 1.f / lsum;
    float* xb = (float*)lds + (size_t)qg * 4096;
    if (which == 1) {
#pragma unroll
        for (int t = 0; t < 4; ++t)
#pragma unroll
            for (int i = 0; i < 16; ++i) xb[(t * 16 + i) * 64 + lane] = o[t][i] * inv;
    }
    __syncthreads();
    if (which == 0) {
        float ss = 0.f;
#pragma unroll
        for (int t = 0; t < 4; ++t)
#pragma unroll
            for (int i = 0; i < 16; ++i) { const float v = o[t][i] * inv - lam * xb[(t * 16 + i) * 64 + lane]; o[t][i] = v; ss += v * v; }
        ss = xhalf_sum(ss);
        const float rs = rsqrtf(ss * (1.f / 128.f) + EPS) * (1.f - lam_init);
        const float* sg = P.in[13] + (size_t)l * 128;
        bf16_t* dst = (bf16_t*)(ptr_l(P.ws) + WS_MIX) + ((size_t)b * LP + q0 + qg * 32 + r32) * 1024 + head * 128 + 4 * hi;
#pragma unroll
        for (int t = 0; t < 4; ++t)
#pragma unroll
            for (int i4 = 0; i4 < 4; ++i4) {
                const f32x4 g = *(const f32x4*)(sg + t * 32 + 8 * i4 + 4 * hi);
                u32x2 w; w.x = pk2(o[t][4 * i4] * rs * g.x, o[t][4 * i4 + 1] * rs * g.y); w.y = pk2(o[t][4 * i4 + 2] * rs * g.z, o[t][4 * i4 + 3] * rs * g.w);
                *(u32x2*)(dst + t * 32 + 8 * i4) = w;
            }
    }
    __syncthreads();
}

struct ConvTile { const float* src; bf16_t* dst; int K, N, mode; };
DEVI ConvTile conv_tile(const Params& P, unsigned char* w, int l, int u) {
    if (u < 4096) { const int w3 = u >= 2048; const int v = u & 2047, le = l * 16 + (v >> 7), k = (v >> 3) & 15, n = v & 7;
        return {P.in[w3 ? 27 : 26] + (size_t)le * 1024 * 2048 + (size_t)(k * 64) * 2048 + n * 256, (bf16_t*)(w + WS_W13T) + (size_t)le * 4096 * 1024 + k * 64, 1024, 2048, (n * 256) | ((1 + w3) << 16)}; }
    const int v = u - 4096, le = l * 16 + (v >> 7), k = (v >> 2) & 31, n = v & 3;
    return {P.in[28] + (size_t)le * 2048 * 1024 + (size_t)(k * 64) * 1024 + n * 256, (bf16_t*)(w + WS_W2T) + (size_t)le * 1024 * 2048 + k * 64, 2048, 1024, n * 256};
}
#define CV_LOAD(v, t) do { const unsigned voff_ = (unsigned)((2 * (tid >> 6)) * (t).N + (tid & 63) * 4) * 4u; \
        _Pragma("unroll") for (int i = 0; i < 8; ++i) { const float* sb_ = (t).src + (size_t)((i >> 1) * 16 + (i & 1)) * (t).N; \
        asm volatile("s_nop 4\n\tglobal_load_dwordx4 %0, %1, %2\n\ts_nop 1" : "=&v"(v[i]) : "v"(voff_), "s"(sb_) : "memory"); } } while (0)
#define CV_WAIT(v, N) asm volatile("s_waitcnt vmcnt(" #N ")" : "+v"(v[0]), "+v"(v[1]), "+v"(v[2]), "+v"(v[3]), "+v"(v[4]), "+v"(v[5]), "+v"(v[6]), "+v"(v[7]) :: "memory")
#define CV_STEP(v, t, N, UNEXT) do { \
        unsigned* tile = (unsigned*)lds + par * (32 * 256); par ^= 1; \
        CV_WAIT(v, N); \
        _Pragma("unroll") for (int j = 0; j < 4; ++j) { const int kp = (tid >> 6) + 8 * j; \
            u32x4 wv; wv.x = pk2(v[2 * j].x, v[2 * j + 1].x); wv.y = pk2(v[2 * j].y, v[2 * j + 1].y); wv.z = pk2(v[2 * j].z, v[2 * j + 1].z); wv.w = pk2(v[2 * j].w, v[2 * j + 1].w); \
            *(u32x4*)(tile + kp * 256 + (((tid & 63) * 4) ^ (((kp >> 2) & 7) << 3))) = wv; } \
        const ConvTile cur = t; \
        if ((UNEXT) >= 0) { t = conv_tile(P, w, l, (UNEXT)); CV_LOAD(v, t); } \
        asm volatile("s_waitcnt lgkmcnt(0)\n\ts_barrier" ::: "memory"); \
        const int n0 = cur.mode & 0xffff, mode = cur.mode >> 16; \
        _Pragma("unroll") for (int i = 0; i < 4; ++i) { \
            const int c = tid + 512 * i, n = c >> 3, kq = c & 7; \
            u32x4 o; o.x = tile[(4 * kq) * 256 + (n ^ (kq << 3))]; o.y = tile[(4 * kq + 1) * 256 + (n ^ (kq << 3))]; o.z = tile[(4 * kq + 2) * 256 + (n ^ (kq << 3))]; o.w = tile[(4 * kq + 3) * 256 + (n ^ (kq << 3))]; \
            const int ng = n0 + n; const int orow = mode == 0 ? ng : ((ng >> 7) * 256 + (mode - 1) * 128 + (ng & 127)); \
            const unsigned so_ = (unsigned)(orow * cur.K + 8 * kq) * 2u; \
            asm volatile("s_nop 4\n\tglobal_store_dwordx4 %0, %1, %2\n\ts_nop 1" :: "v"(so_), "v"(o), "s"(cur.dst) : "memory"); \
        } } while (0)
DEVI void conv_share(char* lds, const Params& P, int l, int bid, int G) {
    unsigned char* w = ptr_l(P.ws);
    const int tid = tid_l();
    if (G != 256) {
        for (int u = bid; u < 3 * 2048; u += G) {
            if (u < 4096) { const int w3 = u >= 2048; const int v = u & 2047, le = l * 16 + (v >> 7), k = (v >> 3) & 15, n = v & 7;
                transpose_unit(lds, P.in[w3 ? 27 : 26] + (size_t)le * 1024 * 2048, 1024, 2048, (bf16_t*)(w + WS_W13T) + (size_t)le * 4096 * 1024, k * 64, n * 256, 1 + w3); }
            else { const int v = u - 4096, le = l * 16 + (v >> 7), k = (v >> 2) & 31, n = v & 3;
                transpose_unit(lds, P.in[28] + (size_t)le * 2048 * 1024, 2048, 1024, (bf16_t*)(w + WS_W2T) + (size_t)le * 1024 * 2048, k * 64, n * 256, 0); }
        }
        return;
    }
    f32x4 va[8], vb[8], vc[8];
    ConvTile ta = conv_tile(P, w, l, bid), tb = conv_tile(P, w, l, bid + 256), tc = conv_tile(P, w, l, bid + 512);
    int par = 0;
    CV_LOAD(va, ta); CV_LOAD(vb, tb); CV_LOAD(vc, tc);
    CV_STEP(va, ta, 16, bid + 3 * 256); CV_STEP(vb, tb, 20, bid + 4 * 256); CV_STEP(vc, tc, 24, bid + 5 * 256);
    for (int r = 2; r < 8; ++r) {
        const int u = bid + (3 * r) * 256;
        CV_STEP(va, ta, 28, u); CV_STEP(vb, tb, 28, u + 256); CV_STEP(vc, tc, 28, u + 512);
    }
    CV_STEP(va, ta, 28, -1); CV_STEP(vb, tb, 20, -1); CV_STEP(vc, tc, 12, -1);
    asm volatile("s_waitcnt vmcnt(0)" ::: "memory");
    __syncthreads();
}
#undef CV_LOAD
#undef CV_WAIT
#undef CV_STEP
constexpr int PH_PER_LAYER = 11, PH_LAYER0 = 2, PH_FINAL = PH_LAYER0 + DEPTH * PH_PER_LAYER, N_PHASES = PH_FINAL + 1;

__global__ void __launch_bounds__(512, 2) fwd_kernel(Params P) {
    extern __shared__ __attribute__((aligned(16))) char lds[];
    volatile LAS unsigned* xbw = (volatile LAS unsigned*)(lds + 131072);
    if (threadIdx.x == 0) { xbw[0] = 0u; xbw[1] = 0u; }
    __syncthreads();
    XcdBarrier bar = xcd_barrier_post((unsigned*)(P.ws + WS_CTL), xbw);
    const int G = gridDim.x, bid = blockIdx.x;
    const int vcu = (G % 8 == 0) ? (bid % 8) * (G / 8) + bid / 8 : bid;
    LAS unsigned char* ldsp = (LAS unsigned char*)lds;
    const int lo = P.lo, hi = P.hi;
#ifndef EN_MASK
#define EN_MASK 0xFFFFFFFFu
#endif
#define PHASE(id) if ((id) >= lo && (id) < hi)
#ifndef REP_MASK
#define REP_MASK 0x0u
#endif
#define PHASE_K(k, id) if (((EN_MASK >> (k)) & 1u) && (id) >= lo && (id) < hi) for (int rep_ = 0; rep_ <= (int)((REP_MASK >> (k)) & 1u); ++rep_)
#define SEAM(id) do { if ((id) >= lo && (id) + 1 < hi) xcd_barrier(bar); } while (0)
    unsigned char* ws0 = P.ws;
#define ws ptr_l(ws0)

    PHASE_K(0, 0) {
        constexpr int U_SSM = 256, U_ROPE = 1, U_ADA = 4 * 96;
        constexpr int T_WIN = 4 * 16 * 8, T_WOUT = 4 * 16 * 4, T_WGLU = 4 * 8 * 2, T_W1 = 64 * 16 * 8, T_W2 = 64 * 32 * 4;
        constexpr int U0 = U_SSM + U_ROPE + U_ADA, U1 = U0 + T_WIN, U2 = U1 + T_WOUT, U3 = U2 + T_WGLU, U4 = U3 + T_W1, U5 = U4 + T_W1, U6 = U5 + T_W2;
        for (int u = bid; u < U3; u += G) {
            if (u < U_SSM) { ssm_tab_unit(lds, P, u >> 6, (u >> 5) & 1, u & 31); }
            else if (u == U_SSM) {
                const int tid = tid_l(), wid = tid >> 6, lane = tid & 63;
                float* rope = (float*)(ws + WS_ROPE);
                for (int i = tid; i < 64 * 16; i += 512) {
                    const int pos = i >> 4, f = i & 15; const float inv = powf(10000.f, -(float)(2 * f) / 32.f);
                    float s, c; sincosf((float)pos * inv, &s, &c); rope[i * 2] = c; rope[i * 2 + 1] = s;
                }
                if (wid < 4) {
                    const float a = P.in[9][wid * 64 + lane] * P.in[10][wid * 64 + lane], c2 = P.in[11][wid * 64 + lane] * P.in[12][wid * 64 + lane];
                    const float s1 = wave_sum(a), s2 = wave_sum(c2);
                    if (lane == 0) ((float*)(ws + WS_LAM))[wid] = expf(s1) - expf(s2) + (0.8f - 0.6f * expf(-0.3f * (float)wid));
                }
            }
            else if (u < U0) { const int v = u - U_SSM - U_ROPE; adaln_unit(lds, P, v / 96, (v % 96) * 64); }
            else if (u < U1) { const int v = u - U0, l = v >> 7, k = (v >> 3) & 15, n = v & 7; transpose_unit(lds, P.in[8] + (size_t)l * 1024 * 2048, 1024, 2048, (bf16_t*)(ws + WS_WINT) + (size_t)l * 2048 * 1024, k * 64, n * 256, 0); }
            else if (u < U2) { const int v = u - U1, l = v >> 6, k = (v >> 2) & 15, n = v & 3; transpose_unit(lds, P.in[24] + (size_t)l * 1024 * 1024, 1024, 1024, (bf16_t*)(ws + WS_WOUTT) + (size_t)l * 1024 * 1024, k * 64, n * 256, 0); }
            else { const int v = u - U2, l = v >> 4, k = (v >> 1) & 7, n = v & 1; transpose_unit(lds, P.in[22] + (size_t)l * 512 * 512, 512, 512, (bf16_t*)(ws + WS_WGLUT) + (size_t)l * 512 * 512, k * 64, n * 256, 0); }
        }
        (void)U4; (void)U5; (void)U6;
    }
    SEAM(0);
    PHASE_K(1, 1) {
        const float* KT = (const float*)(ws + WS_KTAB); const float* PW = (const float*)(ws + WS_PW); const float* BB = (const float*)(ws + WS_BBAR);
        bf16_t* WE = (bf16_t*)(ws + WS_WENDT); bf16_t* B2 = (bf16_t*)(ws + WS_BT2);
        const int tid = tid_l();
        for (int it = bid * 512 + tid; it < 4 * 32 * 256 * 64; it += G * 512) {
            const int k8 = it & 63, n = (it >> 6) & 255, g = (it >> 14) & 31, l = it >> 19;
            u32x4 o = {0u, 0u, 0u, 0u};
            if (k8 < 32) {
                const int d = n >> 7, p = (n >> 1) & 63, ri = n & 1, i = k8 >> 1, h0 = (k8 & 1) * 8;
                const int ldg = (l * 2 + d) * 32 + g, e = d == 0 ? 15 - i : i;
                const f32x2 w = *(const f32x2*)(PW + ((size_t)(ldg * 64 + p) * 17 + e) * 2);
                const f32x4* bp = (const f32x4*)(BB + ((size_t)(ldg * 64 + p) * 16 + h0) * 2);
                const f32x4 b0 = bp[0], b1 = bp[1], b2 = bp[2], b3 = bp[3];
                float v[8];
                if (ri == 0) { v[0] = w.x * b0.x - w.y * b0.y; v[1] = w.x * b0.z - w.y * b0.w; v[2] = w.x * b1.x - w.y * b1.y; v[3] = w.x * b1.z - w.y * b1.w;
                               v[4] = w.x * b2.x - w.y * b2.y; v[5] = w.x * b2.z - w.y * b2.w; v[6] = w.x * b3.x - w.y * b3.y; v[7] = w.x * b3.z - w.y * b3.w; }
                else         { v[0] = w.x * b0.y + w.y * b0.x; v[1] = w.x * b0.w + w.y * b0.z; v[2] = w.x * b1.y + w.y * b1.x; v[3] = w.x * b1.w + w.y * b1.z;
                               v[4] = w.x * b2.y + w.y * b2.x; v[5] = w.x * b2.w + w.y * b2.z; v[6] = w.x * b3.y + w.y * b3.x; v[7] = w.x * b3.w + w.y * b3.z; }
                o.x = pk2(v[0], v[1]); o.y = pk2(v[2], v[3]); o.z = pk2(v[4], v[5]); o.w = pk2(v[6], v[7]);
            }
            *(u32x4*)(WE + (size_t)(it >> 6) * 512 + k8 * 8) = o;
        }
        for (int it = bid * 512 + tid; it < 4 * 32 * 256 * 64; it += G * 512) {
            const int k8 = it & 63, n2 = (it >> 6) & 255, g = (it >> 14) & 31, l = it >> 19;
            const int j = n2 >> 4, h = n2 & 15;
            float v[8];
            if (k8 < 32) {
                const int i = k8 >> 1, h20 = (k8 & 1) * 8;
                f32x4 a0 = {0.f, 0.f, 0.f, 0.f}, a1 = a0;
                if (i <= j) { const f32x4* kp = (const f32x4*)(KT + ((size_t)((l * 2 + 0) * 32 + g) * 16 + (j - i)) * 256 + h * 16 + h20); a0 += kp[0]; a1 += kp[1]; }
                if (i >= j) { const f32x4* kp = (const f32x4*)(KT + ((size_t)((l * 2 + 1) * 32 + g) * 16 + (i - j)) * 256 + h * 16 + h20); a0 += kp[0]; a1 += kp[1]; }
                v[0] = a0.x; v[1] = a0.y; v[2] = a0.z; v[3] = a0.w; v[4] = a1.x; v[5] = a1.y; v[6] = a1.z; v[7] = a1.w;
                if (i == j && (h >> 3) == (k8 & 1)) { const float dd = P.in[21][(size_t)l * 512 + g * 16 + h];
#pragma unroll
                    for (int q = 0; q < 8; ++q) v[q] += (q == (h & 7)) ? dd : 0.f; }
            } else {
                const int n0 = (k8 - 32) * 8, d = n0 >> 7, p0 = (n0 >> 1) & 63;
                const int ldg = (l * 2 + d) * 32 + g, e = d == 0 ? j + 1 : 16 - j;
                const f32x4 cr = *(const f32x4*)(P.in[19] + (size_t)(ldg * 16 + h) * 64 + p0), ci = *(const f32x4*)(P.in[20] + (size_t)(ldg * 16 + h) * 64 + p0);
                const float crv[4] = {cr.x, cr.y, cr.z, cr.w}, civ[4] = {ci.x, ci.y, ci.z, ci.w};
#pragma unroll
                for (int q = 0; q < 4; ++q) {
                    const f32x2 w = *(const f32x2*)(PW + ((size_t)(ldg * 64 + p0 + q) * 17 + e) * 2);
                    v[2 * q] = crv[q] * w.x - civ[q] * w.y; v[2 * q + 1] = -(crv[q] * w.y + civ[q] * w.x);
                }
            }
            u32x4 o; o.x = pk2(v[0], v[1]); o.y = pk2(v[2], v[3]); o.z = pk2(v[4], v[5]); o.w = pk2(v[6], v[7]);
            *(u32x4*)(B2 + (size_t)(it >> 6) * 512 + k8 * 8) = o;
        }
    }
    SEAM(1);

    for (int l = 0; l < DEPTH; ++l) {
        const int ph = PH_LAYER0 + l * PH_PER_LAYER;
        const bool last = l == DEPTH - 1;
        const float* MODl = (const float*)(ws + WS_MOD) + (size_t)l * 9 * 6144;
        PHASE_K(2, ph + 0) { if (l == 0) rowpass1<true>(P, 0); else rowpass1<false>(P, l); }
        SEAM(ph + 0);
        PHASE_K(3, ph + 1) {
            {
                Epi8Inproj ep{(bf16_t*)(ws + WS_QK), (bf16_t*)(ws + WS_VT), (bf16_t*)(ws + WS_US), (const float*)(ws + WS_ROPE)};
                const pg8::Gemm g{(const bf16_t*)(ws + WS_HX), (const bf16_t*)(ws + WS_WINT) + (size_t)l * 2048 * 1024, R, 2048, 1024};
                const TileOrder S{128 * 8, G, vcu, 16, 8, 0, 17, 1};
                pg8::gemm_phase<Epi8Inproj, TileOrder, true, true>(ldsp, g, S, ep);
            }
            for (int u = vcu; u < 16 * 16; u += G) {
                EpiInproj ep{(bf16_t*)(ws + WS_QK), (bf16_t*)(ws + WS_VT), (bf16_t*)(ws + WS_US), (const float*)(ws + WS_ROPE)};
                APlain af{(const bf16_t*)(ws + WS_HX), 1024};
                const int mt = u >> 4, nt = u & 15;
                gemm_unit_dma(lds, af, (const bf16_t*)(ws + WS_WINT) + (size_t)l * 2048 * 1024, 1024, 1024, (mt >> 1) * LP + (mt & 1) * 128, nt * 128, ep);
            }
        }
        SEAM(ph + 1);
        PHASE_K(4, ph + 2) {
            {
                Epi8S1 ep{(unsigned short*)(ws + WS_EB)};
                const pg8::Gemm g{(const bf16_t*)(ws + WS_US), (const bf16_t*)(ws + WS_WENDT) + (size_t)l * 32 * 256 * 512, 32 * NCHP, 32 * 256, 512};
                const TileOrder S{32 * 8, G, vcu, 8, 1, 1, 9, 0};
                pg8::gemm_phase<Epi8S1, TileOrder, true, true>(ldsp, g, S, ep);
            }
            for (int u = vcu; u < 64; u += G) {
                const int g = u >> 1, nt = u & 1;
                EpiS1 ep{(unsigned short*)(ws + WS_EB) + (size_t)g * NCHP * 256};
                APlain af{(const bf16_t*)(ws + WS_US) + (size_t)g * NCHP * 512, 512};
                gemm_unit_dma(lds, af, (const bf16_t*)(ws + WS_WENDT) + ((size_t)l * 32 + g) * 256 * 512, 512, 256, 2048, nt * 128, ep);
            }
        }
        SEAM(ph + 2);
        PHASE_K(15, ph + 3) {
            for (int u = bid * 2; u < NB * 32 * 2; u += G * 2) scan_block(lds, P, l, u);
        }
        SEAM(ph + 3);
        PHASE_K(5, ph + 4) {
            const float lam = ((const float*)(ws + WS_LAM))[l], lam_init = 0.8f - 0.6f * expf(-0.3f * (float)l);
            int rnd = 0;
            for (int u = vcu; u < (last ? 1024 : 1024 + 64); u += G, ++rnd) {
                if (rnd == ((bid >> 3) & 3)) conv_share(lds, P, l, bid, G);
                if (u < 1024) { const int qb = u & 31, bh = u >> 5; attn_unit(lds, P, l, bh >> 2, bh & 3, CTXL + qb * 128, LP, lam, lam_init); }
                else { const int v = u - 1024, qb = v & 1, bh = v >> 1; attn_unit(lds, P, l, bh >> 2, bh & 3, qb * 128, CTXL, lam, lam_init); }
            }
        }
        PHASE_K(6, ph + 4) {
            {
                Epi8S2 ep{(bf16_t*)(ws + WS_YG)};
                const pg8::Gemm g{(const bf16_t*)(ws + WS_US), (const bf16_t*)(ws + WS_BT2) + (size_t)l * 32 * 256 * 512, 32 * NCHP, 32 * 256, 512};
                const TileOrder S{32 * 8, G, vcu, 8, 1, 1, 9, 0};
                pg8::gemm_phase<Epi8S2, TileOrder, true, true>(ldsp, g, S, ep);
            }
            if (!last) for (int u = (vcu + G / 2) % G; u < 64; u += G) {
                const int g = u >> 1, nt = u & 1;
                EpiS2 ep{(bf16_t*)(ws + WS_YG), g};
                APlain af{(const bf16_t*)(ws + WS_US) + (size_t)g * NCHP * 512, 512};
                gemm_unit_dma(lds, af, (const bf16_t*)(ws + WS_BT2) + ((size_t)l * 32 + g) * 256 * 512, 512, 512, 2048, nt * 128, ep);
            }
        }
        SEAM(ph + 4);
        PHASE_K(7, ph + 5) {
            {
                Epi8Glu ep{(const bf16_t*)(ws + WS_YG), (bf16_t*)(ws + WS_MIX), P.in[23] + (size_t)l * 512};
                const pg8::Gemm g{(const bf16_t*)(ws + WS_YG), (const bf16_t*)(ws + WS_WGLUT) + (size_t)l * 512 * 512, R, 512, 512};
                const TileOrder S{128 * 2, G, vcu, 16, 2, 0, 17, 1};
                pg8::gemm_phase<Epi8Glu, TileOrder, true, true>(ldsp, g, S, ep);
            }
            if (!last) for (int u = vcu; u < 8 * 4; u += G) {
                EpiGlu ep{(const bf16_t*)(ws + WS_YG), (bf16_t*)(ws + WS_MIX), P.in[23] + (size_t)l * 512};
                APlain af{(const bf16_t*)(ws + WS_YG), 512};
                gemm_unit<256>(lds, af, (const bf16_t*)(ws + WS_WGLUT) + (size_t)l * 512 * 512, 512, 512, (u >> 2) * LP, (u & 3) * 128, ep);
            }
        }
        SEAM(ph + 5);
        PHASE_K(8, ph + 6) {
            {
                Epi8Out ep{(bf16_t*)(ws + WS_X), MODl};
                const pg8::Gemm g{(const bf16_t*)(ws + WS_MIX), (const bf16_t*)(ws + WS_WOUTT) + (size_t)l * 1024 * 1024, R, 1024, 1024};
                const TileOrder S{128 * 4, G, vcu, 16, 4, 0, 17, 1};
                pg8::gemm_phase<Epi8Out, TileOrder, true, true>(ldsp, g, S, ep);
            }
            if (!last) for (int u = vcu; u < 16 * 8; u += G) {
                EpiOut ep{(bf16_t*)(ws + WS_X), MODl};
                APlain af{(const bf16_t*)(ws + WS_MIX), 1024};
                const int mt = u >> 3, nt = u & 7;
                gemm_unit_dma(lds, af, (const bf16_t*)(ws + WS_WOUTT) + (size_t)l * 1024 * 1024, 1024, 1024, (mt >> 1) * LP + (mt & 1) * 128, nt * 128, ep);
            }
        }
        SEAM(ph + 6);
        PHASE_K(9, ph + 7) { rowpass2(lds, P, l); }
        SEAM(ph + 7);
        PHASE_K(10, ph + 8) {
            for (int u = bid; u < (last ? 128 : 256); u += G) select_unit(lds, P, (u & 127) >> 4, u & 15, u < 128);
        }
        SEAM(ph + 8);
        PHASE_K(11, ph + 9) {
            Epi8Moe1 ep{(bf16_t*)(ws + WS_HG)};
            const pg8::Gemm g{(const bf16_t*)(ws + WS_HX), (const bf16_t*)(ws + WS_W13T) + (size_t)l * 16 * 4096 * 1024, 16 * ROWS_E, 16 * 4096, 1024, (const int*)(ws + WS_IDX), 131072 + 64};
            const TileOrder S = last ? TileOrder{16 * 16 * 16, G, vcu, 16, 16, 16, 17, 0, 1} : TileOrder{16 * 17 * 16, G, vcu, 17, 16, 16, 17, 0, 1};
            pg8::gemm_phase<Epi8Moe1, TileOrder, true, true, true>(ldsp, g, S, ep);
        }
        SEAM(ph + 9);
        PHASE_K(12, ph + 10) {
            {
                Epi8Moe2 ep{(bf16_t*)(ws + WS_OG), (const float*)(ws + WS_GATE)};
                const pg8::Gemm g{(const bf16_t*)(ws + WS_HG), (const bf16_t*)(ws + WS_W2T) + (size_t)l * 16 * 1024 * 2048, 16 * ROWS_E, 16 * 1024, 2048};
                const TileOrder S{16 * 16 * 4, G, vcu, 16, 4, 4, 17, 0};
                pg8::gemm_phase<Epi8Moe2, TileOrder, true, true>(ldsp, g, S, ep);
            }
            if (!last) for (int u = vcu; u < 16 * 2 * 8; u += G) {
                const int e = u >> 4, mt = (u >> 3) & 1, nt = u & 7;
                EpiMoe2 ep{(bf16_t*)(ws + WS_OG) + (size_t)e * ROWS_E * 1024, (const float*)(ws + WS_GATE) + (size_t)e * ROWS_E};
                APlain af{(const bf16_t*)(ws + WS_HG) + (size_t)e * ROWS_E * FF, FF};
                gemm_unit_dma(lds, af, (const bf16_t*)(ws + WS_W2T) + ((size_t)l * 16 + e) * 1024 * 2048, 2048, 2048, NB * CAPL + mt * 128, nt * 128, ep);
            }
        }
        SEAM(ph + 10);
    }
    PHASE_K(13, PH_FINAL) { rowpass1<false>(P, DEPTH); }
#undef ws
}

#ifndef MK_MULTI
#define MK_MULTI 0
#endif

extern "C" void kernel_launch(void* const* d_in, const int* in_sizes, int n_in, void* d_out, int out_size, void* d_ws, size_t ws_size, hipStream_t stream) {
    static int grid = 0;
    if (!grid) {
        int dev = 0, cus = 0, per_cu = 0;
        hipGetDevice(&dev);
        hipDeviceGetAttribute(&cus, hipDeviceAttributeMultiprocessorCount, dev);
        hipFuncSetAttribute((const void*)fwd_kernel, hipFuncAttributeMaxDynamicSharedMemorySize, LDS_BYTES);
        hipOccupancyMaxActiveBlocksPerMultiprocessor(&per_cu, fwd_kernel, 512, LDS_BYTES);
        grid = cus * (per_cu < 1 ? per_cu : 1);
        if (grid <= 0) { fprintf(stderr, "occupancy query failed (per_cu=%d cus=%d)\n", per_cu, cus); grid = 256; }
        if (ws_size < WS_END) fprintf(stderr, "workspace too small: %zu < %zu\n", ws_size, (size_t)WS_END);
    }
    Params p{};
    for (int i = 0; i < 30; ++i) p.in[i] = (const float*)d_in[i];
    p.out = (float*)d_out; p.ws = (unsigned char*)d_ws;
    hipMemsetAsync(d_ws, 0, CTL_BYTES, stream);
#if MK_MULTI
    for (int ph = 0; ph < N_PHASES; ++ph) {
        p.lo = ph; p.hi = ph + 1;
        hipLaunchKernelGGL(fwd_kernel, dim3(grid), dim3(512), LDS_BYTES, stream, p);
    }
#else
    p.lo = 0; p.hi = N_PHASES;
    hipLaunchKernelGGL(fwd_kernel, dim3(grid), dim3(512), LDS_BYTES, stream, p);
#endif
}
```

```cpp
#include <hip/hip_runtime.h>
#include <cstdio>
#include <cstdint>
#include <cmath>

#define DEVI __device__ __forceinline__
#define LAS __attribute__((address_space(3)))

typedef unsigned short bf16_t;
typedef short bf16x8 __attribute__((ext_vector_type(8)));
typedef float f32x2 __attribute__((ext_vector_type(2)));
typedef float f32x4 __attribute__((ext_vector_type(4)));
typedef float f32x16 __attribute__((ext_vector_type(16)));
typedef unsigned u32x2 __attribute__((ext_vector_type(2)));
typedef unsigned u32x4 __attribute__((ext_vector_type(4)));
typedef __bf16 bf16x2_t __attribute__((ext_vector_type(2)));

constexpr int NB = 8, SEQ = 4096, CTXL = 256, DM = 1024, DEPTH = 4;
constexpr int LP = CTXL + SEQ;
constexpr int R = NB * LP;
constexpr int NCHB = LP / 16;
constexpr int NCH = NB * NCHB;
constexpr int NE = 16, CAPL = 512, CAPC = 32, ROWS_BE = CAPL + CAPC  , ROWS_E = NB * ROWS_BE  , FF = 2048;
constexpr int NH = 4;
constexpr float EPS = 1e-6f;
constexpr float QSCALE = 0.125f * 1.4426950408889634f;

constexpr size_t al256(size_t x) { return (x + 255) & ~(size_t)255; }
constexpr size_t WS_CTL = 0, CTL_BYTES = 65536;
constexpr size_t WS_MOD = WS_CTL + CTL_BYTES;
constexpr size_t WS_ROPE = WS_MOD + al256((size_t)4 * 9 * 6144 * 4);
constexpr size_t WS_LAM = WS_ROPE + al256(64 * 16 * 2 * 4);
constexpr size_t WS_KTAB = WS_LAM + 256;
constexpr size_t WS_PW = WS_KTAB + (size_t)4 * 2 * 32 * 4096 * 4;
constexpr size_t WS_BBAR = WS_PW + al256((size_t)4 * 2 * 32 * 64 * 17 * 2 * 4);
constexpr size_t WS_WENDT = WS_BBAR + al256((size_t)4 * 2 * 32 * 64 * 16 * 2 * 4);
constexpr size_t WS_BT2 = WS_WENDT + (size_t)4 * 32 * 256 * 512 * 2;
constexpr size_t WS_WINT = WS_BT2 + (size_t)4 * 32 * 256 * 512 * 2;
constexpr size_t WS_WOUTT = WS_WINT + (size_t)4 * 2048 * 1024 * 2;
constexpr size_t WS_WGLUT = WS_WOUTT + (size_t)4 * 1024 * 1024 * 2;
constexpr size_t WS_W13T = WS_WGLUT + (size_t)4 * 512 * 512 * 2;
constexpr size_t WS_W2T = WS_W13T + (size_t)4 * 16 * 4096 * 1024 * 2;
constexpr size_t WS_X = WS_W2T + (size_t)4 * 16 * 1024 * 2048 * 2;
constexpr size_t WS_HX = WS_X + (size_t)R * 1024 * 4;
constexpr size_t WS_QK = WS_HX + (size_t)R * 1024 * 2;
constexpr size_t WS_VT = WS_QK + (size_t)R * 1024 * 2;
constexpr int NCHP = 2304;
constexpr size_t WS_US = WS_VT + (size_t)R * 512 * 2;
constexpr size_t WS_EB = WS_US + (size_t)32 * NCHP * 512 * 2;
constexpr size_t WS_MIX = WS_EB + (size_t)32 * NCHP * 256 * 4;
constexpr size_t WS_YG = WS_MIX + (size_t)R * 1024 * 2;
constexpr size_t WS_AFFT = WS_YG + (size_t)R * 512 * 2;
constexpr size_t WS_SLOT = WS_AFFT + (size_t)NB * 16 * LP * 4;
constexpr size_t WS_GATE = WS_SLOT + (size_t)R * 16 * 4;
constexpr size_t WS_IDX = WS_GATE + al256((size_t)16 * ROWS_E * 4);
constexpr size_t WS_XG = WS_IDX + al256((size_t)16 * ROWS_E * 4);
constexpr size_t WS_HG = WS_XG + (size_t)16 * ROWS_E * 1024 * 2;
constexpr size_t WS_OG = WS_HG + (size_t)16 * ROWS_E * 2048 * 2;
constexpr size_t WS_END = WS_OG + (size_t)16 * ROWS_E * 1024 * 2;

constexpr int LDS_BYTES = 131072 + 64 + 16384;

DEVI unsigned pk2(float lo, float hi) { f32x2 v = {lo, hi}; bf16x2_t b = __builtin_convertvector(v, bf16x2_t); return __builtin_bit_cast(unsigned, b); }
DEVI bf16_t f2bf(float f) { return (bf16_t)(pk2(f, 0.f) & 0xffffu); }
DEVI float bflo(unsigned u) { return __builtin_bit_cast(float, u << 16); }
DEVI float bfhi(unsigned u) { return __builtin_bit_cast(float, u & 0xffff0000u); }
DEVI f32x4 bf4(u32x2 w) { return (f32x4){bflo(w.x), bfhi(w.x), bflo(w.y), bfhi(w.y)}; }
typedef _Float16 h16x2 __attribute__((ext_vector_type(2)));
DEVI unsigned hpk2(float lo, float hi) { unsigned r; asm("v_cvt_pk_f16_f32 %0, %1, %2" : "=v"(r) : "v"(lo), "v"(hi)); return r; }
DEVI float hlo(unsigned u) { return (float)__builtin_bit_cast(_Float16, (unsigned short)(u & 0xffffu)); }
DEVI float hhi(unsigned u) { return (float)__builtin_bit_cast(_Float16, (unsigned short)(u >> 16)); }
DEVI f32x4 hf4(u32x2 w) { return (f32x4){hlo(w.x), hhi(w.x), hlo(w.y), hhi(w.y)}; }
DEVI int tid_l() { int t = threadIdx.x; asm volatile("" : "+v"(t)); return t; }
#define GAS __attribute__((address_space(1)))
DEVI unsigned char* ptr_l(unsigned char* w) { GAS unsigned char* g = (GAS unsigned char*)w; asm volatile("" : "+s"(g)); return (unsigned char*)g; }
template <int CTRL> DEVI float dppmov(float x) { return __builtin_bit_cast(float, __builtin_amdgcn_update_dpp(0, __builtin_bit_cast(int, x), CTRL, 0xf, 0xf, true)); }
DEVI void swap16(float a, float b, float& r0, float& r1) { const auto r = __builtin_amdgcn_permlane16_swap(__builtin_bit_cast(unsigned, a), __builtin_bit_cast(unsigned, b), false, false); r0 = __builtin_bit_cast(float, (unsigned)r[0]); r1 = __builtin_bit_cast(float, (unsigned)r[1]); }
DEVI void swap32(float a, float b, float& r0, float& r1) { const auto r = __builtin_amdgcn_permlane32_swap(__builtin_bit_cast(unsigned, a), __builtin_bit_cast(unsigned, b), false, false); r0 = __builtin_bit_cast(float, (unsigned)r[0]); r1 = __builtin_bit_cast(float, (unsigned)r[1]); }
DEVI float wave_sum(float v) {
    v += dppmov<0xB1>(v);
    v += dppmov<0x4E>(v);
    v += dppmov<0x124>(v);
    v += dppmov<0x128>(v);
    float r0, r1; swap16(v, v, r0, r1); v = r0 + r1;
    swap32(v, v, r0, r1); return r0 + r1;
}
DEVI float fast_exp2(float x) { return __builtin_amdgcn_exp2f(x); }
DEVI float sigmoidf_(float x) { return __builtin_amdgcn_rcpf(1.f + __expf(-x)); }
DEVI float gelu_tanh(float x) { const float z = 0.7978845608028654f * (x + 0.044715f * x * x * x); const float t = 1.f - 2.f * __builtin_amdgcn_rcpf(__expf(2.f * z) + 1.f); return 0.5f * x * (1.f + t); }
#define MFMA32(a, b, c) __builtin_amdgcn_mfma_f32_32x32x16_bf16(a, b, c, 0, 0, 0)

#define XB_TMO      128
#define XB_XCNT(j)  (256  + 64 * (j))
#define XB_XSUB(j)  (1280 + 64 * (j))
#define XB_XGEN(j)  (2304 + 64 * (j))
#define XB_TOP      3328
#define XB_TOPGEN   3392
#define XCD_BAR_WORDS 3456
#define XB_SPIN_CAP (1u << 20)
DEVI unsigned xb_ld(unsigned* p)              { return __hip_atomic_load(p, __ATOMIC_RELAXED, __HIP_MEMORY_SCOPE_AGENT); }
DEVI unsigned xb_add(unsigned* p, unsigned v) { return __hip_atomic_fetch_add(p, v, __ATOMIC_RELAXED, __HIP_MEMORY_SCOPE_AGENT); }
DEVI unsigned xb_xcc_id() { return (unsigned)__builtin_amdgcn_s_getreg((3 << 11) | 20) & 0xFu; }
#define XB_SPIN(cond, bar) do { unsigned _sp = 0; while (cond) { __builtin_amdgcn_s_sleep(1); \
    if ((++_sp & 255u) == 0u) { if (xb_ld(&(bar)[XB_TMO])) break; if (_sp > XB_SPIN_CAP) { atomicAdd(&(bar)[XB_TMO], 1u); break; } } } } while (0)
struct XcdBarrier { unsigned* bar; unsigned x; volatile LAS unsigned* st; };
DEVI XcdBarrier xcd_barrier_post(unsigned* bar, volatile LAS unsigned* st) {
    XcdBarrier b; b.bar = bar; b.x = xb_xcc_id(); b.st = st;
    if (threadIdx.x == 0) (void)xb_add(&bar[XB_XCNT(b.x)], 1u);
    return b;
}
DEVI void xcd_barrier_complete(unsigned* bar, unsigned x, unsigned& nloc, unsigned& nx) {
    const unsigned G = gridDim.x * gridDim.y * gridDim.z;
    unsigned sum, cnt, mine, sp = 0u;
    for (;;) {
        sum = 0u; cnt = 0u; mine = 0u;
#pragma unroll
        for (unsigned j = 0; j < 16; ++j) { const unsigned c = xb_ld(&bar[XB_XCNT(j)]); sum += c; cnt += (c > 0u) ? 1u : 0u; mine = (j == x) ? c : mine; }
        if (sum == G) break;
        __builtin_amdgcn_s_sleep(1);
        if ((++sp & 255u) == 0u) { if (xb_ld(&bar[XB_TMO])) break; if (sp > XB_SPIN_CAP) { atomicAdd(&bar[XB_TMO], 1u); break; } }
    }
    nloc = mine > 0u ? mine : 1u; nx = cnt > 0u ? cnt : 1u;
}
DEVI void xcd_barrier(const XcdBarrier& b) {
    asm volatile("s_waitcnt vmcnt(0)" ::: "memory");
    __syncthreads();
    if (threadIdx.x == 0) {
        unsigned* bar = b.bar;
        __builtin_amdgcn_s_waitcnt(0);
        unsigned nloc = b.st[0], nx = b.st[1];
        if (nloc == 0u) { xcd_barrier_complete(bar, b.x, nloc, nx); b.st[0] = nloc; b.st[1] = nx; }
        const unsigned old = xb_add(&bar[XB_XSUB(b.x)], 1u);
        const unsigned gen = old / nloc;
        if (old + 1u == (gen + 1u) * nloc) {
            __builtin_amdgcn_fence(__ATOMIC_RELEASE, "agent");
            asm volatile("s_waitcnt vmcnt(0)" ::: "memory");
            const unsigned og = xb_add(&bar[XB_TOP], 1u);
            const unsigned tg = og / nx;
            if (og + 1u == (tg + 1u) * nx) xb_add(&bar[XB_TOPGEN], 1u);
            else XB_SPIN(xb_ld(&bar[XB_TOPGEN]) == tg, bar);
            __builtin_amdgcn_fence(__ATOMIC_ACQUIRE, "agent");
            xb_add(&bar[XB_XGEN(b.x)], 1u);
            asm volatile("s_waitcnt vmcnt(0)" ::: "memory");
        } else {
            XB_SPIN(xb_ld(&bar[XB_XGEN(b.x)]) == gen, bar);
            __builtin_amdgcn_fence(__ATOMIC_ACQUIRE, "agent");
            asm volatile("s_waitcnt vmcnt(0)" ::: "memory");
        }
    }
    __syncthreads();
}

DEVI int chunk_row(int b, int c) { return c >= 16 ? b * 256 + (c - 16) : 2048 + b * 16 + c; }
DEVI int chunk_row_token(int cr) { return cr < 2048 ? (cr >> 8) * LP + (16 + (cr & 255)) * 16 : ((cr - 2048) >> 4) * LP + ((cr - 2048) & 15) * 16; }
DEVI int perm16(int k) { return (k & 3) | ((k & 4) << 1) | ((k & 8) >> 1); }

namespace pg8 {
#define PG8_LAS __attribute__((address_space(3)))
typedef unsigned short bf16_t;
typedef short bf16x8 __attribute__((ext_vector_type(8)));
typedef float f32x4 __attribute__((ext_vector_type(4)));
typedef unsigned u32x4 __attribute__((ext_vector_type(4)));
constexpr int BM = 256, BK = 64, HALF = 128, HTB = HALF * BK * 2  , STAGE_BYTES = 8 * HTB, NXCD = 8, WGM = 8;

__host__ __device__ __forceinline__ int lds_byte(int r, int c) { const int st = (r >> 4) * 2 + (c >> 5), rr = r & 15, cc = c & 31, ob = rr * 64 + cc * 2; return st * 1024 + (ob ^ (((ob >> 9) & 1) << 5)); }
__host__ __device__ __forceinline__ void stage_rc(int b, int& R, int& C) { const int st = b / 1024, sb = b % 1024, swz = sb ^ (((sb >> 9) & 1) << 5); R = (st >> 1) * 16 + swz / 64; C = (st & 1) * 32 + (swz % 64) / 2; }
__host__ __device__ __forceinline__ int perm32(int rho) { const int n = rho >> 4, i = rho & 15; return 8 * (i >> 2) + 4 * n + (i & 3); }

struct Unit { int pm, pn; };
struct Gemm { const bf16_t* A; const bf16_t* Bt; int M, N, K; const int* gidx = nullptr; int islot = 0; };
__device__ __forceinline__ unsigned cvt_pk_bf16(float lo, float hi) { unsigned r; asm volatile("v_cvt_pk_bf16_f32 %0, %1, %2" : "=v"(r) : "v"(lo), "v"(hi)); return r; }
template <class Epi, class Sched, bool ALIGN_EPI = false, bool SP2 = false, bool GATH = false>
__device__ __forceinline__ void gemm_phase(PG8_LAS unsigned char* lds, const Gemm g, const Sched& S, const Epi& E) {
    static_assert(!GATH || SP2, "the gathered-A form is written for the SP2 loop only");
    const int tid = tid_l(), wid = __builtin_amdgcn_readfirstlane(tid >> 6), lane = tid & 63, wr = wid >> 2, wc = wid & 3, fr = lane & 15, fq = lane >> 4;
    const int K = g.K, nt = K / BK;
    unsigned voffA[2], voffB[2];
    int stR[2], stC[2];
#pragma unroll
    for (int i = 0; i < 2; ++i) { int R, C; stage_rc(tid * 16 + i * 8192, R, C); const int Rb = Epi::PERM ? ((R & ~31) + perm32(R & 31)) : R; stR[i] = R; stC[i] = C;
        voffA[i] = (unsigned)(R * K + C) * 2u; voffB[i] = (unsigned)(Rb * K + C) * 2u; }
    unsigned goff[2][2], ngoff[2][2];
    const char* gA = (const char*)g.A;
    const size_t kstep = (size_t)(BK * 2);
    const size_t hstep = (size_t)HALF * K * 2;
    const size_t tstep = 2 * hstep;
    const unsigned ldsw = (unsigned)wid * 1024u;
    const int aoff = lds_byte(wr * 64 + fr, fq * 8), boff = lds_byte(wc * 32 + fr, fq * 8);
#define PG8_SA(b, h) (((b) * 2 + (h)) * HTB)
#define PG8_SB(b, h) ((4 + (b) * 2 + (h)) * HTB)
#define PG8_STAGE(bufoff, gbase, voff) do { _Pragma("unroll") for (int _i = 0; _i < 2; ++_i) \
        __builtin_amdgcn_global_load_lds((const unsigned*)((const char*)(gbase) + (voff)[_i]), (PG8_LAS unsigned*)(lds + (bufoff) + ldsw + _i * 8192), 16, 0, 0); } while (0)
#define PG8_STAGE_A(bufoff, selnext, kt, h) do { if constexpr (GATH) PG8_STAGE(bufoff, gA + (size_t)(kt) * kstep, ((selnext) ? ngoff[h] : goff[h])); \
        else PG8_STAGE(bufoff, ((selnext) ? nA : cA) + (size_t)(kt) * kstep + (size_t)(h) * hstep, voffA); } while (0)
#define PG8_LDA(dst, b, h) do { _Pragma("unroll") for (int m = 0; m < 4; ++m) _Pragma("unroll") for (int k = 0; k < 2; ++k) dst[m][k] = *(const PG8_LAS bf16x8*)(lds + PG8_SA(b, h) + aoff + m * 2048 + k * 1024); } while (0)
#define PG8_LDB(dst, b, h) do { _Pragma("unroll") for (int n = 0; n < 2; ++n) _Pragma("unroll") for (int k = 0; k < 2; ++k) dst[n][k] = *(const PG8_LAS bf16x8*)(lds + PG8_SB(b, h) + boff + n * 2048 + k * 1024); } while (0)
#define PG8_MMA(ai, bj, At, Bt) do { __builtin_amdgcn_s_setprio(1); _Pragma("unroll") for (int m = 0; m < 4; ++m) _Pragma("unroll") for (int n = 0; n < 2; ++n) _Pragma("unroll") for (int k = 0; k < 2; ++k) \
        acc[ai][bj][m][n] = __builtin_amdgcn_mfma_f32_16x16x32_bf16(Bt[n][k], At[m][k], acc[ai][bj][m][n], 0, 0, 0); __builtin_amdgcn_s_setprio(0); } while (0)
#define PG8_WAIT_V(n) asm volatile("s_waitcnt vmcnt(" #n ")" ::: "memory")
#define PG8_WAIT_L(n) asm volatile("s_waitcnt lgkmcnt(" #n ")" ::: "memory")
#define PG8_BAR __builtin_amdgcn_s_barrier()
#define PG8_SCHED __builtin_amdgcn_sched_barrier(0)
    Unit cur, nxt; int ui = 0;
    if (!S.next(0, cur)) return;
    f32x4 acc[2][2][4][2];
#pragma unroll
    for (int a = 0; a < 2; ++a)
#pragma unroll
        for (int b = 0; b < 2; ++b)
#pragma unroll
            for (int m = 0; m < 4; ++m)
#pragma unroll
                for (int n = 0; n < 2; ++n) acc[a][b][m][n] = (f32x4){0.f, 0.f, 0.f, 0.f};
    bf16x8 At[4][2], B0[2][2], B1[2][2];
    const char* cA = (const char*)g.A + (size_t)cur.pm * tstep; const char* cB = (const char*)g.Bt + (size_t)cur.pn * tstep;
    const char* nA = cA;
    if constexpr (GATH) {
#pragma unroll
        for (int h = 0; h < 2; ++h)
#pragma unroll
            for (int i = 0; i < 2; ++i) { goff[h][i] = (unsigned)(g.gidx[cur.pm * 256 + h * 128 + stR[i]] * K + stC[i]) * 2u; ngoff[h][i] = goff[h][i]; }
    }
    S.a_ready(cur);
    if constexpr (SP2) {
        PG8_STAGE(PG8_SB(0, 0), cB, voffB); PG8_STAGE(PG8_SB(0, 1), cB + hstep, voffB); PG8_STAGE_A(PG8_SA(0, 0), false, 0, 0); PG8_STAGE_A(PG8_SA(0, 1), false, 0, 1);
        if (wr == 1) PG8_BAR;
        PG8_WAIT_V(2); PG8_BAR;
        PG8_STAGE(PG8_SB(1, 0), cB + kstep, voffB); PG8_STAGE_A(PG8_SA(1, 0), false, 1, 0); PG8_STAGE(PG8_SB(1, 1), cB + hstep + kstep, voffB);
        PG8_WAIT_V(6); PG8_BAR;
    } else {
        PG8_STAGE(PG8_SB(0, 0), cB, voffB); PG8_STAGE(PG8_SA(0, 0), cA, voffA); PG8_STAGE(PG8_SB(0, 1), cB + hstep, voffB); PG8_STAGE(PG8_SA(0, 1), cA + hstep, voffA);
        if (wr == 1) PG8_BAR;
        PG8_WAIT_V(4); PG8_BAR;
        PG8_STAGE(PG8_SB(1, 0), cB + kstep, voffB); PG8_STAGE(PG8_SA(1, 0), cA + kstep, voffA); PG8_STAGE(PG8_SB(1, 1), cB + hstep + kstep, voffB);
        PG8_WAIT_V(6); PG8_BAR;
    }
    for (;;) {
        const bool has_next = S.next(ui + 1, nxt);
        nA = has_next ? (const char*)g.A + (size_t)nxt.pm * tstep : cA; const char* nB = has_next ? (const char*)g.Bt + (size_t)nxt.pn * tstep : cB;
        if constexpr (GATH) {
            if (has_next) {
#pragma unroll
                for (int h = 0; h < 2; ++h)
#pragma unroll
                    for (int i = 0; i < 2; ++i)
                        __builtin_amdgcn_global_load_lds((const unsigned*)(g.gidx + nxt.pm * 256 + h * 128 + stR[i]), (PG8_LAS unsigned*)(lds + g.islot + ((ui + 1) & 1) * 8192 + (h * 2 + i) * 2048 + wid * 256), 4, 0, 0);
            }
        }
        for (int t = 0; t < nt; t += 2) {
            const bool last = (t == nt - 2);
            if constexpr (GATH) {
                if (last) {
                    if (has_next) {
#pragma unroll
                        for (int h = 0; h < 2; ++h)
#pragma unroll
                            for (int i = 0; i < 2; ++i) { const int ix = *(const PG8_LAS int*)(lds + g.islot + ((ui + 1) & 1) * 8192 + (h * 2 + i) * 2048 + wid * 256 + lane * 4); ngoff[h][i] = (unsigned)(ix * K + stC[i]) * 2u; }
                    } else {
#pragma unroll
                        for (int h = 0; h < 2; ++h)
#pragma unroll
                            for (int i = 0; i < 2; ++i) ngoff[h][i] = goff[h][i];
                    }
                }
            }
            const char* a1 = cA + (size_t)(t + 1) * kstep;
            const char* a2 = last ? nA : cA + (size_t)(t + 2) * kstep; const char* b2 = last ? nB : cB + (size_t)(t + 2) * kstep;
            const char* a3 = a2 + kstep; const char* b3 = b2 + kstep;
            if (last && has_next) S.a_ready(nxt);
            if constexpr (SP2) {
            PG8_LDB(B0, 0, 0); PG8_LDB(B1, 0, 1); PG8_SCHED; PG8_LDA(At, 0, 0); PG8_STAGE_A(PG8_SA(1, 1), false, t + 1, 1);
            PG8_WAIT_V(8); PG8_WAIT_L(0); PG8_BAR; PG8_MMA(0, 0, At, B0); PG8_MMA(0, 1, At, B1); PG8_BAR; PG8_SCHED;
            PG8_LDA(At, 0, 1); PG8_STAGE(PG8_SB(0, 0), b2, voffB); PG8_STAGE(PG8_SB(0, 1), b2 + hstep, voffB); PG8_STAGE_A(PG8_SA(0, 0), last, last ? 0 : t + 2, 0);
            PG8_WAIT_V(8); PG8_WAIT_L(0); PG8_BAR; PG8_MMA(1, 0, At, B0); PG8_MMA(1, 1, At, B1); PG8_BAR; PG8_SCHED;
            PG8_LDB(B0, 1, 0); PG8_LDB(B1, 1, 1); PG8_SCHED; PG8_LDA(At, 1, 0); PG8_STAGE_A(PG8_SA(0, 1), last, last ? 0 : t + 2, 1);
            PG8_WAIT_V(8); PG8_WAIT_L(0); PG8_BAR; PG8_MMA(0, 0, At, B0); PG8_MMA(0, 1, At, B1); PG8_BAR; PG8_SCHED;
            PG8_LDA(At, 1, 1); PG8_STAGE(PG8_SB(1, 0), b3, voffB); PG8_STAGE(PG8_SB(1, 1), b3 + hstep, voffB); PG8_STAGE_A(PG8_SA(1, 0), last, last ? 1 : t + 3, 0);
            PG8_WAIT_V(8); PG8_WAIT_L(0); PG8_BAR; PG8_MMA(1, 0, At, B0); PG8_MMA(1, 1, At, B1); PG8_BAR; PG8_SCHED;
            } else {
            PG8_LDB(B0, 0, 0); PG8_SCHED; PG8_LDA(At, 0, 0); PG8_STAGE(PG8_SA(1, 1), a1 + hstep, voffA);
            PG8_WAIT_L(8); PG8_BAR; PG8_WAIT_L(0); PG8_MMA(0, 0, At, B0); PG8_BAR; PG8_SCHED;
            PG8_LDB(B1, 0, 1); PG8_STAGE(PG8_SB(0, 0), b2, voffB);
            PG8_BAR; PG8_WAIT_L(0); PG8_MMA(0, 1, At, B1); PG8_BAR;
            PG8_LDA(At, 0, 1); PG8_STAGE(PG8_SA(0, 0), a2, voffA);
            PG8_BAR; PG8_WAIT_L(0); PG8_MMA(1, 0, At, B0); PG8_BAR; PG8_SCHED;
            PG8_STAGE(PG8_SB(0, 1), b2 + hstep, voffB);
            PG8_WAIT_V(6); PG8_BAR; PG8_MMA(1, 1, At, B1); PG8_BAR;
            PG8_LDB(B0, 1, 0); PG8_SCHED; PG8_LDA(At, 1, 0); PG8_STAGE(PG8_SA(0, 1), a2 + hstep, voffA);
            PG8_WAIT_L(8); PG8_BAR; PG8_WAIT_L(0); PG8_MMA(0, 0, At, B0); PG8_BAR; PG8_SCHED;
            PG8_LDB(B1, 1, 1); PG8_STAGE(PG8_SB(1, 0), b3, voffB);
            PG8_BAR; PG8_WAIT_L(0); PG8_MMA(0, 1, At, B1); PG8_BAR;
            PG8_LDA(At, 1, 1); PG8_STAGE(PG8_SA(1, 0), a3, voffA);
            PG8_BAR; PG8_WAIT_L(0); PG8_MMA(1, 0, At, B0); PG8_BAR; PG8_SCHED;
            PG8_STAGE(PG8_SB(1, 1), b3 + hstep, voffB);
            PG8_WAIT_V(6); PG8_BAR; PG8_MMA(1, 1, At, B1); PG8_BAR;
            }
        }
        if constexpr (ALIGN_EPI) { if (wr == 0) PG8_BAR; }
        if constexpr (!Epi::AFTER_DRAIN) { E(acc, cur, wr, wc, fr, fq); S.done(cur); }
        if (!has_next) break;
#pragma unroll
        for (int a = 0; a < 2; ++a)
#pragma unroll
            for (int b = 0; b < 2; ++b)
#pragma unroll
                for (int m = 0; m < 4; ++m)
#pragma unroll
                    for (int n = 0; n < 2; ++n) acc[a][b][m][n] = (f32x4){0.f, 0.f, 0.f, 0.f};
        cur = nxt; cA = nA; cB = nB; ++ui;
        if constexpr (GATH) {
#pragma unroll
            for (int h = 0; h < 2; ++h)
#pragma unroll
                for (int i = 0; i < 2; ++i) goff[h][i] = ngoff[h][i];
        }
        if constexpr (ALIGN_EPI) { if (wr == 1) PG8_BAR; }
    }
    PG8_WAIT_V(0);
    if constexpr (!ALIGN_EPI) { if (wr == 0) PG8_BAR; }
    PG8_BAR;
    if constexpr (Epi::AFTER_DRAIN) { E.fused(acc, cur, wr, wc, fr, fq, lds, wid, lane); S.done(cur); }
#undef PG8_SA
#undef PG8_SB
#undef PG8_STAGE
#undef PG8_STAGE_A
#undef PG8_LDA
#undef PG8_LDB
#undef PG8_MMA
#undef PG8_WAIT_V
#undef PG8_WAIT_L
#undef PG8_BAR
#undef PG8_SCHED
}
}


struct TileOrder {
    int nunits, G, c, npm, npn, pn_gs, pm_gs, pm_off, blk48 = 0;
    DEVI bool next(int i, pg8::Unit& u) const {
        const int L = i * G + c; if (L >= nunits) return false;
        const int per = npm * npn, e = L / per, v = L - e * per; int pml = v / npn, pnl = v - pml * npn;
        if (blk48 && v < 256) { const int blk = v >> 5, w = v & 31; pml = (blk >> 1) * 4 + (w >> 3); pnl = (blk & 1) * 8 + (w & 7); }
        u.pm = e * pm_gs + pm_off + pml; u.pn = e * pn_gs + pnl; return true;
    }
    DEVI void a_ready(const pg8::Unit&) const {}
    DEVI void done(const pg8::Unit&) const {}
};

struct Epi8Inproj { static constexpr bool PERM = false, AFTER_DRAIN = false;
    bf16_t* QK; bf16_t* VT; bf16_t* UG; const float* rope;
    DEVI void operator()(const f32x4 (&acc)[2][2][4][2], const pg8::Unit& u, int wr, int wc, int fr, int fq) const {
        const int pn = u.pn;
#pragma unroll
        for (int ai = 0; ai < 2; ++ai)
#pragma unroll
            for (int m = 0; m < 4; ++m) {
                const int r = u.pm * 256 + ai * 128 + wr * 64 + m * 16 + fr, b = r / LP, p = r - b * LP; const bool latent = p >= CTXL; const int t = p - CTXL;
#pragma unroll
                for (int bj = 0; bj < 2; ++bj) {
                    const int cb = bj * 128 + wc * 32;
                    if (pn < 4) {
                        const int head = cb >> 6, dbase = cb & 63, pos = dbase == 0 ? (t >> 6) : (t & 63);
                        const float sc = pn < 2 ? QSCALE : 1.f;
                        f32x4 cs0 = {1.f, 0.f, 1.f, 0.f}, cs1 = {1.f, 0.f, 1.f, 0.f};
                        if (latent) { cs0 = *(const f32x4*)(rope + (pos * 16 + 4 * fq) * 2); cs1 = *(const f32x4*)(rope + (pos * 16 + 4 * fq + 2) * 2); }
                        const float cc[4] = {cs0.x, cs0.z, cs1.x, cs1.z}, sn[4] = {cs0.y, cs0.w, cs1.y, cs1.w};
                        bf16_t* dst = QK + ((size_t)((pn * NB + b) * NH + head) * LP + p) * 64 + dbase + 4 * fq;
#pragma unroll
                        for (int n = 0; n < 2; ++n) {
                            float o[4];
#pragma unroll
                            for (int j = 0; j < 4; ++j) { const float x = acc[ai][bj][m][n][j], y = acc[ai][bj][m][n ^ 1][j]; o[j] = (n == 0 ? x * cc[j] - y * sn[j] : x * cc[j] + y * sn[j]) * sc; }
                            u32x2 w; w.x = pk2(o[0], o[1]); w.y = pk2(o[2], o[3]);
                            *(u32x2*)(dst + 16 * n) = w;
                        }
                    } else if (pn < 6) {
                        const int cv = (pn - 4) * 256 + cb, head = cv >> 7, dv0 = (cv & 127) + 4 * fq;
                        const int pp = (p & ~15) | perm16(p & 15);
                        bf16_t* dst = VT + ((size_t)(b * NH + head) * 128 + dv0) * LP + pp;
#pragma unroll
                        for (int n = 0; n < 2; ++n)
#pragma unroll
                            for (int j = 0; j < 4; ++j) dst[(size_t)(16 * n + j) * LP] = f2bf(acc[ai][bj][m][n][j]);
                    } else {
                        const int ch0 = (pn - 6) * 256 + cb;
                        bf16_t* dst = UG + (size_t)chunk_row(b, p >> 4) * 512 + (p & 15) * 16 + 4 * fq;
#pragma unroll
                        for (int n = 0; n < 2; ++n) {
                            const int g = (ch0 + 16 * n) >> 4;
                            u32x2 w; w.x = pk2(acc[ai][bj][m][n][0], acc[ai][bj][m][n][1]); w.y = pk2(acc[ai][bj][m][n][2], acc[ai][bj][m][n][3]);
                            *(u32x2*)(dst + (size_t)g * NCHP * 512) = w;
                        }
                    }
                }
            }
    }
};

struct Epi8Out { static constexpr bool PERM = true, AFTER_DRAIN = false;
    bf16_t* X; const float* mod;
    DEVI void operator()(const f32x4 (&acc)[2][2][4][2], const pg8::Unit& u, int wr, int wc, int fr, int fq) const {
#pragma unroll
        for (int ai = 0; ai < 2; ++ai)
#pragma unroll
            for (int m = 0; m < 4; ++m) {
                const int r = u.pm * 256 + ai * 128 + wr * 64 + m * 16 + fr, b = r / LP, p = r - b * LP, jm = p < CTXL ? 8 : b;
                const float* g1 = mod + (size_t)jm * 6144 + 2 * 1024;
#pragma unroll
                for (int bj = 0; bj < 2; ++bj) {
                    const int c = u.pn * 256 + bj * 128 + wc * 32 + 8 * fq;
                    bf16_t* xp = X + (size_t)r * 1024 + c;
                    const u32x4 xw = *(const u32x4*)xp;
                    const f32x4 g0 = *(const f32x4*)(g1 + c), g4 = *(const f32x4*)(g1 + c + 4);
                    const f32x4 o0 = hf4((u32x2){xw.x, xw.y}) + g0 * acc[ai][bj][m][0], o1 = hf4((u32x2){xw.z, xw.w}) + g4 * acc[ai][bj][m][1];
                    u32x4 w; w.x = hpk2(o0.x, o0.y); w.y = hpk2(o0.z, o0.w); w.z = hpk2(o1.x, o1.y); w.w = hpk2(o1.z, o1.w);
                    *(u32x4*)xp = w;
                }
            }
    }
};

struct Epi8Moe1 { static constexpr bool PERM = true, AFTER_DRAIN = false;
    bf16_t* HG;
    DEVI void operator()(const f32x4 (&acc)[2][2][4][2], const pg8::Unit& u, int wr, int wc, int fr, int fq) const {
        const int t = u.pn & 15;
#pragma unroll
        for (int ai = 0; ai < 2; ++ai)
#pragma unroll
            for (int m = 0; m < 4; ++m) {
                const size_t row = (size_t)u.pm * 256 + ai * 128 + wr * 64 + m * 16 + fr;
                float o[8];
#pragma unroll
                for (int n = 0; n < 2; ++n)
#pragma unroll
                    for (int j = 0; j < 4; ++j) { const float a1 = acc[ai][0][m][n][j], a3 = acc[ai][1][m][n][j]; o[4 * n + j] = a1 * sigmoidf_(a1) * a3; }
                u32x4 w; w.x = pk2(o[0], o[1]); w.y = pk2(o[2], o[3]); w.z = pk2(o[4], o[5]); w.w = pk2(o[6], o[7]);
                *(u32x4*)(HG + row * FF + t * 128 + wc * 32 + 8 * fq) = w;
            }
    }
};

struct Epi8Moe2 { static constexpr bool PERM = true, AFTER_DRAIN = false;
    bf16_t* OG; const float* gate;
    DEVI void operator()(const f32x4 (&acc)[2][2][4][2], const pg8::Unit& u, int wr, int wc, int fr, int fq) const {
        const int t = u.pn & 3;
#pragma unroll
        for (int ai = 0; ai < 2; ++ai)
#pragma unroll
            for (int m = 0; m < 4; ++m) {
                const size_t row = (size_t)u.pm * 256 + ai * 128 + wr * 64 + m * 16 + fr; const float gt = gate[row];
#pragma unroll
                for (int bj = 0; bj < 2; ++bj) {
                    const f32x4 a = acc[ai][bj][m][0] * gt, c = acc[ai][bj][m][1] * gt;
                    u32x4 w; w.x = pk2(a.x, a.y); w.y = pk2(a.z, a.w); w.z = pk2(c.x, c.y); w.w = pk2(c.z, c.w);
                    *(u32x4*)(OG + row * 1024 + t * 256 + bj * 128 + wc * 32 + 8 * fq) = w;
                }
            }
    }
};

struct Epi8S1 { static constexpr bool PERM = true, AFTER_DRAIN = false;
    unsigned short* E;
    DEVI void operator()(const f32x4 (&acc)[2][2][4][2], const pg8::Unit& u, int wr, int wc, int fr, int fq) const {
        const int g = u.pn, r0 = (u.pm - g * 9) * 256 + wr * 64 + fr;
#pragma unroll
        for (int ai = 0; ai < 2; ++ai)
#pragma unroll
            for (int m = 0; m < 4; ++m) {
                const int cr = r0 + ai * 128 + m * 16;
                if (cr < NCH) {
                    unsigned short* dst = E + ((size_t)g * NCHP + cr) * 256 + wc * 32 + 8 * fq;
#pragma unroll
                    for (int bj = 0; bj < 2; ++bj) {
                        const f32x4 a = acc[ai][bj][m][0], d = acc[ai][bj][m][1];
                        u32x4 w; w.x = hpk2(a.x, a.y); w.y = hpk2(a.z, a.w); w.z = hpk2(d.x, d.y); w.w = hpk2(d.z, d.w);
                        *(u32x4*)(dst + bj * 128) = w;
                    }
                }
            }
    }
};
struct Epi8S2 { static constexpr bool PERM = true, AFTER_DRAIN = false;
    bf16_t* YG;
    DEVI void operator()(const f32x4 (&acc)[2][2][4][2], const pg8::Unit& u, int wr, int wc, int fr, int fq) const {
        const int g = u.pn, r0 = (u.pm - g * 9) * 256 + wr * 64 + fr;
#pragma unroll
        for (int ai = 0; ai < 2; ++ai)
#pragma unroll
            for (int m = 0; m < 4; ++m) {
                const int cr = r0 + ai * 128 + m * 16;
                if (cr < NCH) {
                    const size_t tok0 = (size_t)chunk_row_token(cr);
#pragma unroll
                    for (int bj = 0; bj < 2; ++bj) {
                        const int col = bj * 128 + wc * 32 + 8 * fq, j = col >> 4, h = col & 15;
                        const f32x4 a = acc[ai][bj][m][0], d = acc[ai][bj][m][1];
                        u32x4 w; w.x = pk2(gelu_tanh(a.x), gelu_tanh(a.y)); w.y = pk2(gelu_tanh(a.z), gelu_tanh(a.w)); w.z = pk2(gelu_tanh(d.x), gelu_tanh(d.y)); w.w = pk2(gelu_tanh(d.z), gelu_tanh(d.w));
                        *(u32x4*)(YG + (tok0 + j) * 512 + g * 16 + h) = w;
                    }
                }
            }
    }
};
struct Epi8Glu { static constexpr bool PERM = true, AFTER_DRAIN = false;
    const bf16_t* YG; bf16_t* MIX; const float* bglu;
    DEVI void operator()(const f32x4 (&acc)[2][2][4][2], const pg8::Unit& u, int wr, int wc, int fr, int fq) const {
#pragma unroll
        for (int ai = 0; ai < 2; ++ai)
#pragma unroll
            for (int m = 0; m < 4; ++m) {
                const size_t tok = (size_t)u.pm * 256 + ai * 128 + wr * 64 + m * 16 + fr;
#pragma unroll
                for (int bj = 0; bj < 2; ++bj) {
                    const int n0 = u.pn * 256 + bj * 128 + wc * 32 + 8 * fq;
                    const u32x4 y = *(const u32x4*)(YG + tok * 512 + n0);
                    const f32x4 b0 = *(const f32x4*)(bglu + n0), b1 = *(const f32x4*)(bglu + n0 + 4);
                    const f32x4 a = acc[ai][bj][m][0] + b0, d = acc[ai][bj][m][1] + b1;
                    u32x4 w; w.x = pk2(bflo(y.x) * sigmoidf_(a.x), bfhi(y.x) * sigmoidf_(a.y)); w.y = pk2(bflo(y.y) * sigmoidf_(a.z), bfhi(y.y) * sigmoidf_(a.w));
                    w.z = pk2(bflo(y.z) * sigmoidf_(d.x), bfhi(y.z) * sigmoidf_(d.y)); w.w = pk2(bflo(y.w) * sigmoidf_(d.z), bfhi(y.w) * sigmoidf_(d.w));
                    *(u32x4*)(MIX + tok * 1024 + 512 + n0) = w;
                }
            }
    }
};

struct Params {
    const float* in[30];
    float* out;
    unsigned char* ws;
    int lo, hi;
};

DEVI int swz(int row, int kc) { return row * 128 + ((kc ^ ((row >> 1) & 7)) << 4); }

struct APlain { const bf16_t* A; int lda; DEVI const bf16_t* ptr(int row, int k) const { return A + (size_t)row * lda + k; } };
struct AS2 { const bf16_t* U; const bf16_t* S; DEVI const bf16_t* ptr(int row, int k) const { return (k < 256 ? U : S) + (size_t)row * 8192 + (k & 255); } };

template <int BM, class AF, class Epi>
DEVI void gemm_unit(char* lds, const AF& af, const bf16_t* __restrict__ Bt, int ldb, int K, int m0, int n0, const Epi& epi) {
    constexpr int MT = BM / 128, ACH = BM / 64, A_BYTES = BM * 128, STAGE = A_BYTES + 16384, WM = BM / 4;
    const int tid = tid_l(), lane = tid & 63, wid = tid >> 6, wm = wid >> 1, wn = wid & 1, r32 = lane & 31, hi = lane >> 5;
    f32x16 acc[MT][2];
#pragma unroll
    for (int a = 0; a < MT; ++a)
#pragma unroll
        for (int b = 0; b < 2; ++b)
#pragma unroll
            for (int i = 0; i < 16; ++i) acc[a][b][i] = 0.f;
    u32x4 ra[ACH], rb[2];
    const int nk = K >> 6;
    const int crow = tid >> 3, ckc = tid & 7;
#define G_LOAD(kt) do { \
        _Pragma("unroll") for (int i = 0; i < ACH; ++i) ra[i] = *(const u32x4*)af.ptr(m0 + crow + 64 * i, (kt) * 64 + ckc * 8); \
        _Pragma("unroll") for (int i = 0; i < 2; ++i) rb[i] = *(const u32x4*)(Bt + (size_t)(n0 + crow + 64 * i) * ldb + (kt) * 64 + ckc * 8); } while (0)
#define G_STORE(s) do { char* _a = lds + (s) * STAGE; char* _b = _a + A_BYTES; \
        _Pragma("unroll") for (int i = 0; i < ACH; ++i) *(u32x4*)(_a + swz(crow + 64 * i, ckc)) = ra[i]; \
        _Pragma("unroll") for (int i = 0; i < 2; ++i) *(u32x4*)(_b + swz(crow + 64 * i, ckc)) = rb[i]; } while (0)
    G_LOAD(0); G_STORE(0); __syncthreads();
    for (int kt = 0; kt < nk; ++kt) {
        if (kt + 1 < nk) G_LOAD(kt + 1);
        const char* a = lds + (kt & 1) * STAGE; const char* b = a + A_BYTES;
#pragma unroll
        for (int ks = 0; ks < 4; ++ks) {
            bf16x8 wf[2], xf[MT];
#pragma unroll
            for (int nt = 0; nt < 2; ++nt) wf[nt] = *(const bf16x8*)(b + swz(wn * 64 + nt * 32 + r32, ks * 2 + hi));
#pragma unroll
            for (int mt = 0; mt < MT; ++mt) xf[mt] = *(const bf16x8*)(a + swz(wm * WM + mt * 32 + r32, ks * 2 + hi));
#pragma unroll
            for (int mt = 0; mt < MT; ++mt)
#pragma unroll
                for (int nt = 0; nt < 2; ++nt) acc[mt][nt] = MFMA32(wf[nt], xf[mt], acc[mt][nt]);
        }
        if (kt + 1 < nk) G_STORE((kt + 1) & 1);
        __syncthreads();
    }
#undef G_LOAD
#undef G_STORE
    epi.template run<MT>(acc, m0 + wm * WM + r32, n0 + wn * 64, hi);
}

template <class AF, class Epi>
DEVI void gemm_unit_dma(char* lds, const AF& af, const bf16_t* __restrict__ Bt, int ldb, int K, int m0, int n0, const Epi& epi) {
    const int tid = tid_l(), lane = tid & 63, wid = tid >> 6, wm = wid >> 1, wn = wid & 1, r32 = lane & 31, hi = lane >> 5;
    f32x16 acc[1][2];
#pragma unroll
    for (int b = 0; b < 2; ++b)
#pragma unroll
        for (int i = 0; i < 16; ++i) acc[0][b][i] = 0.f;
    const int nk = K >> 6;
    const int drow0 = wid * 16 + (lane >> 3), drow1 = drow0 + 8;
    const int kc0 = (lane & 7) ^ ((drow0 >> 1) & 7), kc1 = (lane & 7) ^ ((drow1 >> 1) & 7);
    const bf16_t* ga0 = af.ptr(m0 + drow0, kc0 * 8); const bf16_t* ga1 = af.ptr(m0 + drow1, kc1 * 8);
    const bf16_t* gb0 = Bt + (size_t)(n0 + drow0) * ldb + kc0 * 8; const bf16_t* gb1 = Bt + (size_t)(n0 + drow1) * ldb + kc1 * 8;
    LAS unsigned char* dl = (LAS unsigned char*)lds + wid * 2048;
#define GD_LDS(g, off) __builtin_amdgcn_global_load_lds((const unsigned*)(g), (LAS unsigned*)(dl + (off)), 16, 0, 0)
#define GD_ISSUE(kt) do { const int _s = ((kt) & 3) * 32768; GD_LDS(ga0 + (kt) * 64, _s); GD_LDS(ga1 + (kt) * 64, _s + 1024); GD_LDS(gb0 + (kt) * 64, _s + 16384); GD_LDS(gb1 + (kt) * 64, _s + 16384 + 1024); } while (0)
#define GD_WAITBAR(N) asm volatile("s_waitcnt vmcnt(" #N ") lgkmcnt(0)\n\ts_barrier" ::: "memory")
    GD_ISSUE(0); GD_ISSUE(1); GD_ISSUE(2);
    for (int kt = 0; kt < nk; ++kt) {
        if (kt + 2 < nk) GD_WAITBAR(8); else if (kt + 1 < nk) GD_WAITBAR(4); else GD_WAITBAR(0);
        if (kt + 3 < nk) GD_ISSUE(kt + 3);
        const char* a = lds + (kt & 3) * 32768; const char* b = a + 16384;
#pragma unroll
        for (int ks = 0; ks < 4; ++ks) {
            bf16x8 wf[2], xf;
#pragma unroll
            for (int nt = 0; nt < 2; ++nt) wf[nt] = *(const bf16x8*)(b + swz(wn * 64 + nt * 32 + r32, ks * 2 + hi));
            xf = *(const bf16x8*)(a + swz(wm * 32 + r32, ks * 2 + hi));
#pragma unroll
            for (int nt = 0; nt < 2; ++nt) acc[0][nt] = MFMA32(wf[nt], xf, acc[0][nt]);
        }
    }
#undef GD_LDS
#undef GD_ISSUE
#undef GD_WAITBAR
    __syncthreads();
    epi.template run<1>(acc, m0 + wm * 32 + r32, n0 + wn * 64, hi);
}


struct EpiInproj {
    bf16_t* QK; bf16_t* VT; bf16_t* UG; const float* rope;
    template <int MT> DEVI void run(const f32x16 (&acc)[MT][2], int mrow0, int ncol0, int hi) const {
#pragma unroll
        for (int mt = 0; mt < MT; ++mt) {
            const int r = mrow0 + mt * 32, b = r / LP, p = r - b * LP; const bool latent = p >= CTXL; const int t = p - CTXL;
#pragma unroll
            for (int nt = 0; nt < 2; ++nt) {
                const int nb = ncol0 + nt * 32; const f32x16& v = acc[mt][nt];
                if (nb < 1024) {
                    const int which = nb >> 8, head = (nb >> 6) & 3, dbase = nb & 63;
                    const int pos = dbase == 0 ? (t >> 6) : (t & 63);
                    bf16_t* dst = QK + ((size_t)((which * NB + b) * NH + head) * LP + p) * 64 + dbase + 4 * hi;
                    const float sc = which < 2 ? QSCALE : 1.f;
#pragma unroll
                    for (int i4 = 0; i4 < 4; ++i4) {
                        float o[4];
#pragma unroll
                        for (int j = 0; j < 4; ++j) {
                            float x = v[4 * i4 + j];
                            if (latent) {
                                const float y = v[4 * (i4 ^ 2) + j];
                                const f32x2 cs = *(const f32x2*)(rope + (pos * 16 + 8 * (i4 & 1) + 4 * hi + j) * 2);
                                x = (i4 < 2) ? (x * cs.x - y * cs.y) : (x * cs.x + y * cs.y);
                            }
                            o[j] = x * sc;
                        }
                        u32x2 w; w.x = pk2(o[0], o[1]); w.y = pk2(o[2], o[3]);
                        *(u32x2*)(dst + 8 * i4) = w;
                    }
                } else if (nb < 1536) {
                    const int n1 = nb - 1024, head = n1 >> 7, dv0 = n1 & 127;
                    const int pp = (p & ~15) | perm16(p & 15);
                    bf16_t* dst = VT + ((size_t)(b * NH + head) * 128 + dv0 + 4 * hi) * LP + pp;
#pragma unroll
                    for (int i = 0; i < 16; ++i) dst[(size_t)((i & 3) + 8 * (i >> 2)) * LP] = f2bf(v[i]);
                } else {
                    const int n1 = nb - 1536;
                    bf16_t* dst = UG + (size_t)chunk_row(b, p >> 4) * 512 + (p & 15) * 16;
#pragma unroll
                    for (int i4 = 0; i4 < 4; ++i4) {
                        const int ch = n1 + 8 * i4 + 4 * hi, g = ch >> 4, hc = ch & 15;
                        u32x2 w; w.x = pk2(v[4 * i4], v[4 * i4 + 1]); w.y = pk2(v[4 * i4 + 2], v[4 * i4 + 3]);
                        *(u32x2*)(dst + (size_t)g * NCHP * 512 + hc) = w;
                    }
                }
            }
        }
    }
};

struct EpiS1 {
    unsigned short* E;
    template <int MT> DEVI void run(const f32x16 (&acc)[MT][2], int mrow0, int ncol0, int hi) const {
#pragma unroll
        for (int mt = 0; mt < MT; ++mt) {
            unsigned short* dst = E + (size_t)(mrow0 + mt * 32) * 256 + ncol0 + 4 * hi;
#pragma unroll
            for (int nt = 0; nt < 2; ++nt)
#pragma unroll
                for (int i4 = 0; i4 < 4; ++i4) {
                    u32x2 w; w.x = hpk2(acc[mt][nt][4 * i4], acc[mt][nt][4 * i4 + 1]); w.y = hpk2(acc[mt][nt][4 * i4 + 2], acc[mt][nt][4 * i4 + 3]);
                    *(u32x2*)(dst + nt * 32 + 8 * i4) = w;
                }
        }
    }
};

struct EpiS2 {
    bf16_t* YG; int g;
    template <int MT> DEVI void run(const f32x16 (&acc)[MT][2], int mrow0, int ncol0, int hi) const {
#pragma unroll
        for (int mt = 0; mt < MT; ++mt) {
            const size_t tok0 = (size_t)chunk_row_token(mrow0 + mt * 32);
#pragma unroll
            for (int nt = 0; nt < 2; ++nt)
#pragma unroll
                for (int i4 = 0; i4 < 4; ++i4) {
                    const int n = ncol0 + nt * 32 + 8 * i4 + 4 * hi, j = n >> 4, h = n & 15;
                    u32x2 w; w.x = pk2(gelu_tanh(acc[mt][nt][4 * i4]), gelu_tanh(acc[mt][nt][4 * i4 + 1]));
                    w.y = pk2(gelu_tanh(acc[mt][nt][4 * i4 + 2]), gelu_tanh(acc[mt][nt][4 * i4 + 3]));
                    *(u32x2*)(YG + (tok0 + j) * 512 + g * 16 + h) = w;
                }
        }
    }
};

struct EpiGlu {
    const bf16_t* YG; bf16_t* MIX; const float* bglu;
    template <int MT> DEVI void run(const f32x16 (&acc)[MT][2], int mrow0, int ncol0, int hi) const {
#pragma unroll
        for (int mt = 0; mt < MT; ++mt) {
            const size_t tok = mrow0 + mt * 32;
#pragma unroll
            for (int nt = 0; nt < 2; ++nt)
#pragma unroll
                for (int i4 = 0; i4 < 4; ++i4) {
                    const int n = ncol0 + nt * 32 + 8 * i4 + 4 * hi;
                    const u32x2 y = *(const u32x2*)(YG + tok * 512 + n);
                    const f32x4 bb = *(const f32x4*)(bglu + n);
                    const float o0 = bflo(y.x) * sigmoidf_(acc[mt][nt][4 * i4] + bb.x), o1 = bfhi(y.x) * sigmoidf_(acc[mt][nt][4 * i4 + 1] + bb.y);
                    const float o2 = bflo(y.y) * sigmoidf_(acc[mt][nt][4 * i4 + 2] + bb.z), o3 = bfhi(y.y) * sigmoidf_(acc[mt][nt][4 * i4 + 3] + bb.w);
                    u32x2 w; w.x = pk2(o0, o1); w.y = pk2(o2, o3);
                    *(u32x2*)(MIX + tok * 1024 + 512 + n) = w;
                }
        }
    }
};

struct EpiOut {
    bf16_t* X; const float* mod;
    template <int MT> DEVI void run(const f32x16 (&acc)[MT][2], int mrow0, int ncol0, int hi) const {
#pragma unroll
        for (int mt = 0; mt < MT; ++mt) {
            const int r = mrow0 + mt * 32, b = r / LP, p = r - b * LP, j = p < CTXL ? 8 : b;
            const float* g1 = mod + (size_t)j * 6144 + 2 * 1024;
#pragma unroll
            for (int nt = 0; nt < 2; ++nt)
#pragma unroll
                for (int i4 = 0; i4 < 4; ++i4) {
                    const int n = ncol0 + nt * 32 + 8 * i4 + 4 * hi;
                    bf16_t* xp = X + (size_t)r * 1024 + n;
                    f32x4 x = hf4(*(const u32x2*)xp); const f32x4 g = *(const f32x4*)(g1 + n);
                    x.x += g.x * acc[mt][nt][4 * i4]; x.y += g.y * acc[mt][nt][4 * i4 + 1]; x.z += g.z * acc[mt][nt][4 * i4 + 2]; x.w += g.w * acc[mt][nt][4 * i4 + 3];
                    u32x2 w; w.x = hpk2(x.x, x.y); w.y = hpk2(x.z, x.w);
                    *(u32x2*)xp = w;
                }
        }
    }
};

struct EpiMoe1 {
    bf16_t* HG;
    template <int MT> DEVI void run(const f32x16 (&acc)[MT][2], int mrow0, int ncol0, int hi) const {
#pragma unroll
        for (int mt = 0; mt < MT; ++mt) {
            bf16_t* dst = HG + (size_t)(mrow0 + mt * 32) * FF + (ncol0 >> 1) + 4 * hi;
#pragma unroll
            for (int i4 = 0; i4 < 4; ++i4) {
                float o[4];
#pragma unroll
                for (int j = 0; j < 4; ++j) { const float a1 = acc[mt][0][4 * i4 + j], a3 = acc[mt][1][4 * i4 + j]; o[j] = a1 * sigmoidf_(a1) * a3; }
                u32x2 w; w.x = pk2(o[0], o[1]); w.y = pk2(o[2], o[3]);
                *(u32x2*)(dst + 8 * i4) = w;
            }
        }
    }
};

struct EpiMoe2 {
    bf16_t* OG; const float* gate;
    template <int MT> DEVI void run(const f32x16 (&acc)[MT][2], int mrow0, int ncol0, int hi) const {
#pragma unroll
        for (int mt = 0; mt < MT; ++mt) {
            const int row = mrow0 + mt * 32; const float gt = gate[row];
            bf16_t* dst = OG + (size_t)row * 1024 + ncol0 + 4 * hi;
#pragma unroll
            for (int nt = 0; nt < 2; ++nt)
#pragma unroll
                for (int i4 = 0; i4 < 4; ++i4) {
                    u32x2 w; w.x = pk2(acc[mt][nt][4 * i4] * gt, acc[mt][nt][4 * i4 + 1] * gt); w.y = pk2(acc[mt][nt][4 * i4 + 2] * gt, acc[mt][nt][4 * i4 + 3] * gt);
                    *(u32x2*)(dst + nt * 32 + 8 * i4) = w;
                }
        }
    }
};

DEVI void transpose_unit(char* lds, const float* __restrict__ W, int K, int N, bf16_t* __restrict__ out, int k0, int n0, int mode  ) {
    float* tile = (float*)lds;
    const int tid = tid_l();
    f32x4 v[8];
#pragma unroll
    for (int i = 0; i < 8; ++i) { const int c = tid + 512 * i, k = c >> 6, n4 = (c & 63) * 4; v[i] = *(const f32x4*)(W + (size_t)(k0 + k) * N + n0 + n4); }
#pragma unroll
    for (int i = 0; i < 8; ++i) { const int c = tid + 512 * i, k = c >> 6, n4 = (c & 63) * 4; float* t = tile + k * 257 + n4; t[0] = v[i].x; t[1] = v[i].y; t[2] = v[i].z; t[3] = v[i].w; }
    __syncthreads();
#pragma unroll
    for (int i = 0; i < 4; ++i) {
        const int c = tid + 512 * i, n = c >> 3, k8 = (c & 7) * 8;
        float f[8];
#pragma unroll
        for (int j = 0; j < 8; ++j) f[j] = tile[(k8 + j) * 257 + n];
        u32x4 w; w.x = pk2(f[0], f[1]); w.y = pk2(f[2], f[3]); w.z = pk2(f[4], f[5]); w.w = pk2(f[6], f[7]);
        const int ng = n0 + n; const int orow = mode == 0 ? ng : ((ng >> 7) * 256 + (mode - 1) * 128 + (ng & 127));
        *(u32x4*)(out + (size_t)orow * K + k0 + k8) = w;
    }
    __syncthreads();
}

DEVI void adaln_unit(char* lds, const Params& P, int l, int n0) {
    float* sc = (float*)lds;
    float* red = sc + 9 * 1024;
    const int tid = tid_l(), lane = tid & 63, wid = tid >> 6;
    for (int i = tid; i < 9 * 1024; i += 512) { const float c = i < 8192 ? P.in[1][i] : P.in[3][i - 8192]; sc[i] = c * __builtin_amdgcn_rcpf(1.f + __expf(-c)); }
    __syncthreads();
    const float* W = P.in[4] + (size_t)l * 1024 * 6144 + n0 + lane;
    float a[9];
#pragma unroll
    for (int j = 0; j < 9; ++j) a[j] = 0.f;
    for (int kk = 0; kk < 128; kk += 16) {
        float w[16];
#pragma unroll
        for (int u = 0; u < 16; ++u) w[u] = W[(size_t)(wid * 128 + kk + u) * 6144];
#pragma unroll
        for (int u4 = 0; u4 < 4; ++u4)
#pragma unroll
            for (int j = 0; j < 9; ++j) { const f32x4 s4 = *(const f32x4*)(sc + j * 1024 + wid * 128 + kk + 4 * u4); a[j] += s4.x * w[4 * u4] + s4.y * w[4 * u4 + 1] + s4.z * w[4 * u4 + 2] + s4.w * w[4 * u4 + 3]; }
    }
#pragma unroll
    for (int j = 0; j < 9; ++j) red[(wid * 9 + j) * 64 + lane] = a[j];
    __syncthreads();
    for (int i = tid; i < 9 * 64; i += 512) {
        const int j = i >> 6, n = i & 63; float s = 0.f;
#pragma unroll
        for (int w = 0; w < 8; ++w) s += red[(w * 9 + j) * 64 + n];
        ((float*)(ptr_l(P.ws) + WS_MOD))[((size_t)l * 9 + j) * 6144 + n0 + n] = s + P.in[5][(size_t)l * 6144 + n0 + n];
    }
    __syncthreads();
}

DEVI void ssm_tab_unit(char* lds, const Params& P, int l, int d, int g) {
    float* pw = (float*)lds;
    float* bb = pw + 64 * 17 * 2;
    float* cc = bb + 64 * 16 * 2;
    const int tid = tid_l();
    const size_t ldg = ((size_t)l * 2 + d) * 32 + g;
    const float dt = expf(P.in[16][ldg]);
    float* PW = (float*)(ptr_l(P.ws) + WS_PW) + ldg * 64 * 17 * 2;
    float* BB = (float*)(ptr_l(P.ws) + WS_BBAR) + ldg * 64 * 16 * 2;
    for (int i = tid; i < 64 * 17; i += 512) {
        const int p = i / 17, n = i - p * 17;
        const float lr = P.in[14][ldg * 64 + p], li = P.in[15][ldg * 64 + p];
        const float mag = expf(lr * dt * n); float s, c; sincosf(li * dt * n, &s, &c);
        pw[i * 2] = mag * c; pw[i * 2 + 1] = mag * s; PW[i * 2] = mag * c; PW[i * 2 + 1] = mag * s;
    }
    for (int i = tid; i < 64 * 16; i += 512) {
        const int p = i >> 4, h = i & 15;
        const float lr = P.in[14][ldg * 64 + p], li = P.in[15][ldg * 64 + p];
        const float mag = expf(lr * dt); float s, c; sincosf(li * dt, &s, &c);
        const float nr = mag * c - 1.f, ni = mag * s;
        const float den = lr * lr + li * li;
        const float qr = (nr * lr + ni * li) / den, qi = (ni * lr - nr * li) / den;
        const float br = P.in[17][(ldg * 64 + p) * 16 + h], bi = P.in[18][(ldg * 64 + p) * 16 + h];
        const float xr = qr * br - qi * bi, xi = qr * bi + qi * br;
        bb[i * 2] = xr; bb[i * 2 + 1] = xi; BB[i * 2] = xr; BB[i * 2 + 1] = xi;
    }
    for (int i = tid; i < 16 * 64; i += 512) { const int h = i >> 6, p = i & 63; cc[(h * 65 + p) * 2] = P.in[19][ldg * 1024 + i]; cc[(h * 65 + p) * 2 + 1] = P.in[20][ldg * 1024 + i]; }
    __syncthreads();
    float* KT = (float*)(ptr_l(P.ws) + WS_KTAB) + ldg * 4096;
    {
        const int dl = tid >> 5, h = (tid >> 1) & 15, hf = tid & 1;
        float sacc[8];
#pragma unroll
        for (int q = 0; q < 8; ++q) sacc[q] = 0.f;
        for (int p = 0; p < 64; ++p) {
            const f32x2 c = *(const f32x2*)(cc + (h * 65 + p) * 2), w = *(const f32x2*)(pw + (p * 17 + dl) * 2);
            const float tr = c.x * w.x - c.y * w.y, ti = c.x * w.y + c.y * w.x;
            const f32x4* bp = (const f32x4*)(bb + (p * 16 + hf * 8) * 2);
            const f32x4 b0 = bp[0], b1 = bp[1], b2 = bp[2], b3 = bp[3];
            sacc[0] += tr * b0.x - ti * b0.y; sacc[1] += tr * b0.z - ti * b0.w; sacc[2] += tr * b1.x - ti * b1.y; sacc[3] += tr * b1.z - ti * b1.w;
            sacc[4] += tr * b2.x - ti * b2.y; sacc[5] += tr * b2.z - ti * b2.w; sacc[6] += tr * b3.x - ti * b3.y; sacc[7] += tr * b3.z - ti * b3.w;
        }
        float* dst = KT + dl * 256 + h * 16 + hf * 8;
        *(f32x4*)dst = (f32x4){sacc[0], sacc[1], sacc[2], sacc[3]}; *(f32x4*)(dst + 4) = (f32x4){sacc[4], sacc[5], sacc[6], sacc[7]};
    }
    __syncthreads();
}

template <bool FIRST>
DEVI void rowpass1(const Params& P, int l) {
    const int tid = tid_l(), lane = tid & 63, wid = tid >> 6;
    bf16_t* X = (bf16_t*)(ptr_l(P.ws) + WS_X); bf16_t* HX = (bf16_t*)(ptr_l(P.ws) + WS_HX);
    const bf16_t* OG = (const bf16_t*)(ptr_l(P.ws) + WS_OG); const int* SLOT = (const int*)(ptr_l(P.ws) + WS_SLOT);
    const float* MOD = (const float*)(ptr_l(P.ws) + WS_MOD);
    const int stride = gridDim.x * 8;
    int r = blockIdx.x * 8 + wid;
    f32x4 xf[4]; u32x2 xb[4]; int svn = -1;
    auto issue = [&](int rr) {
        if constexpr (FIRST) {
            const int b = rr / LP, p = rr - b * LP;
            const float* src = p < CTXL ? P.in[2] + ((size_t)b * CTXL + p) * 1024 : P.in[0] + ((size_t)b * SEQ + (p - CTXL)) * 1024;
#pragma unroll
            for (int i = 0; i < 4; ++i) xf[i] = *(const f32x4*)(src + lane * 4 + 256 * i);
        } else {
#pragma unroll
            for (int i = 0; i < 4; ++i) xb[i] = *(const u32x2*)(X + (size_t)rr * 1024 + lane * 4 + 256 * i);
            svn = SLOT[(size_t)rr * 16 + (lane & 15)];
        }
    };
    if (r < R) issue(r);
    for (; r < R; r += stride) {
        const int b = r / LP, p = r - b * LP, j = p < CTXL ? 8 : b;
        f32x4 x[4]; const int sv = svn;
#pragma unroll
        for (int i = 0; i < 4; ++i) { if constexpr (FIRST) x[i] = xf[i]; else x[i] = hf4(xb[i]); }
        if (r + stride < R) issue(r + stride);
        if (l == DEPTH && p < CTXL) continue;
        if constexpr (!FIRST) {
            const float* g2 = MOD + ((size_t)(l - 1) * 9 + j) * 6144 + 5 * 1024;
            f32x4 m[4];
#pragma unroll
            for (int i = 0; i < 4; ++i) m[i] = (f32x4){0.f, 0.f, 0.f, 0.f};
            unsigned mask = (unsigned)__ballot(sv >= 0 && lane < 16) & 0xffffu;
            while (mask) {
                const int e0 = __builtin_ctz(mask); mask &= mask - 1;
                const int s0 = __builtin_amdgcn_readlane(sv, e0);
                const bool two = mask != 0u;
                const int e1 = two ? __builtin_ctz(mask) : e0; if (two) mask &= mask - 1;
                const int s1 = __builtin_amdgcn_readlane(sv, e1);
                const bf16_t* o0 = OG + ((size_t)e0 * ROWS_E + s0) * 1024 + lane * 4; const bf16_t* o1 = OG + ((size_t)e1 * ROWS_E + s1) * 1024 + lane * 4;
                u32x2 w0[4], w1[4];
#pragma unroll
                for (int i = 0; i < 4; ++i) { w0[i] = *(const u32x2*)(o0 + 256 * i); w1[i] = *(const u32x2*)(o1 + 256 * i); }
                const float f1 = two ? 1.f : 0.f;
#pragma unroll
                for (int i = 0; i < 4; ++i) m[i] += bf4(w0[i]) + f1 * bf4(w1[i]);
            }
#pragma unroll
            for (int i = 0; i < 4; ++i) { const f32x4 g = *(const f32x4*)(g2 + lane * 4 + 256 * i); x[i] += g * m[i]; }
        }
        float ss = 0.f;
#pragma unroll
        for (int i = 0; i < 4; ++i) ss += x[i].x * x[i].x + x[i].y * x[i].y + x[i].z * x[i].z + x[i].w * x[i].w;
        ss = wave_sum(ss);
        const float rstd = rsqrtf(ss * (1.f / 1024.f) + EPS);
        if (l < DEPTH) {
            const float* ng = P.in[6] + (size_t)l * 1024; const float* sh = MOD + ((size_t)l * 9 + j) * 6144; const float* scl = sh + 1024;
#pragma unroll
            for (int i = 0; i < 4; ++i) {
                const int c = lane * 4 + 256 * i;
                u32x2 xw; xw.x = hpk2(x[i].x, x[i].y); xw.y = hpk2(x[i].z, x[i].w);
                *(u32x2*)(X + (size_t)r * 1024 + c) = xw;
                const f32x4 g = *(const f32x4*)(ng + c), s1 = *(const f32x4*)(scl + c), s0 = *(const f32x4*)(sh + c);
                const f32x4 h = (x[i] * rstd * g) * (1.f + s1) + s0;
                u32x2 w; w.x = pk2(h.x, h.y); w.y = pk2(h.z, h.w);
                *(u32x2*)(HX + (size_t)r * 1024 + c) = w;
            }
        } else {
            float* o = P.out + ((size_t)b * SEQ + (p - CTXL)) * 1024;
#pragma unroll
            for (int i = 0; i < 4; ++i) { const int c = lane * 4 + 256 * i; const f32x4 g = *(const f32x4*)(P.in[29] + c); *(f32x4*)(o + c) = x[i] * rstd * g; }
        }
    }
}

DEVI float router_fold_softmax(const float (&pa)[16], int lane) {
    float q8[8], q4[4], q2[2];
#pragma unroll
    for (int i = 0; i < 8; ++i) { float r0, r1; swap32(pa[i], pa[i + 8], r0, r1); q8[i] = r0 + r1; }
#pragma unroll
    for (int i = 0; i < 4; ++i) { float r0, r1; swap16(q8[i], q8[i + 4], r0, r1); q4[i] = r0 + r1; }
    { const bool hb = (lane & 8) != 0;
#pragma unroll
      for (int i = 0; i < 2; ++i) { const float snd = hb ? q4[i] : q4[i + 2], kp = hb ? q4[i + 2] : q4[i]; q2[i] = kp + dppmov<0x128>(snd); } }
    float lg;
    { const bool hb = (lane & 4) != 0; const float snd = hb ? q2[0] : q2[1], kp = hb ? q2[1] : q2[0];
      const float up = dppmov<0x104>(snd), dn = dppmov<0x114>(snd);
      lg = kp + (hb ? dn : up); }
    lg += dppmov<0x4E>(lg); lg += dppmov<0xB1>(lg);
    float mx = fmaxf(lg, dppmov<0x124>(lg)); mx = fmaxf(mx, dppmov<0x128>(mx));
    { float r0, r1; swap16(mx, mx, r0, r1); mx = fmaxf(r0, r1); swap32(mx, mx, r0, r1); mx = fmaxf(r0, r1); }
    const float ex = expf(lg - mx);
    float sum = ex + dppmov<0x124>(ex); sum += dppmov<0x128>(sum);
    { float r0, r1; swap16(sum, sum, r0, r1); sum = r0 + r1; swap32(sum, sum, r0, r1); sum = r0 + r1; }
    return ex / sum;
}
DEVI void rowpass2(char* lds, const Params& P, int l) {
    const int tid = tid_l(), lane = tid & 63, wid = tid >> 6;
    float* wrT = (float*)lds;
    const float* wr = P.in[25] + (size_t)l * 1024 * 16;
    for (int i = tid; i < 16384; i += 512) { const int k = i >> 4, e = i & 15; wrT[e * 1024 + k] = wr[i]; }
    __syncthreads();
    const bf16_t* X = (const bf16_t*)(ptr_l(P.ws) + WS_X); bf16_t* HX = (bf16_t*)(ptr_l(P.ws) + WS_HX);
    const float* MOD = (const float*)(ptr_l(P.ws) + WS_MOD); float* AFFT = (float*)(ptr_l(P.ws) + WS_AFFT);
    const float* ng = P.in[7] + (size_t)l * 1024;
    const int stride = gridDim.x * 8;
    int r = blockIdx.x * 8 + wid;
    u32x2 xn[2][4];
#pragma unroll
    for (int q = 0; q < 2; ++q) if (r + q * stride < R) {
#pragma unroll
        for (int i = 0; i < 4; ++i) xn[q][i] = *(const u32x2*)(X + (size_t)(r + q * stride) * 1024 + lane * 4 + 256 * i);
    }
    for (; r < R; r += 2 * stride) {
        const bool two = r + stride < R;
        f32x4 h[2][4]; int bb[2], pp[2];
#pragma unroll
        for (int q = 0; q < 2; ++q) {
            const int rq = (q == 0 || two) ? r + q * stride : r;
            const int b = rq / LP, p = rq - b * LP, j = p < CTXL ? 8 : b; bb[q] = b; pp[q] = p;
            float ss = 0.f;
#pragma unroll
            for (int i = 0; i < 4; ++i) { h[q][i] = hf4(xn[q][i]); ss += h[q][i].x * h[q][i].x + h[q][i].y * h[q][i].y + h[q][i].z * h[q][i].z + h[q][i].w * h[q][i].w; }
            ss = wave_sum(ss);
            const float rstd = rsqrtf(ss * (1.f / 1024.f) + EPS);
            const float* sh = MOD + ((size_t)l * 9 + j) * 6144 + 3 * 1024; const float* scl = sh + 1024;
#pragma unroll
            for (int i = 0; i < 4; ++i) {
                const int c = lane * 4 + 256 * i;
                const f32x4 g = *(const f32x4*)(ng + c), s1 = *(const f32x4*)(scl + c), s0 = *(const f32x4*)(sh + c);
                h[q][i] = (h[q][i] * rstd * g) * (1.f + s1) + s0;
                if (q == 0 || two) { u32x2 w; w.x = pk2(h[q][i].x, h[q][i].y); w.y = pk2(h[q][i].z, h[q][i].w); *(u32x2*)(HX + (size_t)rq * 1024 + c) = w; }
            }
        }
#pragma unroll
        for (int q = 0; q < 2; ++q) if (r + (2 + q) * stride < R) {
#pragma unroll
            for (int i = 0; i < 4; ++i) xn[q][i] = *(const u32x2*)(X + (size_t)(r + (2 + q) * stride) * 1024 + lane * 4 + 256 * i);
        }
        float pa[2][16];
#pragma unroll
        for (int eg = 0; eg < 4; ++eg) {
#pragma unroll
            for (int e = 4 * eg; e < 4 * eg + 4; ++e) {
                f32x2 s0 = {0.f, 0.f}, s1 = {0.f, 0.f};
#pragma unroll
                for (int i = 0; i < 4; ++i) { const f32x4 w = *(const f32x4*)(wrT + e * 1024 + lane * 4 + 256 * i);
                    const f32x2 wl = __builtin_shufflevector(w, w, 0, 1), wh = __builtin_shufflevector(w, w, 2, 3);
                    s0 = __builtin_elementwise_fma(__builtin_shufflevector(h[0][i], h[0][i], 0, 1), wl, s0); s0 = __builtin_elementwise_fma(__builtin_shufflevector(h[0][i], h[0][i], 2, 3), wh, s0);
                    s1 = __builtin_elementwise_fma(__builtin_shufflevector(h[1][i], h[1][i], 0, 1), wl, s1); s1 = __builtin_elementwise_fma(__builtin_shufflevector(h[1][i], h[1][i], 2, 3), wh, s1); }
                pa[0][e] = s0.x + s0.y; pa[1][e] = s1.x + s1.y;
            }
            asm volatile("" ::: "memory");
        }
        const float a0 = router_fold_softmax(pa[0], lane), a1 = router_fold_softmax(pa[1], lane);
        if ((lane & 3) == 0) {
            AFFT[((size_t)bb[0] * 16 + (lane >> 2)) * LP + pp[0]] = a0;
            if (two) AFFT[((size_t)bb[1] * 16 + (lane >> 2)) * LP + pp[1]] = a1;
        }
    }
    __syncthreads();
}

DEVI int block_sum_i(int v, volatile int* red, int par, int wid, int lane) {
    if (lane == 0) red[par * 8 + wid] = v;
    __syncthreads();
    int s = 0;
#pragma unroll
    for (int w = 0; w < 8; ++w) s += red[par * 8 + w];
    return s;
}
DEVI int wave_incl_scan_i(int v, int lane) {
#pragma unroll
    for (int o = 1; o < 64; o <<= 1) { const int t = __shfl_up(v, o); if (lane >= o) v += t; }
    return v;
}
DEVI void select_unit(char* lds, const Params& P, int b, int e, bool lat) {
    volatile int* red = (volatile int*)lds;
    volatile int* wtot = (volatile int*)(lds + 64);
    const int tid = tid_l(), lane = tid & 63, wid = tid >> 6;
    const int n = lat ? SEQ : CTXL, K = lat ? CAPL : CAPC, p0 = lat ? CTXL : 0;
    const bool act = 8 * tid < n;
    const float* src = (const float*)(ptr_l(P.ws) + WS_AFFT) + ((size_t)b * 16 + e) * LP + p0 + 8 * tid;
    unsigned bits[8];
    if (act) { const u32x4 v0 = *(const u32x4*)src, v1 = *(const u32x4*)(src + 4); bits[0] = v0.x; bits[1] = v0.y; bits[2] = v0.z; bits[3] = v0.w; bits[4] = v1.x; bits[5] = v1.y; bits[6] = v1.z; bits[7] = v1.w; }
    else {
#pragma unroll
        for (int j = 0; j < 8; ++j) bits[j] = 0u;
    }
    unsigned prefix = 0u; int par = 0;
    for (int bit = 30; bit >= 0; --bit) {
        const unsigned cand = prefix | (1u << bit);
        int c = 0;
#pragma unroll
        for (int j = 0; j < 8; ++j) c += (int)__popcll(__ballot(bits[j] >= cand));
        const int tot = block_sum_i(c, red, par, wid, lane); par ^= 1;
        if (tot >= K) prefix = cand;
    }
    int cg = 0, ceq = 0;
#pragma unroll
    for (int j = 0; j < 8; ++j) { cg += (int)__popcll(__ballot(bits[j] > prefix)); ceq += (bits[j] == prefix) ? 1 : 0; }
    const int need = K - block_sum_i(cg, red, par, wid, lane); par ^= 1;
    int inc = wave_incl_scan_i(ceq, lane);
    if (lane == 63) wtot[par * 8 + wid] = inc;
    __syncthreads();
    int eqb = inc - ceq;
    for (int w = 0; w < wid; ++w) eqb += wtot[par * 8 + w];
    par ^= 1;
    bool sel[8]; int ns = 0;
#pragma unroll
    for (int j = 0; j < 8; ++j) { const bool eq = bits[j] == prefix; sel[j] = (bits[j] > prefix) || (eq && eqb < need); eqb += eq ? 1 : 0; ns += sel[j] ? 1 : 0; }
    inc = wave_incl_scan_i(ns, lane);
    if (lane == 63) wtot[par * 8 + wid] = inc;
    __syncthreads();
    int sb = inc - ns;
    for (int w = 0; w < wid; ++w) sb += wtot[par * 8 + w];
    if (act) {
        int* SLOT = (int*)(ptr_l(P.ws) + WS_SLOT); float* GATE = (float*)(ptr_l(P.ws) + WS_GATE); int* IDX = (int*)(ptr_l(P.ws) + WS_IDX);
#pragma unroll
        for (int j = 0; j < 8; ++j) {
            const int tok = b * LP + p0 + 8 * tid + j;
            if (sel[j]) {
                const int row = (lat ? b * CAPL : NB * CAPL + b * CAPC) + sb; ++sb;
                SLOT[(size_t)tok * 16 + e] = row; GATE[(size_t)e * ROWS_E + row] = __builtin_bit_cast(float, bits[j]); IDX[(size_t)e * ROWS_E + row] = tok;
            } else SLOT[(size_t)tok * 16 + e] = -1;
        }
    }
    __syncthreads();
}
DEVI void gather_rows(const Params& P, bool last) {
    const int tid = tid_l(), lane = tid & 63, wid = tid >> 6;
    const bf16_t* HX = (const bf16_t*)(ptr_l(P.ws) + WS_HX); bf16_t* XG = (bf16_t*)(ptr_l(P.ws) + WS_XG); const int* IDX = (const int*)(ptr_l(P.ws) + WS_IDX);
    const int stride = gridDim.x * 8;
    for (int r0 = blockIdx.x * 8 + wid; r0 < 16 * ROWS_E; r0 += 4 * stride) {
        u32x4 v[4][2];
#pragma unroll
        for (int q = 0; q < 4; ++q) { const int r = r0 + q * stride; if (r < 16 * ROWS_E && !(last && (r % ROWS_E) >= NB * CAPL)) { const u32x4* s = (const u32x4*)(HX + (size_t)IDX[r] * 1024); v[q][0] = s[lane]; v[q][1] = s[lane + 64]; } }
#pragma unroll
        for (int q = 0; q < 4; ++q) { const int r = r0 + q * stride; if (r < 16 * ROWS_E && !(last && (r % ROWS_E) >= NB * CAPL)) { u32x4* d = (u32x4*)(XG + (size_t)r * 1024); d[lane] = v[q][0]; d[lane + 64] = v[q][1]; } }
    }
}

DEVI int scan_ci(int d, int k) { return d == 0 ? k : (k < 16 ? 15 - k : 287 - k); }
DEVI void scan_block(char* lds, const Params& P, int l, int unit0) {
    const int tid = tid_l(), lane = tid & 63, wid = tid >> 6, seg = wid & 3, unit = unit0 + (wid >> 2);
    const int d = unit & 1, g = (unit >> 1) & 31, b = unit >> 6;
    const size_t ldg = ((size_t)l * 2 + d) * 32 + g;
    const float dt = expf(P.in[16][ldg]);
    const float lr = P.in[14][ldg * 64 + lane], li = P.in[15][ldg * 64 + lane];
    const float mag = expf(lr * dt * 16.f); float sn, cs; sincosf(li * dt * 16.f, &sn, &cs);
    const float ar = mag * cs, ai = mag * sn;
    const unsigned short* E = (const unsigned short*)(ptr_l(P.ws) + WS_EB) + (size_t)g * NCHP * 256 + d * 128 + lane * 2;
    bf16_t* S = (bf16_t*)(ptr_l(P.ws) + WS_US) + (size_t)g * NCHP * 512 + 256 + d * 128 + lane * 2;
    f32x2* ends = (f32x2*)lds + (size_t)(wid >> 2) * 4 * 64;
    const int k0 = seg * 68;
    float sr = 0.f, si = 0.f;
    for (int kk = 0; kk < 68; kk += 17) {
        unsigned ev[17];
#pragma unroll
        for (int u = 0; u < 17; ++u) ev[u] = *(const unsigned*)(E + (size_t)chunk_row(b, scan_ci(d, k0 + kk + u)) * 256);
#pragma unroll
        for (int u = 0; u < 17; ++u) { const float nr = ar * sr - ai * si + hlo(ev[u]), ni = ar * si + ai * sr + hhi(ev[u]); sr = nr; si = ni; }
    }
    ends[seg * 64 + lane] = (f32x2){sr, si};
    float pr = ar, pi = ai, p4r = 0.f, p4i = 0.f;
#pragma unroll
    for (int q = 0; q < 6; ++q) { const float nr = pr * pr - pi * pi, ni = 2.f * pr * pi; pr = nr; pi = ni; if (q == 1) { p4r = pr; p4i = pi; } }
    const float br = pr * p4r - pi * p4i, bi = pr * p4i + pi * p4r;
    __syncthreads();
    sr = 0.f; si = 0.f;
    for (int j = 0; j < seg; ++j) { const f32x2 e = ends[j * 64 + lane]; const float nr = br * sr - bi * si + e.x, ni = br * si + bi * sr + e.y; sr = nr; si = ni; }
    for (int kk = 0; kk < 68; kk += 17) {
        unsigned ev[17];
#pragma unroll
        for (int u = 0; u < 17; ++u) ev[u] = *(const unsigned*)(E + (size_t)chunk_row(b, scan_ci(d, k0 + kk + u)) * 256);
#pragma unroll
        for (int u = 0; u < 17; ++u) {
            *(unsigned*)(S + (size_t)chunk_row(b, scan_ci(d, k0 + kk + u)) * 512) = pk2(sr, si);
            const float nr = ar * sr - ai * si + hlo(ev[u]), ni = ar * si + ai * sr + hhi(ev[u]); sr = nr; si = ni;
        }
    }
    __syncthreads();
}

DEVI float max3f(float a, float b, float c) { return fmaxf(fmaxf(a, b), c); }
DEVI float xhalf_max(float x) { const unsigned u = __builtin_bit_cast(unsigned, x); const auto r = __builtin_amdgcn_permlane32_swap(u, u, false, false); return fmaxf(__builtin_bit_cast(float, (unsigned)r[0]), __builtin_bit_cast(float, (unsigned)r[1])); }
DEVI float xhalf_sum(float x) { const unsigned u = __builtin_bit_cast(unsigned, x); const auto r = __builtin_amdgcn_permlane32_swap(u, u, false, false); return __builtin_bit_cast(float, (unsigned)r[0]) + __builtin_bit_cast(float, (unsigned)r[1]); }
DEVI void attn_unit(char* lds, const Params& P, int l, int b, int head, int q0  , int nkeys, float lam, float lam_init) {
    const int tid = tid_l(), lane = tid & 63, wid = tid >> 6, qg = wid >> 1, which = wid & 1, r32 = lane & 31, hi = lane >> 5;
    const bf16_t* QK = (const bf16_t*)(ptr_l(P.ws) + WS_QK);
    const bf16_t* Qs = QK + ((size_t)((which * NB + b) * NH + head) * LP) * 64;
    const bf16_t* K1 = QK + ((size_t)((2 * NB + b) * NH + head) * LP) * 64;
    const bf16_t* K2 = QK + ((size_t)((3 * NB + b) * NH + head) * LP) * 64;
    const bf16_t* Vt = (const bf16_t*)(ptr_l(P.ws) + WS_VT) + (size_t)(b * NH + head) * 128 * LP;
    bf16x8 qf[4];
#pragma unroll
    for (int ks = 0; ks < 4; ++ks) qf[ks] = *(const bf16x8*)(Qs + (size_t)(q0 + qg * 32 + r32) * 64 + ks * 16 + hi * 8);
    f32x16 o[4];
#pragma unroll
    for (int t = 0; t < 4; ++t)
#pragma unroll
        for (int i = 0; i < 16; ++i) o[t][i] = 0.f;
    float m = 0.f, lsum = 0.f;
    const int nt = nkeys >> 6;
    const int drow = wid * 8 + (lane >> 3), dkc = (lane & 7) ^ ((drow >> 1) & 7);
    const unsigned koff = (unsigned)(drow * 64 + dkc * 8), voff = (unsigned)(drow * LP + dkc * 8);
    LAS unsigned char* dl = (LAS unsigned char*)lds + wid * 1024;
#define GLDS(g, off) __builtin_amdgcn_global_load_lds((const unsigned*)(g), (LAS unsigned*)(dl + (off)), 16, 0, 0)
#define K_DMA(kt, s) do { GLDS((K1 + (size_t)(kt) * 4096) + koff, (s) * 16384); GLDS((K2 + (size_t)(kt) * 4096) + koff, (s) * 16384 + 8192); } while (0)
#define V_DMA(kt, s) do { GLDS((Vt + (kt) * 64) + voff, 32768 + (s) * 16384); GLDS((Vt + (kt) * 64 + 64 * LP) + voff, 32768 + (s) * 16384 + 8192); } while (0)
#define QKT(dst, s, init) do { const char* _k = lds + (s) * 16384 + which * 8192; \
        _Pragma("unroll") for (int t2 = 0; t2 < 2; ++t2) _Pragma("unroll") for (int i = 0; i < 16; ++i) dst[t2][i] = (init); \
        _Pragma("unroll") for (int ks = 0; ks < 4; ++ks) _Pragma("unroll") for (int t2 = 0; t2 < 2; ++t2) { \
            const bf16x8 kf = *(const bf16x8*)(_k + swz(t2 * 32 + r32, ks * 2 + hi)); dst[t2] = MFMA32(kf, qf[ks], dst[t2]); } } while (0)
    K_DMA(0, 0); V_DMA(0, 0); K_DMA(1, 1);
    __syncthreads();
    f32x16 sc[2], sn[2];
    QKT(sc, 0, 0.f);
    __syncthreads();
    {
        float tm = max3f(sc[0][0], sc[0][1], sc[0][2]);
#pragma unroll
        for (int i = 3; i < 15; i += 2) tm = max3f(tm, sc[0][i], sc[0][i + 1]);
        tm = fmaxf(tm, sc[0][15]);
#pragma unroll
        for (int i = 0; i < 16; i += 2) tm = max3f(tm, sc[1][i], sc[1][i + 1]);
        tm = xhalf_max(tm);
        m = tm;
#pragma unroll
        for (int t2 = 0; t2 < 2; ++t2)
#pragma unroll
            for (int i = 0; i < 16; ++i) sc[t2][i] -= m;
    }
#define SB() __builtin_amdgcn_sched_barrier(0)
#define SGB(mask, n) __builtin_amdgcn_sched_group_barrier(mask, n, 0)
    int fo[4];
#pragma unroll
    for (int j = 0; j < 4; ++j) fo[j] = swz(r32, 2 * j + hi);
    const char* kbase = lds + which * 8192;
    const char* vbase = lds + 32768;
#define ATT_STEP(KT, PAR, SC, SN) do { \
        const bool has1 = (KT) + 1 < nt, has2 = (KT) + 2 < nt; \
        if (has2) K_DMA((KT) + 2, PAR); \
        if (has1) V_DMA((KT) + 1, 1 - (PAR)); \
        const char* kst = kbase + (1 - (PAR)) * 16384; \
        const char* vs = vbase + (PAR) * 16384; \
        bf16x8 kf[8]; \
        _Pragma("unroll") for (int ks = 0; ks < 4; ++ks) _Pragma("unroll") for (int t2 = 0; t2 < 2; ++t2) kf[ks * 2 + t2] = *(const bf16x8*)(kst + fo[ks] + t2 * 4096); \
        SB(); \
        _Pragma("unroll") for (int t2 = 0; t2 < 2; ++t2) _Pragma("unroll") for (int i = 0; i < 16; ++i) SN[t2][i] = -m; \
        _Pragma("unroll") for (int ks = 0; ks < 4; ++ks) _Pragma("unroll") for (int t2 = 0; t2 < 2; ++t2) SN[t2] = MFMA32(kf[ks * 2 + t2], qf[ks], SN[t2]); \
        bf16x8 va[4], vb[4]; \
        _Pragma("unroll") for (int t = 0; t < 4; ++t) va[t] = *(const bf16x8*)(vs + fo[0] + t * 4096); \
        SGB(0x002, 16); SGB(0x008, 8); SGB(0x100, 4); SB(); \
        if (__any(pprev > 4096.f)) {        \
            const float pr = xhalf_sum(pprev); \
            const float dl = pr > 4096.f ? (float)((int)((__builtin_bit_cast(unsigned, pr) >> 23) & 255u) - 127) : 0.f, al = fast_exp2(-dl); \
            m += dl; lsum *= al; \
            _Pragma("unroll") for (int t = 0; t < 4; ++t) _Pragma("unroll") for (int i = 0; i < 16; ++i) o[t][i] *= al; \
            _Pragma("unroll") for (int t2 = 0; t2 < 2; ++t2) _Pragma("unroll") for (int i = 0; i < 16; ++i) { SC[t2][i] -= dl; SN[t2][i] -= dl; } \
        } \
        float ps = 0.f; \
        _Pragma("unroll") for (int t2 = 0; t2 < 2; ++t2) _Pragma("unroll") for (int i = 0; i < 16; ++i) { SC[t2][i] = fast_exp2(SC[t2][i]); ps += SC[t2][i]; } \
        lsum += ps; pprev = ps; \
        bf16x8 pf[4]; \
        _Pragma("unroll") for (int t2 = 0; t2 < 2; ++t2) _Pragma("unroll") for (int sh = 0; sh < 2; ++sh) { \
            u32x4 pw; pw.x = pk2(SC[t2][8 * sh], SC[t2][8 * sh + 1]); pw.y = pk2(SC[t2][8 * sh + 2], SC[t2][8 * sh + 3]); \
            pw.z = pk2(SC[t2][8 * sh + 4], SC[t2][8 * sh + 5]); pw.w = pk2(SC[t2][8 * sh + 6], SC[t2][8 * sh + 7]); \
            pf[t2 * 2 + sh] = __builtin_bit_cast(bf16x8, pw); } \
        SB(); \
        _Pragma("unroll") for (int t = 0; t < 4; ++t) vb[t] = *(const bf16x8*)(vs + fo[1] + t * 4096); \
        _Pragma("unroll") for (int t = 0; t < 4; ++t) o[t] = MFMA32(va[t], pf[0], o[t]); \
        SGB(0x100, 4); SGB(0x008, 4); SB(); \
        _Pragma("unroll") for (int t = 0; t < 4; ++t) va[t] = *(const bf16x8*)(vs + fo[2] + t * 4096); \
        _Pragma("unroll") for (int t = 0; t < 4; ++t) o[t] = MFMA32(vb[t], pf[1], o[t]); \
        SGB(0x100, 4); SGB(0x008, 4); SB(); \
        _Pragma("unroll") for (int t = 0; t < 4; ++t) vb[t] = *(const bf16x8*)(vs + fo[3] + t * 4096); \
        _Pragma("unroll") for (int t = 0; t < 4; ++t) o[t] = MFMA32(va[t], pf[2], o[t]); \
        SGB(0x100, 4); SGB(0x008, 4); SB(); \
        _Pragma("unroll") for (int t = 0; t < 4; ++t) o[t] = MFMA32(vb[t], pf[3], o[t]); \
        SB(); \
        __syncthreads(); \
    } while (0)
    float pprev = 0.f;
    for (int kt = 0; kt < nt; kt += 2) {
        ATT_STEP(kt, 0, sc, sn);
        ATT_STEP(kt + 1, 1, sn, sc);
    }
#undef ATT_STEP
#undef SB
#undef SGB
#undef GLDS
#undef K_DMA
#undef V_DMA
#undef QKT
    lsum = xhalf_sum(lsum);
    const float inv = 1.f / lsum;
    float* xb = (float*)lds + (size_t)qg * 4096;
    if (which == 1) {
#pragma unroll
        for (int t = 0; t < 4; ++t)
#pragma unroll
            for (int i = 0; i < 16; ++i) xb[(t * 16 + i) * 64 + lane] = o[t][i] * inv;
    }
    __syncthreads();
    if (which == 0) {
        float ss = 0.f;
#pragma unroll
        for (int t = 0; t < 4; ++t)
#pragma unroll
            for (int i = 0; i < 16; ++i) { const float v = o[t][i] * inv - lam * xb[(t * 16 + i) * 64 + lane]; o[t][i] = v; ss += v * v; }
        ss = xhalf_sum(ss);
        const float rs = rsqrtf(ss * (1.f / 128.f) + EPS) * (1.f - lam_init);
        const float* sg = P.in[13] + (size_t)l * 128;
        bf16_t* dst = (bf16_t*)(ptr_l(P.ws) + WS_MIX) + ((size_t)b * LP + q0 + qg * 32 + r32) * 1024 + head * 128 + 4 * hi;
#pragma unroll
        for (int t = 0; t < 4; ++t)
#pragma unroll
            for (int i4 = 0; i4 < 4; ++i4) {
                const f32x4 g = *(const f32x4*)(sg + t * 32 + 8 * i4 + 4 * hi);
                u32x2 w; w.x = pk2(o[t][4 * i4] * rs * g.x, o[t][4 * i4 + 1] * rs * g.y); w.y = pk2(o[t][4 * i4 + 2] * rs * g.z, o[t][4 * i4 + 3] * rs * g.w);
                *(u32x2*)(dst + t * 32 + 8 * i4) = w;
            }
    }
    __syncthreads();
}

struct ConvTile { const float* src; bf16_t* dst; int K, N, mode; };
DEVI ConvTile conv_tile(const Params& P, unsigned char* w, int l, int u) {
    if (u < 4096) { const int w3 = u >= 2048; const int v = u & 2047, le = l * 16 + (v >> 7), k = (v >> 3) & 15, n = v & 7;
        return {P.in[w3 ? 27 : 26] + (size_t)le * 1024 * 2048 + (size_t)(k * 64) * 2048 + n * 256, (bf16_t*)(w + WS_W13T) + (size_t)le * 4096 * 1024 + k * 64, 1024, 2048, (n * 256) | ((1 + w3) << 16)}; }
    const int v = u - 4096, le = l * 16 + (v >> 7), k = (v >> 2) & 31, n = v & 3;
    return {P.in[28] + (size_t)le * 2048 * 1024 + (size_t)(k * 64) * 1024 + n * 256, (bf16_t*)(w + WS_W2T) + (size_t)le * 1024 * 2048 + k * 64, 2048, 1024, n * 256};
}
#define CV_LOAD(v, t) do { const unsigned voff_ = (unsigned)((2 * (tid >> 6)) * (t).N + (tid & 63) * 4) * 4u; \
        _Pragma("unroll") for (int i = 0; i < 8; ++i) { const float* sb_ = (t).src + (size_t)((i >> 1) * 16 + (i & 1)) * (t).N; \
        asm volatile("s_nop 4\n\tglobal_load_dwordx4 %0, %1, %2\n\ts_nop 1" : "=&v"(v[i]) : "v"(voff_), "s"(sb_) : "memory"); } } while (0)
#define CV_WAIT(v, N) asm volatile("s_waitcnt vmcnt(" #N ")" : "+v"(v[0]), "+v"(v[1]), "+v"(v[2]), "+v"(v[3]), "+v"(v[4]), "+v"(v[5]), "+v"(v[6]), "+v"(v[7]) :: "memory")
#define CV_STEP(v, t, N, UNEXT) do { \
        unsigned* tile = (unsigned*)lds + par * (32 * 256); par ^= 1; \
        CV_WAIT(v, N); \
        _Pragma("unroll") for (int j = 0; j < 4; ++j) { const int kp = (tid >> 6) + 8 * j; \
            u32x4 wv; wv.x = pk2(v[2 * j].x, v[2 * j + 1].x); wv.y = pk2(v[2 * j].y, v[2 * j + 1].y); wv.z = pk2(v[2 * j].z, v[2 * j + 1].z); wv.w = pk2(v[2 * j].w, v[2 * j + 1].w); \
            *(u32x4*)(tile + kp * 256 + (((tid & 63) * 4) ^ (((kp >> 2) & 7) << 3))) = wv; } \
        const ConvTile cur = t; \
        if ((UNEXT) >= 0) { t = conv_tile(P, w, l, (UNEXT)); CV_LOAD(v, t); } \
        asm volatile("s_waitcnt lgkmcnt(0)\n\ts_barrier" ::: "memory"); \
        const int n0 = cur.mode & 0xffff, mode = cur.mode >> 16; \
        _Pragma("unroll") for (int i = 0; i < 4; ++i) { \
            const int c = tid + 512 * i, n = c >> 3, kq = c & 7; \
            u32x4 o; o.x = tile[(4 * kq) * 256 + (n ^ (kq << 3))]; o.y = tile[(4 * kq + 1) * 256 + (n ^ (kq << 3))]; o.z = tile[(4 * kq + 2) * 256 + (n ^ (kq << 3))]; o.w = tile[(4 * kq + 3) * 256 + (n ^ (kq << 3))]; \
            const int ng = n0 + n; const int orow = mode == 0 ? ng : ((ng >> 7) * 256 + (mode - 1) * 128 + (ng & 127)); \
            const unsigned so_ = (unsigned)(orow * cur.K + 8 * kq) * 2u; \
            asm volatile("s_nop 4\n\tglobal_store_dwordx4 %0, %1, %2\n\ts_nop 1" :: "v"(so_), "v"(o), "s"(cur.dst) : "memory"); \
        } } while (0)
DEVI void conv_share(char* lds, const Params& P, int l, int bid, int G) {
    unsigned char* w = ptr_l(P.ws);
    const int tid = tid_l();
    if (G != 256) {
        for (int u = bid; u < 3 * 2048; u += G) {
            if (u < 4096) { const int w3 = u >= 2048; const int v = u & 2047, le = l * 16 + (v >> 7), k = (v >> 3) & 15, n = v & 7;
                transpose_unit(lds, P.in[w3 ? 27 : 26] + (size_t)le * 1024 * 2048, 1024, 2048, (bf16_t*)(w + WS_W13T) + (size_t)le * 4096 * 1024, k * 64, n * 256, 1 + w3); }
            else { const int v = u - 4096, le = l * 16 + (v >> 7), k = (v >> 2) & 31, n = v & 3;
                transpose_unit(lds, P.in[28] + (size_t)le * 2048 * 1024, 2048, 1024, (bf16_t*)(w + WS_W2T) + (size_t)le * 1024 * 2048, k * 64, n * 256, 0); }
        }
        return;
    }
    f32x4 va[8], vb[8], vc[8];
    ConvTile ta = conv_tile(P, w, l, bid), tb = conv_tile(P, w, l, bid + 256), tc = conv_tile(P, w, l, bid + 512);
    int par = 0;
    CV_LOAD(va, ta); CV_LOAD(vb, tb); CV_LOAD(vc, tc);
    CV_STEP(va, ta, 16, bid + 3 * 256); CV_STEP(vb, tb, 20, bid + 4 * 256); CV_STEP(vc, tc, 24, bid + 5 * 256);
    for (int r = 2; r < 8; ++r) {
        const int u = bid + (3 * r) * 256;
        CV_STEP(va, ta, 28, u); CV_STEP(vb, tb, 28, u + 256); CV_STEP(vc, tc, 28, u + 512);
    }
    CV_STEP(va, ta, 28, -1); CV_STEP(vb, tb, 20, -1); CV_STEP(vc, tc, 12, -1);
    asm volatile("s_waitcnt vmcnt(0)" ::: "memory");
    __syncthreads();
}
#undef CV_LOAD
#undef CV_WAIT
#undef CV_STEP
constexpr int PH_PER_LAYER = 11, PH_LAYER0 = 2, PH_FINAL = PH_LAYER0 + DEPTH * PH_PER_LAYER, N_PHASES = PH_FINAL + 1;

__global__ void __launch_bounds__(512, 2) fwd_kernel(Params P) {
    extern __shared__ __attribute__((aligned(16))) char lds[];
    volatile LAS unsigned* xbw = (volatile LAS unsigned*)(lds + 131072);
    if (threadIdx.x == 0) { xbw[0] = 0u; xbw[1] = 0u; }
    __syncthreads();
    XcdBarrier bar = xcd_barrier_post((unsigned*)(P.ws + WS_CTL), xbw);
    const int G = gridDim.x, bid = blockIdx.x;
    const int vcu = (G % 8 == 0) ? (bid % 8) * (G / 8) + bid / 8 : bid;
    LAS unsigned char* ldsp = (LAS unsigned char*)lds;
    const int lo = P.lo, hi = P.hi;
#ifndef EN_MASK
#define EN_MASK 0xFFFFFFFFu
#endif
#define PHASE(id) if ((id) >= lo && (id) < hi)
#ifndef REP_MASK
#define REP_MASK 0x0u
#endif
#define PHASE_K(k, id) if (((EN_MASK >> (k)) & 1u) && (id) >= lo && (id) < hi) for (int rep_ = 0; rep_ <= (int)((REP_MASK >> (k)) & 1u); ++rep_)
#define SEAM(id) do { if ((id) >= lo && (id) + 1 < hi) xcd_barrier(bar); } while (0)
    unsigned char* ws0 = P.ws;
#define ws ptr_l(ws0)

    PHASE_K(0, 0) {
        constexpr int U_SSM = 256, U_ROPE = 1, U_ADA = 4 * 96;
        constexpr int T_WIN = 4 * 16 * 8, T_WOUT = 4 * 16 * 4, T_WGLU = 4 * 8 * 2, T_W1 = 64 * 16 * 8, T_W2 = 64 * 32 * 4;
        constexpr int U0 = U_SSM + U_ROPE + U_ADA, U1 = U0 + T_WIN, U2 = U1 + T_WOUT, U3 = U2 + T_WGLU, U4 = U3 + T_W1, U5 = U4 + T_W1, U6 = U5 + T_W2;
        constexpr int A0 = U_SSM + U_ROPE;
        const int nq = G == 256 ? 8 : (U3 - bid + G - 1) / G;
        for (int q = 0; q < nq; ++q) {
            int u = bid + q * G;
            if (G == 256) {
                u = -1;
                if (q == 0) u = bid;
                else if (q == 1) u = A0 + bid;
                else if (q == 7) { if (bid == 0) u = U_SSM; }
                else if (bid >= 128) { if (q == 2) u = A0 + 256 + (bid - 128); else if (q <= 4) u = U0 + 576 + (bid - 128) * 2 + (q - 3); }
                else { if (q <= 5) u = U0 + bid * 4 + (q - 2); else if (bid < 64) u = U0 + 512 + bid; }
                if (u < 0) continue;
            }
            if (u < U_SSM) { ssm_tab_unit(lds, P, u >> 6, (u >> 5) & 1, u & 31); }
            else if (u == U_SSM) {
                const int tid = tid_l(), wid = tid >> 6, lane = tid & 63;
                float* rope = (float*)(ws + WS_ROPE);
                for (int i = tid; i < 64 * 16; i += 512) {
                    const int pos = i >> 4, f = i & 15; const float inv = powf(10000.f, -(float)(2 * f) / 32.f);
                    float s, c; sincosf((float)pos * inv, &s, &c); rope[i * 2] = c; rope[i * 2 + 1] = s;
                }
                if (wid < 4) {
                    const float a = P.in[9][wid * 64 + lane] * P.in[10][wid * 64 + lane], c2 = P.in[11][wid * 64 + lane] * P.in[12][wid * 64 + lane];
                    const float s1 = wave_sum(a), s2 = wave_sum(c2);
                    if (lane == 0) ((float*)(ws + WS_LAM))[wid] = expf(s1) - expf(s2) + (0.8f - 0.6f * expf(-0.3f * (float)wid));
                }
            }
            else if (u < U0) { const int v = u - U_SSM - U_ROPE; adaln_unit(lds, P, v / 96, (v % 96) * 64); }
            else if (u < U1) { const int v = u - U0, l = v >> 7, k = (v >> 3) & 15, n = v & 7; transpose_unit(lds, P.in[8] + (size_t)l * 1024 * 2048, 1024, 2048, (bf16_t*)(ws + WS_WINT) + (size_t)l * 2048 * 1024, k * 64, n * 256, 0); }
            else if (u < U2) { const int v = u - U1, l = v >> 6, k = (v >> 2) & 15, n = v & 3; transpose_unit(lds, P.in[24] + (size_t)l * 1024 * 1024, 1024, 1024, (bf16_t*)(ws + WS_WOUTT) + (size_t)l * 1024 * 1024, k * 64, n * 256, 0); }
            else { const int v = u - U2, l = v >> 4, k = (v >> 1) & 7, n = v & 1; transpose_unit(lds, P.in[22] + (size_t)l * 512 * 512, 512, 512, (bf16_t*)(ws + WS_WGLUT) + (size_t)l * 512 * 512, k * 64, n * 256, 0); }
        }
        (void)U4; (void)U5; (void)U6;
    }
    SEAM(0);
    PHASE_K(1, 1) {
        const float* KT = (const float*)(ws + WS_KTAB); const float* PW = (const float*)(ws + WS_PW); const float* BB = (const float*)(ws + WS_BBAR);
        bf16_t* WE = (bf16_t*)(ws + WS_WENDT); bf16_t* B2 = (bf16_t*)(ws + WS_BT2);
        const int tid = tid_l();
        for (int it = bid * 512 + tid; it < 4 * 32 * 256 * 64; it += G * 512) {
            const int k8 = it & 63, n = (it >> 6) & 255, g = (it >> 14) & 31, l = it >> 19;
            u32x4 o = {0u, 0u, 0u, 0u};
            if (k8 < 32) {
                const int d = n >> 7, p = (n >> 1) & 63, ri = n & 1, i = k8 >> 1, h0 = (k8 & 1) * 8;
                const int ldg = (l * 2 + d) * 32 + g, e = d == 0 ? 15 - i : i;
                const f32x2 w = *(const f32x2*)(PW + ((size_t)(ldg * 64 + p) * 17 + e) * 2);
                const f32x4* bp = (const f32x4*)(BB + ((size_t)(ldg * 64 + p) * 16 + h0) * 2);
                const f32x4 b0 = bp[0], b1 = bp[1], b2 = bp[2], b3 = bp[3];
                float v[8];
                if (ri == 0) { v[0] = w.x * b0.x - w.y * b0.y; v[1] = w.x * b0.z - w.y * b0.w; v[2] = w.x * b1.x - w.y * b1.y; v[3] = w.x * b1.z - w.y * b1.w;
                               v[4] = w.x * b2.x - w.y * b2.y; v[5] = w.x * b2.z - w.y * b2.w; v[6] = w.x * b3.x - w.y * b3.y; v[7] = w.x * b3.z - w.y * b3.w; }
                else         { v[0] = w.x * b0.y + w.y * b0.x; v[1] = w.x * b0.w + w.y * b0.z; v[2] = w.x * b1.y + w.y * b1.x; v[3] = w.x * b1.w + w.y * b1.z;
                               v[4] = w.x * b2.y + w.y * b2.x; v[5] = w.x * b2.w + w.y * b2.z; v[6] = w.x * b3.y + w.y * b3.x; v[7] = w.x * b3.w + w.y * b3.z; }
                o.x = pk2(v[0], v[1]); o.y = pk2(v[2], v[3]); o.z = pk2(v[4], v[5]); o.w = pk2(v[6], v[7]);
            }
            *(u32x4*)(WE + (size_t)(it >> 6) * 512 + k8 * 8) = o;
        }
        for (int it = bid * 512 + tid; it < 4 * 32 * 256 * 64; it += G * 512) {
            const int k8 = it & 63, n2 = (it >> 6) & 255, g = (it >> 14) & 31, l = it >> 19;
            const int j = n2 >> 4, h = n2 & 15;
            float v[8];
            if (k8 < 32) {
                const int i = k8 >> 1, h20 = (k8 & 1) * 8;
                f32x4 a0 = {0.f, 0.f, 0.f, 0.f}, a1 = a0;
                if (i <= j) { const f32x4* kp = (const f32x4*)(KT + ((size_t)((l * 2 + 0) * 32 + g) * 16 + (j - i)) * 256 + h * 16 + h20); a0 += kp[0]; a1 += kp[1]; }
                if (i >= j) { const f32x4* kp = (const f32x4*)(KT + ((size_t)((l * 2 + 1) * 32 + g) * 16 + (i - j)) * 256 + h * 16 + h20); a0 += kp[0]; a1 += kp[1]; }
                v[0] = a0.x; v[1] = a0.y; v[2] = a0.z; v[3] = a0.w; v[4] = a1.x; v[5] = a1.y; v[6] = a1.z; v[7] = a1.w;
                if (i == j && (h >> 3) == (k8 & 1)) { const float dd = P.in[21][(size_t)l * 512 + g * 16 + h];
#pragma unroll
                    for (int q = 0; q < 8; ++q) v[q] += (q == (h & 7)) ? dd : 0.f; }
            } else {
                const int n0 = (k8 - 32) * 8, d = n0 >> 7, p0 = (n0 >> 1) & 63;
                const int ldg = (l * 2 + d) * 32 + g, e = d == 0 ? j + 1 : 16 - j;
                const f32x4 cr = *(const f32x4*)(P.in[19] + (size_t)(ldg * 16 + h) * 64 + p0), ci = *(const f32x4*)(P.in[20] + (size_t)(ldg * 16 + h) * 64 + p0);
                const float crv[4] = {cr.x, cr.y, cr.z, cr.w}, civ[4] = {ci.x, ci.y, ci.z, ci.w};
#pragma unroll
                for (int q = 0; q < 4; ++q) {
                    const f32x2 w = *(const f32x2*)(PW + ((size_t)(ldg * 64 + p0 + q) * 17 + e) * 2);
                    v[2 * q] = crv[q] * w.x - civ[q] * w.y; v[2 * q + 1] = -(crv[q] * w.y + civ[q] * w.x);
                }
            }
            u32x4 o; o.x = pk2(v[0], v[1]); o.y = pk2(v[2], v[3]); o.z = pk2(v[4], v[5]); o.w = pk2(v[6], v[7]);
            *(u32x4*)(B2 + (size_t)(it >> 6) * 512 + k8 * 8) = o;
        }
    }
    SEAM(1);

    for (int l = 0; l < DEPTH; ++l) {
        const int ph = PH_LAYER0 + l * PH_PER_LAYER;
        const bool last = l == DEPTH - 1;
        const float* MODl = (const float*)(ws + WS_MOD) + (size_t)l * 9 * 6144;
        PHASE_K(2, ph + 0) { if (l == 0) rowpass1<true>(P, 0); else rowpass1<false>(P, l); }
        SEAM(ph + 0);
        PHASE_K(3, ph + 1) {
            {
                Epi8Inproj ep{(bf16_t*)(ws + WS_QK), (bf16_t*)(ws + WS_VT), (bf16_t*)(ws + WS_US), (const float*)(ws + WS_ROPE)};
                const pg8::Gemm g{(const bf16_t*)(ws + WS_HX), (const bf16_t*)(ws + WS_WINT) + (size_t)l * 2048 * 1024, R, 2048, 1024};
                const TileOrder S{128 * 8, G, vcu, 16, 8, 0, 17, 1};
                pg8::gemm_phase<Epi8Inproj, TileOrder, true, true>(ldsp, g, S, ep);
            }
            for (int u = vcu; u < 16 * 16; u += G) {
                EpiInproj ep{(bf16_t*)(ws + WS_QK), (bf16_t*)(ws + WS_VT), (bf16_t*)(ws + WS_US), (const float*)(ws + WS_ROPE)};
                APlain af{(const bf16_t*)(ws + WS_HX), 1024};
                const int mt = u >> 4, nt = u & 15;
                gemm_unit_dma(lds, af, (const bf16_t*)(ws + WS_WINT) + (size_t)l * 2048 * 1024, 1024, 1024, (mt >> 1) * LP + (mt & 1) * 128, nt * 128, ep);
            }
        }
        SEAM(ph + 1);
        PHASE_K(4, ph + 2) {
            {
                Epi8S1 ep{(unsigned short*)(ws + WS_EB)};
                const pg8::Gemm g{(const bf16_t*)(ws + WS_US), (const bf16_t*)(ws + WS_WENDT) + (size_t)l * 32 * 256 * 512, 32 * NCHP, 32 * 256, 512};
                const TileOrder S{32 * 8, G, vcu, 8, 1, 1, 9, 0};
                pg8::gemm_phase<Epi8S1, TileOrder, true, true>(ldsp, g, S, ep);
            }
            for (int u = vcu; u < 64; u += G) {
                const int g = u >> 1, nt = u & 1;
                EpiS1 ep{(unsigned short*)(ws + WS_EB) + (size_t)g * NCHP * 256};
                APlain af{(const bf16_t*)(ws + WS_US) + (size_t)g * NCHP * 512, 512};
                gemm_unit_dma(lds, af, (const bf16_t*)(ws + WS_WENDT) + ((size_t)l * 32 + g) * 256 * 512, 512, 256, 2048, nt * 128, ep);
            }
        }
        SEAM(ph + 2);
        PHASE_K(15, ph + 3) {
            for (int u = bid * 2; u < NB * 32 * 2; u += G * 2) scan_block(lds, P, l, u);
        }
        SEAM(ph + 3);
        PHASE_K(5, ph + 4) {
            const float lam = ((const float*)(ws + WS_LAM))[l], lam_init = 0.8f - 0.6f * expf(-0.3f * (float)l);
            int rnd = 0;
            for (int u = vcu; u < (last ? 1024 : 1024 + 64); u += G, ++rnd) {
                if (rnd == ((bid >> 3) & 3)) conv_share(lds, P, l, bid, G);
                if (u < 1024) { const int qb = u & 31, bh = u >> 5; attn_unit(lds, P, l, bh >> 2, bh & 3, CTXL + qb * 128, LP, lam, lam_init); }
                else { const int v = u - 1024, qb = v & 1, bh = v >> 1; attn_unit(lds, P, l, bh >> 2, bh & 3, qb * 128, CTXL, lam, lam_init); }
            }
        }
        PHASE_K(6, ph + 4) {
            {
                Epi8S2 ep{(bf16_t*)(ws + WS_YG)};
                const pg8::Gemm g{(const bf16_t*)(ws + WS_US), (const bf16_t*)(ws + WS_BT2) + (size_t)l * 32 * 256 * 512, 32 * NCHP, 32 * 256, 512};
                const TileOrder S{32 * 8, G, vcu, 8, 1, 1, 9, 0};
                pg8::gemm_phase<Epi8S2, TileOrder, true, true>(ldsp, g, S, ep);
            }
            if (!last) for (int u = (vcu + G / 2) % G; u < 64; u += G) {
                const int g = u >> 1, nt = u & 1;
                EpiS2 ep{(bf16_t*)(ws + WS_YG), g};
                APlain af{(const bf16_t*)(ws + WS_US) + (size_t)g * NCHP * 512, 512};
                gemm_unit_dma(lds, af, (const bf16_t*)(ws + WS_BT2) + ((size_t)l * 32 + g) * 256 * 512, 512, 512, 2048, nt * 128, ep);
            }
        }
        SEAM(ph + 4);
        PHASE_K(7, ph + 5) {
            {
                Epi8Glu ep{(const bf16_t*)(ws + WS_YG), (bf16_t*)(ws + WS_MIX), P.in[23] + (size_t)l * 512};
                const pg8::Gemm g{(const bf16_t*)(ws + WS_YG), (const bf16_t*)(ws + WS_WGLUT) + (size_t)l * 512 * 512, R, 512, 512};
                const TileOrder S{128 * 2, G, vcu, 16, 2, 0, 17, 1};
                pg8::gemm_phase<Epi8Glu, TileOrder, true, true>(ldsp, g, S, ep);
            }
            if (!last) for (int u = vcu; u < 8 * 4; u += G) {
                EpiGlu ep{(const bf16_t*)(ws + WS_YG), (bf16_t*)(ws + WS_MIX), P.in[23] + (size_t)l * 512};
                APlain af{(const bf16_t*)(ws + WS_YG), 512};
                gemm_unit<256>(lds, af, (const bf16_t*)(ws + WS_WGLUT) + (size_t)l * 512 * 512, 512, 512, (u >> 2) * LP, (u & 3) * 128, ep);
            }
        }
        SEAM(ph + 5);
        PHASE_K(8, ph + 6) {
            {
                Epi8Out ep{(bf16_t*)(ws + WS_X), MODl};
                const pg8::Gemm g{(const bf16_t*)(ws + WS_MIX), (const bf16_t*)(ws + WS_WOUTT) + (size_t)l * 1024 * 1024, R, 1024, 1024};
                const TileOrder S{128 * 4, G, vcu, 16, 4, 0, 17, 1};
                pg8::gemm_phase<Epi8Out, TileOrder, true, true>(ldsp, g, S, ep);
            }
            if (!last) for (int u = vcu; u < 16 * 8; u += G) {
                EpiOut ep{(bf16_t*)(ws + WS_X), MODl};
                APlain af{(const bf16_t*)(ws + WS_MIX), 1024};
                const int mt = u >> 3, nt = u & 7;
                gemm_unit_dma(lds, af, (const bf16_t*)(ws + WS_WOUTT) + (size_t)l * 1024 * 1024, 1024, 1024, (mt >> 1) * LP + (mt & 1) * 128, nt * 128, ep);
            }
        }
        SEAM(ph + 6);
        PHASE_K(9, ph + 7) { rowpass2(lds, P, l); }
        SEAM(ph + 7);
        PHASE_K(10, ph + 8) {
            for (int u = bid; u < (last ? 128 : 256); u += G) select_unit(lds, P, (u & 127) >> 4, u & 15, u < 128);
        }
        SEAM(ph + 8);
        PHASE_K(11, ph + 9) {
            Epi8Moe1 ep{(bf16_t*)(ws + WS_HG)};
            const pg8::Gemm g{(const bf16_t*)(ws + WS_HX), (const bf16_t*)(ws + WS_W13T) + (size_t)l * 16 * 4096 * 1024, 16 * ROWS_E, 16 * 4096, 1024, (const int*)(ws + WS_IDX), 131072 + 64};
            const TileOrder S = last ? TileOrder{16 * 16 * 16, G, vcu, 16, 16, 16, 17, 0, 1} : TileOrder{16 * 17 * 16, G, vcu, 17, 16, 16, 17, 0, 1};
            pg8::gemm_phase<Epi8Moe1, TileOrder, true, true, true>(ldsp, g, S, ep);
        }
        SEAM(ph + 9);
        PHASE_K(12, ph + 10) {
            {
                Epi8Moe2 ep{(bf16_t*)(ws + WS_OG), (const float*)(ws + WS_GATE)};
                const pg8::Gemm g{(const bf16_t*)(ws + WS_HG), (const bf16_t*)(ws + WS_W2T) + (size_t)l * 16 * 1024 * 2048, 16 * ROWS_E, 16 * 1024, 2048};
                const TileOrder S{16 * 16 * 4, G, vcu, 16, 4, 4, 17, 0};
                pg8::gemm_phase<Epi8Moe2, TileOrder, true, true>(ldsp, g, S, ep);
            }
            if (!last) for (int u = vcu; u < 16 * 2 * 8; u += G) {
                const int e = u >> 4, mt = (u >> 3) & 1, nt = u & 7;
                EpiMoe2 ep{(bf16_t*)(ws + WS_OG) + (size_t)e * ROWS_E * 1024, (const float*)(ws + WS_GATE) + (size_t)e * ROWS_E};
                APlain af{(const bf16_t*)(ws + WS_HG) + (size_t)e * ROWS_E * FF, FF};
                gemm_unit_dma(lds, af, (const bf16_t*)(ws + WS_W2T) + ((size_t)l * 16 + e) * 1024 * 2048, 2048, 2048, NB * CAPL + mt * 128, nt * 128, ep);
            }
        }
        SEAM(ph + 10);
    }
    PHASE_K(13, PH_FINAL) { rowpass1<false>(P, DEPTH); }
#undef ws
}

#ifndef MK_MULTI
#define MK_MULTI 0
#endif

extern "C" void kernel_launch(void* const* d_in, const int* in_sizes, int n_in, void* d_out, int out_size, void* d_ws, size_t ws_size, hipStream_t stream) {
    static int grid = 0;
    if (!grid) {
        int dev = 0, cus = 0, per_cu = 0;
        hipGetDevice(&dev);
        hipDeviceGetAttribute(&cus, hipDeviceAttributeMultiprocessorCount, dev);
        hipFuncSetAttribute((const void*)fwd_kernel, hipFuncAttributeMaxDynamicSharedMemorySize, LDS_BYTES);
        hipOccupancyMaxActiveBlocksPerMultiprocessor(&per_cu, fwd_kernel, 512, LDS_BYTES);
        grid = cus * (per_cu < 1 ? per_cu : 1);
        if (grid <= 0) { fprintf(stderr, "occupancy query failed (per_cu=%d cus=%d)\n", per_cu, cus); grid = 256; }
        if (ws_size < WS_END) fprintf(stderr, "workspace too small: %zu < %zu\n", ws_size, (size_t)WS_END);
    }
    Params p{};
    for (int i = 0; i < 30; ++i) p.in[i] = (const float*)d_in[i];
    p.out = (float*)d_out; p.ws = (unsigned char*)d_ws;
    hipMemsetAsync(d_ws, 0, CTL_BYTES, stream);
#if MK_MULTI
    for (int ph = 0; ph < N_PHASES; ++ph) {
        p.lo = ph; p.hi = ph + 1;
        hipLaunchKernelGGL(fwd_kernel, dim3(grid), dim3(512), LDS_BYTES, stream, p);
    }
#else
    p.lo = 0; p.hi = N_PHASES;
    hipLaunchKernelGGL(fwd_kernel, dim3(grid), dim3(512), LDS_BYTES, stream, p);
#endif
}
```

```cpp
#include <hip/hip_runtime.h>
#include <cstdio>
#include <cstdint>
#include <cmath>

#define DEVI __device__ __forceinline__
#define LAS __attribute__((address_space(3)))

typedef unsigned short bf16_t;
typedef short bf16x8 __attribute__((ext_vector_type(8)));
typedef float f32x2 __attribute__((ext_vector_type(2)));
typedef float f32x4 __attribute__((ext_vector_type(4)));
typedef float f32x16 __attribute__((ext_vector_type(16)));
typedef unsigned u32x2 __attribute__((ext_vector_type(2)));
typedef unsigned u32x4 __attribute__((ext_vector_type(4)));
typedef __bf16 bf16x2_t __attribute__((ext_vector_type(2)));

constexpr int NB = 8, SEQ = 4096, CTXL = 256, DM = 1024, DEPTH = 4;
constexpr int LP = CTXL + SEQ;
constexpr int R = NB * LP;
constexpr int NCHB = LP / 16;
constexpr int NCH = NB * NCHB;
constexpr int NE = 16, CAPL = 512, CAPC = 32, ROWS_BE = CAPL + CAPC  , ROWS_E = NB * ROWS_BE  , FF = 2048;
constexpr int NH = 4;
constexpr float EPS = 1e-6f;
constexpr float QSCALE = 0.125f * 1.4426950408889634f;

constexpr size_t al256(size_t x) { return (x + 255) & ~(size_t)255; }
constexpr size_t WS_CTL = 0, CTL_BYTES = 65536;
constexpr size_t WS_MOD = WS_CTL + CTL_BYTES;
constexpr size_t WS_ROPE = WS_MOD + al256((size_t)4 * 9 * 6144 * 4);
constexpr size_t WS_LAM = WS_ROPE + al256(64 * 16 * 2 * 4);
constexpr size_t WS_KTAB = WS_LAM + 256;
constexpr size_t WS_PW = WS_KTAB + (size_t)4 * 2 * 32 * 4096 * 4;
constexpr size_t WS_BBAR = WS_PW + al256((size_t)4 * 2 * 32 * 64 * 17 * 2 * 4);
constexpr size_t WS_WENDT = WS_BBAR + al256((size_t)4 * 2 * 32 * 64 * 16 * 2 * 4);
constexpr size_t WS_BT2 = WS_WENDT + (size_t)4 * 32 * 256 * 512 * 2;
constexpr size_t WS_WINT = WS_BT2 + (size_t)4 * 32 * 256 * 512 * 2;
constexpr size_t WS_WOUTT = WS_WINT + (size_t)4 * 2048 * 1024 * 2;
constexpr size_t WS_WGLUT = WS_WOUTT + (size_t)4 * 1024 * 1024 * 2;
constexpr size_t WS_W13T = WS_WGLUT + (size_t)4 * 512 * 512 * 2;
constexpr size_t WS_W2T = WS_W13T + (size_t)4 * 16 * 4096 * 1024 * 2;
constexpr size_t WS_X = WS_W2T + (size_t)4 * 16 * 1024 * 2048 * 2;
constexpr size_t WS_HX = WS_X + (size_t)R * 1024 * 4;
constexpr size_t WS_QK = WS_HX + (size_t)R * 1024 * 2;
constexpr size_t WS_VT = WS_QK + (size_t)R * 1024 * 2;
constexpr int NCHP = 2304;
constexpr size_t WS_US = WS_VT + (size_t)R * 512 * 2;
constexpr size_t WS_EB = WS_US + (size_t)32 * NCHP * 512 * 2;
constexpr size_t WS_MIX = WS_EB + (size_t)32 * NCHP * 256 * 4;
constexpr size_t WS_YG = WS_MIX + (size_t)R * 1024 * 2;
constexpr size_t WS_AFFT = WS_YG + (size_t)R * 512 * 2;
constexpr size_t WS_SLOT = WS_AFFT + (size_t)NB * 16 * LP * 4;
constexpr size_t WS_GATE = WS_SLOT + (size_t)R * 16 * 4;
constexpr size_t WS_IDX = WS_GATE + al256((size_t)16 * ROWS_E * 4);
constexpr size_t WS_XG = WS_IDX + al256((size_t)16 * ROWS_E * 4);
constexpr size_t WS_HG = WS_XG + (size_t)16 * ROWS_E * 1024 * 2;
constexpr size_t WS_OG = WS_HG + (size_t)16 * ROWS_E * 2048 * 2;
constexpr size_t WS_END = WS_OG + (size_t)16 * ROWS_E * 1024 * 2;

constexpr int LDS_BYTES = 131072 + 64 + 16384;

DEVI unsigned pk2(float lo, float hi) { f32x2 v = {lo, hi}; bf16x2_t b = __builtin_convertvector(v, bf16x2_t); return __builtin_bit_cast(unsigned, b); }
DEVI bf16_t f2bf(float f) { return (bf16_t)(pk2(f, 0.f) & 0xffffu); }
DEVI float bflo(unsigned u) { return __builtin_bit_cast(float, u << 16); }
DEVI float bfhi(unsigned u) { return __builtin_bit_cast(float, u & 0xffff0000u); }
DEVI f32x4 bf4(u32x2 w) { return (f32x4){bflo(w.x), bfhi(w.x), bflo(w.y), bfhi(w.y)}; }
typedef _Float16 h16x2 __attribute__((ext_vector_type(2)));
DEVI unsigned hpk2(float lo, float hi) { unsigned r; asm("v_cvt_pk_f16_f32 %0, %1, %2" : "=v"(r) : "v"(lo), "v"(hi)); return r; }
DEVI float hlo(unsigned u) { return (float)__builtin_bit_cast(_Float16, (unsigned short)(u & 0xffffu)); }
DEVI float hhi(unsigned u) { return (float)__builtin_bit_cast(_Float16, (unsigned short)(u >> 16)); }
DEVI f32x4 hf4(u32x2 w) { return (f32x4){hlo(w.x), hhi(w.x), hlo(w.y), hhi(w.y)}; }
DEVI int tid_l() { int t = threadIdx.x; asm volatile("" : "+v"(t)); return t; }
#define GAS __attribute__((address_space(1)))
DEVI unsigned char* ptr_l(unsigned char* w) { GAS unsigned char* g = (GAS unsigned char*)w; asm volatile("" : "+s"(g)); return (unsigned char*)g; }
template <int CTRL> DEVI float dppmov(float x) { return __builtin_bit_cast(float, __builtin_amdgcn_update_dpp(0, __builtin_bit_cast(int, x), CTRL, 0xf, 0xf, true)); }
DEVI void swap16(float a, float b, float& r0, float& r1) { const auto r = __builtin_amdgcn_permlane16_swap(__builtin_bit_cast(unsigned, a), __builtin_bit_cast(unsigned, b), false, false); r0 = __builtin_bit_cast(float, (unsigned)r[0]); r1 = __builtin_bit_cast(float, (unsigned)r[1]); }
DEVI void swap32(float a, float b, float& r0, float& r1) { const auto r = __builtin_amdgcn_permlane32_swap(__builtin_bit_cast(unsigned, a), __builtin_bit_cast(unsigned, b), false, false); r0 = __builtin_bit_cast(float, (unsigned)r[0]); r1 = __builtin_bit_cast(float, (unsigned)r[1]); }
DEVI float wave_sum(float v) {
    v += dppmov<0xB1>(v);
    v += dppmov<0x4E>(v);
    v += dppmov<0x124>(v);
    v += dppmov<0x128>(v);
    float r0, r1; swap16(v, v, r0, r1); v = r0 + r1;
    swap32(v, v, r0, r1); return r0 + r1;
}
DEVI float fast_exp2(float x) { return __builtin_amdgcn_exp2f(x); }
DEVI float sigmoidf_(float x) { return __builtin_amdgcn_rcpf(1.f + __expf(-x)); }
DEVI float gelu_tanh(float x) { const float z = 0.7978845608028654f * (x + 0.044715f * x * x * x); const float t = 1.f - 2.f * __builtin_amdgcn_rcpf(__expf(2.f * z) + 1.f); return 0.5f * x * (1.f + t); }
#define MFMA32(a, b, c) __builtin_amdgcn_mfma_f32_32x32x16_bf16(a, b, c, 0, 0, 0)

#define XB_TMO      128
#define XB_XCNT(j)  (256  + 64 * (j))
#define XB_XSUB(j)  (1280 + 64 * (j))
#define XB_XGEN(j)  (2304 + 64 * (j))
#define XB_TOP      3328
#define XB_TOPGEN   3392
#define XCD_BAR_WORDS 3456
#define XB_SPIN_CAP (1u << 20)
DEVI unsigned xb_ld(unsigned* p)              { return __hip_atomic_load(p, __ATOMIC_RELAXED, __HIP_MEMORY_SCOPE_AGENT); }
DEVI unsigned xb_add(unsigned* p, unsigned v) { return __hip_atomic_fetch_add(p, v, __ATOMIC_RELAXED, __HIP_MEMORY_SCOPE_AGENT); }
DEVI unsigned xb_xcc_id() { return (unsigned)__builtin_amdgcn_s_getreg((3 << 11) | 20) & 0xFu; }
#define XB_SPIN(cond, bar) do { unsigned _sp = 0; while (cond) { __builtin_amdgcn_s_sleep(1); \
    if ((++_sp & 255u) == 0u) { if (xb_ld(&(bar)[XB_TMO])) break; if (_sp > XB_SPIN_CAP) { atomicAdd(&(bar)[XB_TMO], 1u); break; } } } } while (0)
struct XcdBarrier { unsigned* bar; unsigned x; volatile LAS unsigned* st; };
DEVI XcdBarrier xcd_barrier_post(unsigned* bar, volatile LAS unsigned* st) {
    XcdBarrier b; b.bar = bar; b.x = xb_xcc_id(); b.st = st;
    if (threadIdx.x == 0) (void)xb_add(&bar[XB_XCNT(b.x)], 1u);
    return b;
}
DEVI void xcd_barrier_complete(unsigned* bar, unsigned x, unsigned& nloc, unsigned& nx) {
    const unsigned G = gridDim.x * gridDim.y * gridDim.z;
    unsigned sum, cnt, mine, sp = 0u;
    for (;;) {
        sum = 0u; cnt = 0u; mine = 0u;
#pragma unroll
        for (unsigned j = 0; j < 16; ++j) { const unsigned c = xb_ld(&bar[XB_XCNT(j)]); sum += c; cnt += (c > 0u) ? 1u : 0u; mine = (j == x) ? c : mine; }
        if (sum == G) break;
        __builtin_amdgcn_s_sleep(1);
        if ((++sp & 255u) == 0u) { if (xb_ld(&bar[XB_TMO])) break; if (sp > XB_SPIN_CAP) { atomicAdd(&bar[XB_TMO], 1u); break; } }
    }
    nloc = mine > 0u ? mine : 1u; nx = cnt > 0u ? cnt : 1u;
}
DEVI void xcd_barrier(const XcdBarrier& b) {
    asm volatile("s_waitcnt vmcnt(0)" ::: "memory");
    __syncthreads();
    if (threadIdx.x == 0) {
        unsigned* bar = b.bar;
        __builtin_amdgcn_s_waitcnt(0);
        unsigned nloc = b.st[0], nx = b.st[1];
        if (nloc == 0u) { xcd_barrier_complete(bar, b.x, nloc, nx); b.st[0] = nloc; b.st[1] = nx; }
        const unsigned old = xb_add(&bar[XB_XSUB(b.x)], 1u);
        const unsigned gen = old / nloc;
        if (old + 1u == (gen + 1u) * nloc) {
            __builtin_amdgcn_fence(__ATOMIC_RELEASE, "agent");
            asm volatile("s_waitcnt vmcnt(0)" ::: "memory");
            const unsigned og = xb_add(&bar[XB_TOP], 1u);
            const unsigned tg = og / nx;
            if (og + 1u == (tg + 1u) * nx) xb_add(&bar[XB_TOPGEN], 1u);
            else XB_SPIN(xb_ld(&bar[XB_TOPGEN]) == tg, bar);
            __builtin_amdgcn_fence(__ATOMIC_ACQUIRE, "agent");
            xb_add(&bar[XB_XGEN(b.x)], 1u);
            asm volatile("s_waitcnt vmcnt(0)" ::: "memory");
        } else {
            XB_SPIN(xb_ld(&bar[XB_XGEN(b.x)]) == gen, bar);
            __builtin_amdgcn_fence(__ATOMIC_ACQUIRE, "agent");
            asm volatile("s_waitcnt vmcnt(0)" ::: "memory");
        }
    }
    __syncthreads();
}

DEVI int chunk_row(int b, int c) { return c >= 16 ? b * 256 + (c - 16) : 2048 + b * 16 + c; }
DEVI int chunk_row_token(int cr) { return cr < 2048 ? (cr >> 8) * LP + (16 + (cr & 255)) * 16 : ((cr - 2048) >> 4) * LP + ((cr - 2048) & 15) * 16; }
DEVI int perm16(int k) { return (k & 3) | ((k & 4) << 1) | ((k & 8) >> 1); }

namespace pg8 {
#define PG8_LAS __attribute__((address_space(3)))
typedef unsigned short bf16_t;
typedef short bf16x8 __attribute__((ext_vector_type(8)));
typedef float f32x4 __attribute__((ext_vector_type(4)));
typedef unsigned u32x4 __attribute__((ext_vector_type(4)));
constexpr int BM = 256, BK = 64, HALF = 128, HTB = HALF * BK * 2  , STAGE_BYTES = 8 * HTB, NXCD = 8, WGM = 8;

__host__ __device__ __forceinline__ int lds_byte(int r, int c) { const int st = (r >> 4) * 2 + (c >> 5), rr = r & 15, cc = c & 31, ob = rr * 64 + cc * 2; return st * 1024 + (ob ^ (((ob >> 9) & 1) << 5)); }
__host__ __device__ __forceinline__ void stage_rc(int b, int& R, int& C) { const int st = b / 1024, sb = b % 1024, swz = sb ^ (((sb >> 9) & 1) << 5); R = (st >> 1) * 16 + swz / 64; C = (st & 1) * 32 + (swz % 64) / 2; }
__host__ __device__ __forceinline__ int perm32(int rho) { const int n = rho >> 4, i = rho & 15; return 8 * (i >> 2) + 4 * n + (i & 3); }

struct Unit { int pm, pn; };
struct Gemm { const bf16_t* A; const bf16_t* Bt; int M, N, K; const int* gidx = nullptr; int islot = 0; int nkt = 0; };
__device__ __forceinline__ unsigned cvt_pk_bf16(float lo, float hi) { unsigned r; asm volatile("v_cvt_pk_bf16_f32 %0, %1, %2" : "=v"(r) : "v"(lo), "v"(hi)); return r; }
template <class Epi, class Sched, bool ALIGN_EPI = false, bool SP2 = false, bool GATH = false>
__device__ __forceinline__ void gemm_phase(PG8_LAS unsigned char* lds, const Gemm g, const Sched& S, const Epi& E) {
    static_assert(!GATH || SP2, "the gathered-A form is written for the SP2 loop only");
    const int tid = tid_l(), wid = __builtin_amdgcn_readfirstlane(tid >> 6), lane = tid & 63, wr = wid >> 2, wc = wid & 3, fr = lane & 15, fq = lane >> 4;
    const int K = g.K, nt = g.nkt ? g.nkt : K / BK;
    unsigned voffA[2], voffB[2];
    int stR[2], stC[2];
#pragma unroll
    for (int i = 0; i < 2; ++i) { int R, C; stage_rc(tid * 16 + i * 8192, R, C); const int Rb = Epi::PERM ? ((R & ~31) + perm32(R & 31)) : R; stR[i] = R; stC[i] = C;
        voffA[i] = (unsigned)(R * K + C) * 2u; voffB[i] = (unsigned)(Rb * K + C) * 2u; }
    unsigned goff[2][2], ngoff[2][2];
    const char* gA = (const char*)g.A;
    const size_t kstep = (size_t)(BK * 2);
    const size_t hstep = (size_t)HALF * K * 2;
    const size_t tstep = 2 * hstep;
    const unsigned ldsw = (unsigned)wid * 1024u;
    const int aoff = lds_byte(wr * 64 + fr, fq * 8), boff = lds_byte(wc * 32 + fr, fq * 8);
#define PG8_SA(b, h) (((b) * 2 + (h)) * HTB)
#define PG8_SB(b, h) ((4 + (b) * 2 + (h)) * HTB)
#define PG8_STAGE(bufoff, gbase, voff) do { _Pragma("unroll") for (int _i = 0; _i < 2; ++_i) \
        __builtin_amdgcn_global_load_lds((const unsigned*)((const char*)(gbase) + (voff)[_i]), (PG8_LAS unsigned*)(lds + (bufoff) + ldsw + _i * 8192), 16, 0, 0); } while (0)
#define PG8_STAGE_A(bufoff, selnext, kt, h) do { if constexpr (GATH) PG8_STAGE(bufoff, gA + (size_t)(kt) * kstep, ((selnext) ? ngoff[h] : goff[h])); \
        else PG8_STAGE(bufoff, ((selnext) ? nA : cA) + (size_t)(kt) * kstep + (size_t)(h) * hstep, voffA); } while (0)
#define PG8_LDA(dst, b, h) do { _Pragma("unroll") for (int m = 0; m < 4; ++m) _Pragma("unroll") for (int k = 0; k < 2; ++k) dst[m][k] = *(const PG8_LAS bf16x8*)(lds + PG8_SA(b, h) + aoff + m * 2048 + k * 1024); } while (0)
#define PG8_LDB(dst, b, h) do { _Pragma("unroll") for (int n = 0; n < 2; ++n) _Pragma("unroll") for (int k = 0; k < 2; ++k) dst[n][k] = *(const PG8_LAS bf16x8*)(lds + PG8_SB(b, h) + boff + n * 2048 + k * 1024); } while (0)
#define PG8_MMA(ai, bj, At, Bt) do { __builtin_amdgcn_s_setprio(1); _Pragma("unroll") for (int m = 0; m < 4; ++m) _Pragma("unroll") for (int n = 0; n < 2; ++n) _Pragma("unroll") for (int k = 0; k < 2; ++k) \
        acc[ai][bj][m][n] = __builtin_amdgcn_mfma_f32_16x16x32_bf16(Bt[n][k], At[m][k], acc[ai][bj][m][n], 0, 0, 0); __builtin_amdgcn_s_setprio(0); } while (0)
#define PG8_WAIT_V(n) asm volatile("s_waitcnt vmcnt(" #n ")" ::: "memory")
#define PG8_WAIT_L(n) asm volatile("s_waitcnt lgkmcnt(" #n ")" ::: "memory")
#define PG8_BAR __builtin_amdgcn_s_barrier()
#define PG8_SCHED __builtin_amdgcn_sched_barrier(0)
    Unit cur, nxt; int ui = 0;
    if (!S.next(0, cur)) return;
    f32x4 acc[2][2][4][2];
#pragma unroll
    for (int a = 0; a < 2; ++a)
#pragma unroll
        for (int b = 0; b < 2; ++b)
#pragma unroll
            for (int m = 0; m < 4; ++m)
#pragma unroll
                for (int n = 0; n < 2; ++n) acc[a][b][m][n] = (f32x4){0.f, 0.f, 0.f, 0.f};
    bf16x8 At[4][2], B0[2][2], B1[2][2];
    const char* cA = (const char*)g.A + (size_t)cur.pm * tstep; const char* cB = (const char*)g.Bt + (size_t)cur.pn * tstep;
    const char* nA = cA;
    if constexpr (GATH) {
#pragma unroll
        for (int h = 0; h < 2; ++h)
#pragma unroll
            for (int i = 0; i < 2; ++i) { goff[h][i] = (unsigned)(g.gidx[cur.pm * 256 + h * 128 + stR[i]] * K + stC[i]) * 2u; ngoff[h][i] = goff[h][i]; }
    }
    S.a_ready(cur);
    if constexpr (SP2) {
        PG8_STAGE(PG8_SB(0, 0), cB, voffB); PG8_STAGE(PG8_SB(0, 1), cB + hstep, voffB); PG8_STAGE_A(PG8_SA(0, 0), false, 0, 0); PG8_STAGE_A(PG8_SA(0, 1), false, 0, 1);
        if (wr == 1) PG8_BAR;
        PG8_WAIT_V(2); PG8_BAR;
        PG8_STAGE(PG8_SB(1, 0), cB + kstep, voffB); PG8_STAGE_A(PG8_SA(1, 0), false, 1, 0); PG8_STAGE(PG8_SB(1, 1), cB + hstep + kstep, voffB);
        PG8_WAIT_V(6); PG8_BAR;
    } else {
        PG8_STAGE(PG8_SB(0, 0), cB, voffB); PG8_STAGE(PG8_SA(0, 0), cA, voffA); PG8_STAGE(PG8_SB(0, 1), cB + hstep, voffB); PG8_STAGE(PG8_SA(0, 1), cA + hstep, voffA);
        if (wr == 1) PG8_BAR;
        PG8_WAIT_V(4); PG8_BAR;
        PG8_STAGE(PG8_SB(1, 0), cB + kstep, voffB); PG8_STAGE(PG8_SA(1, 0), cA + kstep, voffA); PG8_STAGE(PG8_SB(1, 1), cB + hstep + kstep, voffB);
        PG8_WAIT_V(6); PG8_BAR;
    }
    for (;;) {
        const bool has_next = S.next(ui + 1, nxt);
        nA = has_next ? (const char*)g.A + (size_t)nxt.pm * tstep : cA; const char* nB = has_next ? (const char*)g.Bt + (size_t)nxt.pn * tstep : cB;
        if constexpr (GATH) {
            if (has_next) {
#pragma unroll
                for (int h = 0; h < 2; ++h)
#pragma unroll
                    for (int i = 0; i < 2; ++i)
                        __builtin_amdgcn_global_load_lds((const unsigned*)(g.gidx + nxt.pm * 256 + h * 128 + stR[i]), (PG8_LAS unsigned*)(lds + g.islot + ((ui + 1) & 1) * 8192 + (h * 2 + i) * 2048 + wid * 256), 4, 0, 0);
            }
        }
#pragma unroll 1
        for (int t = 0; t < nt; t += 2) {
            const bool last = (t == nt - 2);
            if constexpr (GATH) {
                if (last) {
                    if (has_next) {
#pragma unroll
                        for (int h = 0; h < 2; ++h)
#pragma unroll
                            for (int i = 0; i < 2; ++i) { const int ix = *(const PG8_LAS int*)(lds + g.islot + ((ui + 1) & 1) * 8192 + (h * 2 + i) * 2048 + wid * 256 + lane * 4); ngoff[h][i] = (unsigned)(ix * K + stC[i]) * 2u; }
                    } else {
#pragma unroll
                        for (int h = 0; h < 2; ++h)
#pragma unroll
                            for (int i = 0; i < 2; ++i) ngoff[h][i] = goff[h][i];
                    }
                }
            }
            const char* a1 = cA + (size_t)(t + 1) * kstep;
            const char* a2 = last ? nA : cA + (size_t)(t + 2) * kstep; const char* b2 = last ? nB : cB + (size_t)(t + 2) * kstep;
            const char* a3 = a2 + kstep; const char* b3 = b2 + kstep;
            if (last && has_next) S.a_ready(nxt);
            if constexpr (SP2) {
            PG8_LDB(B0, 0, 0); PG8_LDB(B1, 0, 1); PG8_SCHED; PG8_LDA(At, 0, 0); PG8_STAGE_A(PG8_SA(1, 1), false, t + 1, 1);
            PG8_WAIT_V(8); PG8_WAIT_L(0); PG8_BAR; PG8_MMA(0, 0, At, B0); PG8_MMA(0, 1, At, B1); PG8_BAR; PG8_SCHED;
            PG8_LDA(At, 0, 1); PG8_STAGE(PG8_SB(0, 0), b2, voffB); PG8_STAGE(PG8_SB(0, 1), b2 + hstep, voffB); PG8_STAGE_A(PG8_SA(0, 0), last, last ? 0 : t + 2, 0);
            PG8_WAIT_V(8); PG8_WAIT_L(0); PG8_BAR; PG8_MMA(1, 0, At, B0); PG8_MMA(1, 1, At, B1); PG8_BAR; PG8_SCHED;
            PG8_LDB(B0, 1, 0); PG8_LDB(B1, 1, 1); PG8_SCHED; PG8_LDA(At, 1, 0); PG8_STAGE_A(PG8_SA(0, 1), last, last ? 0 : t + 2, 1);
            PG8_WAIT_V(8); PG8_WAIT_L(0); PG8_BAR; PG8_MMA(0, 0, At, B0); PG8_MMA(0, 1, At, B1); PG8_BAR; PG8_SCHED;
            PG8_LDA(At, 1, 1); PG8_STAGE(PG8_SB(1, 0), b3, voffB); PG8_STAGE(PG8_SB(1, 1), b3 + hstep, voffB); PG8_STAGE_A(PG8_SA(1, 0), last, last ? 1 : t + 3, 0);
            PG8_WAIT_V(8); PG8_WAIT_L(0); PG8_BAR; PG8_MMA(1, 0, At, B0); PG8_MMA(1, 1, At, B1); PG8_BAR; PG8_SCHED;
            } else {
            PG8_LDB(B0, 0, 0); PG8_SCHED; PG8_LDA(At, 0, 0); PG8_STAGE(PG8_SA(1, 1), a1 + hstep, voffA);
            PG8_WAIT_L(8); PG8_BAR; PG8_WAIT_L(0); PG8_MMA(0, 0, At, B0); PG8_BAR; PG8_SCHED;
            PG8_LDB(B1, 0, 1); PG8_STAGE(PG8_SB(0, 0), b2, voffB);
            PG8_BAR; PG8_WAIT_L(0); PG8_MMA(0, 1, At, B1); PG8_BAR;
            PG8_LDA(At, 0, 1); PG8_STAGE(PG8_SA(0, 0), a2, voffA);
            PG8_BAR; PG8_WAIT_L(0); PG8_MMA(1, 0, At, B0); PG8_BAR; PG8_SCHED;
            PG8_STAGE(PG8_SB(0, 1), b2 + hstep, voffB);
            PG8_WAIT_V(6); PG8_BAR; PG8_MMA(1, 1, At, B1); PG8_BAR;
            PG8_LDB(B0, 1, 0); PG8_SCHED; PG8_LDA(At, 1, 0); PG8_STAGE(PG8_SA(0, 1), a2 + hstep, voffA);
            PG8_WAIT_L(8); PG8_BAR; PG8_WAIT_L(0); PG8_MMA(0, 0, At, B0); PG8_BAR; PG8_SCHED;
            PG8_LDB(B1, 1, 1); PG8_STAGE(PG8_SB(1, 0), b3, voffB);
            PG8_BAR; PG8_WAIT_L(0); PG8_MMA(0, 1, At, B1); PG8_BAR;
            PG8_LDA(At, 1, 1); PG8_STAGE(PG8_SA(1, 0), a3, voffA);
            PG8_BAR; PG8_WAIT_L(0); PG8_MMA(1, 0, At, B0); PG8_BAR; PG8_SCHED;
            PG8_STAGE(PG8_SB(1, 1), b3 + hstep, voffB);
            PG8_WAIT_V(6); PG8_BAR; PG8_MMA(1, 1, At, B1); PG8_BAR;
            }
        }
        if constexpr (ALIGN_EPI) { if (wr == 0) PG8_BAR; }
        if constexpr (!Epi::AFTER_DRAIN) { E(acc, cur, wr, wc, fr, fq); S.done(cur); }
        if (!has_next) break;
#pragma unroll
        for (int a = 0; a < 2; ++a)
#pragma unroll
            for (int b = 0; b < 2; ++b)
#pragma unroll
                for (int m = 0; m < 4; ++m)
#pragma unroll
                    for (int n = 0; n < 2; ++n) acc[a][b][m][n] = (f32x4){0.f, 0.f, 0.f, 0.f};
        cur = nxt; cA = nA; cB = nB; ++ui;
        if constexpr (GATH) {
#pragma unroll
            for (int h = 0; h < 2; ++h)
#pragma unroll
                for (int i = 0; i < 2; ++i) goff[h][i] = ngoff[h][i];
        }
        if constexpr (ALIGN_EPI) { if (wr == 1) PG8_BAR; }
    }
    PG8_WAIT_V(0);
    if constexpr (!ALIGN_EPI) { if (wr == 0) PG8_BAR; }
    PG8_BAR;
    if constexpr (Epi::AFTER_DRAIN) { E.fused(acc, cur, wr, wc, fr, fq, lds, wid, lane); S.done(cur); }
#undef PG8_SA
#undef PG8_SB
#undef PG8_STAGE
#undef PG8_STAGE_A
#undef PG8_LDA
#undef PG8_LDB
#undef PG8_MMA
#undef PG8_WAIT_V
#undef PG8_WAIT_L
#undef PG8_BAR
#undef PG8_SCHED
}
}


struct TileOrder {
    int nunits, G, c, npm, npn, pn_gs, pm_gs, pm_off, blk48 = 0;
    DEVI bool next(int i, pg8::Unit& u) const {
        const int L = i * G + c; if (L >= nunits) return false;
        const int per = npm * npn, e = L / per, v = L - e * per; int pml = v / npn, pnl = v - pml * npn;
        if (blk48 && v < 256) { const int blk = v >> 5, w = v & 31; pml = (blk >> 1) * 4 + (w >> 3); pnl = (blk & 1) * 8 + (w & 7); }
        u.pm = e * pm_gs + pm_off + pml; u.pn = e * pn_gs + pnl; return true;
    }
    DEVI void a_ready(const pg8::Unit&) const {}
    DEVI void done(const pg8::Unit&) const {}
};

struct Epi8Inproj { static constexpr bool PERM = false, AFTER_DRAIN = false;
    bf16_t* QK; bf16_t* VT; bf16_t* UG; const float* rope;
    DEVI void operator()(const f32x4 (&acc)[2][2][4][2], const pg8::Unit& u, int wr, int wc, int fr, int fq) const {
        const int pn = u.pn;
#pragma unroll
        for (int ai = 0; ai < 2; ++ai)
#pragma unroll
            for (int m = 0; m < 4; ++m) {
                const int r = u.pm * 256 + ai * 128 + wr * 64 + m * 16 + fr, b = r / LP, p = r - b * LP; const bool latent = p >= CTXL; const int t = p - CTXL;
#pragma unroll
                for (int bj = 0; bj < 2; ++bj) {
                    const int cb = bj * 128 + wc * 32;
                    if (pn < 4) {
                        const int head = cb >> 6, dbase = cb & 63, pos = dbase == 0 ? (t >> 6) : (t & 63);
                        const float sc = pn < 2 ? QSCALE : 1.f;
                        f32x4 cs0 = {1.f, 0.f, 1.f, 0.f}, cs1 = {1.f, 0.f, 1.f, 0.f};
                        if (latent) { cs0 = *(const f32x4*)(rope + (pos * 16 + 4 * fq) * 2); cs1 = *(const f32x4*)(rope + (pos * 16 + 4 * fq + 2) * 2); }
                        const float cc[4] = {cs0.x, cs0.z, cs1.x, cs1.z}, sn[4] = {cs0.y, cs0.w, cs1.y, cs1.w};
                        bf16_t* dst = QK + ((size_t)((pn * NB + b) * NH + head) * LP + p) * 64 + dbase + 4 * fq;
#pragma unroll
                        for (int n = 0; n < 2; ++n) {
                            float o[4];
#pragma unroll
                            for (int j = 0; j < 4; ++j) { const float x = acc[ai][bj][m][n][j], y = acc[ai][bj][m][n ^ 1][j]; o[j] = (n == 0 ? x * cc[j] - y * sn[j] : x * cc[j] + y * sn[j]) * sc; }
                            u32x2 w; w.x = pk2(o[0], o[1]); w.y = pk2(o[2], o[3]);
                            *(u32x2*)(dst + 16 * n) = w;
                        }
                    } else if (pn < 6) {
                        const int cv = (pn - 4) * 256 + cb, head = cv >> 7, dv0 = (cv & 127) + 4 * fq;
                        const int pp = (p & ~15) | perm16(p & 15);
                        bf16_t* dst = VT + ((size_t)(b * NH + head) * 128 + dv0) * LP + pp;
#pragma unroll
                        for (int n = 0; n < 2; ++n)
#pragma unroll
                            for (int j = 0; j < 4; ++j) dst[(size_t)(16 * n + j) * LP] = f2bf(acc[ai][bj][m][n][j]);
                    } else {
                        const int ch0 = (pn - 6) * 256 + cb;
                        bf16_t* dst = UG + (size_t)chunk_row(b, p >> 4) * 512 + (p & 15) * 16 + 4 * fq;
#pragma unroll
                        for (int n = 0; n < 2; ++n) {
                            const int g = (ch0 + 16 * n) >> 4;
                            u32x2 w; w.x = pk2(acc[ai][bj][m][n][0], acc[ai][bj][m][n][1]); w.y = pk2(acc[ai][bj][m][n][2], acc[ai][bj][m][n][3]);
                            *(u32x2*)(dst + (size_t)g * NCHP * 512) = w;
                        }
                    }
                }
            }
    }
};

struct Epi8Out { static constexpr bool PERM = true, AFTER_DRAIN = false;
    bf16_t* X; const float* mod;
    DEVI void operator()(const f32x4 (&acc)[2][2][4][2], const pg8::Unit& u, int wr, int wc, int fr, int fq) const {
#pragma unroll
        for (int ai = 0; ai < 2; ++ai)
#pragma unroll
            for (int m = 0; m < 4; ++m) {
                const int r = u.pm * 256 + ai * 128 + wr * 64 + m * 16 + fr, b = r / LP, p = r - b * LP, jm = p < CTXL ? 8 : b;
                const float* g1 = mod + (size_t)jm * 6144 + 2 * 1024;
#pragma unroll
                for (int bj = 0; bj < 2; ++bj) {
                    const int c = u.pn * 256 + bj * 128 + wc * 32 + 8 * fq;
                    bf16_t* xp = X + (size_t)r * 1024 + c;
                    const u32x4 xw = *(const u32x4*)xp;
                    const f32x4 g0 = *(const f32x4*)(g1 + c), g4 = *(const f32x4*)(g1 + c + 4);
                    const f32x4 o0 = hf4((u32x2){xw.x, xw.y}) + g0 * acc[ai][bj][m][0], o1 = hf4((u32x2){xw.z, xw.w}) + g4 * acc[ai][bj][m][1];
                    u32x4 w; w.x = hpk2(o0.x, o0.y); w.y = hpk2(o0.z, o0.w); w.z = hpk2(o1.x, o1.y); w.w = hpk2(o1.z, o1.w);
                    *(u32x4*)xp = w;
                }
            }
    }
};

struct Epi8Moe1 { static constexpr bool PERM = true, AFTER_DRAIN = false;
    bf16_t* HG;
    DEVI void operator()(const f32x4 (&acc)[2][2][4][2], const pg8::Unit& u, int wr, int wc, int fr, int fq) const {
        const int t = u.pn & 15;
#pragma unroll
        for (int ai = 0; ai < 2; ++ai)
#pragma unroll
            for (int m = 0; m < 4; ++m) {
                const size_t row = (size_t)u.pm * 256 + ai * 128 + wr * 64 + m * 16 + fr;
                float o[8];
#pragma unroll
                for (int n = 0; n < 2; ++n)
#pragma unroll
                    for (int j = 0; j < 4; ++j) { const float a1 = acc[ai][0][m][n][j], a3 = acc[ai][1][m][n][j]; o[4 * n + j] = a1 * sigmoidf_(a1) * a3; }
                u32x4 w; w.x = pk2(o[0], o[1]); w.y = pk2(o[2], o[3]); w.z = pk2(o[4], o[5]); w.w = pk2(o[6], o[7]);
                *(u32x4*)(HG + row * FF + t * 128 + wc * 32 + 8 * fq) = w;
            }
    }
};

struct Epi8Moe2 { static constexpr bool PERM = true, AFTER_DRAIN = false;
    bf16_t* OG; const float* gate;
    DEVI void operator()(const f32x4 (&acc)[2][2][4][2], const pg8::Unit& u, int wr, int wc, int fr, int fq) const {
        const int t = u.pn & 3;
#pragma unroll
        for (int ai = 0; ai < 2; ++ai)
#pragma unroll
            for (int m = 0; m < 4; ++m) {
                const size_t row = (size_t)u.pm * 256 + ai * 128 + wr * 64 + m * 16 + fr; const float gt = gate[row];
#pragma unroll
                for (int bj = 0; bj < 2; ++bj) {
                    const f32x4 a = acc[ai][bj][m][0] * gt, c = acc[ai][bj][m][1] * gt;
                    u32x4 w; w.x = pk2(a.x, a.y); w.y = pk2(a.z, a.w); w.z = pk2(c.x, c.y); w.w = pk2(c.z, c.w);
                    *(u32x4*)(OG + row * 1024 + t * 256 + bj * 128 + wc * 32 + 8 * fq) = w;
                }
            }
    }
};

struct Epi8S1 { static constexpr bool PERM = true, AFTER_DRAIN = false;
    unsigned short* E;
    DEVI void operator()(const f32x4 (&acc)[2][2][4][2], const pg8::Unit& u, int wr, int wc, int fr, int fq) const {
        const int g = u.pn, r0 = (u.pm - g * 9) * 256 + wr * 64 + fr;
#pragma unroll
        for (int ai = 0; ai < 2; ++ai)
#pragma unroll
            for (int m = 0; m < 4; ++m) {
                const int cr = r0 + ai * 128 + m * 16;
                if (cr < NCH) {
                    unsigned short* dst = E + ((size_t)g * NCHP + cr) * 256 + wc * 32 + 8 * fq;
#pragma unroll
                    for (int bj = 0; bj < 2; ++bj) {
                        const f32x4 a = acc[ai][bj][m][0], d = acc[ai][bj][m][1];
                        u32x4 w; w.x = hpk2(a.x, a.y); w.y = hpk2(a.z, a.w); w.z = hpk2(d.x, d.y); w.w = hpk2(d.z, d.w);
                        *(u32x4*)(dst + bj * 128) = w;
                    }
                }
            }
    }
};
struct Epi8S2 { static constexpr bool PERM = true, AFTER_DRAIN = false;
    bf16_t* YG;
    DEVI void operator()(const f32x4 (&acc)[2][2][4][2], const pg8::Unit& u, int wr, int wc, int fr, int fq) const {
        const int g = u.pn, r0 = (u.pm - g * 9) * 256 + wr * 64 + fr;
#pragma unroll
        for (int ai = 0; ai < 2; ++ai)
#pragma unroll
            for (int m = 0; m < 4; ++m) {
                const int cr = r0 + ai * 128 + m * 16;
                if (cr < NCH) {
                    const size_t tok0 = (size_t)chunk_row_token(cr);
#pragma unroll
                    for (int bj = 0; bj < 2; ++bj) {
                        const int col = bj * 128 + wc * 32 + 8 * fq, j = col >> 4, h = col & 15;
                        const f32x4 a = acc[ai][bj][m][0], d = acc[ai][bj][m][1];
                        u32x4 w; w.x = pk2(gelu_tanh(a.x), gelu_tanh(a.y)); w.y = pk2(gelu_tanh(a.z), gelu_tanh(a.w)); w.z = pk2(gelu_tanh(d.x), gelu_tanh(d.y)); w.w = pk2(gelu_tanh(d.z), gelu_tanh(d.w));
                        *(u32x4*)(YG + (tok0 + j) * 512 + g * 16 + h) = w;
                    }
                }
            }
    }
};
struct Epi8Glu { static constexpr bool PERM = true, AFTER_DRAIN = false;
    const bf16_t* YG; bf16_t* MIX; const float* bglu;
    DEVI void operator()(const f32x4 (&acc)[2][2][4][2], const pg8::Unit& u, int wr, int wc, int fr, int fq) const {
#pragma unroll
        for (int ai = 0; ai < 2; ++ai)
#pragma unroll
            for (int m = 0; m < 4; ++m) {
                const size_t tok = (size_t)u.pm * 256 + ai * 128 + wr * 64 + m * 16 + fr;
#pragma unroll
                for (int bj = 0; bj < 2; ++bj) {
                    const int n0 = u.pn * 256 + bj * 128 + wc * 32 + 8 * fq;
                    const u32x4 y = *(const u32x4*)(YG + tok * 512 + n0);
                    const f32x4 b0 = *(const f32x4*)(bglu + n0), b1 = *(const f32x4*)(bglu + n0 + 4);
                    const f32x4 a = acc[ai][bj][m][0] + b0, d = acc[ai][bj][m][1] + b1;
                    u32x4 w; w.x = pk2(bflo(y.x) * sigmoidf_(a.x), bfhi(y.x) * sigmoidf_(a.y)); w.y = pk2(bflo(y.y) * sigmoidf_(a.z), bfhi(y.y) * sigmoidf_(a.w));
                    w.z = pk2(bflo(y.z) * sigmoidf_(d.x), bfhi(y.z) * sigmoidf_(d.y)); w.w = pk2(bflo(y.w) * sigmoidf_(d.z), bfhi(y.w) * sigmoidf_(d.w));
                    *(u32x4*)(MIX + tok * 1024 + 512 + n0) = w;
                }
            }
    }
};

struct Params {
    const float* in[30];
    float* out;
    unsigned char* ws;
    int lo, hi;
};

DEVI int swz(int row, int kc) { return row * 128 + ((kc ^ ((row >> 1) & 7)) << 4); }

struct APlain { const bf16_t* A; int lda; DEVI const bf16_t* ptr(int row, int k) const { return A + (size_t)row * lda + k; } };
struct AS2 { const bf16_t* U; const bf16_t* S; DEVI const bf16_t* ptr(int row, int k) const { return (k < 256 ? U : S) + (size_t)row * 8192 + (k & 255); } };

template <int BM, class AF, class Epi>
DEVI void gemm_unit(char* lds, const AF& af, const bf16_t* __restrict__ Bt, int ldb, int K, int m0, int n0, const Epi& epi) {
    constexpr int MT = BM / 128, ACH = BM / 64, A_BYTES = BM * 128, STAGE = A_BYTES + 16384, WM = BM / 4;
    const int tid = tid_l(), lane = tid & 63, wid = tid >> 6, wm = wid >> 1, wn = wid & 1, r32 = lane & 31, hi = lane >> 5;
    f32x16 acc[MT][2];
#pragma unroll
    for (int a = 0; a < MT; ++a)
#pragma unroll
        for (int b = 0; b < 2; ++b)
#pragma unroll
            for (int i = 0; i < 16; ++i) acc[a][b][i] = 0.f;
    u32x4 ra[ACH], rb[2];
    const int nk = K >> 6;
    const int crow = tid >> 3, ckc = tid & 7;
#define G_LOAD(kt) do { \
        _Pragma("unroll") for (int i = 0; i < ACH; ++i) ra[i] = *(const u32x4*)af.ptr(m0 + crow + 64 * i, (kt) * 64 + ckc * 8); \
        _Pragma("unroll") for (int i = 0; i < 2; ++i) rb[i] = *(const u32x4*)(Bt + (size_t)(n0 + crow + 64 * i) * ldb + (kt) * 64 + ckc * 8); } while (0)
#define G_STORE(s) do { char* _a = lds + (s) * STAGE; char* _b = _a + A_BYTES; \
        _Pragma("unroll") for (int i = 0; i < ACH; ++i) *(u32x4*)(_a + swz(crow + 64 * i, ckc)) = ra[i]; \
        _Pragma("unroll") for (int i = 0; i < 2; ++i) *(u32x4*)(_b + swz(crow + 64 * i, ckc)) = rb[i]; } while (0)
    G_LOAD(0); G_STORE(0); __syncthreads();
    for (int kt = 0; kt < nk; ++kt) {
        if (kt + 1 < nk) G_LOAD(kt + 1);
        const char* a = lds + (kt & 1) * STAGE; const char* b = a + A_BYTES;
#pragma unroll
        for (int ks = 0; ks < 4; ++ks) {
            bf16x8 wf[2], xf[MT];
#pragma unroll
            for (int nt = 0; nt < 2; ++nt) wf[nt] = *(const bf16x8*)(b + swz(wn * 64 + nt * 32 + r32, ks * 2 + hi));
#pragma unroll
            for (int mt = 0; mt < MT; ++mt) xf[mt] = *(const bf16x8*)(a + swz(wm * WM + mt * 32 + r32, ks * 2 + hi));
#pragma unroll
            for (int mt = 0; mt < MT; ++mt)
#pragma unroll
                for (int nt = 0; nt < 2; ++nt) acc[mt][nt] = MFMA32(wf[nt], xf[mt], acc[mt][nt]);
        }
        if (kt + 1 < nk) G_STORE((kt + 1) & 1);
        __syncthreads();
    }
#undef G_LOAD
#undef G_STORE
    epi.template run<MT>(acc, m0 + wm * WM + r32, n0 + wn * 64, hi);
}

template <class AF, class Epi>
DEVI void gemm_unit_dma(char* lds, const AF& af, const bf16_t* __restrict__ Bt, int ldb, int K, int m0, int n0, const Epi& epi) {
    const int tid = tid_l(), lane = tid & 63, wid = tid >> 6, wm = wid >> 1, wn = wid & 1, r32 = lane & 31, hi = lane >> 5;
    f32x16 acc[1][2];
#pragma unroll
    for (int b = 0; b < 2; ++b)
#pragma unroll
        for (int i = 0; i < 16; ++i) acc[0][b][i] = 0.f;
    const int nk = K >> 6;
    const int drow0 = wid * 16 + (lane >> 3), drow1 = drow0 + 8;
    const int kc0 = (lane & 7) ^ ((drow0 >> 1) & 7), kc1 = (lane & 7) ^ ((drow1 >> 1) & 7);
    const bf16_t* ga0 = af.ptr(m0 + drow0, kc0 * 8); const bf16_t* ga1 = af.ptr(m0 + drow1, kc1 * 8);
    const bf16_t* gb0 = Bt + (size_t)(n0 + drow0) * ldb + kc0 * 8; const bf16_t* gb1 = Bt + (size_t)(n0 + drow1) * ldb + kc1 * 8;
    LAS unsigned char* dl = (LAS unsigned char*)lds + wid * 2048;
#define GD_LDS(g, off) __builtin_amdgcn_global_load_lds((const unsigned*)(g), (LAS unsigned*)(dl + (off)), 16, 0, 0)
#define GD_ISSUE(kt) do { const int _s = ((kt) & 3) * 32768; GD_LDS(ga0 + (kt) * 64, _s); GD_LDS(ga1 + (kt) * 64, _s + 1024); GD_LDS(gb0 + (kt) * 64, _s + 16384); GD_LDS(gb1 + (kt) * 64, _s + 16384 + 1024); } while (0)
#define GD_WAITBAR(N) asm volatile("s_waitcnt vmcnt(" #N ") lgkmcnt(0)\n\ts_barrier" ::: "memory")
    GD_ISSUE(0); GD_ISSUE(1); GD_ISSUE(2);
    for (int kt = 0; kt < nk; ++kt) {
        if (kt + 2 < nk) GD_WAITBAR(8); else if (kt + 1 < nk) GD_WAITBAR(4); else GD_WAITBAR(0);
        if (kt + 3 < nk) GD_ISSUE(kt + 3);
        const char* a = lds + (kt & 3) * 32768; const char* b = a + 16384;
#pragma unroll
        for (int ks = 0; ks < 4; ++ks) {
            bf16x8 wf[2], xf;
#pragma unroll
            for (int nt = 0; nt < 2; ++nt) wf[nt] = *(const bf16x8*)(b + swz(wn * 64 + nt * 32 + r32, ks * 2 + hi));
            xf = *(const bf16x8*)(a + swz(wm * 32 + r32, ks * 2 + hi));
#pragma unroll
            for (int nt = 0; nt < 2; ++nt) acc[0][nt] = MFMA32(wf[nt], xf, acc[0][nt]);
        }
    }
#undef GD_LDS
#undef GD_ISSUE
#undef GD_WAITBAR
    __syncthreads();
    epi.template run<1>(acc, m0 + wm * 32 + r32, n0 + wn * 64, hi);
}


struct EpiInproj {
    bf16_t* QK; bf16_t* VT; bf16_t* UG; const float* rope;
    template <int MT> DEVI void run(const f32x16 (&acc)[MT][2], int mrow0, int ncol0, int hi) const {
#pragma unroll
        for (int mt = 0; mt < MT; ++mt) {
            const int r = mrow0 + mt * 32, b = r / LP, p = r - b * LP; const bool latent = p >= CTXL; const int t = p - CTXL;
#pragma unroll
            for (int nt = 0; nt < 2; ++nt) {
                const int nb = ncol0 + nt * 32; const f32x16& v = acc[mt][nt];
                if (nb < 1024) {
                    const int which = nb >> 8, head = (nb >> 6) & 3, dbase = nb & 63;
                    const int pos = dbase == 0 ? (t >> 6) : (t & 63);
                    bf16_t* dst = QK + ((size_t)((which * NB + b) * NH + head) * LP + p) * 64 + dbase + 4 * hi;
                    const float sc = which < 2 ? QSCALE : 1.f;
#pragma unroll
                    for (int i4 = 0; i4 < 4; ++i4) {
                        float o[4];
#pragma unroll
                        for (int j = 0; j < 4; ++j) {
                            float x = v[4 * i4 + j];
                            if (latent) {
                                const float y = v[4 * (i4 ^ 2) + j];
                                const f32x2 cs = *(const f32x2*)(rope + (pos * 16 + 8 * (i4 & 1) + 4 * hi + j) * 2);
                                x = (i4 < 2) ? (x * cs.x - y * cs.y) : (x * cs.x + y * cs.y);
                            }
                            o[j] = x * sc;
                        }
                        u32x2 w; w.x = pk2(o[0], o[1]); w.y = pk2(o[2], o[3]);
                        *(u32x2*)(dst + 8 * i4) = w;
                    }
                } else if (nb < 1536) {
                    const int n1 = nb - 1024, head = n1 >> 7, dv0 = n1 & 127;
                    const int pp = (p & ~15) | perm16(p & 15);
                    bf16_t* dst = VT + ((size_t)(b * NH + head) * 128 + dv0 + 4 * hi) * LP + pp;
#pragma unroll
                    for (int i = 0; i < 16; ++i) dst[(size_t)((i & 3) + 8 * (i >> 2)) * LP] = f2bf(v[i]);
                } else {
                    const int n1 = nb - 1536;
                    bf16_t* dst = UG + (size_t)chunk_row(b, p >> 4) * 512 + (p & 15) * 16;
#pragma unroll
                    for (int i4 = 0; i4 < 4; ++i4) {
                        const int ch = n1 + 8 * i4 + 4 * hi, g = ch >> 4, hc = ch & 15;
                        u32x2 w; w.x = pk2(v[4 * i4], v[4 * i4 + 1]); w.y = pk2(v[4 * i4 + 2], v[4 * i4 + 3]);
                        *(u32x2*)(dst + (size_t)g * NCHP * 512 + hc) = w;
                    }
                }
            }
        }
    }
};

struct EpiS1 {
    unsigned short* E;
    template <int MT> DEVI void run(const f32x16 (&acc)[MT][2], int mrow0, int ncol0, int hi) const {
#pragma unroll
        for (int mt = 0; mt < MT; ++mt) {
            unsigned short* dst = E + (size_t)(mrow0 + mt * 32) * 256 + ncol0 + 4 * hi;
#pragma unroll
            for (int nt = 0; nt < 2; ++nt)
#pragma unroll
                for (int i4 = 0; i4 < 4; ++i4) {
                    u32x2 w; w.x = hpk2(acc[mt][nt][4 * i4], acc[mt][nt][4 * i4 + 1]); w.y = hpk2(acc[mt][nt][4 * i4 + 2], acc[mt][nt][4 * i4 + 3]);
                    *(u32x2*)(dst + nt * 32 + 8 * i4) = w;
                }
        }
    }
};

struct EpiS2 {
    bf16_t* YG; int g;
    template <int MT> DEVI void run(const f32x16 (&acc)[MT][2], int mrow0, int ncol0, int hi) const {
#pragma unroll
        for (int mt = 0; mt < MT; ++mt) {
            const size_t tok0 = (size_t)chunk_row_token(mrow0 + mt * 32);
#pragma unroll
            for (int nt = 0; nt < 2; ++nt)
#pragma unroll
                for (int i4 = 0; i4 < 4; ++i4) {
                    const int n = ncol0 + nt * 32 + 8 * i4 + 4 * hi, j = n >> 4, h = n & 15;
                    u32x2 w; w.x = pk2(gelu_tanh(acc[mt][nt][4 * i4]), gelu_tanh(acc[mt][nt][4 * i4 + 1]));
                    w.y = pk2(gelu_tanh(acc[mt][nt][4 * i4 + 2]), gelu_tanh(acc[mt][nt][4 * i4 + 3]));
                    *(u32x2*)(YG + (tok0 + j) * 512 + g * 16 + h) = w;
                }
        }
    }
};

struct EpiGlu {
    const bf16_t* YG; bf16_t* MIX; const float* bglu;
    template <int MT> DEVI void run(const f32x16 (&acc)[MT][2], int mrow0, int ncol0, int hi) const {
#pragma unroll
        for (int mt = 0; mt < MT; ++mt) {
            const size_t tok = mrow0 + mt * 32;
#pragma unroll
            for (int nt = 0; nt < 2; ++nt)
#pragma unroll
                for (int i4 = 0; i4 < 4; ++i4) {
                    const int n = ncol0 + nt * 32 + 8 * i4 + 4 * hi;
                    const u32x2 y = *(const u32x2*)(YG + tok * 512 + n);
                    const f32x4 bb = *(const f32x4*)(bglu + n);
                    const float o0 = bflo(y.x) * sigmoidf_(acc[mt][nt][4 * i4] + bb.x), o1 = bfhi(y.x) * sigmoidf_(acc[mt][nt][4 * i4 + 1] + bb.y);
                    const float o2 = bflo(y.y) * sigmoidf_(acc[mt][nt][4 * i4 + 2] + bb.z), o3 = bfhi(y.y) * sigmoidf_(acc[mt][nt][4 * i4 + 3] + bb.w);
                    u32x2 w; w.x = pk2(o0, o1); w.y = pk2(o2, o3);
                    *(u32x2*)(MIX + tok * 1024 + 512 + n) = w;
                }
        }
    }
};

struct EpiOut {
    bf16_t* X; const float* mod;
    template <int MT> DEVI void run(const f32x16 (&acc)[MT][2], int mrow0, int ncol0, int hi) const {
#pragma unroll
        for (int mt = 0; mt < MT; ++mt) {
            const int r = mrow0 + mt * 32, b = r / LP, p = r - b * LP, j = p < CTXL ? 8 : b;
            const float* g1 = mod + (size_t)j * 6144 + 2 * 1024;
#pragma unroll
            for (int nt = 0; nt < 2; ++nt)
#pragma unroll
                for (int i4 = 0; i4 < 4; ++i4) {
                    const int n = ncol0 + nt * 32 + 8 * i4 + 4 * hi;
                    bf16_t* xp = X + (size_t)r * 1024 + n;
                    f32x4 x = hf4(*(const u32x2*)xp); const f32x4 g = *(const f32x4*)(g1 + n);
                    x.x += g.x * acc[mt][nt][4 * i4]; x.y += g.y * acc[mt][nt][4 * i4 + 1]; x.z += g.z * acc[mt][nt][4 * i4 + 2]; x.w += g.w * acc[mt][nt][4 * i4 + 3];
                    u32x2 w; w.x = hpk2(x.x, x.y); w.y = hpk2(x.z, x.w);
                    *(u32x2*)xp = w;
                }
        }
    }
};

struct EpiMoe1 {
    bf16_t* HG;
    template <int MT> DEVI void run(const f32x16 (&acc)[MT][2], int mrow0, int ncol0, int hi) const {
#pragma unroll
        for (int mt = 0; mt < MT; ++mt) {
            bf16_t* dst = HG + (size_t)(mrow0 + mt * 32) * FF + (ncol0 >> 1) + 4 * hi;
#pragma unroll
            for (int i4 = 0; i4 < 4; ++i4) {
                float o[4];
#pragma unroll
                for (int j = 0; j < 4; ++j) { const float a1 = acc[mt][0][4 * i4 + j], a3 = acc[mt][1][4 * i4 + j]; o[j] = a1 * sigmoidf_(a1) * a3; }
                u32x2 w; w.x = pk2(o[0], o[1]); w.y = pk2(o[2], o[3]);
                *(u32x2*)(dst + 8 * i4) = w;
            }
        }
    }
};

struct EpiMoe2 {
    bf16_t* OG; const float* gate;
    template <int MT> DEVI void run(const f32x16 (&acc)[MT][2], int mrow0, int ncol0, int hi) const {
#pragma unroll
        for (int mt = 0; mt < MT; ++mt) {
            const int row = mrow0 + mt * 32; const float gt = gate[row];
            bf16_t* dst = OG + (size_t)row * 1024 + ncol0 + 4 * hi;
#pragma unroll
            for (int nt = 0; nt < 2; ++nt)
#pragma unroll
                for (int i4 = 0; i4 < 4; ++i4) {
                    u32x2 w; w.x = pk2(acc[mt][nt][4 * i4] * gt, acc[mt][nt][4 * i4 + 1] * gt); w.y = pk2(acc[mt][nt][4 * i4 + 2] * gt, acc[mt][nt][4 * i4 + 3] * gt);
                    *(u32x2*)(dst + nt * 32 + 8 * i4) = w;
                }
        }
    }
};

DEVI void transpose_unit(char* lds, const float* __restrict__ W, int K, int N, bf16_t* __restrict__ out, int k0, int n0, int mode  ) {
    float* tile = (float*)lds;
    const int tid = tid_l();
    f32x4 v[8];
#pragma unroll
    for (int i = 0; i < 8; ++i) { const int c = tid + 512 * i, k = c >> 6, n4 = (c & 63) * 4; v[i] = *(const f32x4*)(W + (size_t)(k0 + k) * N + n0 + n4); }
#pragma unroll
    for (int i = 0; i < 8; ++i) { const int c = tid + 512 * i, k = c >> 6, n4 = (c & 63) * 4; float* t = tile + k * 257 + n4; t[0] = v[i].x; t[1] = v[i].y; t[2] = v[i].z; t[3] = v[i].w; }
    __syncthreads();
#pragma unroll
    for (int i = 0; i < 4; ++i) {
        const int c = tid + 512 * i, n = c >> 3, k8 = (c & 7) * 8;
        float f[8];
#pragma unroll
        for (int j = 0; j < 8; ++j) f[j] = tile[(k8 + j) * 257 + n];
        u32x4 w; w.x = pk2(f[0], f[1]); w.y = pk2(f[2], f[3]); w.z = pk2(f[4], f[5]); w.w = pk2(f[6], f[7]);
        const int ng = n0 + n; const int orow = mode == 0 ? ng : ((ng >> 7) * 256 + (mode - 1) * 128 + (ng & 127));
        *(u32x4*)(out + (size_t)orow * K + k0 + k8) = w;
    }
    __syncthreads();
}

DEVI void adaln_unit(char* lds, const Params& P, int l, int n0) {
    float* sc = (float*)lds;
    float* red = sc + 9 * 1024;
    const int tid = tid_l(), lane = tid & 63, wid = tid >> 6;
    for (int i = tid; i < 9 * 1024; i += 512) { const float c = i < 8192 ? P.in[1][i] : P.in[3][i - 8192]; sc[i] = c * __builtin_amdgcn_rcpf(1.f + __expf(-c)); }
    __syncthreads();
    const float* W = P.in[4] + (size_t)l * 1024 * 6144 + n0 + lane;
    float a[9];
#pragma unroll
    for (int j = 0; j < 9; ++j) a[j] = 0.f;
    for (int kk = 0; kk < 128; kk += 16) {
        float w[16];
#pragma unroll
        for (int u = 0; u < 16; ++u) w[u] = W[(size_t)(wid * 128 + kk + u) * 6144];
#pragma unroll
        for (int u4 = 0; u4 < 4; ++u4)
#pragma unroll
            for (int j = 0; j < 9; ++j) { const f32x4 s4 = *(const f32x4*)(sc + j * 1024 + wid * 128 + kk + 4 * u4); a[j] += s4.x * w[4 * u4] + s4.y * w[4 * u4 + 1] + s4.z * w[4 * u4 + 2] + s4.w * w[4 * u4 + 3]; }
    }
#pragma unroll
    for (int j = 0; j < 9; ++j) red[(wid * 9 + j) * 64 + lane] = a[j];
    __syncthreads();
    for (int i = tid; i < 9 * 64; i += 512) {
        const int j = i >> 6, n = i & 63; float s = 0.f;
#pragma unroll
        for (int w = 0; w < 8; ++w) s += red[(w * 9 + j) * 64 + n];
        ((float*)(ptr_l(P.ws) + WS_MOD))[((size_t)l * 9 + j) * 6144 + n0 + n] = s + P.in[5][(size_t)l * 6144 + n0 + n];
    }
    __syncthreads();
}

DEVI void ssm_tab_unit(char* lds, const Params& P, int l, int d, int g) {
    float* pw = (float*)lds;
    float* bb = pw + 64 * 17 * 2;
    float* cc = bb + 64 * 16 * 2;
    const int tid = tid_l();
    const size_t ldg = ((size_t)l * 2 + d) * 32 + g;
    const float dt = expf(P.in[16][ldg]);
    float* PW = (float*)(ptr_l(P.ws) + WS_PW) + ldg * 64 * 17 * 2;
    float* BB = (float*)(ptr_l(P.ws) + WS_BBAR) + ldg * 64 * 16 * 2;
    for (int i = tid; i < 64 * 17; i += 512) {
        const int p = i / 17, n = i - p * 17;
        const float lr = P.in[14][ldg * 64 + p], li = P.in[15][ldg * 64 + p];
        const float mag = expf(lr * dt * n); float s, c; sincosf(li * dt * n, &s, &c);
        pw[i * 2] = mag * c; pw[i * 2 + 1] = mag * s; PW[i * 2] = mag * c; PW[i * 2 + 1] = mag * s;
    }
    for (int i = tid; i < 64 * 16; i += 512) {
        const int p = i >> 4, h = i & 15;
        const float lr = P.in[14][ldg * 64 + p], li = P.in[15][ldg * 64 + p];
        const float mag = expf(lr * dt); float s, c; sincosf(li * dt, &s, &c);
        const float nr = mag * c - 1.f, ni = mag * s;
        const float den = lr * lr + li * li;
        const float qr = (nr * lr + ni * li) / den, qi = (ni * lr - nr * li) / den;
        const float br = P.in[17][(ldg * 64 + p) * 16 + h], bi = P.in[18][(ldg * 64 + p) * 16 + h];
        const float xr = qr * br - qi * bi, xi = qr * bi + qi * br;
        bb[i * 2] = xr; bb[i * 2 + 1] = xi; BB[i * 2] = xr; BB[i * 2 + 1] = xi;
    }
    for (int i = tid; i < 16 * 64; i += 512) { const int h = i >> 6, p = i & 63; cc[(h * 65 + p) * 2] = P.in[19][ldg * 1024 + i]; cc[(h * 65 + p) * 2 + 1] = P.in[20][ldg * 1024 + i]; }
    __syncthreads();
    float* KT = (float*)(ptr_l(P.ws) + WS_KTAB) + ldg * 4096;
    {
        const int dl = tid >> 5, h = (tid >> 1) & 15, hf = tid & 1;
        float sacc[8];
#pragma unroll
        for (int q = 0; q < 8; ++q) sacc[q] = 0.f;
        for (int p = 0; p < 64; ++p) {
            const f32x2 c = *(const f32x2*)(cc + (h * 65 + p) * 2), w = *(const f32x2*)(pw + (p * 17 + dl) * 2);
            const float tr = c.x * w.x - c.y * w.y, ti = c.x * w.y + c.y * w.x;
            const f32x4* bp = (const f32x4*)(bb + (p * 16 + hf * 8) * 2);
            const f32x4 b0 = bp[0], b1 = bp[1], b2 = bp[2], b3 = bp[3];
            sacc[0] += tr * b0.x - ti * b0.y; sacc[1] += tr * b0.z - ti * b0.w; sacc[2] += tr * b1.x - ti * b1.y; sacc[3] += tr * b1.z - ti * b1.w;
            sacc[4] += tr * b2.x - ti * b2.y; sacc[5] += tr * b2.z - ti * b2.w; sacc[6] += tr * b3.x - ti * b3.y; sacc[7] += tr * b3.z - ti * b3.w;
        }
        float* dst = KT + dl * 256 + h * 16 + hf * 8;
        *(f32x4*)dst = (f32x4){sacc[0], sacc[1], sacc[2], sacc[3]}; *(f32x4*)(dst + 4) = (f32x4){sacc[4], sacc[5], sacc[6], sacc[7]};
    }
    __syncthreads();
}

template <bool FIRST>
DEVI void rowpass1(const Params& P, int l) {
    const int tid = tid_l(), lane = tid & 63, wid = tid >> 6;
    bf16_t* X = (bf16_t*)(ptr_l(P.ws) + WS_X); bf16_t* HX = (bf16_t*)(ptr_l(P.ws) + WS_HX);
    const bf16_t* OG = (const bf16_t*)(ptr_l(P.ws) + WS_OG); const int* SLOT = (const int*)(ptr_l(P.ws) + WS_SLOT);
    const float* MOD = (const float*)(ptr_l(P.ws) + WS_MOD);
    const int stride = gridDim.x * 8;
    int r = blockIdx.x * 8 + wid;
    f32x4 xf[4]; u32x2 xb[4]; int svn = -1;
    auto issue = [&](int rr) {
        if constexpr (FIRST) {
            const int b = rr / LP, p = rr - b * LP;
            const float* src = p < CTXL ? P.in[2] + ((size_t)b * CTXL + p) * 1024 : P.in[0] + ((size_t)b * SEQ + (p - CTXL)) * 1024;
#pragma unroll
            for (int i = 0; i < 4; ++i) xf[i] = *(const f32x4*)(src + lane * 4 + 256 * i);
        } else {
#pragma unroll
            for (int i = 0; i < 4; ++i) xb[i] = *(const u32x2*)(X + (size_t)rr * 1024 + lane * 4 + 256 * i);
            svn = SLOT[(size_t)rr * 16 + (lane & 15)];
        }
    };
    if (r < R) issue(r);
    for (; r < R; r += stride) {
        const int b = r / LP, p = r - b * LP, j = p < CTXL ? 8 : b;
        f32x4 x[4]; const int sv = svn;
#pragma unroll
        for (int i = 0; i < 4; ++i) { if constexpr (FIRST) x[i] = xf[i]; else x[i] = hf4(xb[i]); }
        if (r + stride < R) issue(r + stride);
        if (l == DEPTH && p < CTXL) continue;
        if constexpr (!FIRST) {
            const float* g2 = MOD + ((size_t)(l - 1) * 9 + j) * 6144 + 5 * 1024;
            f32x4 m[4];
#pragma unroll
            for (int i = 0; i < 4; ++i) m[i] = (f32x4){0.f, 0.f, 0.f, 0.f};
            unsigned mask = (unsigned)__ballot(sv >= 0 && lane < 16) & 0xffffu;
            while (mask) {
                const int e0 = __builtin_ctz(mask); mask &= mask - 1;
                const int s0 = __builtin_amdgcn_readlane(sv, e0);
                const bool two = mask != 0u;
                const int e1 = two ? __builtin_ctz(mask) : e0; if (two) mask &= mask - 1;
                const int s1 = __builtin_amdgcn_readlane(sv, e1);
                const bf16_t* o0 = OG + ((size_t)e0 * ROWS_E + s0) * 1024 + lane * 4; const bf16_t* o1 = OG + ((size_t)e1 * ROWS_E + s1) * 1024 + lane * 4;
                u32x2 w0[4], w1[4];
#pragma unroll
                for (int i = 0; i < 4; ++i) { w0[i] = *(const u32x2*)(o0 + 256 * i); w1[i] = *(const u32x2*)(o1 + 256 * i); }
                const float f1 = two ? 1.f : 0.f;
#pragma unroll
                for (int i = 0; i < 4; ++i) m[i] += bf4(w0[i]) + f1 * bf4(w1[i]);
            }
#pragma unroll
            for (int i = 0; i < 4; ++i) { const f32x4 g = *(const f32x4*)(g2 + lane * 4 + 256 * i); x[i] += g * m[i]; }
        }
        float ss = 0.f;
#pragma unroll
        for (int i = 0; i < 4; ++i) ss += x[i].x * x[i].x + x[i].y * x[i].y + x[i].z * x[i].z + x[i].w * x[i].w;
        ss = wave_sum(ss);
        const float rstd = rsqrtf(ss * (1.f / 1024.f) + EPS);
        if (l < DEPTH) {
            const float* ng = P.in[6] + (size_t)l * 1024; const float* sh = MOD + ((size_t)l * 9 + j) * 6144; const float* scl = sh + 1024;
#pragma unroll
            for (int i = 0; i < 4; ++i) {
                const int c = lane * 4 + 256 * i;
                u32x2 xw; xw.x = hpk2(x[i].x, x[i].y); xw.y = hpk2(x[i].z, x[i].w);
                *(u32x2*)(X + (size_t)r * 1024 + c) = xw;
                const f32x4 g = *(const f32x4*)(ng + c), s1 = *(const f32x4*)(scl + c), s0 = *(const f32x4*)(sh + c);
                const f32x4 h = (x[i] * rstd * g) * (1.f + s1) + s0;
                u32x2 w; w.x = pk2(h.x, h.y); w.y = pk2(h.z, h.w);
                *(u32x2*)(HX + (size_t)r * 1024 + c) = w;
            }
        } else {
            float* o = P.out + ((size_t)b * SEQ + (p - CTXL)) * 1024;
#pragma unroll
            for (int i = 0; i < 4; ++i) { const int c = lane * 4 + 256 * i; const f32x4 g = *(const f32x4*)(P.in[29] + c); *(f32x4*)(o + c) = x[i] * rstd * g; }
        }
    }
}

DEVI float router_fold_softmax(const float (&pa)[16], int lane) {
    float q8[8], q4[4], q2[2];
#pragma unroll
    for (int i = 0; i < 8; ++i) { float r0, r1; swap32(pa[i], pa[i + 8], r0, r1); q8[i] = r0 + r1; }
#pragma unroll
    for (int i = 0; i < 4; ++i) { float r0, r1; swap16(q8[i], q8[i + 4], r0, r1); q4[i] = r0 + r1; }
    { const bool hb = (lane & 8) != 0;
#pragma unroll
      for (int i = 0; i < 2; ++i) { const float snd = hb ? q4[i] : q4[i + 2], kp = hb ? q4[i + 2] : q4[i]; q2[i] = kp + dppmov<0x128>(snd); } }
    float lg;
    { const bool hb = (lane & 4) != 0; const float snd = hb ? q2[0] : q2[1], kp = hb ? q2[1] : q2[0];
      const float up = dppmov<0x104>(snd), dn = dppmov<0x114>(snd);
      lg = kp + (hb ? dn : up); }
    lg += dppmov<0x4E>(lg); lg += dppmov<0xB1>(lg);
    float mx = fmaxf(lg, dppmov<0x124>(lg)); mx = fmaxf(mx, dppmov<0x128>(mx));
    { float r0, r1; swap16(mx, mx, r0, r1); mx = fmaxf(r0, r1); swap32(mx, mx, r0, r1); mx = fmaxf(r0, r1); }
    const float ex = expf(lg - mx);
    float sum = ex + dppmov<0x124>(ex); sum += dppmov<0x128>(sum);
    { float r0, r1; swap16(sum, sum, r0, r1); sum = r0 + r1; swap32(sum, sum, r0, r1); sum = r0 + r1; }
    return ex / sum;
}
DEVI void rowpass2(char* lds, const Params& P, int l) {
    const int tid = tid_l(), lane = tid & 63, wid = tid >> 6;
    float* wrT = (float*)lds;
    const float* wr = P.in[25] + (size_t)l * 1024 * 16;
    for (int i = tid; i < 16384; i += 512) { const int k = i >> 4, e = i & 15; wrT[e * 1024 + k] = wr[i]; }
    __syncthreads();
    const bf16_t* X = (const bf16_t*)(ptr_l(P.ws) + WS_X); bf16_t* HX = (bf16_t*)(ptr_l(P.ws) + WS_HX);
    const float* MOD = (const float*)(ptr_l(P.ws) + WS_MOD); float* AFFT = (float*)(ptr_l(P.ws) + WS_AFFT);
    const float* ng = P.in[7] + (size_t)l * 1024;
    const int stride = gridDim.x * 8;
    int r = blockIdx.x * 8 + wid;
    u32x2 xn[2][4];
#pragma unroll
    for (int q = 0; q < 2; ++q) if (r + q * stride < R) {
#pragma unroll
        for (int i = 0; i < 4; ++i) xn[q][i] = *(const u32x2*)(X + (size_t)(r + q * stride) * 1024 + lane * 4 + 256 * i);
    }
    for (; r < R; r += 2 * stride) {
        const bool two = r + stride < R;
        f32x4 h[2][4]; int bb[2], pp[2];
#pragma unroll
        for (int q = 0; q < 2; ++q) {
            const int rq = (q == 0 || two) ? r + q * stride : r;
            const int b = rq / LP, p = rq - b * LP, j = p < CTXL ? 8 : b; bb[q] = b; pp[q] = p;
            float ss = 0.f;
#pragma unroll
            for (int i = 0; i < 4; ++i) { h[q][i] = hf4(xn[q][i]); ss += h[q][i].x * h[q][i].x + h[q][i].y * h[q][i].y + h[q][i].z * h[q][i].z + h[q][i].w * h[q][i].w; }
            ss = wave_sum(ss);
            const float rstd = rsqrtf(ss * (1.f / 1024.f) + EPS);
            const float* sh = MOD + ((size_t)l * 9 + j) * 6144 + 3 * 1024; const float* scl = sh + 1024;
#pragma unroll
            for (int i = 0; i < 4; ++i) {
                const int c = lane * 4 + 256 * i;
                const f32x4 g = *(const f32x4*)(ng + c), s1 = *(const f32x4*)(scl + c), s0 = *(const f32x4*)(sh + c);
                h[q][i] = (h[q][i] * rstd * g) * (1.f + s1) + s0;
                if (q == 0 || two) { u32x2 w; w.x = pk2(h[q][i].x, h[q][i].y); w.y = pk2(h[q][i].z, h[q][i].w); *(u32x2*)(HX + (size_t)rq * 1024 + c) = w; }
            }
        }
#pragma unroll
        for (int q = 0; q < 2; ++q) if (r + (2 + q) * stride < R) {
#pragma unroll
            for (int i = 0; i < 4; ++i) xn[q][i] = *(const u32x2*)(X + (size_t)(r + (2 + q) * stride) * 1024 + lane * 4 + 256 * i);
        }
        float pa[2][16];
#pragma unroll
        for (int eg = 0; eg < 4; ++eg) {
#pragma unroll
            for (int e = 4 * eg; e < 4 * eg + 4; ++e) {
                f32x2 s0 = {0.f, 0.f}, s1 = {0.f, 0.f};
#pragma unroll
                for (int i = 0; i < 4; ++i) { const f32x4 w = *(const f32x4*)(wrT + e * 1024 + lane * 4 + 256 * i);
                    const f32x2 wl = __builtin_shufflevector(w, w, 0, 1), wh = __builtin_shufflevector(w, w, 2, 3);
                    s0 = __builtin_elementwise_fma(__builtin_shufflevector(h[0][i], h[0][i], 0, 1), wl, s0); s0 = __builtin_elementwise_fma(__builtin_shufflevector(h[0][i], h[0][i], 2, 3), wh, s0);
                    s1 = __builtin_elementwise_fma(__builtin_shufflevector(h[1][i], h[1][i], 0, 1), wl, s1); s1 = __builtin_elementwise_fma(__builtin_shufflevector(h[1][i], h[1][i], 2, 3), wh, s1); }
                pa[0][e] = s0.x + s0.y; pa[1][e] = s1.x + s1.y;
            }
            asm volatile("" ::: "memory");
        }
        const float a0 = router_fold_softmax(pa[0], lane), a1 = router_fold_softmax(pa[1], lane);
        if ((lane & 3) == 0) {
            AFFT[((size_t)bb[0] * 16 + (lane >> 2)) * LP + pp[0]] = a0;
            if (two) AFFT[((size_t)bb[1] * 16 + (lane >> 2)) * LP + pp[1]] = a1;
        }
    }
    __syncthreads();
}

DEVI int block_sum_i(int v, volatile int* red, int par, int wid, int lane) {
    if (lane == 0) red[par * 8 + wid] = v;
    __syncthreads();
    int s = 0;
#pragma unroll
    for (int w = 0; w < 8; ++w) s += red[par * 8 + w];
    return s;
}
DEVI int wave_incl_scan_i(int v, int lane) {
#pragma unroll
    for (int o = 1; o < 64; o <<= 1) { const int t = __shfl_up(v, o); if (lane >= o) v += t; }
    return v;
}
DEVI void select_unit(char* lds, const Params& P, int b, int e, bool lat) {
    volatile int* red = (volatile int*)lds;
    volatile int* wtot = (volatile int*)(lds + 64);
    const int tid = tid_l(), lane = tid & 63, wid = tid >> 6;
    const int n = lat ? SEQ : CTXL, K = lat ? CAPL : CAPC, p0 = lat ? CTXL : 0;
    const bool act = 8 * tid < n;
    const float* src = (const float*)(ptr_l(P.ws) + WS_AFFT) + ((size_t)b * 16 + e) * LP + p0 + 8 * tid;
    unsigned bits[8];
    if (act) { const u32x4 v0 = *(const u32x4*)src, v1 = *(const u32x4*)(src + 4); bits[0] = v0.x; bits[1] = v0.y; bits[2] = v0.z; bits[3] = v0.w; bits[4] = v1.x; bits[5] = v1.y; bits[6] = v1.z; bits[7] = v1.w; }
    else {
#pragma unroll
        for (int j = 0; j < 8; ++j) bits[j] = 0u;
    }
    unsigned prefix = 0u; int par = 0;
    for (int bit = 30; bit >= 0; --bit) {
        const unsigned cand = prefix | (1u << bit);
        int c = 0;
#pragma unroll
        for (int j = 0; j < 8; ++j) c += (int)__popcll(__ballot(bits[j] >= cand));
        const int tot = block_sum_i(c, red, par, wid, lane); par ^= 1;
        if (tot >= K) prefix = cand;
    }
    int cg = 0, ceq = 0;
#pragma unroll
    for (int j = 0; j < 8; ++j) { cg += (int)__popcll(__ballot(bits[j] > prefix)); ceq += (bits[j] == prefix) ? 1 : 0; }
    const int need = K - block_sum_i(cg, red, par, wid, lane); par ^= 1;
    int inc = wave_incl_scan_i(ceq, lane);
    if (lane == 63) wtot[par * 8 + wid] = inc;
    __syncthreads();
    int eqb = inc - ceq;
    for (int w = 0; w < wid; ++w) eqb += wtot[par * 8 + w];
    par ^= 1;
    bool sel[8]; int ns = 0;
#pragma unroll
    for (int j = 0; j < 8; ++j) { const bool eq = bits[j] == prefix; sel[j] = (bits[j] > prefix) || (eq && eqb < need); eqb += eq ? 1 : 0; ns += sel[j] ? 1 : 0; }
    inc = wave_incl_scan_i(ns, lane);
    if (lane == 63) wtot[par * 8 + wid] = inc;
    __syncthreads();
    int sb = inc - ns;
    for (int w = 0; w < wid; ++w) sb += wtot[par * 8 + w];
    if (act) {
        int* SLOT = (int*)(ptr_l(P.ws) + WS_SLOT); float* GATE = (float*)(ptr_l(P.ws) + WS_GATE); int* IDX = (int*)(ptr_l(P.ws) + WS_IDX);
#pragma unroll
        for (int j = 0; j < 8; ++j) {
            const int tok = b * LP + p0 + 8 * tid + j;
            if (sel[j]) {
                const int row = (lat ? b * CAPL : NB * CAPL + b * CAPC) + sb; ++sb;
                SLOT[(size_t)tok * 16 + e] = row; GATE[(size_t)e * ROWS_E + row] = __builtin_bit_cast(float, bits[j]); IDX[(size_t)e * ROWS_E + row] = tok;
            } else SLOT[(size_t)tok * 16 + e] = -1;
        }
    }
    __syncthreads();
}
DEVI void gather_rows(const Params& P, bool last) {
    const int tid = tid_l(), lane = tid & 63, wid = tid >> 6;
    const bf16_t* HX = (const bf16_t*)(ptr_l(P.ws) + WS_HX); bf16_t* XG = (bf16_t*)(ptr_l(P.ws) + WS_XG); const int* IDX = (const int*)(ptr_l(P.ws) + WS_IDX);
    const int stride = gridDim.x * 8;
    for (int r0 = blockIdx.x * 8 + wid; r0 < 16 * ROWS_E; r0 += 4 * stride) {
        u32x4 v[4][2];
#pragma unroll
        for (int q = 0; q < 4; ++q) { const int r = r0 + q * stride; if (r < 16 * ROWS_E && !(last && (r % ROWS_E) >= NB * CAPL)) { const u32x4* s = (const u32x4*)(HX + (size_t)IDX[r] * 1024); v[q][0] = s[lane]; v[q][1] = s[lane + 64]; } }
#pragma unroll
        for (int q = 0; q < 4; ++q) { const int r = r0 + q * stride; if (r < 16 * ROWS_E && !(last && (r % ROWS_E) >= NB * CAPL)) { u32x4* d = (u32x4*)(XG + (size_t)r * 1024); d[lane] = v[q][0]; d[lane + 64] = v[q][1]; } }
    }
}

DEVI int scan_ci(int d, int k) { return d == 0 ? k : (k < 16 ? 15 - k : 287 - k); }
DEVI void scan_block(char* lds, const Params& P, int l, int unit0) {
    const int tid = tid_l(), lane = tid & 63, wid = tid >> 6, seg = wid & 3, unit = unit0 + (wid >> 2);
    const int d = unit & 1, g = (unit >> 1) & 31, b = unit >> 6;
    const size_t ldg = ((size_t)l * 2 + d) * 32 + g;
    const float dt = expf(P.in[16][ldg]);
    const float lr = P.in[14][ldg * 64 + lane], li = P.in[15][ldg * 64 + lane];
    const float mag = expf(lr * dt * 16.f); float sn, cs; sincosf(li * dt * 16.f, &sn, &cs);
    const float ar = mag * cs, ai = mag * sn;
    const unsigned short* E = (const unsigned short*)(ptr_l(P.ws) + WS_EB) + (size_t)g * NCHP * 256 + d * 128 + lane * 2;
    bf16_t* S = (bf16_t*)(ptr_l(P.ws) + WS_US) + (size_t)g * NCHP * 512 + 256 + d * 128 + lane * 2;
    f32x2* ends = (f32x2*)lds + (size_t)(wid >> 2) * 4 * 64;
    const int k0 = seg * 68;
    float sr = 0.f, si = 0.f;
    for (int kk = 0; kk < 68; kk += 17) {
        unsigned ev[17];
#pragma unroll
        for (int u = 0; u < 17; ++u) ev[u] = *(const unsigned*)(E + (size_t)chunk_row(b, scan_ci(d, k0 + kk + u)) * 256);
#pragma unroll
        for (int u = 0; u < 17; ++u) { const float nr = ar * sr - ai * si + hlo(ev[u]), ni = ar * si + ai * sr + hhi(ev[u]); sr = nr; si = ni; }
    }
    ends[seg * 64 + lane] = (f32x2){sr, si};
    float pr = ar, pi = ai, p4r = 0.f, p4i = 0.f;
#pragma unroll
    for (int q = 0; q < 6; ++q) { const float nr = pr * pr - pi * pi, ni = 2.f * pr * pi; pr = nr; pi = ni; if (q == 1) { p4r = pr; p4i = pi; } }
    const float br = pr * p4r - pi * p4i, bi = pr * p4i + pi * p4r;
    __syncthreads();
    sr = 0.f; si = 0.f;
    for (int j = 0; j < seg; ++j) { const f32x2 e = ends[j * 64 + lane]; const float nr = br * sr - bi * si + e.x, ni = br * si + bi * sr + e.y; sr = nr; si = ni; }
    for (int kk = 0; kk < 68; kk += 17) {
        unsigned ev[17];
#pragma unroll
        for (int u = 0; u < 17; ++u) ev[u] = *(const unsigned*)(E + (size_t)chunk_row(b, scan_ci(d, k0 + kk + u)) * 256);
#pragma unroll
        for (int u = 0; u < 17; ++u) {
            *(unsigned*)(S + (size_t)chunk_row(b, scan_ci(d, k0 + kk + u)) * 512) = pk2(sr, si);
            const float nr = ar * sr - ai * si + hlo(ev[u]), ni = ar * si + ai * sr + hhi(ev[u]); sr = nr; si = ni;
        }
    }
    __syncthreads();
}

DEVI float max3f(float a, float b, float c) { return fmaxf(fmaxf(a, b), c); }
DEVI float xhalf_max(float x) { const unsigned u = __builtin_bit_cast(unsigned, x); const auto r = __builtin_amdgcn_permlane32_swap(u, u, false, false); return fmaxf(__builtin_bit_cast(float, (unsigned)r[0]), __builtin_bit_cast(float, (unsigned)r[1])); }
DEVI float xhalf_sum(float x) { const unsigned u = __builtin_bit_cast(unsigned, x); const auto r = __builtin_amdgcn_permlane32_swap(u, u, false, false); return __builtin_bit_cast(float, (unsigned)r[0]) + __builtin_bit_cast(float, (unsigned)r[1]); }
DEVI void attn_unit(char* lds, const Params& P, int l, int b, int head, int q0  , int nkeys, float lam, float lam_init) {
    const int tid = tid_l(), lane = tid & 63, wid = tid >> 6, qg = wid >> 1, which = wid & 1, r32 = lane & 31, hi = lane >> 5;
    const bf16_t* QK = (const bf16_t*)(ptr_l(P.ws) + WS_QK);
    const bf16_t* Qs = QK + ((size_t)((which * NB + b) * NH + head) * LP) * 64;
    const bf16_t* K1 = QK + ((size_t)((2 * NB + b) * NH + head) * LP) * 64;
    const bf16_t* K2 = QK + ((size_t)((3 * NB + b) * NH + head) * LP) * 64;
    const bf16_t* Vt = (const bf16_t*)(ptr_l(P.ws) + WS_VT) + (size_t)(b * NH + head) * 128 * LP;
    bf16x8 qf[4];
#pragma unroll
    for (int ks = 0; ks < 4; ++ks) qf[ks] = *(const bf16x8*)(Qs + (size_t)(q0 + qg * 32 + r32) * 64 + ks * 16 + hi * 8);
    f32x16 o[4];
#pragma unroll
    for (int t = 0; t < 4; ++t)
#pragma unroll
        for (int i = 0; i < 16; ++i) o[t][i] = 0.f;
    float m = 0.f, lsum = 0.f;
    const int nt = nkeys >> 6;
    const int drow = wid * 8 + (lane >> 3), dkc = (lane & 7) ^ ((drow >> 1) & 7);
    const unsigned koff = (unsigned)(drow * 64 + dkc * 8), voff = (unsigned)(drow * LP + dkc * 8);
    LAS unsigned char* dl = (LAS unsigned char*)lds + wid * 1024;
#define GLDS(g, off) __builtin_amdgcn_global_load_lds((const unsigned*)(g), (LAS unsigned*)(dl + (off)), 16, 0, 0)
#define K_DMA(kt, s) do { GLDS((K1 + (size_t)(kt) * 4096) + koff, (s) * 16384); GLDS((K2 + (size_t)(kt) * 4096) + koff, (s) * 16384 + 8192); } while (0)
#define V_DMA(kt, s) do { GLDS((Vt + (kt) * 64) + voff, 32768 + (s) * 16384); GLDS((Vt + (kt) * 64 + 64 * LP) + voff, 32768 + (s) * 16384 + 8192); } while (0)
#define QKT(dst, s, init) do { const char* _k = lds + (s) * 16384 + which * 8192; \
        _Pragma("unroll") for (int t2 = 0; t2 < 2; ++t2) _Pragma("unroll") for (int i = 0; i < 16; ++i) dst[t2][i] = (init); \
        _Pragma("unroll") for (int ks = 0; ks < 4; ++ks) _Pragma("unroll") for (int t2 = 0; t2 < 2; ++t2) { \
            const bf16x8 kf = *(const bf16x8*)(_k + swz(t2 * 32 + r32, ks * 2 + hi)); dst[t2] = MFMA32(kf, qf[ks], dst[t2]); } } while (0)
    K_DMA(0, 0); V_DMA(0, 0); K_DMA(1, 1);
    __syncthreads();
    f32x16 sc[2], sn[2];
    QKT(sc, 0, 0.f);
    __syncthreads();
    {
        float tm = max3f(sc[0][0], sc[0][1], sc[0][2]);
#pragma unroll
        for (int i = 3; i < 15; i += 2) tm = max3f(tm, sc[0][i], sc[0][i + 1]);
        tm = fmaxf(tm, sc[0][15]);
#pragma unroll
        for (int i = 0; i < 16; i += 2) tm = max3f(tm, sc[1][i], sc[1][i + 1]);
        tm = xhalf_max(tm);
        m = tm;
#pragma unroll
        for (int t2 = 0; t2 < 2; ++t2)
#pragma unroll
            for (int i = 0; i < 16; ++i) sc[t2][i] -= m;
    }
#define SB() __builtin_amdgcn_sched_barrier(0)
#define SGB(mask, n) __builtin_amdgcn_sched_group_barrier(mask, n, 0)
    int fo[4];
#pragma unroll
    for (int j = 0; j < 4; ++j) fo[j] = swz(r32, 2 * j + hi);
    const char* kbase = lds + which * 8192;
    const char* vbase = lds + 32768;
#define ATT_STEP(KT, PAR, SC, SN) do { \
        const bool has1 = (KT) + 1 < nt, has2 = (KT) + 2 < nt; \
        if (has2) K_DMA((KT) + 2, PAR); \
        if (has1) V_DMA((KT) + 1, 1 - (PAR)); \
        const char* kst = kbase + (1 - (PAR)) * 16384; \
        const char* vs = vbase + (PAR) * 16384; \
        bf16x8 kf[8]; \
        _Pragma("unroll") for (int ks = 0; ks < 4; ++ks) _Pragma("unroll") for (int t2 = 0; t2 < 2; ++t2) kf[ks * 2 + t2] = *(const bf16x8*)(kst + fo[ks] + t2 * 4096); \
        SB(); \
        _Pragma("unroll") for (int t2 = 0; t2 < 2; ++t2) _Pragma("unroll") for (int i = 0; i < 16; ++i) SN[t2][i] = -m; \
        _Pragma("unroll") for (int ks = 0; ks < 4; ++ks) _Pragma("unroll") for (int t2 = 0; t2 < 2; ++t2) SN[t2] = MFMA32(kf[ks * 2 + t2], qf[ks], SN[t2]); \
        bf16x8 va[4], vb[4]; \
        _Pragma("unroll") for (int t = 0; t < 4; ++t) va[t] = *(const bf16x8*)(vs + fo[0] + t * 4096); \
        SGB(0x002, 16); SGB(0x008, 8); SGB(0x100, 4); SB(); \
        if (__any(pprev > 4096.f)) {        \
            const float pr = xhalf_sum(pprev); \
            const float dl = pr > 4096.f ? (float)((int)((__builtin_bit_cast(unsigned, pr) >> 23) & 255u) - 127) : 0.f, al = fast_exp2(-dl); \
            m += dl; lsum *= al; \
            _Pragma("unroll") for (int t = 0; t < 4; ++t) _Pragma("unroll") for (int i = 0; i < 16; ++i) o[t][i] *= al; \
            _Pragma("unroll") for (int t2 = 0; t2 < 2; ++t2) _Pragma("unroll") for (int i = 0; i < 16; ++i) { SC[t2][i] -= dl; SN[t2][i] -= dl; } \
        } \
        float ps = 0.f; \
        _Pragma("unroll") for (int t2 = 0; t2 < 2; ++t2) _Pragma("unroll") for (int i = 0; i < 16; ++i) { SC[t2][i] = fast_exp2(SC[t2][i]); ps += SC[t2][i]; } \
        lsum += ps; pprev = ps; \
        bf16x8 pf[4]; \
        _Pragma("unroll") for (int t2 = 0; t2 < 2; ++t2) _Pragma("unroll") for (int sh = 0; sh < 2; ++sh) { \
            u32x4 pw; pw.x = pk2(SC[t2][8 * sh], SC[t2][8 * sh + 1]); pw.y = pk2(SC[t2][8 * sh + 2], SC[t2][8 * sh + 3]); \
            pw.z = pk2(SC[t2][8 * sh + 4], SC[t2][8 * sh + 5]); pw.w = pk2(SC[t2][8 * sh + 6], SC[t2][8 * sh + 7]); \
            pf[t2 * 2 + sh] = __builtin_bit_cast(bf16x8, pw); } \
        SB(); \
        _Pragma("unroll") for (int t = 0; t < 4; ++t) vb[t] = *(const bf16x8*)(vs + fo[1] + t * 4096); \
        _Pragma("unroll") for (int t = 0; t < 4; ++t) o[t] = MFMA32(va[t], pf[0], o[t]); \
        SGB(0x100, 4); SGB(0x008, 4); SB(); \
        _Pragma("unroll") for (int t = 0; t < 4; ++t) va[t] = *(const bf16x8*)(vs + fo[2] + t * 4096); \
        _Pragma("unroll") for (int t = 0; t < 4; ++t) o[t] = MFMA32(vb[t], pf[1], o[t]); \
        SGB(0x100, 4); SGB(0x008, 4); SB(); \
        _Pragma("unroll") for (int t = 0; t < 4; ++t) vb[t] = *(const bf16x8*)(vs + fo[3] + t * 4096); \
        _Pragma("unroll") for (int t = 0; t < 4; ++t) o[t] = MFMA32(va[t], pf[2], o[t]); \
        SGB(0x100, 4); SGB(0x008, 4); SB(); \
        _Pragma("unroll") for (int t = 0; t < 4; ++t) o[t] = MFMA32(vb[t], pf[3], o[t]); \
        SB(); \
        __syncthreads(); \
    } while (0)
    float pprev = 0.f;
    for (int kt = 0; kt < nt; kt += 2) {
        ATT_STEP(kt, 0, sc, sn);
        ATT_STEP(kt + 1, 1, sn, sc);
    }
#undef ATT_STEP
#undef SB
#undef SGB
#undef GLDS
#undef K_DMA
#undef V_DMA
#undef QKT
    lsum = xhalf_sum(lsum);
    const float inv = 1.f / lsum;
    float* xb = (float*)lds + (size_t)qg * 4096;
    if (which == 1) {
#pragma unroll
        for (int t = 0; t < 4; ++t)
#pragma unroll
            for (int i = 0; i < 16; ++i) xb[(t * 16 + i) * 64 + lane] = o[t][i] * inv;
    }
    __syncthreads();
    if (which == 0) {
        float ss = 0.f;
#pragma unroll
        for (int t = 0; t < 4; ++t)
#pragma unroll
            for (int i = 0; i < 16; ++i) { const float v = o[t][i] * inv - lam * xb[(t * 16 + i) * 64 + lane]; o[t][i] = v; ss += v * v; }
        ss = xhalf_sum(ss);
        const float rs = rsqrtf(ss * (1.f / 128.f) + EPS) * (1.f - lam_init);
        const float* sg = P.in[13] + (size_t)l * 128;
        bf16_t* dst = (bf16_t*)(ptr_l(P.ws) + WS_MIX) + ((size_t)b * LP + q0 + qg * 32 + r32) * 1024 + head * 128 + 4 * hi;
#pragma unroll
        for (int t = 0; t < 4; ++t)
#pragma unroll
            for (int i4 = 0; i4 < 4; ++i4) {
                const f32x4 g = *(const f32x4*)(sg + t * 32 + 8 * i4 + 4 * hi);
                u32x2 w; w.x = pk2(o[t][4 * i4] * rs * g.x, o[t][4 * i4 + 1] * rs * g.y); w.y = pk2(o[t][4 * i4 + 2] * rs * g.z, o[t][4 * i4 + 3] * rs * g.w);
                *(u32x2*)(dst + t * 32 + 8 * i4) = w;
            }
    }
    __syncthreads();
}

struct ConvTile { const float* src; bf16_t* dst; int K, N, mode; };
DEVI ConvTile conv_tile(const Params& P, unsigned char* w, int l, int u) {
    if (u < 4096) { const int w3 = u >= 2048; const int v = u & 2047, le = l * 16 + (v >> 7), k = (v >> 3) & 15, n = v & 7;
        return {P.in[w3 ? 27 : 26] + (size_t)le * 1024 * 2048 + (size_t)(k * 64) * 2048 + n * 256, (bf16_t*)(w + WS_W13T) + (size_t)le * 4096 * 1024 + k * 64, 1024, 2048, (n * 256) | ((1 + w3) << 16)}; }
    const int v = u - 4096, le = l * 16 + (v >> 7), k = (v >> 2) & 31, n = v & 3;
    return {P.in[28] + (size_t)le * 2048 * 1024 + (size_t)(k * 64) * 1024 + n * 256, (bf16_t*)(w + WS_W2T) + (size_t)le * 1024 * 2048 + k * 64, 2048, 1024, n * 256};
}
#define CV_LOAD(v, t) do { const unsigned voff_ = (unsigned)((2 * (tid >> 6)) * (t).N + (tid & 63) * 4) * 4u; \
        _Pragma("unroll") for (int i = 0; i < 8; ++i) { const float* sb_ = (t).src + (size_t)((i >> 1) * 16 + (i & 1)) * (t).N; \
        asm volatile("s_nop 4\n\tglobal_load_dwordx4 %0, %1, %2\n\ts_nop 1" : "=&v"(v[i]) : "v"(voff_), "s"(sb_) : "memory"); } } while (0)
#define CV_WAIT(v, N) asm volatile("s_waitcnt vmcnt(" #N ")" : "+v"(v[0]), "+v"(v[1]), "+v"(v[2]), "+v"(v[3]), "+v"(v[4]), "+v"(v[5]), "+v"(v[6]), "+v"(v[7]) :: "memory")
#define CV_STEP(v, t, N, UNEXT) do { \
        unsigned* tile = (unsigned*)lds + par * (32 * 256); par ^= 1; \
        CV_WAIT(v, N); \
        _Pragma("unroll") for (int j = 0; j < 4; ++j) { const int kp = (tid >> 6) + 8 * j; \
            u32x4 wv; wv.x = pk2(v[2 * j].x, v[2 * j + 1].x); wv.y = pk2(v[2 * j].y, v[2 * j + 1].y); wv.z = pk2(v[2 * j].z, v[2 * j + 1].z); wv.w = pk2(v[2 * j].w, v[2 * j + 1].w); \
            *(u32x4*)(tile + kp * 256 + (((tid & 63) * 4) ^ (((kp >> 2) & 7) << 3))) = wv; } \
        const ConvTile cur = t; \
        if ((UNEXT) >= 0) { t = conv_tile(P, w, l, (UNEXT)); CV_LOAD(v, t); } \
        asm volatile("s_waitcnt lgkmcnt(0)\n\ts_barrier" ::: "memory"); \
        const int n0 = cur.mode & 0xffff, mode = cur.mode >> 16; \
        _Pragma("unroll") for (int i = 0; i < 4; ++i) { \
            const int c = tid + 512 * i, n = c >> 3, kq = c & 7; \
            u32x4 o; o.x = tile[(4 * kq) * 256 + (n ^ (kq << 3))]; o.y = tile[(4 * kq + 1) * 256 + (n ^ (kq << 3))]; o.z = tile[(4 * kq + 2) * 256 + (n ^ (kq << 3))]; o.w = tile[(4 * kq + 3) * 256 + (n ^ (kq << 3))]; \
            const int ng = n0 + n; const int orow = mode == 0 ? ng : ((ng >> 7) * 256 + (mode - 1) * 128 + (ng & 127)); \
            const unsigned so_ = (unsigned)(orow * cur.K + 8 * kq) * 2u; \
            asm volatile("s_nop 4\n\tglobal_store_dwordx4 %0, %1, %2\n\ts_nop 1" :: "v"(so_), "v"(o), "s"(cur.dst) : "memory"); \
        } } while (0)
DEVI void conv_share(char* lds, const Params& P, int l, int bid, int G) {
    unsigned char* w = ptr_l(P.ws);
    const int tid = tid_l();
    if (G != 256) {
        for (int u = bid; u < 3 * 2048; u += G) {
            if (u < 4096) { const int w3 = u >= 2048; const int v = u & 2047, le = l * 16 + (v >> 7), k = (v >> 3) & 15, n = v & 7;
                transpose_unit(lds, P.in[w3 ? 27 : 26] + (size_t)le * 1024 * 2048, 1024, 2048, (bf16_t*)(w + WS_W13T) + (size_t)le * 4096 * 1024, k * 64, n * 256, 1 + w3); }
            else { const int v = u - 4096, le = l * 16 + (v >> 7), k = (v >> 2) & 31, n = v & 3;
                transpose_unit(lds, P.in[28] + (size_t)le * 2048 * 1024, 2048, 1024, (bf16_t*)(w + WS_W2T) + (size_t)le * 1024 * 2048, k * 64, n * 256, 0); }
        }
        return;
    }
    f32x4 va[8], vb[8], vc[8];
    ConvTile ta = conv_tile(P, w, l, bid), tb = conv_tile(P, w, l, bid + 256), tc = conv_tile(P, w, l, bid + 512);
    int par = 0;
    CV_LOAD(va, ta); CV_LOAD(vb, tb); CV_LOAD(vc, tc);
    CV_STEP(va, ta, 16, bid + 3 * 256); CV_STEP(vb, tb, 20, bid + 4 * 256); CV_STEP(vc, tc, 24, bid + 5 * 256);
    for (int r = 2; r < 8; ++r) {
        const int u = bid + (3 * r) * 256;
        CV_STEP(va, ta, 28, u); CV_STEP(vb, tb, 28, u + 256); CV_STEP(vc, tc, 28, u + 512);
    }
    CV_STEP(va, ta, 28, -1); CV_STEP(vb, tb, 20, -1); CV_STEP(vc, tc, 12, -1);
    asm volatile("s_waitcnt vmcnt(0)" ::: "memory");
    __syncthreads();
}
#undef CV_LOAD
#undef CV_WAIT
#undef CV_STEP
constexpr int PH_PER_LAYER = 11, PH_LAYER0 = 2, PH_FINAL = PH_LAYER0 + DEPTH * PH_PER_LAYER, N_PHASES = PH_FINAL + 1;

__global__ void __launch_bounds__(512, 2) fwd_kernel(Params P) {
    extern __shared__ __attribute__((aligned(16))) char lds[];
    volatile LAS unsigned* xbw = (volatile LAS unsigned*)(lds + 131072);
    if (threadIdx.x == 0) { xbw[0] = 0u; xbw[1] = 0u; }
    __syncthreads();
    XcdBarrier bar = xcd_barrier_post((unsigned*)(P.ws + WS_CTL), xbw);
    const int G = gridDim.x, bid = blockIdx.x;
    const int vcu = (G % 8 == 0) ? (bid % 8) * (G / 8) + bid / 8 : bid;
    LAS unsigned char* ldsp = (LAS unsigned char*)lds;
    const int lo = P.lo, hi = P.hi;
#ifndef EN_MASK
#define EN_MASK 0xFFFFFFFFu
#endif
#define PHASE(id) if ((id) >= lo && (id) < hi)
#ifndef REP_MASK
#define REP_MASK 0x0u
#endif
#define PHASE_K(k, id) if (((EN_MASK >> (k)) & 1u) && (id) >= lo && (id) < hi) for (int rep_ = 0; rep_ <= (int)((REP_MASK >> (k)) & 1u); ++rep_)
#define SEAM(id) do { if ((id) >= lo && (id) + 1 < hi) xcd_barrier(bar); } while (0)
    unsigned char* ws0 = P.ws;
#define ws ptr_l(ws0)

    PHASE_K(0, 0) {
        constexpr int U_SSM = 256, U_ROPE = 1, U_ADA = 4 * 96;
        constexpr int T_WIN = 4 * 16 * 8, T_WOUT = 4 * 16 * 4, T_WGLU = 4 * 8 * 2, T_W1 = 64 * 16 * 8, T_W2 = 64 * 32 * 4;
        constexpr int U0 = U_SSM + U_ROPE + U_ADA, U1 = U0 + T_WIN, U2 = U1 + T_WOUT, U3 = U2 + T_WGLU, U4 = U3 + T_W1, U5 = U4 + T_W1, U6 = U5 + T_W2;
        constexpr int A0 = U_SSM + U_ROPE;
        const int nq = G == 256 ? 8 : (U3 - bid + G - 1) / G;
        for (int q = 0; q < nq; ++q) {
            int u = bid + q * G;
            if (G == 256) {
                u = -1;
                if (q == 0) u = bid;
                else if (q == 1) u = A0 + bid;
                else if (q == 7) { if (bid == 0) u = U_SSM; }
                else if (bid >= 128) { if (q == 2) u = A0 + 256 + (bid - 128); else if (q <= 4) u = U0 + 576 + (bid - 128) * 2 + (q - 3); }
                else { if (q <= 5) u = U0 + bid * 4 + (q - 2); else if (bid < 64) u = U0 + 512 + bid; }
                if (u < 0) continue;
            }
            if (u < U_SSM) { ssm_tab_unit(lds, P, u >> 6, (u >> 5) & 1, u & 31); }
            else if (u == U_SSM) {
                const int tid = tid_l(), wid = tid >> 6, lane = tid & 63;
                float* rope = (float*)(ws + WS_ROPE);
                for (int i = tid; i < 64 * 16; i += 512) {
                    const int pos = i >> 4, f = i & 15; const float inv = powf(10000.f, -(float)(2 * f) / 32.f);
                    float s, c; sincosf((float)pos * inv, &s, &c); rope[i * 2] = c; rope[i * 2 + 1] = s;
                }
                if (wid < 4) {
                    const float a = P.in[9][wid * 64 + lane] * P.in[10][wid * 64 + lane], c2 = P.in[11][wid * 64 + lane] * P.in[12][wid * 64 + lane];
                    const float s1 = wave_sum(a), s2 = wave_sum(c2);
                    if (lane == 0) ((float*)(ws + WS_LAM))[wid] = expf(s1) - expf(s2) + (0.8f - 0.6f * expf(-0.3f * (float)wid));
                }
            }
            else if (u < U0) { const int v = u - U_SSM - U_ROPE; adaln_unit(lds, P, v / 96, (v % 96) * 64); }
            else if (u < U1) { const int v = u - U0, l = v >> 7, k = (v >> 3) & 15, n = v & 7; transpose_unit(lds, P.in[8] + (size_t)l * 1024 * 2048, 1024, 2048, (bf16_t*)(ws + WS_WINT) + (size_t)l * 2048 * 1024, k * 64, n * 256, 0); }
            else if (u < U2) { const int v = u - U1, l = v >> 6, k = (v >> 2) & 15, n = v & 3; transpose_unit(lds, P.in[24] + (size_t)l * 1024 * 1024, 1024, 1024, (bf16_t*)(ws + WS_WOUTT) + (size_t)l * 1024 * 1024, k * 64, n * 256, 0); }
            else { const int v = u - U2, l = v >> 4, k = (v >> 1) & 7, n = v & 1; transpose_unit(lds, P.in[22] + (size_t)l * 512 * 512, 512, 512, (bf16_t*)(ws + WS_WGLUT) + (size_t)l * 512 * 512, k * 64, n * 256, 0); }
        }
        (void)U4; (void)U5; (void)U6;
    }
    SEAM(0);
    PHASE_K(1, 1) {
        const float* KT = (const float*)(ws + WS_KTAB); const float* PW = (const float*)(ws + WS_PW); const float* BB = (const float*)(ws + WS_BBAR);
        bf16_t* WE = (bf16_t*)(ws + WS_WENDT); bf16_t* B2 = (bf16_t*)(ws + WS_BT2);
        const int tid = tid_l();
        for (int it = bid * 512 + tid; it < 4 * 32 * 256 * 64; it += G * 512) {
            const int k8 = it & 63, n = (it >> 6) & 255, g = (it >> 14) & 31, l = it >> 19;
            u32x4 o = {0u, 0u, 0u, 0u};
            if (k8 < 32) {
                const int d = n >> 7, p = (n >> 1) & 63, ri = n & 1, i = k8 >> 1, h0 = (k8 & 1) * 8;
                const int ldg = (l * 2 + d) * 32 + g, e = d == 0 ? 15 - i : i;
                const f32x2 w = *(const f32x2*)(PW + ((size_t)(ldg * 64 + p) * 17 + e) * 2);
                const f32x4* bp = (const f32x4*)(BB + ((size_t)(ldg * 64 + p) * 16 + h0) * 2);
                const f32x4 b0 = bp[0], b1 = bp[1], b2 = bp[2], b3 = bp[3];
                float v[8];
                if (ri == 0) { v[0] = w.x * b0.x - w.y * b0.y; v[1] = w.x * b0.z - w.y * b0.w; v[2] = w.x * b1.x - w.y * b1.y; v[3] = w.x * b1.z - w.y * b1.w;
                               v[4] = w.x * b2.x - w.y * b2.y; v[5] = w.x * b2.z - w.y * b2.w; v[6] = w.x * b3.x - w.y * b3.y; v[7] = w.x * b3.z - w.y * b3.w; }
                else         { v[0] = w.x * b0.y + w.y * b0.x; v[1] = w.x * b0.w + w.y * b0.z; v[2] = w.x * b1.y + w.y * b1.x; v[3] = w.x * b1.w + w.y * b1.z;
                               v[4] = w.x * b2.y + w.y * b2.x; v[5] = w.x * b2.w + w.y * b2.z; v[6] = w.x * b3.y + w.y * b3.x; v[7] = w.x * b3.w + w.y * b3.z; }
                o.x = pk2(v[0], v[1]); o.y = pk2(v[2], v[3]); o.z = pk2(v[4], v[5]); o.w = pk2(v[6], v[7]);
            }
            *(u32x4*)(WE + (size_t)(it >> 6) * 512 + k8 * 8) = o;
        }
        for (int it = bid * 512 + tid; it < 4 * 32 * 256 * 64; it += G * 512) {
            const int k8 = it & 63, n2 = (it >> 6) & 255, g = (it >> 14) & 31, l = it >> 19;
            const int j = n2 >> 4, h = n2 & 15;
            float v[8];
            if (k8 < 32) {
                const int i = k8 >> 1, h20 = (k8 & 1) * 8;
                f32x4 a0 = {0.f, 0.f, 0.f, 0.f}, a1 = a0;
                if (i <= j) { const f32x4* kp = (const f32x4*)(KT + ((size_t)((l * 2 + 0) * 32 + g) * 16 + (j - i)) * 256 + h * 16 + h20); a0 += kp[0]; a1 += kp[1]; }
                if (i >= j) { const f32x4* kp = (const f32x4*)(KT + ((size_t)((l * 2 + 1) * 32 + g) * 16 + (i - j)) * 256 + h * 16 + h20); a0 += kp[0]; a1 += kp[1]; }
                v[0] = a0.x; v[1] = a0.y; v[2] = a0.z; v[3] = a0.w; v[4] = a1.x; v[5] = a1.y; v[6] = a1.z; v[7] = a1.w;
                if (i == j && (h >> 3) == (k8 & 1)) { const float dd = P.in[21][(size_t)l * 512 + g * 16 + h];
#pragma unroll
                    for (int q = 0; q < 8; ++q) v[q] += (q == (h & 7)) ? dd : 0.f; }
            } else {
                const int n0 = (k8 - 32) * 8, d = n0 >> 7, p0 = (n0 >> 1) & 63;
                const int ldg = (l * 2 + d) * 32 + g, e = d == 0 ? j + 1 : 16 - j;
                const f32x4 cr = *(const f32x4*)(P.in[19] + (size_t)(ldg * 16 + h) * 64 + p0), ci = *(const f32x4*)(P.in[20] + (size_t)(ldg * 16 + h) * 64 + p0);
                const float crv[4] = {cr.x, cr.y, cr.z, cr.w}, civ[4] = {ci.x, ci.y, ci.z, ci.w};
#pragma unroll
                for (int q = 0; q < 4; ++q) {
                    const f32x2 w = *(const f32x2*)(PW + ((size_t)(ldg * 64 + p0 + q) * 17 + e) * 2);
                    v[2 * q] = crv[q] * w.x - civ[q] * w.y; v[2 * q + 1] = -(crv[q] * w.y + civ[q] * w.x);
                }
            }
            u32x4 o; o.x = pk2(v[0], v[1]); o.y = pk2(v[2], v[3]); o.z = pk2(v[4], v[5]); o.w = pk2(v[6], v[7]);
            *(u32x4*)(B2 + (size_t)(it >> 6) * 512 + k8 * 8) = o;
        }
    }
    SEAM(1);

    for (int l = 0; l < DEPTH; ++l) {
        const int ph = PH_LAYER0 + l * PH_PER_LAYER;
        const bool last = l == DEPTH - 1;
        const float* MODl = (const float*)(ws + WS_MOD) + (size_t)l * 9 * 6144;
        PHASE_K(2, ph + 0) { if (l == 0) rowpass1<true>(P, 0); else rowpass1<false>(P, l); }
        SEAM(ph + 0);
        PHASE_K(3, ph + 1) {
            {
                Epi8Inproj ep{(bf16_t*)(ws + WS_QK), (bf16_t*)(ws + WS_VT), (bf16_t*)(ws + WS_US), (const float*)(ws + WS_ROPE)};
                const pg8::Gemm g{(const bf16_t*)(ws + WS_HX), (const bf16_t*)(ws + WS_WINT) + (size_t)l * 2048 * 1024, R, 2048, 1024};
                const TileOrder S{128 * 8, G, vcu, 16, 8, 0, 17, 1};
                pg8::gemm_phase<Epi8Inproj, TileOrder, true, true>(ldsp, g, S, ep);
            }
            for (int u = vcu; u < 16 * 16; u += G) {
                EpiInproj ep{(bf16_t*)(ws + WS_QK), (bf16_t*)(ws + WS_VT), (bf16_t*)(ws + WS_US), (const float*)(ws + WS_ROPE)};
                APlain af{(const bf16_t*)(ws + WS_HX), 1024};
                const int mt = u >> 4, nt = u & 15;
                gemm_unit_dma(lds, af, (const bf16_t*)(ws + WS_WINT) + (size_t)l * 2048 * 1024, 1024, 1024, (mt >> 1) * LP + (mt & 1) * 128, nt * 128, ep);
            }
        }
        SEAM(ph + 1);
        PHASE_K(4, ph + 2) {
            {
                Epi8S1 ep{(unsigned short*)(ws + WS_EB)};
                const pg8::Gemm g{(const bf16_t*)(ws + WS_US), (const bf16_t*)(ws + WS_WENDT) + (size_t)l * 32 * 256 * 512, 32 * NCHP, 32 * 256, 512, nullptr, 0, 4};
                const TileOrder S{32 * 8, G, vcu, 8, 1, 1, 9, 0};
                pg8::gemm_phase<Epi8S1, TileOrder, true, true>(ldsp, g, S, ep);
            }
            for (int u = vcu; u < 64; u += G) {
                const int g = u >> 1, nt = u & 1;
                EpiS1 ep{(unsigned short*)(ws + WS_EB) + (size_t)g * NCHP * 256};
                APlain af{(const bf16_t*)(ws + WS_US) + (size_t)g * NCHP * 512, 512};
                gemm_unit_dma(lds, af, (const bf16_t*)(ws + WS_WENDT) + ((size_t)l * 32 + g) * 256 * 512, 512, 256, 2048, nt * 128, ep);
            }
        }
        SEAM(ph + 2);
        PHASE_K(15, ph + 3) {
            for (int u = bid * 2; u < NB * 32 * 2; u += G * 2) scan_block(lds, P, l, u);
        }
        SEAM(ph + 3);
        PHASE_K(5, ph + 4) {
            const float lam = ((const float*)(ws + WS_LAM))[l], lam_init = 0.8f - 0.6f * expf(-0.3f * (float)l);
            int rnd = 0;
            for (int u = vcu; u < (last ? 1024 : 1024 + 64); u += G, ++rnd) {
                if (rnd == ((bid >> 3) & 3)) conv_share(lds, P, l, bid, G);
                if (u < 1024) { const int qb = u & 31, bh = u >> 5; attn_unit(lds, P, l, bh >> 2, bh & 3, CTXL + qb * 128, LP, lam, lam_init); }
                else { const int v = u - 1024, qb = v & 1, bh = v >> 1; attn_unit(lds, P, l, bh >> 2, bh & 3, qb * 128, CTXL, lam, lam_init); }
            }
        }
        PHASE_K(6, ph + 4) {
            {
                Epi8S2 ep{(bf16_t*)(ws + WS_YG)};
                const pg8::Gemm g{(const bf16_t*)(ws + WS_US), (const bf16_t*)(ws + WS_BT2) + (size_t)l * 32 * 256 * 512, 32 * NCHP, 32 * 256, 512};
                const TileOrder S{32 * 8, G, vcu, 8, 1, 1, 9, 0};
                pg8::gemm_phase<Epi8S2, TileOrder, true, true>(ldsp, g, S, ep);
            }
            if (!last) for (int u = (vcu + G / 2) % G; u < 64; u += G) {
                const int g = u >> 1, nt = u & 1;
                EpiS2 ep{(bf16_t*)(ws + WS_YG), g};
                APlain af{(const bf16_t*)(ws + WS_US) + (size_t)g * NCHP * 512, 512};
                gemm_unit_dma(lds, af, (const bf16_t*)(ws + WS_BT2) + ((size_t)l * 32 + g) * 256 * 512, 512, 512, 2048, nt * 128, ep);
            }
        }
        SEAM(ph + 4);
        PHASE_K(7, ph + 5) {
            {
                Epi8Glu ep{(const bf16_t*)(ws + WS_YG), (bf16_t*)(ws + WS_MIX), P.in[23] + (size_t)l * 512};
                const pg8::Gemm g{(const bf16_t*)(ws + WS_YG), (const bf16_t*)(ws + WS_WGLUT) + (size_t)l * 512 * 512, R, 512, 512};
                const TileOrder S{128 * 2, G, vcu, 16, 2, 0, 17, 1};
                pg8::gemm_phase<Epi8Glu, TileOrder, true, true>(ldsp, g, S, ep);
            }
            if (!last) for (int u = vcu; u < 8 * 4; u += G) {
                EpiGlu ep{(const bf16_t*)(ws + WS_YG), (bf16_t*)(ws + WS_MIX), P.in[23] + (size_t)l * 512};
                APlain af{(const bf16_t*)(ws + WS_YG), 512};
                gemm_unit<256>(lds, af, (const bf16_t*)(ws + WS_WGLUT) + (size_t)l * 512 * 512, 512, 512, (u >> 2) * LP, (u & 3) * 128, ep);
            }
        }
        SEAM(ph + 5);
        PHASE_K(8, ph + 6) {
            {
                Epi8Out ep{(bf16_t*)(ws + WS_X), MODl};
                const pg8::Gemm g{(const bf16_t*)(ws + WS_MIX), (const bf16_t*)(ws + WS_WOUTT) + (size_t)l * 1024 * 1024, R, 1024, 1024};
                const TileOrder S{128 * 4, G, vcu, 16, 4, 0, 17, 1};
                pg8::gemm_phase<Epi8Out, TileOrder, true, true>(ldsp, g, S, ep);
            }
            if (!last) for (int u = vcu; u < 16 * 8; u += G) {
                EpiOut ep{(bf16_t*)(ws + WS_X), MODl};
                APlain af{(const bf16_t*)(ws + WS_MIX), 1024};
                const int mt = u >> 3, nt = u & 7;
                gemm_unit_dma(lds, af, (const bf16_t*)(ws + WS_WOUTT) + (size_t)l * 1024 * 1024, 1024, 1024, (mt >> 1) * LP + (mt & 1) * 128, nt * 128, ep);
            }
        }
        SEAM(ph + 6);
        PHASE_K(9, ph + 7) { rowpass2(lds, P, l); }
        SEAM(ph + 7);
        PHASE_K(10, ph + 8) {
            for (int u = bid; u < (last ? 128 : 256); u += G) select_unit(lds, P, (u & 127) >> 4, u & 15, u < 128);
        }
        SEAM(ph + 8);
        PHASE_K(11, ph + 9) {
            Epi8Moe1 ep{(bf16_t*)(ws + WS_HG)};
            const pg8::Gemm g{(const bf16_t*)(ws + WS_HX), (const bf16_t*)(ws + WS_W13T) + (size_t)l * 16 * 4096 * 1024, 16 * ROWS_E, 16 * 4096, 1024, (const int*)(ws + WS_IDX), 131072 + 64};
            const TileOrder S = last ? TileOrder{16 * 16 * 16, G, vcu, 16, 16, 16, 17, 0, 1} : TileOrder{16 * 17 * 16, G, vcu, 17, 16, 16, 17, 0, 1};
            pg8::gemm_phase<Epi8Moe1, TileOrder, true, true, true>(ldsp, g, S, ep);
        }
        SEAM(ph + 9);
        PHASE_K(12, ph + 10) {
            {
                Epi8Moe2 ep{(bf16_t*)(ws + WS_OG), (const float*)(ws + WS_GATE)};
                const pg8::Gemm g{(const bf16_t*)(ws + WS_HG), (const bf16_t*)(ws + WS_W2T) + (size_t)l * 16 * 1024 * 2048, 16 * ROWS_E, 16 * 1024, 2048};
                const TileOrder S{16 * 16 * 4, G, vcu, 16, 4, 4, 17, 0};
                pg8::gemm_phase<Epi8Moe2, TileOrder, true, true>(ldsp, g, S, ep);
            }
            if (!last) for (int u = vcu; u < 16 * 2 * 8; u += G) {
                const int e = u >> 4, mt = (u >> 3) & 1, nt = u & 7;
                EpiMoe2 ep{(bf16_t*)(ws + WS_OG) + (size_t)e * ROWS_E * 1024, (const float*)(ws + WS_GATE) + (size_t)e * ROWS_E};
                APlain af{(const bf16_t*)(ws + WS_HG) + (size_t)e * ROWS_E * FF, FF};
                gemm_unit_dma(lds, af, (const bf16_t*)(ws + WS_W2T) + ((size_t)l * 16 + e) * 1024 * 2048, 2048, 2048, NB * CAPL + mt * 128, nt * 128, ep);
            }
        }
        SEAM(ph + 10);
    }
    PHASE_K(13, PH_FINAL) { rowpass1<false>(P, DEPTH); }
#undef ws
}

#ifndef MK_MULTI
#define MK_MULTI 0
#endif

extern "C" void kernel_launch(void* const* d_in, const int* in_sizes, int n_in, void* d_out, int out_size, void* d_ws, size_t ws_size, hipStream_t stream) {
    static int grid = 0;
    if (!grid) {
        int dev = 0, cus = 0, per_cu = 0;
        hipGetDevice(&dev);
        hipDeviceGetAttribute(&cus, hipDeviceAttributeMultiprocessorCount, dev);
        hipFuncSetAttribute((const void*)fwd_kernel, hipFuncAttributeMaxDynamicSharedMemorySize, LDS_BYTES);
        hipOccupancyMaxActiveBlocksPerMultiprocessor(&per_cu, fwd_kernel, 512, LDS_BYTES);
        grid = cus * (per_cu < 1 ? per_cu : 1);
        if (grid <= 0) { fprintf(stderr, "occupancy query failed (per_cu=%d cus=%d)\n", per_cu, cus); grid = 256; }
        if (ws_size < WS_END) fprintf(stderr, "workspace too small: %zu < %zu\n", ws_size, (size_t)WS_END);
    }
    Params p{};
    for (int i = 0; i < 30; ++i) p.in[i] = (const float*)d_in[i];
    p.out = (float*)d_out; p.ws = (unsigned char*)d_ws;
    hipMemsetAsync(d_ws, 0, CTL_BYTES, stream);
#if MK_MULTI
    for (int ph = 0; ph < N_PHASES; ++ph) {
        p.lo = ph; p.hi = ph + 1;
        hipLaunchKernelGGL(fwd_kernel, dim3(grid), dim3(512), LDS_BYTES, stream, p);
    }
#else
    p.lo = 0; p.hi = N_PHASES;
    hipLaunchKernelGGL(fwd_kernel, dim3(grid), dim3(512), LDS_BYTES, stream, p);
#endif
}
```

```cpp
#include <hip/hip_runtime.h>
#include <cstdio>
#include <cstdint>
#include <cmath>

#define DEVI __device__ __forceinline__
#define LAS __attribute__((address_space(3)))

typedef unsigned short bf16_t;
typedef short bf16x8 __attribute__((ext_vector_type(8)));
typedef float f32x2 __attribute__((ext_vector_type(2)));
typedef float f32x4 __attribute__((ext_vector_type(4)));
typedef float f32x16 __attribute__((ext_vector_type(16)));
typedef unsigned u32x2 __attribute__((ext_vector_type(2)));
typedef unsigned u32x4 __attribute__((ext_vector_type(4)));
typedef __bf16 bf16x2_t __attribute__((ext_vector_type(2)));

constexpr int NB = 8, SEQ = 4096, CTXL = 256, DM = 1024, DEPTH = 4;
constexpr int LP = CTXL + SEQ;
constexpr int R = NB * LP;
constexpr int NCHB = LP / 16;
constexpr int NCH = NB * NCHB;
constexpr int NE = 16, CAPL = 512, CAPC = 32, ROWS_BE = CAPL + CAPC  , ROWS_E = NB * ROWS_BE  , FF = 2048;
constexpr int NH = 4;
constexpr float EPS = 1e-6f;
constexpr float QSCALE = 0.125f * 1.4426950408889634f;

constexpr size_t al256(size_t x) { return (x + 255) & ~(size_t)255; }
constexpr size_t WS_CTL = 0, CTL_BYTES = 65536;
constexpr size_t WS_MOD = WS_CTL + CTL_BYTES;
constexpr size_t WS_ROPE = WS_MOD + al256((size_t)4 * 9 * 6144 * 4);
constexpr size_t WS_LAM = WS_ROPE + al256(64 * 16 * 2 * 4);
constexpr size_t WS_KTAB = WS_LAM + 256;
constexpr size_t WS_PW = WS_KTAB + (size_t)4 * 2 * 32 * 4096 * 4;
constexpr size_t WS_BBAR = WS_PW + al256((size_t)4 * 2 * 32 * 64 * 17 * 2 * 4);
constexpr size_t WS_WENDT = WS_BBAR + al256((size_t)4 * 2 * 32 * 64 * 16 * 2 * 4);
constexpr size_t WS_BT2 = WS_WENDT + (size_t)4 * 32 * 256 * 512 * 2;
constexpr size_t WS_WINT = WS_BT2 + (size_t)4 * 32 * 256 * 512 * 2;
constexpr size_t WS_WOUTT = WS_WINT + (size_t)4 * 2048 * 1024 * 2;
constexpr size_t WS_WGLUT = WS_WOUTT + (size_t)4 * 1024 * 1024 * 2;
constexpr size_t WS_W13T = WS_WGLUT + (size_t)4 * 512 * 512 * 2;
constexpr size_t WS_W2T = WS_W13T + (size_t)4 * 16 * 4096 * 1024 * 2;
constexpr size_t WS_X = WS_W2T + (size_t)4 * 16 * 1024 * 2048 * 2;
constexpr size_t WS_HX = WS_X + (size_t)R * 1024 * 4;
constexpr size_t WS_QK = WS_HX + (size_t)R * 1024 * 2;
constexpr size_t WS_VT = WS_QK + (size_t)R * 1024 * 2;
constexpr int NCHP = 2304;
constexpr size_t WS_US = WS_VT + (size_t)R * 512 * 2;
constexpr size_t WS_EB = WS_US + (size_t)32 * NCHP * 512 * 2;
constexpr size_t WS_MIX = WS_EB + (size_t)32 * NCHP * 256 * 4;
constexpr size_t WS_YG = WS_MIX + (size_t)R * 1024 * 2;
constexpr size_t WS_AFFT = WS_YG + (size_t)R * 512 * 2;
constexpr size_t WS_SLOT = WS_AFFT + (size_t)NB * 16 * LP * 4;
constexpr size_t WS_GATE = WS_SLOT + (size_t)R * 16 * 4;
constexpr size_t WS_IDX = WS_GATE + al256((size_t)16 * ROWS_E * 4);
constexpr size_t WS_XG = WS_IDX + al256((size_t)16 * ROWS_E * 4);
constexpr size_t WS_HG = WS_XG + (size_t)16 * ROWS_E * 1024 * 2;
constexpr size_t WS_OG = WS_HG + (size_t)16 * ROWS_E * 2048 * 2;
constexpr size_t WS_END = WS_OG + (size_t)16 * ROWS_E * 1024 * 2;

constexpr int LDS_BYTES = 131072 + 64 + 16384;

DEVI unsigned pk2(float lo, float hi) { f32x2 v = {lo, hi}; bf16x2_t b = __builtin_convertvector(v, bf16x2_t); return __builtin_bit_cast(unsigned, b); }
DEVI bf16_t f2bf(float f) { return (bf16_t)(pk2(f, 0.f) & 0xffffu); }
DEVI float bflo(unsigned u) { return __builtin_bit_cast(float, u << 16); }
DEVI float bfhi(unsigned u) { return __builtin_bit_cast(float, u & 0xffff0000u); }
DEVI f32x4 bf4(u32x2 w) { return (f32x4){bflo(w.x), bfhi(w.x), bflo(w.y), bfhi(w.y)}; }
typedef _Float16 h16x2 __attribute__((ext_vector_type(2)));
DEVI unsigned hpk2(float lo, float hi) { unsigned r; asm("v_cvt_pk_f16_f32 %0, %1, %2" : "=v"(r) : "v"(lo), "v"(hi)); return r; }
DEVI float hlo(unsigned u) { return (float)__builtin_bit_cast(_Float16, (unsigned short)(u & 0xffffu)); }
DEVI float hhi(unsigned u) { return (float)__builtin_bit_cast(_Float16, (unsigned short)(u >> 16)); }
DEVI f32x4 hf4(u32x2 w) { return (f32x4){hlo(w.x), hhi(w.x), hlo(w.y), hhi(w.y)}; }
DEVI int tid_l() { int t = threadIdx.x; asm volatile("" : "+v"(t)); return t; }
#define GAS __attribute__((address_space(1)))
DEVI unsigned char* ptr_l(unsigned char* w) { GAS unsigned char* g = (GAS unsigned char*)w; asm volatile("" : "+s"(g)); return (unsigned char*)g; }
template <int CTRL> DEVI float dppmov(float x) { return __builtin_bit_cast(float, __builtin_amdgcn_update_dpp(0, __builtin_bit_cast(int, x), CTRL, 0xf, 0xf, true)); }
DEVI void swap16(float a, float b, float& r0, float& r1) { const auto r = __builtin_amdgcn_permlane16_swap(__builtin_bit_cast(unsigned, a), __builtin_bit_cast(unsigned, b), false, false); r0 = __builtin_bit_cast(float, (unsigned)r[0]); r1 = __builtin_bit_cast(float, (unsigned)r[1]); }
DEVI void swap32(float a, float b, float& r0, float& r1) { const auto r = __builtin_amdgcn_permlane32_swap(__builtin_bit_cast(unsigned, a), __builtin_bit_cast(unsigned, b), false, false); r0 = __builtin_bit_cast(float, (unsigned)r[0]); r1 = __builtin_bit_cast(float, (unsigned)r[1]); }
DEVI float wave_sum(float v) {
    v += dppmov<0xB1>(v);
    v += dppmov<0x4E>(v);
    v += dppmov<0x124>(v);
    v += dppmov<0x128>(v);
    float r0, r1; swap16(v, v, r0, r1); v = r0 + r1;
    swap32(v, v, r0, r1); return r0 + r1;
}
DEVI float fast_exp2(float x) { return __builtin_amdgcn_exp2f(x); }
DEVI float sigmoidf_(float x) { return __builtin_amdgcn_rcpf(1.f + __expf(-x)); }
DEVI float gelu_tanh(float x) { const float z = 0.7978845608028654f * (x + 0.044715f * x * x * x); const float t = 1.f - 2.f * __builtin_amdgcn_rcpf(__expf(2.f * z) + 1.f); return 0.5f * x * (1.f + t); }
#define MFMA32(a, b, c) __builtin_amdgcn_mfma_f32_32x32x16_bf16(a, b, c, 0, 0, 0)

#define XB_TMO      128
#define XB_XCNT(j)  (256  + 64 * (j))
#define XB_XSUB(j)  (1280 + 64 * (j))
#define XB_XGEN(j)  (2304 + 64 * (j))
#define XB_TOP      3328
#define XB_TOPGEN   3392
#define XCD_BAR_WORDS 3456
#define XB_SPIN_CAP (1u << 20)
DEVI unsigned xb_ld(unsigned* p)              { return __hip_atomic_load(p, __ATOMIC_RELAXED, __HIP_MEMORY_SCOPE_AGENT); }
DEVI unsigned xb_add(unsigned* p, unsigned v) { return __hip_atomic_fetch_add(p, v, __ATOMIC_RELAXED, __HIP_MEMORY_SCOPE_AGENT); }
DEVI unsigned xb_xcc_id() { return (unsigned)__builtin_amdgcn_s_getreg((3 << 11) | 20) & 0xFu; }
#define XB_SPIN(cond, bar) do { unsigned _sp = 0; while (cond) { __builtin_amdgcn_s_sleep(1); \
    if ((++_sp & 255u) == 0u) { if (xb_ld(&(bar)[XB_TMO])) break; if (_sp > XB_SPIN_CAP) { atomicAdd(&(bar)[XB_TMO], 1u); break; } } } } while (0)
struct XcdBarrier { unsigned* bar; unsigned x; volatile LAS unsigned* st; };
DEVI XcdBarrier xcd_barrier_post(unsigned* bar, volatile LAS unsigned* st) {
    XcdBarrier b; b.bar = bar; b.x = xb_xcc_id(); b.st = st;
    if (threadIdx.x == 0) (void)xb_add(&bar[XB_XCNT(b.x)], 1u);
    return b;
}
DEVI void xcd_barrier_complete(unsigned* bar, unsigned x, unsigned& nloc, unsigned& nx) {
    const unsigned G = gridDim.x * gridDim.y * gridDim.z;
    unsigned sum, cnt, mine, sp = 0u;
    for (;;) {
        sum = 0u; cnt = 0u; mine = 0u;
#pragma unroll
        for (unsigned j = 0; j < 16; ++j) { const unsigned c = xb_ld(&bar[XB_XCNT(j)]); sum += c; cnt += (c > 0u) ? 1u : 0u; mine = (j == x) ? c : mine; }
        if (sum == G) break;
        __builtin_amdgcn_s_sleep(1);
        if ((++sp & 255u) == 0u) { if (xb_ld(&bar[XB_TMO])) break; if (sp > XB_SPIN_CAP) { atomicAdd(&bar[XB_TMO], 1u); break; } }
    }
    nloc = mine > 0u ? mine : 1u; nx = cnt > 0u ? cnt : 1u;
}
DEVI void xcd_barrier(const XcdBarrier& b) {
    asm volatile("s_waitcnt vmcnt(0)" ::: "memory");
    __syncthreads();
    if (threadIdx.x == 0) {
        unsigned* bar = b.bar;
        __builtin_amdgcn_s_waitcnt(0);
        unsigned nloc = b.st[0], nx = b.st[1];
        if (nloc == 0u) { xcd_barrier_complete(bar, b.x, nloc, nx); b.st[0] = nloc; b.st[1] = nx; }
        const unsigned old = xb_add(&bar[XB_XSUB(b.x)], 1u);
        const unsigned gen = old / nloc;
        if (old + 1u == (gen + 1u) * nloc) {
            __builtin_amdgcn_fence(__ATOMIC_RELEASE, "agent");
            asm volatile("s_waitcnt vmcnt(0)" ::: "memory");
            const unsigned og = xb_add(&bar[XB_TOP], 1u);
            const unsigned tg = og / nx;
            if (og + 1u == (tg + 1u) * nx) xb_add(&bar[XB_TOPGEN], 1u);
            else XB_SPIN(xb_ld(&bar[XB_TOPGEN]) == tg, bar);
            __builtin_amdgcn_fence(__ATOMIC_ACQUIRE, "agent");
            xb_add(&bar[XB_XGEN(b.x)], 1u);
            asm volatile("s_waitcnt vmcnt(0)" ::: "memory");
        } else {
            XB_SPIN(xb_ld(&bar[XB_XGEN(b.x)]) == gen, bar);
            __builtin_amdgcn_fence(__ATOMIC_ACQUIRE, "agent");
            asm volatile("s_waitcnt vmcnt(0)" ::: "memory");
        }
    }
    __syncthreads();
}

DEVI int chunk_row(int b, int c) { return c >= 16 ? b * 256 + (c - 16) : 2048 + b * 16 + c; }
DEVI int chunk_row_token(int cr) { return cr < 2048 ? (cr >> 8) * LP + (16 + (cr & 255)) * 16 : ((cr - 2048) >> 4) * LP + ((cr - 2048) & 15) * 16; }
DEVI int perm16(int k) { return (k & 3) | ((k & 4) << 1) | ((k & 8) >> 1); }

namespace pg8 {
#define PG8_LAS __attribute__((address_space(3)))
typedef unsigned short bf16_t;
typedef short bf16x8 __attribute__((ext_vector_type(8)));
typedef float f32x4 __attribute__((ext_vector_type(4)));
typedef unsigned u32x4 __attribute__((ext_vector_type(4)));
constexpr int BM = 256, BK = 64, HALF = 128, HTB = HALF * BK * 2  , STAGE_BYTES = 8 * HTB, NXCD = 8, WGM = 8;

__host__ __device__ __forceinline__ int lds_byte(int r, int c) { const int st = (r >> 4) * 2 + (c >> 5), rr = r & 15, cc = c & 31, ob = rr * 64 + cc * 2; return st * 1024 + (ob ^ (((ob >> 9) & 1) << 5)); }
__host__ __device__ __forceinline__ void stage_rc(int b, int& R, int& C) { const int st = b / 1024, sb = b % 1024, swz = sb ^ (((sb >> 9) & 1) << 5); R = (st >> 1) * 16 + swz / 64; C = (st & 1) * 32 + (swz % 64) / 2; }
__host__ __device__ __forceinline__ int perm32(int rho) { const int n = rho >> 4, i = rho & 15; return 8 * (i >> 2) + 4 * n + (i & 3); }

struct Unit { int pm, pn; };
struct Gemm { const bf16_t* A; const bf16_t* Bt; int M, N, K; const int* gidx = nullptr; int islot = 0; int nkt = 0; };
__device__ __forceinline__ unsigned cvt_pk_bf16(float lo, float hi) { unsigned r; asm volatile("v_cvt_pk_bf16_f32 %0, %1, %2" : "=v"(r) : "v"(lo), "v"(hi)); return r; }
template <class Epi, class Sched, bool ALIGN_EPI = false, bool SP2 = false, bool GATH = false>
__device__ __forceinline__ void gemm_phase(PG8_LAS unsigned char* lds, const Gemm g, const Sched& S, const Epi& E) {
    static_assert(!GATH || SP2, "the gathered-A form is written for the SP2 loop only");
    const int tid = tid_l(), wid = __builtin_amdgcn_readfirstlane(tid >> 6), lane = tid & 63, wr = wid >> 2, wc = wid & 3, fr = lane & 15, fq = lane >> 4;
    const int K = g.K, nt = g.nkt ? g.nkt : K / BK;
    unsigned voffA[2], voffB[2];
    int stR[2], stC[2];
#pragma unroll
    for (int i = 0; i < 2; ++i) { int R, C; stage_rc(tid * 16 + i * 8192, R, C); const int Rb = Epi::PERM ? ((R & ~31) + perm32(R & 31)) : R; stR[i] = R; stC[i] = C;
        voffA[i] = (unsigned)(R * K + C) * 2u; voffB[i] = (unsigned)(Rb * K + C) * 2u; }
    unsigned goff[2][2], ngoff[2][2];
    const char* gA = (const char*)g.A;
    const size_t kstep = (size_t)(BK * 2);
    const size_t hstep = (size_t)HALF * K * 2;
    const size_t tstep = 2 * hstep;
    const unsigned ldsw = (unsigned)wid * 1024u;
    const int aoff = lds_byte(wr * 64 + fr, fq * 8), boff = lds_byte(wc * 32 + fr, fq * 8);
#define PG8_SA(b, h) (((b) * 2 + (h)) * HTB)
#define PG8_SB(b, h) ((4 + (b) * 2 + (h)) * HTB)
#define PG8_STAGE(bufoff, gbase, voff) do { _Pragma("unroll") for (int _i = 0; _i < 2; ++_i) \
        __builtin_amdgcn_global_load_lds((const unsigned*)((const char*)(gbase) + (voff)[_i]), (PG8_LAS unsigned*)(lds + (bufoff) + ldsw + _i * 8192), 16, 0, 0); } while (0)
#define PG8_STAGE_A(bufoff, selnext, kt, h) do { if constexpr (GATH) PG8_STAGE(bufoff, gA + (size_t)(kt) * kstep, ((selnext) ? ngoff[h] : goff[h])); \
        else PG8_STAGE(bufoff, ((selnext) ? nA : cA) + (size_t)(kt) * kstep + (size_t)(h) * hstep, voffA); } while (0)
#define PG8_LDA(dst, b, h) do { _Pragma("unroll") for (int m = 0; m < 4; ++m) _Pragma("unroll") for (int k = 0; k < 2; ++k) dst[m][k] = *(const PG8_LAS bf16x8*)(lds + PG8_SA(b, h) + aoff + m * 2048 + k * 1024); } while (0)
#define PG8_LDB(dst, b, h) do { _Pragma("unroll") for (int n = 0; n < 2; ++n) _Pragma("unroll") for (int k = 0; k < 2; ++k) dst[n][k] = *(const PG8_LAS bf16x8*)(lds + PG8_SB(b, h) + boff + n * 2048 + k * 1024); } while (0)
#define PG8_MMA(ai, bj, At, Bt) do { __builtin_amdgcn_s_setprio(1); _Pragma("unroll") for (int m = 0; m < 4; ++m) _Pragma("unroll") for (int n = 0; n < 2; ++n) _Pragma("unroll") for (int k = 0; k < 2; ++k) \
        acc[ai][bj][m][n] = __builtin_amdgcn_mfma_f32_16x16x32_bf16(Bt[n][k], At[m][k], acc[ai][bj][m][n], 0, 0, 0); __builtin_amdgcn_s_setprio(0); } while (0)
#define PG8_WAIT_V(n) asm volatile("s_waitcnt vmcnt(" #n ")" ::: "memory")
#define PG8_WAIT_L(n) asm volatile("s_waitcnt lgkmcnt(" #n ")" ::: "memory")
#define PG8_BAR __builtin_amdgcn_s_barrier()
#define PG8_SCHED __builtin_amdgcn_sched_barrier(0)
    Unit cur, nxt; int ui = 0;
    if (!S.next(0, cur)) return;
    f32x4 acc[2][2][4][2];
#pragma unroll
    for (int a = 0; a < 2; ++a)
#pragma unroll
        for (int b = 0; b < 2; ++b)
#pragma unroll
            for (int m = 0; m < 4; ++m)
#pragma unroll
                for (int n = 0; n < 2; ++n) acc[a][b][m][n] = (f32x4){0.f, 0.f, 0.f, 0.f};
    bf16x8 At[4][2], B0[2][2], B1[2][2];
    const char* cA = (const char*)g.A + (size_t)cur.pm * tstep; const char* cB = (const char*)g.Bt + (size_t)cur.pn * tstep;
    const char* nA = cA;
    if constexpr (GATH) {
#pragma unroll
        for (int h = 0; h < 2; ++h)
#pragma unroll
            for (int i = 0; i < 2; ++i) { goff[h][i] = (unsigned)(g.gidx[cur.pm * 256 + h * 128 + stR[i]] * K + stC[i]) * 2u; ngoff[h][i] = goff[h][i]; }
    }
    S.a_ready(cur);
    if constexpr (SP2) {
        PG8_STAGE(PG8_SB(0, 0), cB, voffB); PG8_STAGE(PG8_SB(0, 1), cB + hstep, voffB); PG8_STAGE_A(PG8_SA(0, 0), false, 0, 0); PG8_STAGE_A(PG8_SA(0, 1), false, 0, 1);
        if (wr == 1) PG8_BAR;
        PG8_WAIT_V(2); PG8_BAR;
        PG8_STAGE(PG8_SB(1, 0), cB + kstep, voffB); PG8_STAGE_A(PG8_SA(1, 0), false, 1, 0); PG8_STAGE(PG8_SB(1, 1), cB + hstep + kstep, voffB);
        PG8_WAIT_V(6); PG8_BAR;
    } else {
        PG8_STAGE(PG8_SB(0, 0), cB, voffB); PG8_STAGE(PG8_SA(0, 0), cA, voffA); PG8_STAGE(PG8_SB(0, 1), cB + hstep, voffB); PG8_STAGE(PG8_SA(0, 1), cA + hstep, voffA);
        if (wr == 1) PG8_BAR;
        PG8_WAIT_V(4); PG8_BAR;
        PG8_STAGE(PG8_SB(1, 0), cB + kstep, voffB); PG8_STAGE(PG8_SA(1, 0), cA + kstep, voffA); PG8_STAGE(PG8_SB(1, 1), cB + hstep + kstep, voffB);
        PG8_WAIT_V(6); PG8_BAR;
    }
    for (;;) {
        const bool has_next = S.next(ui + 1, nxt);
        nA = has_next ? (const char*)g.A + (size_t)nxt.pm * tstep : cA; const char* nB = has_next ? (const char*)g.Bt + (size_t)nxt.pn * tstep : cB;
        if constexpr (GATH) {
            if (has_next) {
#pragma unroll
                for (int h = 0; h < 2; ++h)
#pragma unroll
                    for (int i = 0; i < 2; ++i)
                        __builtin_amdgcn_global_load_lds((const unsigned*)(g.gidx + nxt.pm * 256 + h * 128 + stR[i]), (PG8_LAS unsigned*)(lds + g.islot + ((ui + 1) & 1) * 8192 + (h * 2 + i) * 2048 + wid * 256), 4, 0, 0);
            }
        }
#pragma unroll 1
        for (int t = 0; t < nt; t += 2) {
            const bool last = (t == nt - 2);
            if constexpr (GATH) {
                if (last) {
                    if (has_next) {
#pragma unroll
                        for (int h = 0; h < 2; ++h)
#pragma unroll
                            for (int i = 0; i < 2; ++i) { const int ix = *(const PG8_LAS int*)(lds + g.islot + ((ui + 1) & 1) * 8192 + (h * 2 + i) * 2048 + wid * 256 + lane * 4); ngoff[h][i] = (unsigned)(ix * K + stC[i]) * 2u; }
                    } else {
#pragma unroll
                        for (int h = 0; h < 2; ++h)
#pragma unroll
                            for (int i = 0; i < 2; ++i) ngoff[h][i] = goff[h][i];
                    }
                }
            }
            const char* a1 = cA + (size_t)(t + 1) * kstep;
            const char* a2 = last ? nA : cA + (size_t)(t + 2) * kstep; const char* b2 = last ? nB : cB + (size_t)(t + 2) * kstep;
            const char* a3 = a2 + kstep; const char* b3 = b2 + kstep;
            if (last && has_next) S.a_ready(nxt);
            if constexpr (SP2) {
            PG8_LDB(B0, 0, 0); PG8_LDB(B1, 0, 1); PG8_SCHED; PG8_LDA(At, 0, 0); PG8_STAGE_A(PG8_SA(1, 1), false, t + 1, 1);
            PG8_WAIT_V(8); PG8_WAIT_L(0); PG8_BAR; PG8_MMA(0, 0, At, B0); PG8_MMA(0, 1, At, B1); PG8_BAR; PG8_SCHED;
            PG8_LDA(At, 0, 1); PG8_STAGE(PG8_SB(0, 0), b2, voffB); PG8_STAGE(PG8_SB(0, 1), b2 + hstep, voffB); PG8_STAGE_A(PG8_SA(0, 0), last, last ? 0 : t + 2, 0);
            PG8_WAIT_V(8); PG8_WAIT_L(0); PG8_BAR; PG8_MMA(1, 0, At, B0); PG8_MMA(1, 1, At, B1); PG8_BAR; PG8_SCHED;
            PG8_LDB(B0, 1, 0); PG8_LDB(B1, 1, 1); PG8_SCHED; PG8_LDA(At, 1, 0); PG8_STAGE_A(PG8_SA(0, 1), last, last ? 0 : t + 2, 1);
            PG8_WAIT_V(8); PG8_WAIT_L(0); PG8_BAR; PG8_MMA(0, 0, At, B0); PG8_MMA(0, 1, At, B1); PG8_BAR; PG8_SCHED;
            PG8_LDA(At, 1, 1); PG8_STAGE(PG8_SB(1, 0), b3, voffB); PG8_STAGE(PG8_SB(1, 1), b3 + hstep, voffB); PG8_STAGE_A(PG8_SA(1, 0), last, last ? 1 : t + 3, 0);
            PG8_WAIT_V(8); PG8_WAIT_L(0); PG8_BAR; PG8_MMA(1, 0, At, B0); PG8_MMA(1, 1, At, B1); PG8_BAR; PG8_SCHED;
            } else {
            PG8_LDB(B0, 0, 0); PG8_SCHED; PG8_LDA(At, 0, 0); PG8_STAGE(PG8_SA(1, 1), a1 + hstep, voffA);
            PG8_WAIT_L(8); PG8_BAR; PG8_WAIT_L(0); PG8_MMA(0, 0, At, B0); PG8_BAR; PG8_SCHED;
            PG8_LDB(B1, 0, 1); PG8_STAGE(PG8_SB(0, 0), b2, voffB);
            PG8_BAR; PG8_WAIT_L(0); PG8_MMA(0, 1, At, B1); PG8_BAR;
            PG8_LDA(At, 0, 1); PG8_STAGE(PG8_SA(0, 0), a2, voffA);
            PG8_BAR; PG8_WAIT_L(0); PG8_MMA(1, 0, At, B0); PG8_BAR; PG8_SCHED;
            PG8_STAGE(PG8_SB(0, 1), b2 + hstep, voffB);
            PG8_WAIT_V(6); PG8_BAR; PG8_MMA(1, 1, At, B1); PG8_BAR;
            PG8_LDB(B0, 1, 0); PG8_SCHED; PG8_LDA(At, 1, 0); PG8_STAGE(PG8_SA(0, 1), a2 + hstep, voffA);
            PG8_WAIT_L(8); PG8_BAR; PG8_WAIT_L(0); PG8_MMA(0, 0, At, B0); PG8_BAR; PG8_SCHED;
            PG8_LDB(B1, 1, 1); PG8_STAGE(PG8_SB(1, 0), b3, voffB);
            PG8_BAR; PG8_WAIT_L(0); PG8_MMA(0, 1, At, B1); PG8_BAR;
            PG8_LDA(At, 1, 1); PG8_STAGE(PG8_SA(1, 0), a3, voffA);
            PG8_BAR; PG8_WAIT_L(0); PG8_MMA(1, 0, At, B0); PG8_BAR; PG8_SCHED;
            PG8_STAGE(PG8_SB(1, 1), b3 + hstep, voffB);
            PG8_WAIT_V(6); PG8_BAR; PG8_MMA(1, 1, At, B1); PG8_BAR;
            }
        }
        if constexpr (ALIGN_EPI) { if (wr == 0) PG8_BAR; }
        if constexpr (!Epi::AFTER_DRAIN) { E(acc, cur, wr, wc, fr, fq); S.done(cur); }
        if (!has_next) break;
#pragma unroll
        for (int a = 0; a < 2; ++a)
#pragma unroll
            for (int b = 0; b < 2; ++b)
#pragma unroll
                for (int m = 0; m < 4; ++m)
#pragma unroll
                    for (int n = 0; n < 2; ++n) acc[a][b][m][n] = (f32x4){0.f, 0.f, 0.f, 0.f};
        cur = nxt; cA = nA; cB = nB; ++ui;
        if constexpr (GATH) {
#pragma unroll
            for (int h = 0; h < 2; ++h)
#pragma unroll
                for (int i = 0; i < 2; ++i) goff[h][i] = ngoff[h][i];
        }
        if constexpr (ALIGN_EPI) { if (wr == 1) PG8_BAR; }
    }
    PG8_WAIT_V(0);
    if constexpr (!ALIGN_EPI) { if (wr == 0) PG8_BAR; }
    PG8_BAR;
    if constexpr (Epi::AFTER_DRAIN) { E.fused(acc, cur, wr, wc, fr, fq, lds, wid, lane); S.done(cur); }
#undef PG8_SA
#undef PG8_SB
#undef PG8_STAGE
#undef PG8_STAGE_A
#undef PG8_LDA
#undef PG8_LDB
#undef PG8_MMA
#undef PG8_WAIT_V
#undef PG8_WAIT_L
#undef PG8_BAR
#undef PG8_SCHED
}
}


struct TileOrder {
    int nunits, G, c, npm, npn, pn_gs, pm_gs, pm_off, blk48 = 0;
    DEVI bool next(int i, pg8::Unit& u) const {
        const int L = i * G + c; if (L >= nunits) return false;
        const int per = npm * npn, e = L / per, v = L - e * per; int pml = v / npn, pnl = v - pml * npn;
        if (blk48 && v < 256) { const int blk = v >> 5, w = v & 31; pml = (blk >> 1) * 4 + (w >> 3); pnl = (blk & 1) * 8 + (w & 7); }
        u.pm = e * pm_gs + pm_off + pml; u.pn = e * pn_gs + pnl; return true;
    }
    DEVI void a_ready(const pg8::Unit&) const {}
    DEVI void done(const pg8::Unit&) const {}
};

struct Epi8Inproj { static constexpr bool PERM = false, AFTER_DRAIN = false;
    bf16_t* QK; bf16_t* VT; bf16_t* UG; const float* rope;
    DEVI void operator()(const f32x4 (&acc)[2][2][4][2], const pg8::Unit& u, int wr, int wc, int fr, int fq) const {
        const int pn = u.pn;
#pragma unroll
        for (int ai = 0; ai < 2; ++ai)
#pragma unroll
            for (int m = 0; m < 4; ++m) {
                const int r = u.pm * 256 + ai * 128 + wr * 64 + m * 16 + fr, b = r / LP, p = r - b * LP; const bool latent = p >= CTXL; const int t = p - CTXL;
#pragma unroll
                for (int bj = 0; bj < 2; ++bj) {
                    const int cb = bj * 128 + wc * 32;
                    if (pn < 4) {
                        const int head = cb >> 6, dbase = cb & 63, pos = dbase == 0 ? (t >> 6) : (t & 63);
                        const float sc = pn < 2 ? QSCALE : 1.f;
                        f32x4 cs0 = {1.f, 0.f, 1.f, 0.f}, cs1 = {1.f, 0.f, 1.f, 0.f};
                        if (latent) { cs0 = *(const f32x4*)(rope + (pos * 16 + 4 * fq) * 2); cs1 = *(const f32x4*)(rope + (pos * 16 + 4 * fq + 2) * 2); }
                        const float cc[4] = {cs0.x, cs0.z, cs1.x, cs1.z}, sn[4] = {cs0.y, cs0.w, cs1.y, cs1.w};
                        bf16_t* dst = QK + ((size_t)((pn * NB + b) * NH + head) * LP + p) * 64 + dbase + 4 * fq;
#pragma unroll
                        for (int n = 0; n < 2; ++n) {
                            float o[4];
#pragma unroll
                            for (int j = 0; j < 4; ++j) { const float x = acc[ai][bj][m][n][j], y = acc[ai][bj][m][n ^ 1][j]; o[j] = (n == 0 ? x * cc[j] - y * sn[j] : x * cc[j] + y * sn[j]) * sc; }
                            u32x2 w; w.x = pk2(o[0], o[1]); w.y = pk2(o[2], o[3]);
                            *(u32x2*)(dst + 16 * n) = w;
                        }
                    } else if (pn < 6) {
                        const int cv = (pn - 4) * 256 + cb, head = cv >> 7, dv0 = (cv & 127) + 4 * fq;
                        const int pp = (p & ~15) | perm16(p & 15);
                        bf16_t* dst = VT + ((size_t)(b * NH + head) * 128 + dv0) * LP + pp;
#pragma unroll
                        for (int n = 0; n < 2; ++n)
#pragma unroll
                            for (int j = 0; j < 4; ++j) dst[(size_t)(16 * n + j) * LP] = f2bf(acc[ai][bj][m][n][j]);
                    } else {
                        const int ch0 = (pn - 6) * 256 + cb;
                        bf16_t* dst = UG + (size_t)chunk_row(b, p >> 4) * 512 + (p & 15) * 16 + 4 * fq;
#pragma unroll
                        for (int n = 0; n < 2; ++n) {
                            const int g = (ch0 + 16 * n) >> 4;
                            u32x2 w; w.x = pk2(acc[ai][bj][m][n][0], acc[ai][bj][m][n][1]); w.y = pk2(acc[ai][bj][m][n][2], acc[ai][bj][m][n][3]);
                            *(u32x2*)(dst + (size_t)g * NCHP * 512) = w;
                        }
                    }
                }
            }
    }
};

struct Epi8Out { static constexpr bool PERM = true, AFTER_DRAIN = false;
    bf16_t* X; const float* mod;
    DEVI void operator()(const f32x4 (&acc)[2][2][4][2], const pg8::Unit& u, int wr, int wc, int fr, int fq) const {
#pragma unroll
        for (int ai = 0; ai < 2; ++ai)
#pragma unroll
            for (int m = 0; m < 4; ++m) {
                const int r = u.pm * 256 + ai * 128 + wr * 64 + m * 16 + fr, b = r / LP, p = r - b * LP, jm = p < CTXL ? 8 : b;
                const float* g1 = mod + (size_t)jm * 6144 + 2 * 1024;
#pragma unroll
                for (int bj = 0; bj < 2; ++bj) {
                    const int c = u.pn * 256 + bj * 128 + wc * 32 + 8 * fq;
                    bf16_t* xp = X + (size_t)r * 1024 + c;
                    const u32x4 xw = *(const u32x4*)xp;
                    const f32x4 g0 = *(const f32x4*)(g1 + c), g4 = *(const f32x4*)(g1 + c + 4);
                    const f32x4 o0 = hf4((u32x2){xw.x, xw.y}) + g0 * acc[ai][bj][m][0], o1 = hf4((u32x2){xw.z, xw.w}) + g4 * acc[ai][bj][m][1];
                    u32x4 w; w.x = hpk2(o0.x, o0.y); w.y = hpk2(o0.z, o0.w); w.z = hpk2(o1.x, o1.y); w.w = hpk2(o1.z, o1.w);
                    *(u32x4*)xp = w;
                }
            }
    }
};

struct Epi8Moe1 { static constexpr bool PERM = true, AFTER_DRAIN = false;
    bf16_t* HG;
    DEVI void operator()(const f32x4 (&acc)[2][2][4][2], const pg8::Unit& u, int wr, int wc, int fr, int fq) const {
        const int t = u.pn & 15;
#pragma unroll
        for (int ai = 0; ai < 2; ++ai)
#pragma unroll
            for (int m = 0; m < 4; ++m) {
                const size_t row = (size_t)u.pm * 256 + ai * 128 + wr * 64 + m * 16 + fr;
                float o[8];
#pragma unroll
                for (int n = 0; n < 2; ++n)
#pragma unroll
                    for (int j = 0; j < 4; ++j) { const float a1 = acc[ai][0][m][n][j], a3 = acc[ai][1][m][n][j]; o[4 * n + j] = a1 * sigmoidf_(a1) * a3; }
                u32x4 w; w.x = pk2(o[0], o[1]); w.y = pk2(o[2], o[3]); w.z = pk2(o[4], o[5]); w.w = pk2(o[6], o[7]);
                *(u32x4*)(HG + row * FF + t * 128 + wc * 32 + 8 * fq) = w;
            }
    }
};

struct Epi8Moe2 { static constexpr bool PERM = true, AFTER_DRAIN = false;
    bf16_t* OG; const float* gate;
    DEVI void operator()(const f32x4 (&acc)[2][2][4][2], const pg8::Unit& u, int wr, int wc, int fr, int fq) const {
        const int t = u.pn & 3;
#pragma unroll
        for (int ai = 0; ai < 2; ++ai)
#pragma unroll
            for (int m = 0; m < 4; ++m) {
                const size_t row = (size_t)u.pm * 256 + ai * 128 + wr * 64 + m * 16 + fr; const float gt = gate[row];
#pragma unroll
                for (int bj = 0; bj < 2; ++bj) {
                    const f32x4 a = acc[ai][bj][m][0] * gt, c = acc[ai][bj][m][1] * gt;
                    u32x4 w; w.x = pk2(a.x, a.y); w.y = pk2(a.z, a.w); w.z = pk2(c.x, c.y); w.w = pk2(c.z, c.w);
                    *(u32x4*)(OG + row * 1024 + t * 256 + bj * 128 + wc * 32 + 8 * fq) = w;
                }
            }
    }
};

struct Epi8S1 { static constexpr bool PERM = true, AFTER_DRAIN = false;
    unsigned short* E;
    DEVI void operator()(const f32x4 (&acc)[2][2][4][2], const pg8::Unit& u, int wr, int wc, int fr, int fq) const {
        const int g = u.pn, r0 = (u.pm - g * 9) * 256 + wr * 64 + fr;
#pragma unroll
        for (int ai = 0; ai < 2; ++ai)
#pragma unroll
            for (int m = 0; m < 4; ++m) {
                const int cr = r0 + ai * 128 + m * 16;
                if (cr < NCH) {
                    unsigned short* dst = E + ((size_t)g * NCHP + cr) * 256 + wc * 32 + 8 * fq;
#pragma unroll
                    for (int bj = 0; bj < 2; ++bj) {
                        const f32x4 a = acc[ai][bj][m][0], d = acc[ai][bj][m][1];
                        u32x4 w; w.x = hpk2(a.x, a.y); w.y = hpk2(a.z, a.w); w.z = hpk2(d.x, d.y); w.w = hpk2(d.z, d.w);
                        *(u32x4*)(dst + bj * 128) = w;
                    }
                }
            }
    }
};
struct Epi8S2 { static constexpr bool PERM = true, AFTER_DRAIN = false;
    bf16_t* YG;
    DEVI void operator()(const f32x4 (&acc)[2][2][4][2], const pg8::Unit& u, int wr, int wc, int fr, int fq) const {
        const int g = u.pn, r0 = (u.pm - g * 9) * 256 + wr * 64 + fr;
#pragma unroll
        for (int ai = 0; ai < 2; ++ai)
#pragma unroll
            for (int m = 0; m < 4; ++m) {
                const int cr = r0 + ai * 128 + m * 16;
                if (cr < NCH) {
                    const size_t tok0 = (size_t)chunk_row_token(cr);
#pragma unroll
                    for (int bj = 0; bj < 2; ++bj) {
                        const int col = bj * 128 + wc * 32 + 8 * fq, j = col >> 4, h = col & 15;
                        const f32x4 a = acc[ai][bj][m][0], d = acc[ai][bj][m][1];
                        u32x4 w; w.x = pk2(gelu_tanh(a.x), gelu_tanh(a.y)); w.y = pk2(gelu_tanh(a.z), gelu_tanh(a.w)); w.z = pk2(gelu_tanh(d.x), gelu_tanh(d.y)); w.w = pk2(gelu_tanh(d.z), gelu_tanh(d.w));
                        *(u32x4*)(YG + (tok0 + j) * 512 + g * 16 + h) = w;
                    }
                }
            }
    }
};
struct Epi8Glu { static constexpr bool PERM = true, AFTER_DRAIN = false;
    const bf16_t* YG; bf16_t* MIX; const float* bglu;
    DEVI void operator()(const f32x4 (&acc)[2][2][4][2], const pg8::Unit& u, int wr, int wc, int fr, int fq) const {
#pragma unroll
        for (int ai = 0; ai < 2; ++ai)
#pragma unroll
            for (int m = 0; m < 4; ++m) {
                const size_t tok = (size_t)u.pm * 256 + ai * 128 + wr * 64 + m * 16 + fr;
#pragma unroll
                for (int bj = 0; bj < 2; ++bj) {
                    const int n0 = u.pn * 256 + bj * 128 + wc * 32 + 8 * fq;
                    const u32x4 y = *(const u32x4*)(YG + tok * 512 + n0);
                    const f32x4 b0 = *(const f32x4*)(bglu + n0), b1 = *(const f32x4*)(bglu + n0 + 4);
                    const f32x4 a = acc[ai][bj][m][0] + b0, d = acc[ai][bj][m][1] + b1;
                    u32x4 w; w.x = pk2(bflo(y.x) * sigmoidf_(a.x), bfhi(y.x) * sigmoidf_(a.y)); w.y = pk2(bflo(y.y) * sigmoidf_(a.z), bfhi(y.y) * sigmoidf_(a.w));
                    w.z = pk2(bflo(y.z) * sigmoidf_(d.x), bfhi(y.z) * sigmoidf_(d.y)); w.w = pk2(bflo(y.w) * sigmoidf_(d.z), bfhi(y.w) * sigmoidf_(d.w));
                    *(u32x4*)(MIX + tok * 1024 + 512 + n0) = w;
                }
            }
    }
};

struct Params {
    const float* in[30];
    float* out;
    unsigned char* ws;
    int lo, hi;
};

DEVI int swz(int row, int kc) { return row * 128 + ((kc ^ ((row >> 1) & 7)) << 4); }

struct APlain { const bf16_t* A; int lda; DEVI const bf16_t* ptr(int row, int k) const { return A + (size_t)row * lda + k; } };
struct AS2 { const bf16_t* U; const bf16_t* S; DEVI const bf16_t* ptr(int row, int k) const { return (k < 256 ? U : S) + (size_t)row * 8192 + (k & 255); } };

template <int BM, class AF, class Epi>
DEVI void gemm_unit(char* lds, const AF& af, const bf16_t* __restrict__ Bt, int ldb, int K, int m0, int n0, const Epi& epi) {
    constexpr int MT = BM / 128, ACH = BM / 64, A_BYTES = BM * 128, STAGE = A_BYTES + 16384, WM = BM / 4;
    const int tid = tid_l(), lane = tid & 63, wid = tid >> 6, wm = wid >> 1, wn = wid & 1, r32 = lane & 31, hi = lane >> 5;
    f32x16 acc[MT][2];
#pragma unroll
    for (int a = 0; a < MT; ++a)
#pragma unroll
        for (int b = 0; b < 2; ++b)
#pragma unroll
            for (int i = 0; i < 16; ++i) acc[a][b][i] = 0.f;
    u32x4 ra[ACH], rb[2];
    const int nk = K >> 6;
    const int crow = tid >> 3, ckc = tid & 7;
#define G_LOAD(kt) do { \
        _Pragma("unroll") for (int i = 0; i < ACH; ++i) ra[i] = *(const u32x4*)af.ptr(m0 + crow + 64 * i, (kt) * 64 + ckc * 8); \
        _Pragma("unroll") for (int i = 0; i < 2; ++i) rb[i] = *(const u32x4*)(Bt + (size_t)(n0 + crow + 64 * i) * ldb + (kt) * 64 + ckc * 8); } while (0)
#define G_STORE(s) do { char* _a = lds + (s) * STAGE; char* _b = _a + A_BYTES; \
        _Pragma("unroll") for (int i = 0; i < ACH; ++i) *(u32x4*)(_a + swz(crow + 64 * i, ckc)) = ra[i]; \
        _Pragma("unroll") for (int i = 0; i < 2; ++i) *(u32x4*)(_b + swz(crow + 64 * i, ckc)) = rb[i]; } while (0)
    G_LOAD(0); G_STORE(0); __syncthreads();
    for (int kt = 0; kt < nk; ++kt) {
        if (kt + 1 < nk) G_LOAD(kt + 1);
        const char* a = lds + (kt & 1) * STAGE; const char* b = a + A_BYTES;
#pragma unroll
        for (int ks = 0; ks < 4; ++ks) {
            bf16x8 wf[2], xf[MT];
#pragma unroll
            for (int nt = 0; nt < 2; ++nt) wf[nt] = *(const bf16x8*)(b + swz(wn * 64 + nt * 32 + r32, ks * 2 + hi));
#pragma unroll
            for (int mt = 0; mt < MT; ++mt) xf[mt] = *(const bf16x8*)(a + swz(wm * WM + mt * 32 + r32, ks * 2 + hi));
#pragma unroll
            for (int mt = 0; mt < MT; ++mt)
#pragma unroll
                for (int nt = 0; nt < 2; ++nt) acc[mt][nt] = MFMA32(wf[nt], xf[mt], acc[mt][nt]);
        }
        if (kt + 1 < nk) G_STORE((kt + 1) & 1);
        __syncthreads();
    }
#undef G_LOAD
#undef G_STORE
    epi.template run<MT>(acc, m0 + wm * WM + r32, n0 + wn * 64, hi);
}

template <class AF, class Epi>
DEVI void gemm_unit_dma(char* lds, const AF& af, const bf16_t* __restrict__ Bt, int ldb, int K, int m0, int n0, const Epi& epi) {
    const int tid = tid_l(), lane = tid & 63, wid = tid >> 6, wm = wid >> 1, wn = wid & 1, r32 = lane & 31, hi = lane >> 5;
    f32x16 acc[1][2];
#pragma unroll
    for (int b = 0; b < 2; ++b)
#pragma unroll
        for (int i = 0; i < 16; ++i) acc[0][b][i] = 0.f;
    const int nk = K >> 6;
    const int drow0 = wid * 16 + (lane >> 3), drow1 = drow0 + 8;
    const int kc0 = (lane & 7) ^ ((drow0 >> 1) & 7), kc1 = (lane & 7) ^ ((drow1 >> 1) & 7);
    const bf16_t* ga0 = af.ptr(m0 + drow0, kc0 * 8); const bf16_t* ga1 = af.ptr(m0 + drow1, kc1 * 8);
    const bf16_t* gb0 = Bt + (size_t)(n0 + drow0) * ldb + kc0 * 8; const bf16_t* gb1 = Bt + (size_t)(n0 + drow1) * ldb + kc1 * 8;
    LAS unsigned char* dl = (LAS unsigned char*)lds + wid * 2048;
#define GD_LDS(g, off) __builtin_amdgcn_global_load_lds((const unsigned*)(g), (LAS unsigned*)(dl + (off)), 16, 0, 0)
#define GD_ISSUE(kt) do { const int _s = ((kt) & 3) * 32768; GD_LDS(ga0 + (kt) * 64, _s); GD_LDS(ga1 + (kt) * 64, _s + 1024); GD_LDS(gb0 + (kt) * 64, _s + 16384); GD_LDS(gb1 + (kt) * 64, _s + 16384 + 1024); } while (0)
#define GD_WAITBAR(N) asm volatile("s_waitcnt vmcnt(" #N ") lgkmcnt(0)\n\ts_barrier" ::: "memory")
    GD_ISSUE(0); GD_ISSUE(1); GD_ISSUE(2);
    for (int kt = 0; kt < nk; ++kt) {
        if (kt + 2 < nk) GD_WAITBAR(8); else if (kt + 1 < nk) GD_WAITBAR(4); else GD_WAITBAR(0);
        if (kt + 3 < nk) GD_ISSUE(kt + 3);
        const char* a = lds + (kt & 3) * 32768; const char* b = a + 16384;
#pragma unroll
        for (int ks = 0; ks < 4; ++ks) {
            bf16x8 wf[2], xf;
#pragma unroll
            for (int nt = 0; nt < 2; ++nt) wf[nt] = *(const bf16x8*)(b + swz(wn * 64 + nt * 32 + r32, ks * 2 + hi));
            xf = *(const bf16x8*)(a + swz(wm * 32 + r32, ks * 2 + hi));
#pragma unroll
            for (int nt = 0; nt < 2; ++nt) acc[0][nt] = MFMA32(wf[nt], xf, acc[0][nt]);
        }
    }
#undef GD_LDS
#undef GD_ISSUE
#undef GD_WAITBAR
    __syncthreads();
    epi.template run<1>(acc, m0 + wm * 32 + r32, n0 + wn * 64, hi);
}


struct EpiInproj {
    bf16_t* QK; bf16_t* VT; bf16_t* UG; const float* rope;
    template <int MT> DEVI void run(const f32x16 (&acc)[MT][2], int mrow0, int ncol0, int hi) const {
#pragma unroll
        for (int mt = 0; mt < MT; ++mt) {
            const int r = mrow0 + mt * 32, b = r / LP, p = r - b * LP; const bool latent = p >= CTXL; const int t = p - CTXL;
#pragma unroll
            for (int nt = 0; nt < 2; ++nt) {
                const int nb = ncol0 + nt * 32; const f32x16& v = acc[mt][nt];
                if (nb < 1024) {
                    const int which = nb >> 8, head = (nb >> 6) & 3, dbase = nb & 63;
                    const int pos = dbase == 0 ? (t >> 6) : (t & 63);
                    bf16_t* dst = QK + ((size_t)((which * NB + b) * NH + head) * LP + p) * 64 + dbase + 4 * hi;
                    const float sc = which < 2 ? QSCALE : 1.f;
#pragma unroll
                    for (int i4 = 0; i4 < 4; ++i4) {
                        float o[4];
#pragma unroll
                        for (int j = 0; j < 4; ++j) {
                            float x = v[4 * i4 + j];
                            if (latent) {
                                const float y = v[4 * (i4 ^ 2) + j];
                                const f32x2 cs = *(const f32x2*)(rope + (pos * 16 + 8 * (i4 & 1) + 4 * hi + j) * 2);
                                x = (i4 < 2) ? (x * cs.x - y * cs.y) : (x * cs.x + y * cs.y);
                            }
                            o[j] = x * sc;
                        }
                        u32x2 w; w.x = pk2(o[0], o[1]); w.y = pk2(o[2], o[3]);
                        *(u32x2*)(dst + 8 * i4) = w;
                    }
                } else if (nb < 1536) {
                    const int n1 = nb - 1024, head = n1 >> 7, dv0 = n1 & 127;
                    const int pp = (p & ~15) | perm16(p & 15);
                    bf16_t* dst = VT + ((size_t)(b * NH + head) * 128 + dv0 + 4 * hi) * LP + pp;
#pragma unroll
                    for (int i = 0; i < 16; ++i) dst[(size_t)((i & 3) + 8 * (i >> 2)) * LP] = f2bf(v[i]);
                } else {
                    const int n1 = nb - 1536;
                    bf16_t* dst = UG + (size_t)chunk_row(b, p >> 4) * 512 + (p & 15) * 16;
#pragma unroll
                    for (int i4 = 0; i4 < 4; ++i4) {
                        const int ch = n1 + 8 * i4 + 4 * hi, g = ch >> 4, hc = ch & 15;
                        u32x2 w; w.x = pk2(v[4 * i4], v[4 * i4 + 1]); w.y = pk2(v[4 * i4 + 2], v[4 * i4 + 3]);
                        *(u32x2*)(dst + (size_t)g * NCHP * 512 + hc) = w;
                    }
                }
            }
        }
    }
};

struct EpiS1 {
    unsigned short* E;
    template <int MT> DEVI void run(const f32x16 (&acc)[MT][2], int mrow0, int ncol0, int hi) const {
#pragma unroll
        for (int mt = 0; mt < MT; ++mt) {
            unsigned short* dst = E + (size_t)(mrow0 + mt * 32) * 256 + ncol0 + 4 * hi;
#pragma unroll
            for (int nt = 0; nt < 2; ++nt)
#pragma unroll
                for (int i4 = 0; i4 < 4; ++i4) {
                    u32x2 w; w.x = hpk2(acc[mt][nt][4 * i4], acc[mt][nt][4 * i4 + 1]); w.y = hpk2(acc[mt][nt][4 * i4 + 2], acc[mt][nt][4 * i4 + 3]);
                    *(u32x2*)(dst + nt * 32 + 8 * i4) = w;
                }
        }
    }
};

struct EpiS2 {
    bf16_t* YG; int g;
    template <int MT> DEVI void run(const f32x16 (&acc)[MT][2], int mrow0, int ncol0, int hi) const {
#pragma unroll
        for (int mt = 0; mt < MT; ++mt) {
            const size_t tok0 = (size_t)chunk_row_token(mrow0 + mt * 32);
#pragma unroll
            for (int nt = 0; nt < 2; ++nt)
#pragma unroll
                for (int i4 = 0; i4 < 4; ++i4) {
                    const int n = ncol0 + nt * 32 + 8 * i4 + 4 * hi, j = n >> 4, h = n & 15;
                    u32x2 w; w.x = pk2(gelu_tanh(acc[mt][nt][4 * i4]), gelu_tanh(acc[mt][nt][4 * i4 + 1]));
                    w.y = pk2(gelu_tanh(acc[mt][nt][4 * i4 + 2]), gelu_tanh(acc[mt][nt][4 * i4 + 3]));
                    *(u32x2*)(YG + (tok0 + j) * 512 + g * 16 + h) = w;
                }
        }
    }
};

struct EpiGlu {
    const bf16_t* YG; bf16_t* MIX; const float* bglu;
    template <int MT> DEVI void run(const f32x16 (&acc)[MT][2], int mrow0, int ncol0, int hi) const {
#pragma unroll
        for (int mt = 0; mt < MT; ++mt) {
            const size_t tok = mrow0 + mt * 32;
#pragma unroll
            for (int nt = 0; nt < 2; ++nt)
#pragma unroll
                for (int i4 = 0; i4 < 4; ++i4) {
                    const int n = ncol0 + nt * 32 + 8 * i4 + 4 * hi;
                    const u32x2 y = *(const u32x2*)(YG + tok * 512 + n);
                    const f32x4 bb = *(const f32x4*)(bglu + n);
                    const float o0 = bflo(y.x) * sigmoidf_(acc[mt][nt][4 * i4] + bb.x), o1 = bfhi(y.x) * sigmoidf_(acc[mt][nt][4 * i4 + 1] + bb.y);
                    const float o2 = bflo(y.y) * sigmoidf_(acc[mt][nt][4 * i4 + 2] + bb.z), o3 = bfhi(y.y) * sigmoidf_(acc[mt][nt][4 * i4 + 3] + bb.w);
                    u32x2 w; w.x = pk2(o0, o1); w.y = pk2(o2, o3);
                    *(u32x2*)(MIX + tok * 1024 + 512 + n) = w;
                }
        }
    }
};

struct EpiOut {
    bf16_t* X; const float* mod;
    template <int MT> DEVI void run(const f32x16 (&acc)[MT][2], int mrow0, int ncol0, int hi) const {
#pragma unroll
        for (int mt = 0; mt < MT; ++mt) {
            const int r = mrow0 + mt * 32, b = r / LP, p = r - b * LP, j = p < CTXL ? 8 : b;
            const float* g1 = mod + (size_t)j * 6144 + 2 * 1024;
#pragma unroll
            for (int nt = 0; nt < 2; ++nt)
#pragma unroll
                for (int i4 = 0; i4 < 4; ++i4) {
                    const int n = ncol0 + nt * 32 + 8 * i4 + 4 * hi;
                    bf16_t* xp = X + (size_t)r * 1024 + n;
                    f32x4 x = hf4(*(const u32x2*)xp); const f32x4 g = *(const f32x4*)(g1 + n);
                    x.x += g.x * acc[mt][nt][4 * i4]; x.y += g.y * acc[mt][nt][4 * i4 + 1]; x.z += g.z * acc[mt][nt][4 * i4 + 2]; x.w += g.w * acc[mt][nt][4 * i4 + 3];
                    u32x2 w; w.x = hpk2(x.x, x.y); w.y = hpk2(x.z, x.w);
                    *(u32x2*)xp = w;
                }
        }
    }
};

struct EpiMoe1 {
    bf16_t* HG;
    template <int MT> DEVI void run(const f32x16 (&acc)[MT][2], int mrow0, int ncol0, int hi) const {
#pragma unroll
        for (int mt = 0; mt < MT; ++mt) {
            bf16_t* dst = HG + (size_t)(mrow0 + mt * 32) * FF + (ncol0 >> 1) + 4 * hi;
#pragma unroll
            for (int i4 = 0; i4 < 4; ++i4) {
                float o[4];
#pragma unroll
                for (int j = 0; j < 4; ++j) { const float a1 = acc[mt][0][4 * i4 + j], a3 = acc[mt][1][4 * i4 + j]; o[j] = a1 * sigmoidf_(a1) * a3; }
                u32x2 w; w.x = pk2(o[0], o[1]); w.y = pk2(o[2], o[3]);
                *(u32x2*)(dst + 8 * i4) = w;
            }
        }
    }
};

struct EpiMoe2 {
    bf16_t* OG; const float* gate;
    template <int MT> DEVI void run(const f32x16 (&acc)[MT][2], int mrow0, int ncol0, int hi) const {
#pragma unroll
        for (int mt = 0; mt < MT; ++mt) {
            const int row = mrow0 + mt * 32; const float gt = gate[row];
            bf16_t* dst = OG + (size_t)row * 1024 + ncol0 + 4 * hi;
#pragma unroll
            for (int nt = 0; nt < 2; ++nt)
#pragma unroll
                for (int i4 = 0; i4 < 4; ++i4) {
                    u32x2 w; w.x = pk2(acc[mt][nt][4 * i4] * gt, acc[mt][nt][4 * i4 + 1] * gt); w.y = pk2(acc[mt][nt][4 * i4 + 2] * gt, acc[mt][nt][4 * i4 + 3] * gt);
                    *(u32x2*)(dst + nt * 32 + 8 * i4) = w;
                }
        }
    }
};

DEVI void transpose_unit(char* lds, const float* __restrict__ W, int K, int N, bf16_t* __restrict__ out, int k0, int n0, int mode  ) {
    float* tile = (float*)lds;
    const int tid = tid_l();
    f32x4 v[8];
#pragma unroll
    for (int i = 0; i < 8; ++i) { const int c = tid + 512 * i, k = c >> 6, n4 = (c & 63) * 4; v[i] = *(const f32x4*)(W + (size_t)(k0 + k) * N + n0 + n4); }
#pragma unroll
    for (int i = 0; i < 8; ++i) { const int c = tid + 512 * i, k = c >> 6, n4 = (c & 63) * 4; float* t = tile + k * 257 + n4; t[0] = v[i].x; t[1] = v[i].y; t[2] = v[i].z; t[3] = v[i].w; }
    __syncthreads();
#pragma unroll
    for (int i = 0; i < 4; ++i) {
        const int c = tid + 512 * i, n = c >> 3, k8 = (c & 7) * 8;
        float f[8];
#pragma unroll
        for (int j = 0; j < 8; ++j) f[j] = tile[(k8 + j) * 257 + n];
        u32x4 w; w.x = pk2(f[0], f[1]); w.y = pk2(f[2], f[3]); w.z = pk2(f[4], f[5]); w.w = pk2(f[6], f[7]);
        const int ng = n0 + n; const int orow = mode == 0 ? ng : ((ng >> 7) * 256 + (mode - 1) * 128 + (ng & 127));
        *(u32x4*)(out + (size_t)orow * K + k0 + k8) = w;
    }
    __syncthreads();
}

DEVI void adaln_unit(char* lds, const Params& P, int l, int n0) {
    float* sc = (float*)lds;
    float* red = sc + 9 * 1024;
    const int tid = tid_l(), lane = tid & 63, wid = tid >> 6;
    for (int i = tid; i < 9 * 1024; i += 512) { const float c = i < 8192 ? P.in[1][i] : P.in[3][i - 8192]; sc[i] = c * __builtin_amdgcn_rcpf(1.f + __expf(-c)); }
    __syncthreads();
    const float* W = P.in[4] + (size_t)l * 1024 * 6144 + n0 + lane;
    float a[9];
#pragma unroll
    for (int j = 0; j < 9; ++j) a[j] = 0.f;
    for (int kk = 0; kk < 128; kk += 16) {
        float w[16];
#pragma unroll
        for (int u = 0; u < 16; ++u) w[u] = W[(size_t)(wid * 128 + kk + u) * 6144];
#pragma unroll
        for (int u4 = 0; u4 < 4; ++u4)
#pragma unroll
            for (int j = 0; j < 9; ++j) { const f32x4 s4 = *(const f32x4*)(sc + j * 1024 + wid * 128 + kk + 4 * u4); a[j] += s4.x * w[4 * u4] + s4.y * w[4 * u4 + 1] + s4.z * w[4 * u4 + 2] + s4.w * w[4 * u4 + 3]; }
    }
#pragma unroll
    for (int j = 0; j < 9; ++j) red[(wid * 9 + j) * 64 + lane] = a[j];
    __syncthreads();
    for (int i = tid; i < 9 * 64; i += 512) {
        const int j = i >> 6, n = i & 63; float s = 0.f;
#pragma unroll
        for (int w = 0; w < 8; ++w) s += red[(w * 9 + j) * 64 + n];
        ((float*)(ptr_l(P.ws) + WS_MOD))[((size_t)l * 9 + j) * 6144 + n0 + n] = s + P.in[5][(size_t)l * 6144 + n0 + n];
    }
    __syncthreads();
}

DEVI void ssm_tab_unit(char* lds, const Params& P, int l, int d, int g) {
    float* pw = (float*)lds;
    float* bb = pw + 64 * 17 * 2;
    float* cc = bb + 64 * 16 * 2;
    const int tid = tid_l();
    const size_t ldg = ((size_t)l * 2 + d) * 32 + g;
    const float dt = expf(P.in[16][ldg]);
    float* PW = (float*)(ptr_l(P.ws) + WS_PW) + ldg * 64 * 17 * 2;
    float* BB = (float*)(ptr_l(P.ws) + WS_BBAR) + ldg * 64 * 16 * 2;
    for (int i = tid; i < 64 * 17; i += 512) {
        const int p = i / 17, n = i - p * 17;
        const float lr = P.in[14][ldg * 64 + p], li = P.in[15][ldg * 64 + p];
        const float mag = expf(lr * dt * n); float s, c; sincosf(li * dt * n, &s, &c);
        pw[i * 2] = mag * c; pw[i * 2 + 1] = mag * s; PW[i * 2] = mag * c; PW[i * 2 + 1] = mag * s;
    }
    for (int i = tid; i < 64 * 16; i += 512) {
        const int p = i >> 4, h = i & 15;
        const float lr = P.in[14][ldg * 64 + p], li = P.in[15][ldg * 64 + p];
        const float mag = expf(lr * dt); float s, c; sincosf(li * dt, &s, &c);
        const float nr = mag * c - 1.f, ni = mag * s;
        const float den = lr * lr + li * li;
        const float qr = (nr * lr + ni * li) / den, qi = (ni * lr - nr * li) / den;
        const float br = P.in[17][(ldg * 64 + p) * 16 + h], bi = P.in[18][(ldg * 64 + p) * 16 + h];
        const float xr = qr * br - qi * bi, xi = qr * bi + qi * br;
        bb[i * 2] = xr; bb[i * 2 + 1] = xi; BB[i * 2] = xr; BB[i * 2 + 1] = xi;
    }
    for (int i = tid; i < 16 * 64; i += 512) { const int h = i >> 6, p = i & 63; cc[(h * 65 + p) * 2] = P.in[19][ldg * 1024 + i]; cc[(h * 65 + p) * 2 + 1] = P.in[20][ldg * 1024 + i]; }
    __syncthreads();
    float* KT = (float*)(ptr_l(P.ws) + WS_KTAB) + ldg * 4096;
    {
        const int dl = tid >> 5, h = (tid >> 1) & 15, hf = tid & 1;
        float sacc[8];
#pragma unroll
        for (int q = 0; q < 8; ++q) sacc[q] = 0.f;
        for (int p = 0; p < 64; ++p) {
            const f32x2 c = *(const f32x2*)(cc + (h * 65 + p) * 2), w = *(const f32x2*)(pw + (p * 17 + dl) * 2);
            const float tr = c.x * w.x - c.y * w.y, ti = c.x * w.y + c.y * w.x;
            const f32x4* bp = (const f32x4*)(bb + (p * 16 + hf * 8) * 2);
            const f32x4 b0 = bp[0], b1 = bp[1], b2 = bp[2], b3 = bp[3];
            sacc[0] += tr * b0.x - ti * b0.y; sacc[1] += tr * b0.z - ti * b0.w; sacc[2] += tr * b1.x - ti * b1.y; sacc[3] += tr * b1.z - ti * b1.w;
            sacc[4] += tr * b2.x - ti * b2.y; sacc[5] += tr * b2.z - ti * b2.w; sacc[6] += tr * b3.x - ti * b3.y; sacc[7] += tr * b3.z - ti * b3.w;
        }
        float* dst = KT + dl * 256 + h * 16 + hf * 8;
        *(f32x4*)dst = (f32x4){sacc[0], sacc[1], sacc[2], sacc[3]}; *(f32x4*)(dst + 4) = (f32x4){sacc[4], sacc[5], sacc[6], sacc[7]};
    }
    __syncthreads();
}

template <bool FIRST>
DEVI void rowpass1(const Params& P, int l) {
    const int tid = tid_l(), lane = tid & 63, wid = tid >> 6;
    bf16_t* X = (bf16_t*)(ptr_l(P.ws) + WS_X); bf16_t* HX = (bf16_t*)(ptr_l(P.ws) + WS_HX);
    const bf16_t* OG = (const bf16_t*)(ptr_l(P.ws) + WS_OG); const int* SLOT = (const int*)(ptr_l(P.ws) + WS_SLOT);
    const float* MOD = (const float*)(ptr_l(P.ws) + WS_MOD);
    const int stride = gridDim.x * 8;
    int r = blockIdx.x * 8 + wid;
    f32x4 xf[4]; u32x2 xb[4]; int svn = -1;
    auto issue = [&](int rr) {
        if constexpr (FIRST) {
            const int b = rr / LP, p = rr - b * LP;
            const float* src = p < CTXL ? P.in[2] + ((size_t)b * CTXL + p) * 1024 : P.in[0] + ((size_t)b * SEQ + (p - CTXL)) * 1024;
#pragma unroll
            for (int i = 0; i < 4; ++i) xf[i] = *(const f32x4*)(src + lane * 4 + 256 * i);
        } else {
#pragma unroll
            for (int i = 0; i < 4; ++i) xb[i] = *(const u32x2*)(X + (size_t)rr * 1024 + lane * 4 + 256 * i);
            svn = SLOT[(size_t)rr * 16 + (lane & 15)];
        }
    };
    if (r < R) issue(r);
    for (; r < R; r += stride) {
        const int b = r / LP, p = r - b * LP, j = p < CTXL ? 8 : b;
        f32x4 x[4]; const int sv = svn;
#pragma unroll
        for (int i = 0; i < 4; ++i) { if constexpr (FIRST) x[i] = xf[i]; else x[i] = hf4(xb[i]); }
        if (r + stride < R) issue(r + stride);
        if (l == DEPTH && p < CTXL) continue;
        if constexpr (!FIRST) {
            const float* g2 = MOD + ((size_t)(l - 1) * 9 + j) * 6144 + 5 * 1024;
            f32x4 m[4];
#pragma unroll
            for (int i = 0; i < 4; ++i) m[i] = (f32x4){0.f, 0.f, 0.f, 0.f};
            unsigned mask = (unsigned)__ballot(sv >= 0 && lane < 16) & 0xffffu;
            while (mask) {
                const int e0 = __builtin_ctz(mask); mask &= mask - 1;
                const int s0 = __builtin_amdgcn_readlane(sv, e0);
                const bool two = mask != 0u;
                const int e1 = two ? __builtin_ctz(mask) : e0; if (two) mask &= mask - 1;
                const int s1 = __builtin_amdgcn_readlane(sv, e1);
                const bf16_t* o0 = OG + ((size_t)e0 * ROWS_E + s0) * 1024 + lane * 4; const bf16_t* o1 = OG + ((size_t)e1 * ROWS_E + s1) * 1024 + lane * 4;
                u32x2 w0[4], w1[4];
#pragma unroll
                for (int i = 0; i < 4; ++i) { w0[i] = *(const u32x2*)(o0 + 256 * i); w1[i] = *(const u32x2*)(o1 + 256 * i); }
                const float f1 = two ? 1.f : 0.f;
#pragma unroll
                for (int i = 0; i < 4; ++i) m[i] += bf4(w0[i]) + f1 * bf4(w1[i]);
            }
#pragma unroll
            for (int i = 0; i < 4; ++i) { const f32x4 g = *(const f32x4*)(g2 + lane * 4 + 256 * i); x[i] += g * m[i]; }
        }
        float ss = 0.f;
#pragma unroll
        for (int i = 0; i < 4; ++i) ss += x[i].x * x[i].x + x[i].y * x[i].y + x[i].z * x[i].z + x[i].w * x[i].w;
        ss = wave_sum(ss);
        const float rstd = rsqrtf(ss * (1.f / 1024.f) + EPS);
        if (l < DEPTH) {
            const float* ng = P.in[6] + (size_t)l * 1024; const float* sh = MOD + ((size_t)l * 9 + j) * 6144; const float* scl = sh + 1024;
#pragma unroll
            for (int i = 0; i < 4; ++i) {
                const int c = lane * 4 + 256 * i;
                u32x2 xw; xw.x = hpk2(x[i].x, x[i].y); xw.y = hpk2(x[i].z, x[i].w);
                *(u32x2*)(X + (size_t)r * 1024 + c) = xw;
                const f32x4 g = *(const f32x4*)(ng + c), s1 = *(const f32x4*)(scl + c), s0 = *(const f32x4*)(sh + c);
                const f32x4 h = (x[i] * rstd * g) * (1.f + s1) + s0;
                u32x2 w; w.x = pk2(h.x, h.y); w.y = pk2(h.z, h.w);
                *(u32x2*)(HX + (size_t)r * 1024 + c) = w;
            }
        } else {
            float* o = P.out + ((size_t)b * SEQ + (p - CTXL)) * 1024;
#pragma unroll
            for (int i = 0; i < 4; ++i) { const int c = lane * 4 + 256 * i; const f32x4 g = *(const f32x4*)(P.in[29] + c); *(f32x4*)(o + c) = x[i] * rstd * g; }
        }
    }
}

DEVI float router_fold_softmax(const float (&pa)[16], int lane) {
    float q8[8], q4[4], q2[2];
#pragma unroll
    for (int i = 0; i < 8; ++i) { float r0, r1; swap32(pa[i], pa[i + 8], r0, r1); q8[i] = r0 + r1; }
#pragma unroll
    for (int i = 0; i < 4; ++i) { float r0, r1; swap16(q8[i], q8[i + 4], r0, r1); q4[i] = r0 + r1; }
    { const bool hb = (lane & 8) != 0;
#pragma unroll
      for (int i = 0; i < 2; ++i) { const float snd = hb ? q4[i] : q4[i + 2], kp = hb ? q4[i + 2] : q4[i]; q2[i] = kp + dppmov<0x128>(snd); } }
    float lg;
    { const bool hb = (lane & 4) != 0; const float snd = hb ? q2[0] : q2[1], kp = hb ? q2[1] : q2[0];
      const float up = dppmov<0x104>(snd), dn = dppmov<0x114>(snd);
      lg = kp + (hb ? dn : up); }
    lg += dppmov<0x4E>(lg); lg += dppmov<0xB1>(lg);
    float mx = fmaxf(lg, dppmov<0x124>(lg)); mx = fmaxf(mx, dppmov<0x128>(mx));
    { float r0, r1; swap16(mx, mx, r0, r1); mx = fmaxf(r0, r1); swap32(mx, mx, r0, r1); mx = fmaxf(r0, r1); }
    const float ex = expf(lg - mx);
    float sum = ex + dppmov<0x124>(ex); sum += dppmov<0x128>(sum);
    { float r0, r1; swap16(sum, sum, r0, r1); sum = r0 + r1; swap32(sum, sum, r0, r1); sum = r0 + r1; }
    return ex / sum;
}
DEVI void rowpass2(char* lds, const Params& P, int l) {
    const int tid = tid_l(), lane = tid & 63, wid = tid >> 6;
    float* wrT = (float*)lds;
    const float* wr = P.in[25] + (size_t)l * 1024 * 16;
    for (int i = tid; i < 16384; i += 512) { const int k = i >> 4, e = i & 15; wrT[e * 1024 + k] = wr[i]; }
    __syncthreads();
    const bf16_t* X = (const bf16_t*)(ptr_l(P.ws) + WS_X); bf16_t* HX = (bf16_t*)(ptr_l(P.ws) + WS_HX);
    const float* MOD = (const float*)(ptr_l(P.ws) + WS_MOD); float* AFFT = (float*)(ptr_l(P.ws) + WS_AFFT);
    const float* ng = P.in[7] + (size_t)l * 1024;
    const int stride = gridDim.x * 8;
    int r = blockIdx.x * 8 + wid;
    u32x2 xn[2][4];
#pragma unroll
    for (int q = 0; q < 2; ++q) if (r + q * stride < R) {
#pragma unroll
        for (int i = 0; i < 4; ++i) xn[q][i] = *(const u32x2*)(X + (size_t)(r + q * stride) * 1024 + lane * 4 + 256 * i);
    }
    for (; r < R; r += 2 * stride) {
        const bool two = r + stride < R;
        f32x4 h[2][4]; int bb[2], pp[2];
#pragma unroll
        for (int q = 0; q < 2; ++q) {
            const int rq = (q == 0 || two) ? r + q * stride : r;
            const int b = rq / LP, p = rq - b * LP, j = p < CTXL ? 8 : b; bb[q] = b; pp[q] = p;
            float ss = 0.f;
#pragma unroll
            for (int i = 0; i < 4; ++i) { h[q][i] = hf4(xn[q][i]); ss += h[q][i].x * h[q][i].x + h[q][i].y * h[q][i].y + h[q][i].z * h[q][i].z + h[q][i].w * h[q][i].w; }
            ss = wave_sum(ss);
            const float rstd = rsqrtf(ss * (1.f / 1024.f) + EPS);
            const float* sh = MOD + ((size_t)l * 9 + j) * 6144 + 3 * 1024; const float* scl = sh + 1024;
#pragma unroll
            for (int i = 0; i < 4; ++i) {
                const int c = lane * 4 + 256 * i;
                const f32x4 g = *(const f32x4*)(ng + c), s1 = *(const f32x4*)(scl + c), s0 = *(const f32x4*)(sh + c);
                h[q][i] = (h[q][i] * rstd * g) * (1.f + s1) + s0;
                if (q == 0 || two) { u32x2 w; w.x = pk2(h[q][i].x, h[q][i].y); w.y = pk2(h[q][i].z, h[q][i].w); *(u32x2*)(HX + (size_t)rq * 1024 + c) = w; }
            }
        }
#pragma unroll
        for (int q = 0; q < 2; ++q) if (r + (2 + q) * stride < R) {
#pragma unroll
            for (int i = 0; i < 4; ++i) xn[q][i] = *(const u32x2*)(X + (size_t)(r + (2 + q) * stride) * 1024 + lane * 4 + 256 * i);
        }
        float pa[2][16];
#pragma unroll
        for (int eg = 0; eg < 4; ++eg) {
#pragma unroll
            for (int e = 4 * eg; e < 4 * eg + 4; ++e) {
                f32x2 s0 = {0.f, 0.f}, s1 = {0.f, 0.f};
#pragma unroll
                for (int i = 0; i < 4; ++i) { const f32x4 w = *(const f32x4*)(wrT + e * 1024 + lane * 4 + 256 * i);
                    const f32x2 wl = __builtin_shufflevector(w, w, 0, 1), wh = __builtin_shufflevector(w, w, 2, 3);
                    s0 = __builtin_elementwise_fma(__builtin_shufflevector(h[0][i], h[0][i], 0, 1), wl, s0); s0 = __builtin_elementwise_fma(__builtin_shufflevector(h[0][i], h[0][i], 2, 3), wh, s0);
                    s1 = __builtin_elementwise_fma(__builtin_shufflevector(h[1][i], h[1][i], 0, 1), wl, s1); s1 = __builtin_elementwise_fma(__builtin_shufflevector(h[1][i], h[1][i], 2, 3), wh, s1); }
                pa[0][e] = s0.x + s0.y; pa[1][e] = s1.x + s1.y;
            }
            asm volatile("" ::: "memory");
        }
        const float a0 = router_fold_softmax(pa[0], lane), a1 = router_fold_softmax(pa[1], lane);
        if ((lane & 3) == 0) {
            AFFT[((size_t)bb[0] * 16 + (lane >> 2)) * LP + pp[0]] = a0;
            if (two) AFFT[((size_t)bb[1] * 16 + (lane >> 2)) * LP + pp[1]] = a1;
        }
    }
    __syncthreads();
}

DEVI int block_sum_i(int v, volatile int* red, int par, int wid, int lane) {
    if (lane == 0) red[par * 8 + wid] = v;
    __syncthreads();
    int s = 0;
#pragma unroll
    for (int w = 0; w < 8; ++w) s += red[par * 8 + w];
    return s;
}
DEVI int wave_incl_scan_i(int v, int lane) {
#pragma unroll
    for (int o = 1; o < 64; o <<= 1) { const int t = __shfl_up(v, o); if (lane >= o) v += t; }
    return v;
}
DEVI void select_unit(char* lds, const Params& P, int b, int e, bool lat) {
    volatile int* red = (volatile int*)lds;
    volatile int* wtot = (volatile int*)(lds + 64);
    const int tid = tid_l(), lane = tid & 63, wid = tid >> 6;
    const int n = lat ? SEQ : CTXL, K = lat ? CAPL : CAPC, p0 = lat ? CTXL : 0;
    const bool act = 8 * tid < n;
    const float* src = (const float*)(ptr_l(P.ws) + WS_AFFT) + ((size_t)b * 16 + e) * LP + p0 + 8 * tid;
    unsigned bits[8];
    if (act) { const u32x4 v0 = *(const u32x4*)src, v1 = *(const u32x4*)(src + 4); bits[0] = v0.x; bits[1] = v0.y; bits[2] = v0.z; bits[3] = v0.w; bits[4] = v1.x; bits[5] = v1.y; bits[6] = v1.z; bits[7] = v1.w; }
    else {
#pragma unroll
        for (int j = 0; j < 8; ++j) bits[j] = 0u;
    }
    unsigned prefix = 0u; int par = 0;
    for (int bit = 30; bit >= 0; --bit) {
        const unsigned cand = prefix | (1u << bit);
        int c = 0;
#pragma unroll
        for (int j = 0; j < 8; ++j) c += (int)__popcll(__ballot(bits[j] >= cand));
        const int tot = block_sum_i(c, red, par, wid, lane); par ^= 1;
        if (tot >= K) prefix = cand;
    }
    int cg = 0, ceq = 0;
#pragma unroll
    for (int j = 0; j < 8; ++j) { cg += (int)__popcll(__ballot(bits[j] > prefix)); ceq += (bits[j] == prefix) ? 1 : 0; }
    const int need = K - block_sum_i(cg, red, par, wid, lane); par ^= 1;
    int inc = wave_incl_scan_i(ceq, lane);
    if (lane == 63) wtot[par * 8 + wid] = inc;
    __syncthreads();
    int eqb = inc - ceq;
    for (int w = 0; w < wid; ++w) eqb += wtot[par * 8 + w];
    par ^= 1;
    bool sel[8]; int ns = 0;
#pragma unroll
    for (int j = 0; j < 8; ++j) { const bool eq = bits[j] == prefix; sel[j] = (bits[j] > prefix) || (eq && eqb < need); eqb += eq ? 1 : 0; ns += sel[j] ? 1 : 0; }
    inc = wave_incl_scan_i(ns, lane);
    if (lane == 63) wtot[par * 8 + wid] = inc;
    __syncthreads();
    int sb = inc - ns;
    for (int w = 0; w < wid; ++w) sb += wtot[par * 8 + w];
    if (act) {
        int* SLOT = (int*)(ptr_l(P.ws) + WS_SLOT); float* GATE = (float*)(ptr_l(P.ws) + WS_GATE); int* IDX = (int*)(ptr_l(P.ws) + WS_IDX);
#pragma unroll
        for (int j = 0; j < 8; ++j) {
            const int tok = b * LP + p0 + 8 * tid + j;
            if (sel[j]) {
                const int row = (lat ? b * CAPL : NB * CAPL + b * CAPC) + sb; ++sb;
                SLOT[(size_t)tok * 16 + e] = row; GATE[(size_t)e * ROWS_E + row] = __builtin_bit_cast(float, bits[j]); IDX[(size_t)e * ROWS_E + row] = tok;
            } else SLOT[(size_t)tok * 16 + e] = -1;
        }
    }
    __syncthreads();
}
DEVI void gather_rows(const Params& P, bool last) {
    const int tid = tid_l(), lane = tid & 63, wid = tid >> 6;
    const bf16_t* HX = (const bf16_t*)(ptr_l(P.ws) + WS_HX); bf16_t* XG = (bf16_t*)(ptr_l(P.ws) + WS_XG); const int* IDX = (const int*)(ptr_l(P.ws) + WS_IDX);
    const int stride = gridDim.x * 8;
    for (int r0 = blockIdx.x * 8 + wid; r0 < 16 * ROWS_E; r0 += 4 * stride) {
        u32x4 v[4][2];
#pragma unroll
        for (int q = 0; q < 4; ++q) { const int r = r0 + q * stride; if (r < 16 * ROWS_E && !(last && (r % ROWS_E) >= NB * CAPL)) { const u32x4* s = (const u32x4*)(HX + (size_t)IDX[r] * 1024); v[q][0] = s[lane]; v[q][1] = s[lane + 64]; } }
#pragma unroll
        for (int q = 0; q < 4; ++q) { const int r = r0 + q * stride; if (r < 16 * ROWS_E && !(last && (r % ROWS_E) >= NB * CAPL)) { u32x4* d = (u32x4*)(XG + (size_t)r * 1024); d[lane] = v[q][0]; d[lane + 64] = v[q][1]; } }
    }
}

DEVI int scan_ci(int d, int k) { return d == 0 ? k : (k < 16 ? 15 - k : 287 - k); }
DEVI void scan_block(char* lds, const Params& P, int l, int unit0) {
    const int tid = tid_l(), lane = tid & 63, wid = tid >> 6, seg = wid & 3, unit = unit0 + (wid >> 2);
    const int d = unit & 1, g = (unit >> 1) & 31, b = unit >> 6;
    const size_t ldg = ((size_t)l * 2 + d) * 32 + g;
    const float dt = expf(P.in[16][ldg]);
    const float lr = P.in[14][ldg * 64 + lane], li = P.in[15][ldg * 64 + lane];
    const float mag = expf(lr * dt * 16.f); float sn, cs; sincosf(li * dt * 16.f, &sn, &cs);
    const float ar = mag * cs, ai = mag * sn;
    const unsigned short* E = (const unsigned short*)(ptr_l(P.ws) + WS_EB) + (size_t)g * NCHP * 256 + d * 128 + lane * 2;
    bf16_t* S = (bf16_t*)(ptr_l(P.ws) + WS_US) + (size_t)g * NCHP * 512 + 256 + d * 128 + lane * 2;
    f32x2* ends = (f32x2*)lds + (size_t)(wid >> 2) * 4 * 64;
    const int k0 = seg * 68;
    float sr = 0.f, si = 0.f;
    for (int kk = 0; kk < 68; kk += 17) {
        unsigned ev[17];
#pragma unroll
        for (int u = 0; u < 17; ++u) ev[u] = *(const unsigned*)(E + (size_t)chunk_row(b, scan_ci(d, k0 + kk + u)) * 256);
#pragma unroll
        for (int u = 0; u < 17; ++u) { const float nr = ar * sr - ai * si + hlo(ev[u]), ni = ar * si + ai * sr + hhi(ev[u]); sr = nr; si = ni; }
    }
    ends[seg * 64 + lane] = (f32x2){sr, si};
    float pr = ar, pi = ai, p4r = 0.f, p4i = 0.f;
#pragma unroll
    for (int q = 0; q < 6; ++q) { const float nr = pr * pr - pi * pi, ni = 2.f * pr * pi; pr = nr; pi = ni; if (q == 1) { p4r = pr; p4i = pi; } }
    const float br = pr * p4r - pi * p4i, bi = pr * p4i + pi * p4r;
    __syncthreads();
    sr = 0.f; si = 0.f;
    for (int j = 0; j < seg; ++j) { const f32x2 e = ends[j * 64 + lane]; const float nr = br * sr - bi * si + e.x, ni = br * si + bi * sr + e.y; sr = nr; si = ni; }
    for (int kk = 0; kk < 68; kk += 17) {
        unsigned ev[17];
#pragma unroll
        for (int u = 0; u < 17; ++u) ev[u] = *(const unsigned*)(E + (size_t)chunk_row(b, scan_ci(d, k0 + kk + u)) * 256);
#pragma unroll
        for (int u = 0; u < 17; ++u) {
            *(unsigned*)(S + (size_t)chunk_row(b, scan_ci(d, k0 + kk + u)) * 512) = pk2(sr, si);
            const float nr = ar * sr - ai * si + hlo(ev[u]), ni = ar * si + ai * sr + hhi(ev[u]); sr = nr; si = ni;
        }
    }
    __syncthreads();
}

DEVI float max3f(float a, float b, float c) { return fmaxf(fmaxf(a, b), c); }
DEVI float xhalf_max(float x) { const unsigned u = __builtin_bit_cast(unsigned, x); const auto r = __builtin_amdgcn_permlane32_swap(u, u, false, false); return fmaxf(__builtin_bit_cast(float, (unsigned)r[0]), __builtin_bit_cast(float, (unsigned)r[1])); }
DEVI float xhalf_sum(float x) { const unsigned u = __builtin_bit_cast(unsigned, x); const auto r = __builtin_amdgcn_permlane32_swap(u, u, false, false); return __builtin_bit_cast(float, (unsigned)r[0]) + __builtin_bit_cast(float, (unsigned)r[1]); }
DEVI void attn_unit(char* lds, const Params& P, int l, int b, int head, int q0  , int nkeys, float lam, float lam_init) {
    const int tid = tid_l(), lane = tid & 63, wid = tid >> 6, qg = wid >> 1, which = wid & 1, r32 = lane & 31, hi = lane >> 5;
    const bf16_t* QK = (const bf16_t*)(ptr_l(P.ws) + WS_QK);
    const bf16_t* Qs = QK + ((size_t)((which * NB + b) * NH + head) * LP) * 64;
    const bf16_t* K1 = QK + ((size_t)((2 * NB + b) * NH + head) * LP) * 64;
    const bf16_t* K2 = QK + ((size_t)((3 * NB + b) * NH + head) * LP) * 64;
    const bf16_t* Vt = (const bf16_t*)(ptr_l(P.ws) + WS_VT) + (size_t)(b * NH + head) * 128 * LP;
    bf16x8 qf[4];
#pragma unroll
    for (int ks = 0; ks < 4; ++ks) qf[ks] = *(const bf16x8*)(Qs + (size_t)(q0 + qg * 32 + r32) * 64 + ks * 16 + hi * 8);
    f32x16 o[4];
#pragma unroll
    for (int t = 0; t < 4; ++t)
#pragma unroll
        for (int i = 0; i < 16; ++i) o[t][i] = 0.f;
    float m = 0.f, lsum = 0.f;
    const int nt = nkeys >> 6;
    const int drow = wid * 8 + (lane >> 3), dkc = (lane & 7) ^ ((drow >> 1) & 7);
    const unsigned koff = (unsigned)(drow * 64 + dkc * 8), voff = (unsigned)(drow * LP + dkc * 8);
    LAS unsigned char* dl = (LAS unsigned char*)lds + wid * 1024;
#define GLDS(g, off) __builtin_amdgcn_global_load_lds((const unsigned*)(g), (LAS unsigned*)(dl + (off)), 16, 0, 0)
#define K_DMA(kt, s) do { GLDS((K1 + (size_t)(kt) * 4096) + koff, (s) * 16384); GLDS((K2 + (size_t)(kt) * 4096) + koff, (s) * 16384 + 8192); } while (0)
#define V_DMA(kt, s) do { GLDS((Vt + (kt) * 64) + voff, 32768 + (s) * 16384); GLDS((Vt + (kt) * 64 + 64 * LP) + voff, 32768 + (s) * 16384 + 8192); } while (0)
#define QKT(dst, s, init) do { const char* _k = lds + (s) * 16384 + which * 8192; \
        _Pragma("unroll") for (int t2 = 0; t2 < 2; ++t2) _Pragma("unroll") for (int i = 0; i < 16; ++i) dst[t2][i] = (init); \
        _Pragma("unroll") for (int ks = 0; ks < 4; ++ks) _Pragma("unroll") for (int t2 = 0; t2 < 2; ++t2) { \
            const bf16x8 kf = *(const bf16x8*)(_k + swz(t2 * 32 + r32, ks * 2 + hi)); dst[t2] = MFMA32(kf, qf[ks], dst[t2]); } } while (0)
    K_DMA(0, 0); V_DMA(0, 0); K_DMA(1, 1);
    __syncthreads();
    f32x16 sc[2], sn[2];
    QKT(sc, 0, 0.f);
    __syncthreads();
    {
        float tm = max3f(sc[0][0], sc[0][1], sc[0][2]);
#pragma unroll
        for (int i = 3; i < 15; i += 2) tm = max3f(tm, sc[0][i], sc[0][i + 1]);
        tm = fmaxf(tm, sc[0][15]);
#pragma unroll
        for (int i = 0; i < 16; i += 2) tm = max3f(tm, sc[1][i], sc[1][i + 1]);
        tm = xhalf_max(tm);
        m = tm;
#pragma unroll
        for (int t2 = 0; t2 < 2; ++t2)
#pragma unroll
            for (int i = 0; i < 16; ++i) sc[t2][i] -= m;
    }
#define SB() __builtin_amdgcn_sched_barrier(0)
#define SGB(mask, n) __builtin_amdgcn_sched_group_barrier(mask, n, 0)
    int fo[4];
#pragma unroll
    for (int j = 0; j < 4; ++j) fo[j] = swz(r32, 2 * j + hi);
    const char* kbase = lds + which * 8192;
    const char* vbase = lds + 32768;
#define ATT_STEP(KT, PAR, SC, SN) do { \
        const bool has1 = (KT) + 1 < nt, has2 = (KT) + 2 < nt; \
        if (has2) K_DMA((KT) + 2, PAR); \
        if (has1) V_DMA((KT) + 1, 1 - (PAR)); \
        const char* kst = kbase + (1 - (PAR)) * 16384; \
        const char* vs = vbase + (PAR) * 16384; \
        bf16x8 kf[8]; \
        _Pragma("unroll") for (int ks = 0; ks < 4; ++ks) _Pragma("unroll") for (int t2 = 0; t2 < 2; ++t2) kf[ks * 2 + t2] = *(const bf16x8*)(kst + fo[ks] + t2 * 4096); \
        SB(); \
        _Pragma("unroll") for (int t2 = 0; t2 < 2; ++t2) _Pragma("unroll") for (int i = 0; i < 16; ++i) SN[t2][i] = -m; \
        _Pragma("unroll") for (int ks = 0; ks < 4; ++ks) _Pragma("unroll") for (int t2 = 0; t2 < 2; ++t2) SN[t2] = MFMA32(kf[ks * 2 + t2], qf[ks], SN[t2]); \
        bf16x8 va[4], vb[4]; \
        _Pragma("unroll") for (int t = 0; t < 4; ++t) va[t] = *(const bf16x8*)(vs + fo[0] + t * 4096); \
        SGB(0x002, 16); SGB(0x008, 8); SGB(0x100, 4); SB(); \
        if (__any(pprev > 4096.f)) {        \
            const float pr = xhalf_sum(pprev); \
            const float dl = pr > 4096.f ? (float)((int)((__builtin_bit_cast(unsigned, pr) >> 23) & 255u) - 127) : 0.f, al = fast_exp2(-dl); \
            m += dl; lsum *= al; \
            _Pragma("unroll") for (int t = 0; t < 4; ++t) _Pragma("unroll") for (int i = 0; i < 16; ++i) o[t][i] *= al; \
            _Pragma("unroll") for (int t2 = 0; t2 < 2; ++t2) _Pragma("unroll") for (int i = 0; i < 16; ++i) { SC[t2][i] -= dl; SN[t2][i] -= dl; } \
        } \
        float ps = 0.f; \
        _Pragma("unroll") for (int t2 = 0; t2 < 2; ++t2) _Pragma("unroll") for (int i = 0; i < 16; ++i) { SC[t2][i] = fast_exp2(SC[t2][i]); ps += SC[t2][i]; } \
        lsum += ps; pprev = ps; \
        bf16x8 pf[4]; \
        _Pragma("unroll") for (int t2 = 0; t2 < 2; ++t2) _Pragma("unroll") for (int sh = 0; sh < 2; ++sh) { \
            u32x4 pw; pw.x = pk2(SC[t2][8 * sh], SC[t2][8 * sh + 1]); pw.y = pk2(SC[t2][8 * sh + 2], SC[t2][8 * sh + 3]); \
            pw.z = pk2(SC[t2][8 * sh + 4], SC[t2][8 * sh + 5]); pw.w = pk2(SC[t2][8 * sh + 6], SC[t2][8 * sh + 7]); \
            pf[t2 * 2 + sh] = __builtin_bit_cast(bf16x8, pw); } \
        SB(); \
        _Pragma("unroll") for (int t = 0; t < 4; ++t) vb[t] = *(const bf16x8*)(vs + fo[1] + t * 4096); \
        _Pragma("unroll") for (int t = 0; t < 4; ++t) o[t] = MFMA32(va[t], pf[0], o[t]); \
        SGB(0x100, 4); SGB(0x008, 4); SB(); \
        _Pragma("unroll") for (int t = 0; t < 4; ++t) va[t] = *(const bf16x8*)(vs + fo[2] + t * 4096); \
        _Pragma("unroll") for (int t = 0; t < 4; ++t) o[t] = MFMA32(vb[t], pf[1], o[t]); \
        SGB(0x100, 4); SGB(0x008, 4); SB(); \
        _Pragma("unroll") for (int t = 0; t < 4; ++t) vb[t] = *(const bf16x8*)(vs + fo[3] + t * 4096); \
        _Pragma("unroll") for (int t = 0; t < 4; ++t) o[t] = MFMA32(va[t], pf[2], o[t]); \
        SGB(0x100, 4); SGB(0x008, 4); SB(); \
        _Pragma("unroll") for (int t = 0; t < 4; ++t) o[t] = MFMA32(vb[t], pf[3], o[t]); \
        SB(); \
        __syncthreads(); \
    } while (0)
    float pprev = 0.f;
    for (int kt = 0; kt < nt; kt += 2) {
        ATT_STEP(kt, 0, sc, sn);
        ATT_STEP(kt + 1, 1, sn, sc);
    }
#undef ATT_STEP
#undef SB
#undef SGB
#undef GLDS
#undef K_DMA
#undef V_DMA
#undef QKT
    lsum = xhalf_sum(lsum);
    const float inv = 1.f / lsum;
    float* xb = (float*)lds + (size_t)qg * 4096;
    if (which == 1) {
#pragma unroll
        for (int t = 0; t < 4; ++t)
#pragma unroll
            for (int i = 0; i < 16; ++i) xb[(t * 16 + i) * 64 + lane] = o[t][i] * inv;
    }
    __syncthreads();
    if (which == 0) {
        float ss = 0.f;
#pragma unroll
        for (int t = 0; t < 4; ++t)
#pragma unroll
            for (int i = 0; i < 16; ++i) { const float v = o[t][i] * inv - lam * xb[(t * 16 + i) * 64 + lane]; o[t][i] = v; ss += v * v; }
        ss = xhalf_sum(ss);
        const float rs = rsqrtf(ss * (1.f / 128.f) + EPS) * (1.f - lam_init);
        const float* sg = P.in[13] + (size_t)l * 128;
        bf16_t* dst = (bf16_t*)(ptr_l(P.ws) + WS_MIX) + ((size_t)b * LP + q0 + qg * 32 + r32) * 1024 + head * 128 + 4 * hi;
#pragma unroll
        for (int t = 0; t < 4; ++t)
#pragma unroll
            for (int i4 = 0; i4 < 4; ++i4) {
                const f32x4 g = *(const f32x4*)(sg + t * 32 + 8 * i4 + 4 * hi);
                u32x2 w; w.x = pk2(o[t][4 * i4] * rs * g.x, o[t][4 * i4 + 1] * rs * g.y); w.y = pk2(o[t][4 * i4 + 2] * rs * g.z, o[t][4 * i4 + 3] * rs * g.w);
                *(u32x2*)(dst + t * 32 + 8 * i4) = w;
            }
    }
    __syncthreads();
}

struct ConvTile { const float* src; bf16_t* dst; int K, N, mode; };
DEVI ConvTile conv_tile(const Params& P, unsigned char* w, int l, int u) {
    if (u < 4096) { const int w3 = u >= 2048; const int v = u & 2047, le = l * 16 + (v >> 7), k = (v >> 3) & 15, n = v & 7;
        return {P.in[w3 ? 27 : 26] + (size_t)le * 1024 * 2048 + (size_t)(k * 64) * 2048 + n * 256, (bf16_t*)(w + WS_W13T) + (size_t)le * 4096 * 1024 + k * 64, 1024, 2048, (n * 256) | ((1 + w3) << 16)}; }
    const int v = u - 4096, le = l * 16 + (v >> 7), k = (v >> 2) & 31, n = v & 3;
    return {P.in[28] + (size_t)le * 2048 * 1024 + (size_t)(k * 64) * 1024 + n * 256, (bf16_t*)(w + WS_W2T) + (size_t)le * 1024 * 2048 + k * 64, 2048, 1024, n * 256};
}
#define CV_LOAD(v, t) do { const unsigned voff_ = (unsigned)((2 * (tid >> 6)) * (t).N + (tid & 63) * 4) * 4u; \
        _Pragma("unroll") for (int i = 0; i < 8; ++i) { const float* sb_ = (t).src + (size_t)((i >> 1) * 16 + (i & 1)) * (t).N; \
        asm volatile("s_nop 4\n\tglobal_load_dwordx4 %0, %1, %2\n\ts_nop 1" : "=&v"(v[i]) : "v"(voff_), "s"(sb_) : "memory"); } } while (0)
#define CV_WAIT(v, N) asm volatile("s_waitcnt vmcnt(" #N ")" : "+v"(v[0]), "+v"(v[1]), "+v"(v[2]), "+v"(v[3]), "+v"(v[4]), "+v"(v[5]), "+v"(v[6]), "+v"(v[7]) :: "memory")
#define CV_STEP(v, t, N, UNEXT) do { \
        unsigned* tile = (unsigned*)lds + par * (32 * 256); par ^= 1; \
        CV_WAIT(v, N); \
        _Pragma("unroll") for (int j = 0; j < 4; ++j) { const int kp = (tid >> 6) + 8 * j; \
            u32x4 wv; wv.x = pk2(v[2 * j].x, v[2 * j + 1].x); wv.y = pk2(v[2 * j].y, v[2 * j + 1].y); wv.z = pk2(v[2 * j].z, v[2 * j + 1].z); wv.w = pk2(v[2 * j].w, v[2 * j + 1].w); \
            *(u32x4*)(tile + kp * 256 + (((tid & 63) * 4) ^ (((kp >> 2) & 7) << 3))) = wv; } \
        const ConvTile cur = t; \
        if ((UNEXT) >= 0) { t = conv_tile(P, w, l, (UNEXT)); CV_LOAD(v, t); } \
        asm volatile("s_waitcnt lgkmcnt(0)\n\ts_barrier" ::: "memory"); \
        const int n0 = cur.mode & 0xffff, mode = cur.mode >> 16; \
        _Pragma("unroll") for (int i = 0; i < 4; ++i) { \
            const int c = tid + 512 * i, n = c >> 3, kq = c & 7; \
            u32x4 o; o.x = tile[(4 * kq) * 256 + (n ^ (kq << 3))]; o.y = tile[(4 * kq + 1) * 256 + (n ^ (kq << 3))]; o.z = tile[(4 * kq + 2) * 256 + (n ^ (kq << 3))]; o.w = tile[(4 * kq + 3) * 256 + (n ^ (kq << 3))]; \
            const int ng = n0 + n; const int orow = mode == 0 ? ng : ((ng >> 7) * 256 + (mode - 1) * 128 + (ng & 127)); \
            const unsigned so_ = (unsigned)(orow * cur.K + 8 * kq) * 2u; \
            asm volatile("s_nop 4\n\tglobal_store_dwordx4 %0, %1, %2\n\ts_nop 1" :: "v"(so_), "v"(o), "s"(cur.dst) : "memory"); \
        } } while (0)
DEVI void conv_share(char* lds, const Params& P, int l, int bid, int G) {
    unsigned char* w = ptr_l(P.ws);
    const int tid = tid_l();
    if (G != 256) {
        for (int u = bid; u < 3 * 2048; u += G) {
            if (u < 4096) { const int w3 = u >= 2048; const int v = u & 2047, le = l * 16 + (v >> 7), k = (v >> 3) & 15, n = v & 7;
                transpose_unit(lds, P.in[w3 ? 27 : 26] + (size_t)le * 1024 * 2048, 1024, 2048, (bf16_t*)(w + WS_W13T) + (size_t)le * 4096 * 1024, k * 64, n * 256, 1 + w3); }
            else { const int v = u - 4096, le = l * 16 + (v >> 7), k = (v >> 2) & 31, n = v & 3;
                transpose_unit(lds, P.in[28] + (size_t)le * 2048 * 1024, 2048, 1024, (bf16_t*)(w + WS_W2T) + (size_t)le * 1024 * 2048, k * 64, n * 256, 0); }
        }
        return;
    }
    f32x4 va[8], vb[8], vc[8];
    ConvTile ta = conv_tile(P, w, l, bid), tb = conv_tile(P, w, l, bid + 256), tc = conv_tile(P, w, l, bid + 512);
    int par = 0;
    CV_LOAD(va, ta); CV_LOAD(vb, tb); CV_LOAD(vc, tc);
    CV_STEP(va, ta, 16, bid + 3 * 256); CV_STEP(vb, tb, 20, bid + 4 * 256); CV_STEP(vc, tc, 24, bid + 5 * 256);
    for (int r = 2; r < 8; ++r) {
        const int u = bid + (3 * r) * 256;
        CV_STEP(va, ta, 28, u); CV_STEP(vb, tb, 28, u + 256); CV_STEP(vc, tc, 28, u + 512);
    }
    CV_STEP(va, ta, 28, -1); CV_STEP(vb, tb, 20, -1); CV_STEP(vc, tc, 12, -1);
    asm volatile("s_waitcnt vmcnt(0)" ::: "memory");
    __syncthreads();
}
#undef CV_LOAD
#undef CV_WAIT
#undef CV_STEP
constexpr int PH_PER_LAYER = 11, PH_LAYER0 = 2, PH_FINAL = PH_LAYER0 + DEPTH * PH_PER_LAYER, N_PHASES = PH_FINAL + 1;

__global__ void __launch_bounds__(512, 2) fwd_kernel(Params P) {
    extern __shared__ __attribute__((aligned(16))) char lds[];
    volatile LAS unsigned* xbw = (volatile LAS unsigned*)(lds + 131072);
    if (threadIdx.x == 0) { xbw[0] = 0u; xbw[1] = 0u; }
    __syncthreads();
    XcdBarrier bar = xcd_barrier_post((unsigned*)(P.ws + WS_CTL), xbw);
    const int G = gridDim.x, bid = blockIdx.x;
    const int vcu = (G % 8 == 0) ? (bid % 8) * (G / 8) + bid / 8 : bid;
    LAS unsigned char* ldsp = (LAS unsigned char*)lds;
    const int lo = P.lo, hi = P.hi;
#ifndef EN_MASK
#define EN_MASK 0xFFFFFFFFu
#endif
#define PHASE(id) if ((id) >= lo && (id) < hi)
#ifndef REP_MASK
#define REP_MASK 0x0u
#endif
#define PHASE_K(k, id) if (((EN_MASK >> (k)) & 1u) && (id) >= lo && (id) < hi) for (int rep_ = 0; rep_ <= (int)((REP_MASK >> (k)) & 1u); ++rep_)
#define SEAM(id) do { if ((id) >= lo && (id) + 1 < hi) xcd_barrier(bar); } while (0)
    unsigned char* ws0 = P.ws;
#define ws ptr_l(ws0)

    PHASE_K(0, 0) {
        constexpr int U_SSM = 256, U_ROPE = 1, U_ADA = 4 * 96;
        constexpr int T_WIN = 4 * 16 * 8, T_WOUT = 4 * 16 * 4, T_WGLU = 4 * 8 * 2, T_W1 = 64 * 16 * 8, T_W2 = 64 * 32 * 4;
        constexpr int U0 = U_SSM + U_ROPE + U_ADA, U1 = U0 + T_WIN, U2 = U1 + T_WOUT, U3 = U2 + T_WGLU, U4 = U3 + T_W1, U5 = U4 + T_W1, U6 = U5 + T_W2;
        constexpr int A0 = U_SSM + U_ROPE;
        const int nq = G == 256 ? 8 : (U3 - bid + G - 1) / G;
        for (int q = 0; q < nq; ++q) {
            int u = bid + q * G;
            if (G == 256) {
                u = -1;
                if (q == 0) u = bid;
                else if (q == 1) u = A0 + bid;
                else if (q == 7) { if (bid == 0) u = U_SSM; }
                else if (bid >= 128) { if (q == 2) u = A0 + 256 + (bid - 128); else if (q <= 4) u = U0 + 576 + (bid - 128) * 2 + (q - 3); }
                else { if (q <= 5) u = U0 + bid * 4 + (q - 2); else if (bid < 64) u = U0 + 512 + bid; }
                if (u < 0) continue;
            }
            if (u < U_SSM) { ssm_tab_unit(lds, P, u >> 6, (u >> 5) & 1, u & 31); }
            else if (u == U_SSM) {
                const int tid = tid_l(), wid = tid >> 6, lane = tid & 63;
                float* rope = (float*)(ws + WS_ROPE);
                for (int i = tid; i < 64 * 16; i += 512) {
                    const int pos = i >> 4, f = i & 15; const float inv = powf(10000.f, -(float)(2 * f) / 32.f);
                    float s, c; sincosf((float)pos * inv, &s, &c); rope[i * 2] = c; rope[i * 2 + 1] = s;
                }
                if (wid < 4) {
                    const float a = P.in[9][wid * 64 + lane] * P.in[10][wid * 64 + lane], c2 = P.in[11][wid * 64 + lane] * P.in[12][wid * 64 + lane];
                    const float s1 = wave_sum(a), s2 = wave_sum(c2);
                    if (lane == 0) ((float*)(ws + WS_LAM))[wid] = expf(s1) - expf(s2) + (0.8f - 0.6f * expf(-0.3f * (float)wid));
                }
            }
            else if (u < U0) { const int v = u - U_SSM - U_ROPE; adaln_unit(lds, P, v / 96, (v % 96) * 64); }
            else if (u < U1) { const int v = u - U0, l = v >> 7, k = (v >> 3) & 15, n = v & 7; transpose_unit(lds, P.in[8] + (size_t)l * 1024 * 2048, 1024, 2048, (bf16_t*)(ws + WS_WINT) + (size_t)l * 2048 * 1024, k * 64, n * 256, 0); }
            else if (u < U2) { const int v = u - U1, l = v >> 6, k = (v >> 2) & 15, n = v & 3; transpose_unit(lds, P.in[24] + (size_t)l * 1024 * 1024, 1024, 1024, (bf16_t*)(ws + WS_WOUTT) + (size_t)l * 1024 * 1024, k * 64, n * 256, 0); }
            else { const int v = u - U2, l = v >> 4, k = (v >> 1) & 7, n = v & 1; transpose_unit(lds, P.in[22] + (size_t)l * 512 * 512, 512, 512, (bf16_t*)(ws + WS_WGLUT) + (size_t)l * 512 * 512, k * 64, n * 256, 0); }
        }
        (void)U4; (void)U5; (void)U6;
    }
    SEAM(0);
    PHASE_K(1, 1) {
        const float* KT = (const float*)(ws + WS_KTAB); const float* PW = (const float*)(ws + WS_PW); const float* BB = (const float*)(ws + WS_BBAR);
        bf16_t* WE = (bf16_t*)(ws + WS_WENDT); bf16_t* B2 = (bf16_t*)(ws + WS_BT2);
        const int tid = tid_l();
        for (int it = bid * 512 + tid; it < 4 * 32 * 256 * 32; it += G * 512) {
            const int k8 = it & 31, n = (it >> 5) & 255, g = (it >> 13) & 31, l = it >> 18;
            const int d = n >> 7, p = (n >> 1) & 63, ri = n & 1, i = k8 >> 1, h0 = (k8 & 1) * 8;
            const int ldg = (l * 2 + d) * 32 + g, e = d == 0 ? 15 - i : i;
            const f32x2 w = *(const f32x2*)(PW + ((size_t)(ldg * 64 + p) * 17 + e) * 2);
            const f32x4* bp = (const f32x4*)(BB + ((size_t)(ldg * 64 + p) * 16 + h0) * 2);
            const f32x4 b0 = bp[0], b1 = bp[1], b2 = bp[2], b3 = bp[3];
            float v[8];
            if (ri == 0) { v[0] = w.x * b0.x - w.y * b0.y; v[1] = w.x * b0.z - w.y * b0.w; v[2] = w.x * b1.x - w.y * b1.y; v[3] = w.x * b1.z - w.y * b1.w;
                           v[4] = w.x * b2.x - w.y * b2.y; v[5] = w.x * b2.z - w.y * b2.w; v[6] = w.x * b3.x - w.y * b3.y; v[7] = w.x * b3.z - w.y * b3.w; }
            else         { v[0] = w.x * b0.y + w.y * b0.x; v[1] = w.x * b0.w + w.y * b0.z; v[2] = w.x * b1.y + w.y * b1.x; v[3] = w.x * b1.w + w.y * b1.z;
                           v[4] = w.x * b2.y + w.y * b2.x; v[5] = w.x * b2.w + w.y * b2.z; v[6] = w.x * b3.y + w.y * b3.x; v[7] = w.x * b3.w + w.y * b3.z; }
            u32x4 o; o.x = pk2(v[0], v[1]); o.y = pk2(v[2], v[3]); o.z = pk2(v[4], v[5]); o.w = pk2(v[6], v[7]);
            *(u32x4*)(WE + (size_t)(it >> 5) * 512 + k8 * 8) = o;
        }
        for (int it = bid * 512 + tid; it < 4 * 32 * 256 * 64; it += G * 512) {
            const int k8 = it & 63, n2 = (it >> 6) & 255, g = (it >> 14) & 31, l = it >> 19;
            const int j = n2 >> 4, h = n2 & 15;
            float v[8];
            if (k8 < 32) {
                const int i = k8 >> 1, h20 = (k8 & 1) * 8;
                f32x4 a0 = {0.f, 0.f, 0.f, 0.f}, a1 = a0;
                if (i <= j) { const f32x4* kp = (const f32x4*)(KT + ((size_t)((l * 2 + 0) * 32 + g) * 16 + (j - i)) * 256 + h * 16 + h20); a0 += kp[0]; a1 += kp[1]; }
                if (i >= j) { const f32x4* kp = (const f32x4*)(KT + ((size_t)((l * 2 + 1) * 32 + g) * 16 + (i - j)) * 256 + h * 16 + h20); a0 += kp[0]; a1 += kp[1]; }
                v[0] = a0.x; v[1] = a0.y; v[2] = a0.z; v[3] = a0.w; v[4] = a1.x; v[5] = a1.y; v[6] = a1.z; v[7] = a1.w;
                if (i == j && (h >> 3) == (k8 & 1)) { const float dd = P.in[21][(size_t)l * 512 + g * 16 + h];
#pragma unroll
                    for (int q = 0; q < 8; ++q) v[q] += (q == (h & 7)) ? dd : 0.f; }
            } else {
                const int n0 = (k8 - 32) * 8, d = n0 >> 7, p0 = (n0 >> 1) & 63;
                const int ldg = (l * 2 + d) * 32 + g, e = d == 0 ? j + 1 : 16 - j;
                const f32x4 cr = *(const f32x4*)(P.in[19] + (size_t)(ldg * 16 + h) * 64 + p0), ci = *(const f32x4*)(P.in[20] + (size_t)(ldg * 16 + h) * 64 + p0);
                const float crv[4] = {cr.x, cr.y, cr.z, cr.w}, civ[4] = {ci.x, ci.y, ci.z, ci.w};
#pragma unroll
                for (int q = 0; q < 4; ++q) {
                    const f32x2 w = *(const f32x2*)(PW + ((size_t)(ldg * 64 + p0 + q) * 17 + e) * 2);
                    v[2 * q] = crv[q] * w.x - civ[q] * w.y; v[2 * q + 1] = -(crv[q] * w.y + civ[q] * w.x);
                }
            }
            u32x4 o; o.x = pk2(v[0], v[1]); o.y = pk2(v[2], v[3]); o.z = pk2(v[4], v[5]); o.w = pk2(v[6], v[7]);
            *(u32x4*)(B2 + (size_t)(it >> 6) * 512 + k8 * 8) = o;
        }
    }
    SEAM(1);

    for (int l = 0; l < DEPTH; ++l) {
        const int ph = PH_LAYER0 + l * PH_PER_LAYER;
        const bool last = l == DEPTH - 1;
        const float* MODl = (const float*)(ws + WS_MOD) + (size_t)l * 9 * 6144;
        PHASE_K(2, ph + 0) { if (l == 0) rowpass1<true>(P, 0); else rowpass1<false>(P, l); }
        SEAM(ph + 0);
        PHASE_K(3, ph + 1) {
            {
                Epi8Inproj ep{(bf16_t*)(ws + WS_QK), (bf16_t*)(ws + WS_VT), (bf16_t*)(ws + WS_US), (const float*)(ws + WS_ROPE)};
                const pg8::Gemm g{(const bf16_t*)(ws + WS_HX), (const bf16_t*)(ws + WS_WINT) + (size_t)l * 2048 * 1024, R, 2048, 1024};
                const TileOrder S{128 * 8, G, vcu, 16, 8, 0, 17, 1};
                pg8::gemm_phase<Epi8Inproj, TileOrder, true, true>(ldsp, g, S, ep);
            }
            for (int u = vcu; u < 16 * 16; u += G) {
                EpiInproj ep{(bf16_t*)(ws + WS_QK), (bf16_t*)(ws + WS_VT), (bf16_t*)(ws + WS_US), (const float*)(ws + WS_ROPE)};
                APlain af{(const bf16_t*)(ws + WS_HX), 1024};
                const int mt = u >> 4, nt = u & 15;
                gemm_unit_dma(lds, af, (const bf16_t*)(ws + WS_WINT) + (size_t)l * 2048 * 1024, 1024, 1024, (mt >> 1) * LP + (mt & 1) * 128, nt * 128, ep);
            }
        }
        SEAM(ph + 1);
        PHASE_K(4, ph + 2) {
            {
                Epi8S1 ep{(unsigned short*)(ws + WS_EB)};
                const pg8::Gemm g{(const bf16_t*)(ws + WS_US), (const bf16_t*)(ws + WS_WENDT) + (size_t)l * 32 * 256 * 512, 32 * NCHP, 32 * 256, 512, nullptr, 0, 4};
                const TileOrder S{32 * 8, G, vcu, 8, 1, 1, 9, 0};
                pg8::gemm_phase<Epi8S1, TileOrder, true, true>(ldsp, g, S, ep);
            }
            for (int u = vcu; u < 64; u += G) {
                const int g = u >> 1, nt = u & 1;
                EpiS1 ep{(unsigned short*)(ws + WS_EB) + (size_t)g * NCHP * 256};
                APlain af{(const bf16_t*)(ws + WS_US) + (size_t)g * NCHP * 512, 512};
                gemm_unit_dma(lds, af, (const bf16_t*)(ws + WS_WENDT) + ((size_t)l * 32 + g) * 256 * 512, 512, 256, 2048, nt * 128, ep);
            }
        }
        SEAM(ph + 2);
        PHASE_K(15, ph + 3) {
            for (int u = bid * 2; u < NB * 32 * 2; u += G * 2) scan_block(lds, P, l, u);
        }
        SEAM(ph + 3);
        PHASE_K(5, ph + 4) {
            const float lam = ((const float*)(ws + WS_LAM))[l], lam_init = 0.8f - 0.6f * expf(-0.3f * (float)l);
            int rnd = 0;
            for (int u = vcu; u < (last ? 1024 : 1024 + 64); u += G, ++rnd) {
                if (rnd == ((bid >> 3) & 3)) conv_share(lds, P, l, bid, G);
                if (u < 1024) { const int qb = u & 31, bh = u >> 5; attn_unit(lds, P, l, bh >> 2, bh & 3, CTXL + qb * 128, LP, lam, lam_init); }
                else { const int v = u - 1024, qb = v & 1, bh = v >> 1; attn_unit(lds, P, l, bh >> 2, bh & 3, qb * 128, CTXL, lam, lam_init); }
            }
        }
        PHASE_K(6, ph + 4) {
            {
                Epi8S2 ep{(bf16_t*)(ws + WS_YG)};
                const pg8::Gemm g{(const bf16_t*)(ws + WS_US), (const bf16_t*)(ws + WS_BT2) + (size_t)l * 32 * 256 * 512, 32 * NCHP, 32 * 256, 512};
                const TileOrder S{32 * 8, G, vcu, 8, 1, 1, 9, 0};
                pg8::gemm_phase<Epi8S2, TileOrder, true, true>(ldsp, g, S, ep);
            }
            if (!last) for (int u = (vcu + G / 2) % G; u < 64; u += G) {
                const int g = u >> 1, nt = u & 1;
                EpiS2 ep{(bf16_t*)(ws + WS_YG), g};
                APlain af{(const bf16_t*)(ws + WS_US) + (size_t)g * NCHP * 512, 512};
                gemm_unit_dma(lds, af, (const bf16_t*)(ws + WS_BT2) + ((size_t)l * 32 + g) * 256 * 512, 512, 512, 2048, nt * 128, ep);
            }
        }
        SEAM(ph + 4);
        PHASE_K(7, ph + 5) {
            {
                Epi8Glu ep{(const bf16_t*)(ws + WS_YG), (bf16_t*)(ws + WS_MIX), P.in[23] + (size_t)l * 512};
                const pg8::Gemm g{(const bf16_t*)(ws + WS_YG), (const bf16_t*)(ws + WS_WGLUT) + (size_t)l * 512 * 512, R, 512, 512};
                const TileOrder S{128 * 2, G, vcu, 16, 2, 0, 17, 1};
                pg8::gemm_phase<Epi8Glu, TileOrder, true, true>(ldsp, g, S, ep);
            }
            if (!last) for (int u = vcu; u < 8 * 4; u += G) {
                EpiGlu ep{(const bf16_t*)(ws + WS_YG), (bf16_t*)(ws + WS_MIX), P.in[23] + (size_t)l * 512};
                APlain af{(const bf16_t*)(ws + WS_YG), 512};
                gemm_unit<256>(lds, af, (const bf16_t*)(ws + WS_WGLUT) + (size_t)l * 512 * 512, 512, 512, (u >> 2) * LP, (u & 3) * 128, ep);
            }
        }
        SEAM(ph + 5);
        PHASE_K(8, ph + 6) {
            {
                Epi8Out ep{(bf16_t*)(ws + WS_X), MODl};
                const pg8::Gemm g{(const bf16_t*)(ws + WS_MIX), (const bf16_t*)(ws + WS_WOUTT) + (size_t)l * 1024 * 1024, R, 1024, 1024};
                const TileOrder S{128 * 4, G, vcu, 16, 4, 0, 17, 1};
                pg8::gemm_phase<Epi8Out, TileOrder, true, true>(ldsp, g, S, ep);
            }
            if (!last) for (int u = vcu; u < 16 * 8; u += G) {
                EpiOut ep{(bf16_t*)(ws + WS_X), MODl};
                APlain af{(const bf16_t*)(ws + WS_MIX), 1024};
                const int mt = u >> 3, nt = u & 7;
                gemm_unit_dma(lds, af, (const bf16_t*)(ws + WS_WOUTT) + (size_t)l * 1024 * 1024, 1024, 1024, (mt >> 1) * LP + (mt & 1) * 128, nt * 128, ep);
            }
        }
        SEAM(ph + 6);
        PHASE_K(9, ph + 7) { rowpass2(lds, P, l); }
        SEAM(ph + 7);
        PHASE_K(10, ph + 8) {
            for (int u = bid; u < (last ? 128 : 256); u += G) select_unit(lds, P, (u & 127) >> 4, u & 15, u < 128);
        }
        SEAM(ph + 8);
        PHASE_K(11, ph + 9) {
            Epi8Moe1 ep{(bf16_t*)(ws + WS_HG)};
            const pg8::Gemm g{(const bf16_t*)(ws + WS_HX), (const bf16_t*)(ws + WS_W13T) + (size_t)l * 16 * 4096 * 1024, 16 * ROWS_E, 16 * 4096, 1024, (const int*)(ws + WS_IDX), 131072 + 64};
            const TileOrder S = last ? TileOrder{16 * 16 * 16, G, vcu, 16, 16, 16, 17, 0, 1} : TileOrder{16 * 17 * 16, G, vcu, 17, 16, 16, 17, 0, 1};
            pg8::gemm_phase<Epi8Moe1, TileOrder, true, true, true>(ldsp, g, S, ep);
        }
        SEAM(ph + 9);
        PHASE_K(12, ph + 10) {
            {
                Epi8Moe2 ep{(bf16_t*)(ws + WS_OG), (const float*)(ws + WS_GATE)};
                const pg8::Gemm g{(const bf16_t*)(ws + WS_HG), (const bf16_t*)(ws + WS_W2T) + (size_t)l * 16 * 1024 * 2048, 16 * ROWS_E, 16 * 1024, 2048};
                const TileOrder S{16 * 16 * 4, G, vcu, 16, 4, 4, 17, 0};
                pg8::gemm_phase<Epi8Moe2, TileOrder, true, true>(ldsp, g, S, ep);
            }
            if (!last) for (int u = vcu; u < 16 * 2 * 8; u += G) {
                const int e = u >> 4, mt = (u >> 3) & 1, nt = u & 7;
                EpiMoe2 ep{(bf16_t*)(ws + WS_OG) + (size_t)e * ROWS_E * 1024, (const float*)(ws + WS_GATE) + (size_t)e * ROWS_E};
                APlain af{(const bf16_t*)(ws + WS_HG) + (size_t)e * ROWS_E * FF, FF};
                gemm_unit_dma(lds, af, (const bf16_t*)(ws + WS_W2T) + ((size_t)l * 16 + e) * 1024 * 2048, 2048, 2048, NB * CAPL + mt * 128, nt * 128, ep);
            }
        }
        SEAM(ph + 10);
    }
    PHASE_K(13, PH_FINAL) { rowpass1<false>(P, DEPTH); }
#undef ws
}

#ifndef MK_MULTI
#define MK_MULTI 0
#endif

extern "C" void kernel_launch(void* const* d_in, const int* in_sizes, int n_in, void* d_out, int out_size, void* d_ws, size_t ws_size, hipStream_t stream) {
    static int grid = 0;
    if (!grid) {
        int dev = 0, cus = 0, per_cu = 0;
        hipGetDevice(&dev);
        hipDeviceGetAttribute(&cus, hipDeviceAttributeMultiprocessorCount, dev);
        hipFuncSetAttribute((const void*)fwd_kernel, hipFuncAttributeMaxDynamicSharedMemorySize, LDS_BYTES);
        hipOccupancyMaxActiveBlocksPerMultiprocessor(&per_cu, fwd_kernel, 512, LDS_BYTES);
        grid = cus * (per_cu < 1 ? per_cu : 1);
        if (grid <= 0) { fprintf(stderr, "occupancy query failed (per_cu=%d cus=%d)\n", per_cu, cus); grid = 256; }
        if (ws_size < WS_END) fprintf(stderr, "workspace too small: %zu < %zu\n", ws_size, (size_t)WS_END);
    }
    Params p{};
    for (int i = 0; i < 30; ++i) p.in[i] = (const float*)d_in[i];
    p.out = (float*)d_out; p.ws = (unsigned char*)d_ws;
    hipMemsetAsync(d_ws, 0, CTL_BYTES, stream);
#if MK_MULTI
    for (int ph = 0; ph < N_PHASES; ++ph) {
        p.lo = ph; p.hi = ph + 1;
        hipLaunchKernelGGL(fwd_kernel, dim3(grid), dim3(512), LDS_BYTES, stream, p);
    }
#else
    p.lo = 0; p.hi = N_PHASES;
    hipLaunchKernelGGL(fwd_kernel, dim3(grid), dim3(512), LDS_BYTES, stream, p);
#endif
}
```
